# Optimizing an MI355X kernel written in HIP

```python
import jax, jax.numpy as jnp
from jax import lax
import numpy as np

D_MODEL = 1024
BATCH = 8
SEQ = 4096
DEPTH = 1

HEAD_DIM = 64
RET_HEADS = 8
SWA_Q_HEADS = 8
SWA_KV_HEADS = 2
SWA_GROUP = SWA_Q_HEADS // SWA_KV_HEADS
RET_WIDTH = RET_HEADS * HEAD_DIM
SWA_Q_WIDTH = SWA_Q_HEADS * HEAD_DIM
SWA_KV_WIDTH = SWA_KV_HEADS * HEAD_DIM
MIX_WIDTH = RET_WIDTH + SWA_Q_WIDTH
IN_SPLITS = (RET_WIDTH, RET_WIDTH, RET_WIDTH, RET_WIDTH, SWA_Q_WIDTH, SWA_KV_WIDTH, SWA_KV_WIDTH)
IN_WIDTH = sum(IN_SPLITS)
RET_CHUNK = 128
ROPE_BASE = 10000.0
WINDOW = 128
SWA_BLOCK = 128
PEER_HEADS = 8
PEER_KEYS = 128
PEER_EXPERTS = PEER_KEYS * PEER_KEYS
PEER_QDIM = 256
PEER_HALF = PEER_QDIM // 2
PEER_TOPK = 16
PEER_TOKEN_BLOCK = 128
PLE_DIM = 256
EPS = 1e-6

kernel_name = "hybrid_retention_swa_peer_block"


def rmsnorm(x, g):
    xf = x.astype(jnp.float32)
    y = xf * lax.rsqrt(jnp.mean(xf * xf, axis=-1, keepdims=True) + EPS)
    return (y * g.astype(jnp.float32)).astype(x.dtype)


def head_layernorm(x):
    xf = x.astype(jnp.float32)
    mu = jnp.mean(xf, axis=-1, keepdims=True)
    xc = xf - mu
    var = jnp.mean(xc * xc, axis=-1, keepdims=True)
    return (xc * lax.rsqrt(var + EPS)).astype(x.dtype)


def rotary(x, pos):
    d = x.shape[-1]
    half = d // 2
    freqs = ROPE_BASE ** (-jnp.arange(half, dtype=jnp.float32) / half)
    ang = pos[:, None] * freqs[None, :]
    c = jnp.cos(ang)[None, :, None, :]
    s = jnp.sin(ang)[None, :, None, :]
    x1, x2 = x[..., :half], x[..., half:]
    out = jnp.concatenate([x1 * c - x2 * s, x1 * s + x2 * c], axis=-1)
    return out.astype(x.dtype)


def retention_chunkwise(q, k, v):
    B, S, H, d = q.shape
    C = RET_CHUNK
    NC = S // C
    gamma = 1.0 - jnp.exp2(-5.0 - jnp.arange(H, dtype=jnp.float32))
    log_g = jnp.log(gamma)
    k = k * (d ** -0.5)
    qc = q.reshape(B, NC, C, H, d)
    kc = k.reshape(B, NC, C, H, d)
    vc = v.reshape(B, NC, C, H, d)
    idx = jnp.arange(C)
    rel = idx[:, None] - idx[None, :]
    dec = jnp.where(rel[None] >= 0,
                    jnp.exp(log_g[:, None, None] * jnp.maximum(rel, 0)[None].astype(jnp.float32)),
                    0.0)
    att = jnp.einsum('bnihd,bnjhd->bnhij', qc, kc) * dec[None, None]
    o_intra = jnp.einsum('bnhij,bnjhe->bnihe', att, vc)
    w_k = jnp.exp(log_g[None, :] * (C - 1 - idx)[:, None].astype(jnp.float32))
    kv = jnp.einsum('bnjhd,jh,bnjhe->bnhde', kc, w_k, vc)
    chunk_decay = jnp.exp(log_g * C)

    def step(state, kv_n):
        return state * chunk_decay[None, :, None, None] + kv_n, state

    init = jnp.zeros((B, H, d, d), dtype=kv.dtype)
    _, prev = lax.scan(step, init, jnp.moveaxis(kv, 1, 0))
    prev = jnp.moveaxis(prev, 0, 1)
    w_q = jnp.exp(log_g[None, :] * (idx + 1)[:, None].astype(jnp.float32))
    o_cross = jnp.einsum('bnihd,bnhde->bnihe', qc, prev) * w_q[None, None, :, :, None]
    return (o_intra + o_cross).reshape(B, S, H, d)


def sliding_window_sink_attention(q, k, v, sinks):
    B, S, Hq, d = q.shape
    L = SWA_BLOCK
    NB = S // L
    qb = q.reshape(B, NB, L, SWA_KV_HEADS, SWA_GROUP, d)
    kb = k.reshape(B, NB, L, SWA_KV_HEADS, d)
    vb = v.reshape(B, NB, L, SWA_KV_HEADS, d)
    pad = ((0, 0), (1, 0), (0, 0), (0, 0), (0, 0))
    kcat = jnp.concatenate([jnp.pad(kb, pad)[:, :-1], kb], axis=2)
    vcat = jnp.concatenate([jnp.pad(vb, pad)[:, :-1], vb], axis=2)
    s = jnp.einsum('bnqhgd,bnkhd->bnhgqk', qb, kcat).astype(jnp.float32) * (d ** -0.5)
    qi = jnp.arange(L)[:, None]
    ki = jnp.arange(2 * L)[None, :]
    rel = qi + L - ki
    band = (rel >= 0) & (rel < WINDOW)
    mask = band[None] & ((jnp.arange(NB) > 0)[:, None, None] | (ki >= L)[None])
    s = jnp.where(mask[None, :, None, None], s, -jnp.inf)
    sink = sinks.astype(jnp.float32).reshape(SWA_KV_HEADS, SWA_GROUP)[None, None, :, :, None, None]
    m = jnp.maximum(jnp.max(s, axis=-1, keepdims=True), sink)
    e = jnp.exp(s - m)
    pr = e / (jnp.sum(e, axis=-1, keepdims=True) + jnp.exp(sink - m))
    o = jnp.einsum('bnhgqk,bnkhd->bnqhgd', pr.astype(v.dtype), vcat)
    return o.reshape(B, S, Hq * d)


def peer_ffn(h, w_query, sub_keys, emb_u, emb_v):
    B, S, D = h.shape
    q = (h @ w_query).reshape(B, S, PEER_HEADS, 2, PEER_HALF)
    sc = jnp.einsum('bshpc,pkc->bshpk', q, sub_keys).astype(jnp.float32)
    top_s, top_i = lax.top_k(sc, PEER_TOPK)
    cand_s = top_s[..., 0, :, None] + top_s[..., 1, None, :]
    cand_i = top_i[..., 0, :, None] * PEER_KEYS + top_i[..., 1, None, :]
    cand_s = cand_s.reshape(B, S, PEER_HEADS, PEER_TOPK * PEER_TOPK)
    cand_i = cand_i.reshape(B, S, PEER_HEADS, PEER_TOPK * PEER_TOPK)
    best_s, pos = lax.top_k(cand_s, PEER_TOPK)
    expert = jnp.take_along_axis(cand_i, pos, axis=-1)
    gate = jax.nn.softmax(best_s, axis=-1).astype(h.dtype)
    T = B * S
    nblk = T // PEER_TOKEN_BLOCK
    hb = h.reshape(nblk, PEER_TOKEN_BLOCK, D)
    eb = expert.reshape(nblk, PEER_TOKEN_BLOCK, PEER_HEADS, PEER_TOPK)
    gb = gate.reshape(nblk, PEER_TOKEN_BLOCK, PEER_HEADS, PEER_TOPK)

    def block(args):
        hx, ex, gx = args
        u = emb_u[ex]
        a = jnp.einsum('td,thkd->thk', hx, u)
        act = jax.nn.gelu(a, approximate=False) * gx
        vv = emb_v[ex]
        return jnp.einsum('thk,thkd->td', act, vv)

    y = lax.map(block, (hb, eb, gb))
    return y.reshape(B, S, D)


def setup_inputs(seed: int = 0) -> dict:
    key = jax.random.key(seed)
    ks = jax.random.split(key, 16)
    f32 = jnp.float32
    nrm = lambda k, shape, scale: jax.random.normal(k, shape, f32) * scale
    return {
        "x": nrm(ks[0], (BATCH, SEQ, D_MODEL), 1.0),
        "p": nrm(ks[1], (DEPTH, BATCH, SEQ, PLE_DIM), 1.0),
        "g_mix": 1.0 + nrm(ks[2], (DEPTH, D_MODEL), 0.02),
        "w_in": nrm(ks[3], (DEPTH, D_MODEL, IN_WIDTH), D_MODEL ** -0.5),
        "q_norm": 1.0 + nrm(ks[4], (DEPTH, HEAD_DIM), 0.02),
        "k_norm": 1.0 + nrm(ks[5], (DEPTH, HEAD_DIM), 0.02),
        "sinks": nrm(ks[6], (DEPTH, SWA_Q_HEADS), 0.5),
        "w_out": nrm(ks[7], (DEPTH, MIX_WIDTH, D_MODEL), MIX_WIDTH ** -0.5),
        "g_ffn": 1.0 + nrm(ks[8], (DEPTH, D_MODEL), 0.02),
        "peer_w_query": nrm(ks[9], (DEPTH, D_MODEL, PEER_HEADS * PEER_QDIM), D_MODEL ** -0.5),
        "peer_sub_keys": nrm(ks[10], (DEPTH, 2, PEER_KEYS, PEER_HALF), PEER_HALF ** -0.5),
        "peer_u": nrm(ks[11], (DEPTH, PEER_EXPERTS, D_MODEL), D_MODEL ** -0.5),
        "peer_v": nrm(ks[12], (DEPTH, PEER_EXPERTS, D_MODEL), 0.3),
        "g_ple": 1.0 + nrm(ks[13], (DEPTH, D_MODEL), 0.02),
        "w_ple_gate": nrm(ks[14], (DEPTH, D_MODEL, D_MODEL), D_MODEL ** -0.5),
        "w_ple_proj": nrm(ks[15], (DEPTH, PLE_DIM, D_MODEL), PLE_DIM ** -0.5),
    }


def reference(x, p, g_mix, w_in, q_norm, k_norm, sinks, w_out, g_ffn,
              peer_w_query, peer_sub_keys, peer_u, peer_v, g_ple, w_ple_gate, w_ple_proj):
    B, S, _ = x.shape
    pos = jnp.arange(S, dtype=jnp.float32)
    split_pts = list(np.cumsum(IN_SPLITS)[:-1])
    for i in range(DEPTH):
        h = rmsnorm(x, g_mix[i])
        proj = h @ w_in[i]
        rq, rk, rv, rg, sq, sk, sv = jnp.split(proj, split_pts, axis=-1)
        rq = rotary(rq.reshape(B, S, RET_HEADS, HEAD_DIM), pos)
        rk = rotary(rk.reshape(B, S, RET_HEADS, HEAD_DIM), pos)
        rv = rv.reshape(B, S, RET_HEADS, HEAD_DIM)
        ro = head_layernorm(retention_chunkwise(rq, rk, rv)).reshape(B, S, RET_WIDTH)
        ro = jax.nn.silu(rg) * ro.astype(rg.dtype)
        sq = rmsnorm(sq.reshape(B, S, SWA_Q_HEADS, HEAD_DIM), q_norm[i])
        sk = rmsnorm(sk.reshape(B, S, SWA_KV_HEADS, HEAD_DIM), k_norm[i])
        sv = sv.reshape(B, S, SWA_KV_HEADS, HEAD_DIM)
        so = sliding_window_sink_attention(sq, sk, sv, sinks[i])
        mixed = jnp.concatenate([ro, so.astype(ro.dtype)], axis=-1)
        x = x + mixed @ w_out[i]
        h = rmsnorm(x, g_ffn[i])
        x = x + peer_ffn(h, peer_w_query[i], peer_sub_keys[i], peer_u[i], peer_v[i]).astype(x.dtype)
        gate = jax.nn.sigmoid(rmsnorm(x, g_ple[i]) @ w_ple_gate[i])
        x = x + gate * (p[i] @ w_ple_proj[i])
    return x
```

```cpp
#include <hip/hip_runtime.h>
#include <cstdio>
#include <cstdint>

#define SEQ 4096
#define NB 8
#define DM 1024
#define INW 2816
#define EPSF 1e-6f

__device__ __forceinline__ float wave_sum(float v) {
#pragma unroll
    for (int o = 1; o < 64; o <<= 1) v += __shfl_xor(v, o);
    return v;
}

__global__ __launch_bounds__(256) void k_rmsnorm(const float* __restrict__ x, const float* __restrict__ g, float* __restrict__ y, int rows) {
    const int wave = threadIdx.x >> 6, lane = threadIdx.x & 63;
    const int row = blockIdx.x * 4 + wave;
    if (row >= rows) return;
    const float4* xr = (const float4*)(x + (size_t)row * DM);
    const float4* gr = (const float4*)g;
    float4 v[4]; float ss = 0.f;
#pragma unroll
    for (int j = 0; j < 4; ++j) { v[j] = xr[lane + 64 * j]; ss += v[j].x * v[j].x + v[j].y * v[j].y + v[j].z * v[j].z + v[j].w * v[j].w; }
    ss = wave_sum(ss);
    const float r = 1.0f / sqrtf(ss * (1.0f / DM) + EPSF);
    float4* yr = (float4*)(y + (size_t)row * DM);
#pragma unroll
    for (int j = 0; j < 4; ++j) { const float4 gg = gr[lane + 64 * j]; float4 o; o.x = v[j].x * r * gg.x; o.y = v[j].y * r * gg.y; o.z = v[j].z * r * gg.z; o.w = v[j].w * r * gg.w; yr[lane + 64 * j] = o; }
}

__global__ __launch_bounds__(256) void k_gemm(const float* __restrict__ A, int lda, const float* __restrict__ B, int ldb, float* __restrict__ C, int ldc,
                                              const float* __restrict__ R, int ldr, int K) {
    __shared__ float As[16][68];
    __shared__ float Bs[16][68];
    const int tid = threadIdx.x, tx = tid & 15, ty = tid >> 4;
    const int m0 = blockIdx.y * 64, n0 = blockIdx.x * 64;
    float acc[4][4];
#pragma unroll
    for (int i = 0; i < 4; ++i)
#pragma unroll
        for (int j = 0; j < 4; ++j) acc[i][j] = 0.f;
    for (int k0 = 0; k0 < K; k0 += 16) {
        { const int m = tid >> 2, kk = (tid & 3) * 4; const float4 a = *(const float4*)(A + (size_t)(m0 + m) * lda + k0 + kk);
          As[kk + 0][m] = a.x; As[kk + 1][m] = a.y; As[kk + 2][m] = a.z; As[kk + 3][m] = a.w; }
        { const int kk = tid >> 4, n = (tid & 15) * 4; const float4 b = *(const float4*)(B + (size_t)(k0 + kk) * ldb + n0 + n);
          *(float4*)&Bs[kk][n] = b; }
        __syncthreads();
#pragma unroll
        for (int k = 0; k < 16; ++k) {
            const float4 a = *(const float4*)&As[k][ty * 4];
            const float4 b = *(const float4*)&Bs[k][tx * 4];
            const float av[4] = {a.x, a.y, a.z, a.w}, bv[4] = {b.x, b.y, b.z, b.w};
#pragma unroll
            for (int i = 0; i < 4; ++i)
#pragma unroll
                for (int j = 0; j < 4; ++j) acc[i][j] += av[i] * bv[j];
        }
        __syncthreads();
    }
#pragma unroll
    for (int i = 0; i < 4; ++i) {
        const int m = m0 + ty * 4 + i, n = n0 + tx * 4;
        float4 o = make_float4(acc[i][0], acc[i][1], acc[i][2], acc[i][3]);
        if (R) { const float4 r = *(const float4*)(R + (size_t)m * ldr + n); o.x += r.x; o.y += r.y; o.z += r.z; o.w += r.w; }
        *(float4*)(C + (size_t)m * ldc + n) = o;
    }
}

__global__ __launch_bounds__(256) void k_retention(const float* __restrict__ proj, float* __restrict__ mixed) {
    extern __shared__ float smem[];
    float* Ks = smem; float* Vs = smem + 128 * 64; float* St = smem + 2 * 128 * 64; float* Qs = St + 64 * 64;
    const int h = blockIdx.x, tid = threadIdx.x;
    const float gamma = 1.0f - exp2f(-5.0f - (float)h);
    const float lg = logf(gamma);
    for (int i = tid; i < 64 * 64; i += 256) St[i] = 0.f;
    const int row = tid >> 1, e0 = (tid & 1) * 32;
    for (int n = 0; n < 32; ++n) {
        __syncthreads();
        for (int idx = tid; idx < 128 * 32; idx += 256) {
            const int j = idx >> 5, c = idx & 31; const int pos = n * 128 + j;
            const float* pr = proj + (size_t)pos * INW;
            const float x1 = pr[512 + h * 64 + c], x2 = pr[512 + h * 64 + c + 32];
            const float freq = powf(10000.0f, -(float)c / 32.0f);
            const float ang = (float)pos * freq;
            float sn, cs; sincosf(ang, &sn, &cs);
            Ks[j * 64 + c] = (x1 * cs - x2 * sn) * 0.125f; Ks[j * 64 + c + 32] = (x1 * sn + x2 * cs) * 0.125f;
            Vs[j * 64 + c] = pr[1024 + h * 64 + c]; Vs[j * 64 + c + 32] = pr[1024 + h * 64 + c + 32];
            const float y1 = pr[h * 64 + c], y2 = pr[h * 64 + c + 32];
            Qs[j * 65 + c] = y1 * cs - y2 * sn; Qs[j * 65 + c + 32] = y1 * sn + y2 * cs;
        }
        __syncthreads();
        const float* q = Qs + row * 65;
        float acc[32];
#pragma unroll
        for (int e = 0; e < 32; ++e) acc[e] = 0.f;
        for (int j = 0; j <= row; ++j) {
            float s = 0.f;
#pragma unroll 8
            for (int d = 0; d < 64; ++d) s += q[d] * Ks[j * 64 + d];
            s *= expf(lg * (float)(row - j));
#pragma unroll
            for (int e = 0; e < 32; ++e) acc[e] += s * Vs[j * 64 + e0 + e];
        }
        {
            const float wq = expf(lg * (float)(row + 1));
#pragma unroll 1
            for (int d = 0; d < 64; ++d) { const float qd = q[d] * wq;
#pragma unroll
                for (int e = 0; e < 32; ++e) acc[e] += qd * St[d * 64 + e0 + e]; }
        }
        float s1 = 0.f;
#pragma unroll
        for (int e = 0; e < 32; ++e) s1 += acc[e];
        s1 += __shfl_xor(s1, 1);
        const float mu = s1 * (1.0f / 64.0f);
        float s2 = 0.f;
#pragma unroll
        for (int e = 0; e < 32; ++e) { const float dd = acc[e] - mu; s2 += dd * dd; }
        s2 += __shfl_xor(s2, 1);
        const float rs = 1.0f / sqrtf(s2 * (1.0f / 64.0f) + EPSF);
        {
            const int pos = n * 128 + row; const float* gp = proj + (size_t)pos * INW + 1536 + h * 64 + e0; float* op = mixed + (size_t)pos * DM + h * 64 + e0;
#pragma unroll
            for (int e = 0; e < 32; ++e) { const float g = gp[e]; const float sg = g / (1.0f + expf(-g)); op[e] = sg * ((acc[e] - mu) * rs); }
        }
        __syncthreads();
        const float cd = expf(lg * 128.0f);
        for (int m = 0; m < 16; ++m) {
            const int idx = tid + 256 * m, d = idx >> 6, e = idx & 63;
            float a = 0.f;
            for (int j = 0; j < 128; ++j) a += expf(lg * (float)(127 - j)) * Ks[j * 64 + d] * Vs[j * 64 + e];
            St[idx] = St[idx] * cd + a;
        }
    }
}

__global__ __launch_bounds__(128) void k_swa(const float* __restrict__ proj, const float* __restrict__ qn, const float* __restrict__ kn, const float* __restrict__ sinks, float* __restrict__ mixed) {
    extern __shared__ float smem[];
    float* Kn = smem; float* Vv = smem + 256 * 65;
    const int n = blockIdx.x, hq = blockIdx.y, kvh = hq >> 2, tid = threadIdx.x;
    for (int r = tid; r < 256; r += 128) {
        const int pos = (n - 1) * 128 + r;
        if (pos >= 0) {
            const float* kr = proj + (size_t)pos * INW + 2560 + kvh * 64; const float* vr = proj + (size_t)pos * INW + 2688 + kvh * 64;
            float ss = 0.f;
            for (int c = 0; c < 64; ++c) { const float v = kr[c]; ss += v * v; }
            const float rr = 1.0f / sqrtf(ss * (1.0f / 64.0f) + EPSF);
            for (int c = 0; c < 64; ++c) { Kn[r * 65 + c] = kr[c] * rr * kn[c]; Vv[r * 65 + c] = vr[c]; }
        } else {
            for (int c = 0; c < 64; ++c) { Kn[r * 65 + c] = 0.f; Vv[r * 65 + c] = 0.f; }
        }
    }
    float q[64];
    const int qpos = n * 128 + tid;
    {
        const float* qr = proj + (size_t)qpos * INW + 2048 + hq * 64; float ss = 0.f;
#pragma unroll
        for (int c = 0; c < 64; ++c) { q[c] = qr[c]; ss += q[c] * q[c]; }
        const float rr = 1.0f / sqrtf(ss * (1.0f / 64.0f) + EPSF);
#pragma unroll
        for (int c = 0; c < 64; ++c) q[c] = q[c] * rr * qn[c];
    }
    __syncthreads();
    const float sink = sinks[hq];
    float m = sink, l = 1.0f; float acc[64];
#pragma unroll
    for (int c = 0; c < 64; ++c) acc[c] = 0.f;
    for (int ki = tid + 1; ki <= tid + 128; ++ki) {
        if (n == 0 && ki < 128) continue;
        float s = 0.f;
#pragma unroll
        for (int c = 0; c < 64; ++c) s += q[c] * Kn[ki * 65 + c];
        s *= 0.125f;
        const float mn = fmaxf(m, s), sc = expf(m - mn), pe = expf(s - mn);
        l = l * sc + pe;
#pragma unroll
        for (int c = 0; c < 64; ++c) acc[c] = acc[c] * sc + pe * Vv[ki * 65 + c];
        m = mn;
    }
    const float inv = 1.0f / l;
    float* op = mixed + (size_t)qpos * DM + 512 + hq * 64;
#pragma unroll
    for (int c = 0; c < 64; ++c) op[c] = acc[c] * inv;
}

__global__ __launch_bounds__(256) void k_peer_topk(const float* __restrict__ q, const float* __restrict__ keys, int* __restrict__ eidx, float* __restrict__ egate) {
    __shared__ float sc[2048];
    __shared__ float qs[2048];
    __shared__ float ts[8][2][16]; __shared__ int ti[8][2][16];
    const int t = blockIdx.x, tid = threadIdx.x, wave = tid >> 6, lane = tid & 63;
    for (int i = tid; i < 2048; i += 256) qs[i] = q[(size_t)t * 2048 + i];
    __syncthreads();
    for (int i = tid; i < 2048; i += 256) {
        const int h = i >> 8, p = (i >> 7) & 1, k = i & 127;
        const float* kr = keys + ((size_t)p * 128 + k) * 128; const float* qq = qs + h * 256 + p * 128;
        float s = 0.f;
        for (int c = 0; c < 128; ++c) s += qq[c] * kr[c];
        sc[i] = s;
    }
    __syncthreads();
    for (int li = wave * 4; li < wave * 4 + 4; ++li) {
        float v0 = sc[li * 128 + lane], v1 = sc[li * 128 + 64 + lane];
        for (int r = 0; r < 16; ++r) {
            float bv; int bi;
            if (v0 >= v1) { bv = v0; bi = lane; } else { bv = v1; bi = lane + 64; }
#pragma unroll
            for (int o = 1; o < 64; o <<= 1) {
                const float ov = __shfl_xor(bv, o); const int oi = __shfl_xor(bi, o);
                if (ov > bv || (ov == bv && oi < bi)) { bv = ov; bi = oi; }
            }
            if (lane == 0) { ts[li >> 1][li & 1][r] = bv; ti[li >> 1][li & 1][r] = bi; }
            if (bi == lane) v0 = -INFINITY; if (bi == lane + 64) v1 = -INFINITY;
        }
    }
    __syncthreads();
    for (int h = wave * 2; h < wave * 2 + 2; ++h) {
        float cv[4]; int ci[4];
#pragma unroll
        for (int u = 0; u < 4; ++u) { const int f = lane * 4 + u, i = f >> 4, j = f & 15; cv[u] = ts[h][0][i] + ts[h][1][j]; ci[u] = f; }
        float bs[16]; int be[16];
#pragma unroll
        for (int r = 0; r < 16; ++r) {
            float bv = cv[0]; int bi = ci[0];
#pragma unroll
            for (int u = 1; u < 4; ++u) if (cv[u] > bv) { bv = cv[u]; bi = ci[u]; }
#pragma unroll
            for (int o = 1; o < 64; o <<= 1) {
                const float ov = __shfl_xor(bv, o); const int oi = __shfl_xor(bi, o);
                if (ov > bv || (ov == bv && oi < bi)) { bv = ov; bi = oi; }
            }
            bs[r] = bv; be[r] = bi;
#pragma unroll
            for (int u = 0; u < 4; ++u) if (ci[u] == bi) cv[u] = -INFINITY;
        }
        float e[16], sum = 0.f;
#pragma unroll
        for (int r = 0; r < 16; ++r) { e[r] = expf(bs[r] - bs[0]); sum += e[r]; }
        if (lane < 16) {
            float myg = 0.f; int myf = 0;
#pragma unroll
            for (int r = 0; r < 16; ++r) if (lane == r) { myg = e[r] / sum; myf = be[r]; }
            const int i = myf >> 4, j = myf & 15;
            eidx[(size_t)t * 128 + h * 16 + lane] = ti[h][0][i] * 128 + ti[h][1][j];
            egate[(size_t)t * 128 + h * 16 + lane] = myg;
        }
    }
}

__global__ __launch_bounds__(256) void k_peer_gather(const float* __restrict__ h, const int* __restrict__ eidx, const float* __restrict__ egate,
                                                     const float* __restrict__ U, const float* __restrict__ V, float* __restrict__ x1) {
    __shared__ float act[128]; __shared__ int ee[128];
    const int t = blockIdx.x, tid = threadIdx.x, wave = tid >> 6, lane = tid & 63;
    if (tid < 128) ee[tid] = eidx[(size_t)t * 128 + tid];
    float4 hv[4];
    const float4* hr = (const float4*)(h + (size_t)t * DM);
#pragma unroll
    for (int j = 0; j < 4; ++j) hv[j] = hr[lane + 64 * j];
    __syncthreads();
    for (int k = wave * 32; k < wave * 32 + 32; ++k) {
        const float4* ur = (const float4*)(U + (size_t)ee[k] * DM);
        float s = 0.f;
#pragma unroll
        for (int j = 0; j < 4; ++j) { const float4 u = ur[lane + 64 * j]; s += u.x * hv[j].x + u.y * hv[j].y + u.z * hv[j].z + u.w * hv[j].w; }
        s = wave_sum(s);
        if (lane == 0) { const float g = 0.5f * s * (1.0f + erff(s * 0.70710678118654752f)); act[k] = g * egate[(size_t)t * 128 + k]; }
    }
    __syncthreads();
    float4 y = make_float4(0.f, 0.f, 0.f, 0.f);
    for (int k = 0; k < 128; ++k) {
        const float a = act[k]; const float4 v = ((const float4*)(V + (size_t)ee[k] * DM))[tid];
        y.x += a * v.x; y.y += a * v.y; y.z += a * v.z; y.w += a * v.w;
    }
    float4* xr = (float4*)(x1 + (size_t)t * DM) + tid;
    float4 o = *xr; o.x += y.x; o.y += y.y; o.z += y.z; o.w += y.w; *xr = o;
}

__global__ __launch_bounds__(256) void k_ple_final(float* __restrict__ x2, const float* __restrict__ gp, const float* __restrict__ pp, size_t n4) {
    const size_t i = (size_t)blockIdx.x * 256 + threadIdx.x; if (i >= n4) return;
    float4 x = ((float4*)x2)[i]; const float4 g = ((const float4*)gp)[i], p = ((const float4*)pp)[i];
    x.x += p.x / (1.0f + expf(-g.x)); x.y += p.y / (1.0f + expf(-g.y)); x.z += p.z / (1.0f + expf(-g.z)); x.w += p.w / (1.0f + expf(-g.w));
    ((float4*)x2)[i] = x;
}

extern "C" void kernel_launch(void* const* d_in, const int* in_sizes, int n_in, void* d_out, int out_size, void* d_ws, size_t ws_size, hipStream_t stream) {
    const float* x = (const float*)d_in[0]; const float* p = (const float*)d_in[1]; const float* g_mix = (const float*)d_in[2]; const float* w_in = (const float*)d_in[3];
    const float* q_norm = (const float*)d_in[4]; const float* k_norm = (const float*)d_in[5]; const float* sinks = (const float*)d_in[6]; const float* w_out = (const float*)d_in[7];
    const float* g_ffn = (const float*)d_in[8]; const float* w_query = (const float*)d_in[9]; const float* sub_keys = (const float*)d_in[10]; const float* peer_u = (const float*)d_in[11];
    const float* peer_v = (const float*)d_in[12]; const float* g_ple = (const float*)d_in[13]; const float* w_gate = (const float*)d_in[14]; const float* w_proj = (const float*)d_in[15];
    float* out = (float*)d_out;
    float* ws = (float*)d_ws;
    float* hbuf = ws;
    float* proj = hbuf + (size_t)SEQ * DM;
    float* mixed = proj + (size_t)SEQ * INW;
    float* qb = mixed + (size_t)SEQ * DM;
    float* gp = qb + (size_t)SEQ * 2048;
    float* pp = gp + (size_t)SEQ * DM;
    float* egate = pp + (size_t)SEQ * DM;
    int* eidx = (int*)(egate + (size_t)SEQ * 128);
    static bool attr_set = false;
    if (!attr_set) {
        hipFuncSetAttribute((const void*)k_retention, hipFuncAttributeMaxDynamicSharedMemorySize, (2 * 128 * 64 + 64 * 64 + 128 * 65) * 4);
        hipFuncSetAttribute((const void*)k_swa, hipFuncAttributeMaxDynamicSharedMemorySize, 2 * 256 * 65 * 4);
        attr_set = true;
    }
    for (int b = 0; b < NB; ++b) {
        const float* xb = x + (size_t)b * SEQ * DM; float* ob = out + (size_t)b * SEQ * DM; const float* pb = p + (size_t)b * SEQ * 256;
        k_rmsnorm<<<SEQ / 4, 256, 0, stream>>>(xb, g_mix, hbuf, SEQ);
        k_gemm<<<dim3(INW / 64, SEQ / 64), 256, 0, stream>>>(hbuf, DM, w_in, INW, proj, INW, nullptr, 0, DM);
        k_retention<<<8, 256, (2 * 128 * 64 + 64 * 64 + 128 * 65) * 4, stream>>>(proj, mixed);
        k_swa<<<dim3(32, 8), 128, 2 * 256 * 65 * 4, stream>>>(proj, q_norm, k_norm, sinks, mixed);
        k_gemm<<<dim3(DM / 64, SEQ / 64), 256, 0, stream>>>(mixed, DM, w_out, DM, ob, DM, xb, DM, DM);
        k_rmsnorm<<<SEQ / 4, 256, 0, stream>>>(ob, g_ffn, hbuf, SEQ);
        k_gemm<<<dim3(2048 / 64, SEQ / 64), 256, 0, stream>>>(hbuf, DM, w_query, 2048, qb, 2048, nullptr, 0, DM);
        k_peer_topk<<<SEQ, 256, 0, stream>>>(qb, sub_keys, eidx, egate);
        k_peer_gather<<<SEQ, 256, 0, stream>>>(hbuf, eidx, egate, peer_u, peer_v, ob);
        k_rmsnorm<<<SEQ / 4, 256, 0, stream>>>(ob, g_ple, hbuf, SEQ);
        k_gemm<<<dim3(DM / 64, SEQ / 64), 256, 0, stream>>>(hbuf, DM, w_gate, DM, gp, DM, nullptr, 0, DM);
        k_gemm<<<dim3(DM / 64, SEQ / 64), 256, 0, stream>>>(pb, 256, w_proj, DM, pp, DM, nullptr, 0, 256);
        k_ple_final<<<(SEQ * DM / 4 + 255) / 256, 256, 0, stream>>>(ob, gp, pp, (size_t)SEQ * DM / 4);
    }
}
```

```cpp
#include <hip/hip_runtime.h>
#include <cstdio>
#include <cstdint>
#define LAS __attribute__((address_space(3)))
#define GAS __attribute__((address_space(1)))
namespace pg8 {
#define PG8_LAS __attribute__((address_space(3)))
typedef unsigned short bf16_t;
typedef short bf16x8 __attribute__((ext_vector_type(8)));
typedef float f32x4 __attribute__((ext_vector_type(4)));
typedef unsigned u32x4 __attribute__((ext_vector_type(4)));
constexpr int BM = 256, BK = 64, HALF = 128, HTB = HALF * BK * 2  , STAGE_BYTES = 8 * HTB, NXCD = 8, WGM = 8;

__host__ __device__ __forceinline__ int lds_byte(int r, int c) { const int st = (r >> 4) * 2 + (c >> 5), rr = r & 15, cc = c & 31, ob = rr * 64 + cc * 2; return st * 1024 + (ob ^ (((ob >> 9) & 1) << 5)); }
__host__ __device__ __forceinline__ void stage_rc(int b, int& R, int& C) { const int st = b / 1024, sb = b % 1024, swz = sb ^ (((sb >> 9) & 1) << 5); R = (st >> 1) * 16 + swz / 64; C = (st & 1) * 32 + (swz % 64) / 2; }
__host__ __device__ __forceinline__ int perm32(int rho) { const int n = rho >> 4, i = rho & 15; return 8 * (i >> 2) + 4 * n + (i & 3); }

struct Unit { int pm, pn; };
struct Gemm { const bf16_t* A; const bf16_t* Bt; int M, N, K; };

struct StaticOrder {
    int nM, nN, nwg, G, c;
    __host__ __device__ void init(int M, int N, int G_, int c_) { nM = M / BM; nN = N / BM; nwg = nM * nN; G = G_; c = c_; }
    __host__ __device__ bool next(int i, Unit& u) const {
        const long L = (long)i * G + c; if (L >= nwg) return false;
        int wgid = (int)L; { const int q = nwg / NXCD, r = nwg % NXCD, xcd = wgid % NXCD, off = wgid / NXCD; wgid = (xcd < r ? xcd * (q + 1) : r * (q + 1) + (xcd - r) * q) + off; }
        const int nig = WGM * nN, gid = wgid / nig, fm = gid * WGM, gsz = (nM - fm) < WGM ? (nM - fm) : WGM;
        u.pm = fm + ((wgid % nig) % gsz); u.pn = (wgid % nig) / gsz; return true;
    }
    __device__ __forceinline__ void a_ready(const Unit&) const {}
    __device__ __forceinline__ void done(const Unit&) const {}
};
__device__ __forceinline__ unsigned cvt_pk_bf16(float lo, float hi) { unsigned r; asm volatile("v_cvt_pk_bf16_f32 %0, %1, %2" : "=v"(r) : "v"(lo), "v"(hi)); return r; }
template <class Epi, class Sched, bool ALIGN_EPI = false, bool SP2 = false>
__device__ __forceinline__ void gemm_phase(PG8_LAS unsigned char* lds, const Gemm g, const Sched& S, const Epi& E) {
    const int tid = threadIdx.x, wid = __builtin_amdgcn_readfirstlane(tid >> 6), lane = tid & 63, wr = wid >> 2, wc = wid & 3, fr = lane & 15, fq = lane >> 4;
    const int K = g.K, nt = K / BK;
    unsigned voffA[2], voffB[2];
#pragma unroll
    for (int i = 0; i < 2; ++i) { int R, C; stage_rc(tid * 16 + i * 8192, R, C); const int Rb = Epi::PERM ? ((R & ~31) + perm32(R & 31)) : R;
        voffA[i] = (unsigned)(R * K + C) * 2u; voffB[i] = (unsigned)(Rb * K + C) * 2u; }
    const size_t kstep = (size_t)(BK * 2);
    const size_t hstep = (size_t)HALF * K * 2;
    const size_t tstep = 2 * hstep;
    const unsigned ldsw = (unsigned)wid * 1024u;
    const int aoff = lds_byte(wr * 64 + fr, fq * 8), boff = lds_byte(wc * 32 + fr, fq * 8);
#define PG8_SA(b, h) (((b) * 2 + (h)) * HTB)
#define PG8_SB(b, h) ((4 + (b) * 2 + (h)) * HTB)
#define PG8_STAGE(bufoff, gbase, voff) do { _Pragma("unroll") for (int _i = 0; _i < 2; ++_i) \
        __builtin_amdgcn_global_load_lds((const unsigned*)((const char*)(gbase) + (voff)[_i]), (PG8_LAS unsigned*)(lds + (bufoff) + ldsw + _i * 8192), 16, 0, 0); } while (0)
#define PG8_LDA(dst, b, h) do { _Pragma("unroll") for (int m = 0; m < 4; ++m) _Pragma("unroll") for (int k = 0; k < 2; ++k) dst[m][k] = *(const PG8_LAS bf16x8*)(lds + PG8_SA(b, h) + aoff + m * 2048 + k * 1024); } while (0)
#define PG8_LDB(dst, b, h) do { _Pragma("unroll") for (int n = 0; n < 2; ++n) _Pragma("unroll") for (int k = 0; k < 2; ++k) dst[n][k] = *(const PG8_LAS bf16x8*)(lds + PG8_SB(b, h) + boff + n * 2048 + k * 1024); } while (0)
#define PG8_MMA(ai, bj, At, Bt) do { __builtin_amdgcn_s_setprio(1); _Pragma("unroll") for (int m = 0; m < 4; ++m) _Pragma("unroll") for (int n = 0; n < 2; ++n) _Pragma("unroll") for (int k = 0; k < 2; ++k) \
        acc[ai][bj][m][n] = __builtin_amdgcn_mfma_f32_16x16x32_bf16(Bt[n][k], At[m][k], acc[ai][bj][m][n], 0, 0, 0); __builtin_amdgcn_s_setprio(0); } while (0)
#define PG8_WAIT_V(n) asm volatile("s_waitcnt vmcnt(" #n ")" ::: "memory")
#define PG8_WAIT_L(n) asm volatile("s_waitcnt lgkmcnt(" #n ")" ::: "memory")
#define PG8_BAR __builtin_amdgcn_s_barrier()
#define PG8_SCHED __builtin_amdgcn_sched_barrier(0)
    Unit cur, nxt; int ui = 0;
    if (!S.next(0, cur)) return;
    f32x4 acc[2][2][4][2];
#pragma unroll
    for (int a = 0; a < 2; ++a)
#pragma unroll
        for (int b = 0; b < 2; ++b)
#pragma unroll
            for (int m = 0; m < 4; ++m)
#pragma unroll
                for (int n = 0; n < 2; ++n) acc[a][b][m][n] = (f32x4){0.f, 0.f, 0.f, 0.f};
    bf16x8 At[4][2], B0[2][2], B1[2][2];
    const char* cA = (const char*)g.A + (size_t)cur.pm * tstep; const char* cB = (const char*)g.Bt + (size_t)cur.pn * tstep;
    S.a_ready(cur);
    if constexpr (SP2) {
        PG8_STAGE(PG8_SB(0, 0), cB, voffB); PG8_STAGE(PG8_SB(0, 1), cB + hstep, voffB); PG8_STAGE(PG8_SA(0, 0), cA, voffA); PG8_STAGE(PG8_SA(0, 1), cA + hstep, voffA);
        if (wr == 1) PG8_BAR;
        PG8_WAIT_V(2); PG8_BAR;
        PG8_STAGE(PG8_SB(1, 0), cB + kstep, voffB); PG8_STAGE(PG8_SA(1, 0), cA + kstep, voffA); PG8_STAGE(PG8_SB(1, 1), cB + hstep + kstep, voffB);
        PG8_WAIT_V(6); PG8_BAR;
    } else {
        PG8_STAGE(PG8_SB(0, 0), cB, voffB); PG8_STAGE(PG8_SA(0, 0), cA, voffA); PG8_STAGE(PG8_SB(0, 1), cB + hstep, voffB); PG8_STAGE(PG8_SA(0, 1), cA + hstep, voffA);
        if (wr == 1) PG8_BAR;
        PG8_WAIT_V(4); PG8_BAR;
        PG8_STAGE(PG8_SB(1, 0), cB + kstep, voffB); PG8_STAGE(PG8_SA(1, 0), cA + kstep, voffA); PG8_STAGE(PG8_SB(1, 1), cB + hstep + kstep, voffB);
        PG8_WAIT_V(6); PG8_BAR;
    }
    for (;;) {
        const bool has_next = S.next(ui + 1, nxt);
        const char* nA = has_next ? (const char*)g.A + (size_t)nxt.pm * tstep : cA; const char* nB = has_next ? (const char*)g.Bt + (size_t)nxt.pn * tstep : cB;
        for (int t = 0; t < nt; t += 2) {
            const bool last = (t == nt - 2);
            const char* a1 = cA + (size_t)(t + 1) * kstep;
            const char* a2 = last ? nA : cA + (size_t)(t + 2) * kstep; const char* b2 = last ? nB : cB + (size_t)(t + 2) * kstep;
            const char* a3 = a2 + kstep; const char* b3 = b2 + kstep;
            if (last && has_next) S.a_ready(nxt);
            if constexpr (SP2) {
            PG8_LDB(B0, 0, 0); PG8_LDB(B1, 0, 1); PG8_SCHED; PG8_LDA(At, 0, 0); PG8_STAGE(PG8_SA(1, 1), a1 + hstep, voffA);
            PG8_WAIT_V(8); PG8_WAIT_L(0); PG8_BAR; PG8_MMA(0, 0, At, B0); PG8_MMA(0, 1, At, B1); PG8_BAR; PG8_SCHED;
            PG8_LDA(At, 0, 1); PG8_STAGE(PG8_SB(0, 0), b2, voffB); PG8_STAGE(PG8_SB(0, 1), b2 + hstep, voffB); PG8_STAGE(PG8_SA(0, 0), a2, voffA);
            PG8_WAIT_V(8); PG8_WAIT_L(0); PG8_BAR; PG8_MMA(1, 0, At, B0); PG8_MMA(1, 1, At, B1); PG8_BAR; PG8_SCHED;
            PG8_LDB(B0, 1, 0); PG8_LDB(B1, 1, 1); PG8_SCHED; PG8_LDA(At, 1, 0); PG8_STAGE(PG8_SA(0, 1), a2 + hstep, voffA);
            PG8_WAIT_V(8); PG8_WAIT_L(0); PG8_BAR; PG8_MMA(0, 0, At, B0); PG8_MMA(0, 1, At, B1); PG8_BAR; PG8_SCHED;
            PG8_LDA(At, 1, 1); PG8_STAGE(PG8_SB(1, 0), b3, voffB); PG8_STAGE(PG8_SB(1, 1), b3 + hstep, voffB); PG8_STAGE(PG8_SA(1, 0), a3, voffA);
            PG8_WAIT_V(8); PG8_WAIT_L(0); PG8_BAR; PG8_MMA(1, 0, At, B0); PG8_MMA(1, 1, At, B1); PG8_BAR; PG8_SCHED;
            } else {
            PG8_LDB(B0, 0, 0); PG8_SCHED; PG8_LDA(At, 0, 0); PG8_STAGE(PG8_SA(1, 1), a1 + hstep, voffA);
            PG8_WAIT_L(8); PG8_BAR; PG8_WAIT_L(0); PG8_MMA(0, 0, At, B0); PG8_BAR; PG8_SCHED;
            PG8_LDB(B1, 0, 1); PG8_STAGE(PG8_SB(0, 0), b2, voffB);
            PG8_BAR; PG8_WAIT_L(0); PG8_MMA(0, 1, At, B1); PG8_BAR;
            PG8_LDA(At, 0, 1); PG8_STAGE(PG8_SA(0, 0), a2, voffA);
            PG8_BAR; PG8_WAIT_L(0); PG8_MMA(1, 0, At, B0); PG8_BAR; PG8_SCHED;
            PG8_STAGE(PG8_SB(0, 1), b2 + hstep, voffB);
            PG8_WAIT_V(6); PG8_BAR; PG8_MMA(1, 1, At, B1); PG8_BAR;
            PG8_LDB(B0, 1, 0); PG8_SCHED; PG8_LDA(At, 1, 0); PG8_STAGE(PG8_SA(0, 1), a2 + hstep, voffA);
            PG8_WAIT_L(8); PG8_BAR; PG8_WAIT_L(0); PG8_MMA(0, 0, At, B0); PG8_BAR; PG8_SCHED;
            PG8_LDB(B1, 1, 1); PG8_STAGE(PG8_SB(1, 0), b3, voffB);
            PG8_BAR; PG8_WAIT_L(0); PG8_MMA(0, 1, At, B1); PG8_BAR;
            PG8_LDA(At, 1, 1); PG8_STAGE(PG8_SA(1, 0), a3, voffA);
            PG8_BAR; PG8_WAIT_L(0); PG8_MMA(1, 0, At, B0); PG8_BAR; PG8_SCHED;
            PG8_STAGE(PG8_SB(1, 1), b3 + hstep, voffB);
            PG8_WAIT_V(6); PG8_BAR; PG8_MMA(1, 1, At, B1); PG8_BAR;
            }
        }
        if constexpr (ALIGN_EPI) { if (wr == 0) PG8_BAR; }
        if constexpr (!Epi::AFTER_DRAIN) { E(acc, cur, wr, wc, fr, fq); S.done(cur); }
        if (!has_next) break;
#pragma unroll
        for (int a = 0; a < 2; ++a)
#pragma unroll
            for (int b = 0; b < 2; ++b)
#pragma unroll
                for (int m = 0; m < 4; ++m)
#pragma unroll
                    for (int n = 0; n < 2; ++n) acc[a][b][m][n] = (f32x4){0.f, 0.f, 0.f, 0.f};
        cur = nxt; cA = nA; cB = nB; ++ui;
        if constexpr (ALIGN_EPI) { if (wr == 1) PG8_BAR; }
    }
    PG8_WAIT_V(0);
    if constexpr (!ALIGN_EPI) { if (wr == 0) PG8_BAR; }
    PG8_BAR;
    if constexpr (Epi::AFTER_DRAIN) { E.fused(acc, cur, wr, wc, fr, fq, lds, wid, lane); S.done(cur); }
#undef PG8_SA
#undef PG8_SB
#undef PG8_STAGE
#undef PG8_LDA
#undef PG8_LDB
#undef PG8_MMA
#undef PG8_WAIT_V
#undef PG8_WAIT_L
#undef PG8_BAR
#undef PG8_SCHED
}
}
#define XB_TMO      128
#define XB_XCNT(j)  (256  + 64 * (j))
#define XB_XSUB(j)  (1280 + 64 * (j))
#define XB_XGEN(j)  (2304 + 64 * (j))
#define XB_TOP      3328
#define XB_TOPGEN   3392
#define XCD_BAR_WORDS 3456
#define XB_SPIN_CAP (1u << 18)

__device__ __forceinline__ unsigned xb_ld(unsigned* p)              { return __hip_atomic_load(p, __ATOMIC_RELAXED, __HIP_MEMORY_SCOPE_AGENT); }
__device__ __forceinline__ unsigned xb_add(unsigned* p, unsigned v) { return __hip_atomic_fetch_add(p, v, __ATOMIC_RELAXED, __HIP_MEMORY_SCOPE_AGENT); }
__device__ __forceinline__ unsigned xb_xcc_id() { return (unsigned)__builtin_amdgcn_s_getreg((3 << 11) | 20) & 0xFu; }
#define XB_SPIN(cond, bar) do { unsigned _sp = 0; while (cond) { __builtin_amdgcn_s_sleep(1); \
    if ((++_sp & 255u) == 0u) { if (xb_ld(&(bar)[XB_TMO])) break; if (_sp > XB_SPIN_CAP) { atomicAdd(&(bar)[XB_TMO], 1u); break; } } } } while (0)

struct XcdBarrier {
    unsigned* bar; unsigned x;
    volatile LAS unsigned* st;
};

__device__ __forceinline__ XcdBarrier xcd_barrier_post(unsigned* bar, volatile LAS unsigned* st) {
    XcdBarrier b; b.bar = bar; b.x = xb_xcc_id(); b.st = st;
    if (threadIdx.x == 0) (void)xb_add(&bar[XB_XCNT(b.x)], 1u);
    return b;
}
__device__ __forceinline__ void xcd_barrier_complete(unsigned* bar, unsigned x, unsigned& nloc, unsigned& nx) {
    const unsigned G = gridDim.x * gridDim.y * gridDim.z;
    unsigned sum, cnt, mine, sp = 0u;
    for (;;) {
        sum = 0u; cnt = 0u; mine = 0u;
#pragma unroll
        for (unsigned j = 0; j < 16; ++j) { const unsigned c = xb_ld(&bar[XB_XCNT(j)]); sum += c; cnt += (c > 0u) ? 1u : 0u; mine = (j == x) ? c : mine; }
        if (sum == G) break;
        __builtin_amdgcn_s_sleep(1);
        if ((++sp & 255u) == 0u) { if (xb_ld(&bar[XB_TMO])) break; if (sp > XB_SPIN_CAP) { atomicAdd(&bar[XB_TMO], 1u); break; } }
    }
    nloc = mine > 0u ? mine : 1u; nx = cnt > 0u ? cnt : 1u;
}

__device__ __forceinline__ void xcd_barrier(const XcdBarrier& b) {
    asm volatile("s_waitcnt vmcnt(0)" ::: "memory");
    __syncthreads();
    if (threadIdx.x == 0) {
        unsigned* bar = b.bar;
        __builtin_amdgcn_s_waitcnt(0);
        unsigned nloc = b.st[0], nx = b.st[1];
        if (nloc == 0u) { xcd_barrier_complete(bar, b.x, nloc, nx); b.st[0] = nloc; b.st[1] = nx; }
        const unsigned old = xb_add(&bar[XB_XSUB(b.x)], 1u);
        const unsigned gen = old / nloc;
        if (old + 1u == (gen + 1u) * nloc) {
            __builtin_amdgcn_fence(__ATOMIC_RELEASE, "agent");
            asm volatile("s_waitcnt vmcnt(0)" ::: "memory");
            const unsigned og = xb_add(&bar[XB_TOP], 1u);
            const unsigned tg = og / nx;
            if (og + 1u == (tg + 1u) * nx) xb_add(&bar[XB_TOPGEN], 1u);
            else XB_SPIN(xb_ld(&bar[XB_TOPGEN]) == tg, bar);
            __builtin_amdgcn_fence(__ATOMIC_ACQUIRE, "agent");
            xb_add(&bar[XB_XGEN(b.x)], 1u);
            asm volatile("s_waitcnt vmcnt(0)" ::: "memory");
        } else {
            XB_SPIN(xb_ld(&bar[XB_XGEN(b.x)]) == gen, bar);
            __builtin_amdgcn_fence(__ATOMIC_ACQUIRE, "agent");
            asm volatile("s_waitcnt vmcnt(0)" ::: "memory");
        }
    }
    __syncthreads();
}
namespace mk {
typedef unsigned short bf16;
typedef unsigned v4u __attribute__((ext_vector_type(4)));
typedef unsigned v2u __attribute__((ext_vector_type(2)));
typedef float f32x4 __attribute__((ext_vector_type(4)));
typedef float f32x16 __attribute__((ext_vector_type(16)));
typedef short bf16x8 __attribute__((ext_vector_type(8)));
typedef short bf16x4 __attribute__((ext_vector_type(4)));

constexpr int T = 32768, D = 1024, SQ = 4096, NIN = 2816, NQ = 2048, PLE = 256, NEXP = 16384;
constexpr int NWAVES = 8, NTHR = 512;
constexpr int RING_BYTES = 131072, LDS_BYTES = 163840, MISC_OFF = LDS_BYTES - 256;

constexpr size_t MB = 1024 * 1024;
constexpr size_t WS_CTL = 0, CTL_BYTES = 256 * 1024;
constexpr size_t WS_WIN = WS_CTL + CTL_BYTES;
constexpr size_t WS_WOUT = WS_WIN + (size_t)NIN * D * 2;
constexpr size_t WS_WQ = WS_WOUT + (size_t)D * D * 2;
constexpr size_t WS_WG = WS_WQ + (size_t)NQ * D * 2;
constexpr size_t WS_WP = WS_WG + (size_t)D * D * 2;
constexpr size_t WS_KEYS = WS_WP + (size_t)D * PLE * 2;
constexpr size_t WS_ROPE = WS_KEYS + 2 * 128 * 128 * 2;
constexpr size_t WS_RSTD2 = WS_ROPE + 2 * (size_t)SQ * 32 * 4;
constexpr size_t WS_UB = 16 * MB;
constexpr size_t WS_VB = WS_UB + 32 * MB;
constexpr size_t WS_PB = WS_VB + 32 * MB;
constexpr size_t WS_R1 = WS_PB + 16 * MB;
constexpr size_t WS_R2 = WS_R1 + 64 * MB;
constexpr size_t WS_PP = WS_R2 + 192 * MB;
constexpr size_t WS_END = WS_PP + 64 * MB;
static_assert(WS_RSTD2 + (size_t)T * 4 <= WS_UB, "ws map");
constexpr int CW_BAR = 1024;

#define LDS_WAIT() asm volatile("s_waitcnt lgkmcnt(0)" ::: "memory")
#define VM_WAIT() asm volatile("s_waitcnt vmcnt(0)" ::: "memory")
typedef float f32x2 __attribute__((ext_vector_type(2)));
typedef __bf16 b16x2 __attribute__((ext_vector_type(2)));
__device__ __forceinline__ unsigned pk2(float lo, float hi) { const f32x2 v = {lo, hi}; return __builtin_bit_cast(unsigned, __builtin_convertvector(v, b16x2)); }
__device__ __forceinline__ float bf_lo(unsigned w) { return __uint_as_float(w << 16); }
__device__ __forceinline__ float bf_hi(unsigned w) { return __uint_as_float(w & 0xffff0000u); }
__device__ __forceinline__ float wave_sum(float v) {
#pragma unroll
    for (int o = 1; o < 64; o <<= 1) v += __shfl_xor(v, o);
    return v;
}

struct Args { const float* in[16]; float* out; unsigned char* ws; int ph_lo, ph_hi, li, pad; };

struct EpiStoreBf16 {
    static constexpr bool PERM = true, AFTER_DRAIN = false;
    bf16* O; int ldc;
    __device__ __forceinline__ void operator()(const pg8::f32x4 (&acc)[2][2][4][2], const pg8::Unit& u, int wr, int wc, int fr, int fq) const {
        const int row0 = u.pm * 256 + wr * 64 + fr, col0 = u.pn * 256 + wc * 32 + 8 * fq;
#pragma unroll
        for (int ai = 0; ai < 2; ++ai)
#pragma unroll
            for (int m = 0; m < 4; ++m) { bf16* rowp = O + (size_t)(row0 + ai * 128 + m * 16) * ldc + col0;
#pragma unroll
                for (int bj = 0; bj < 2; ++bj) { const pg8::f32x4 v0 = acc[ai][bj][m][0], v1 = acc[ai][bj][m][1];
                    pg8::u32x4 w; w.x = pk2(v0[0], v0[1]); w.y = pk2(v0[2], v0[3]); w.z = pk2(v1[0], v1[1]); w.w = pk2(v1[2], v1[3]);
                    *(pg8::u32x4*)(rowp + bj * 128) = w; } }
    }
};


struct EpiResid {
    static constexpr bool PERM = true, AFTER_DRAIN = false;
    const float* X; float* O; bf16* XB;
    __device__ __forceinline__ void operator()(const pg8::f32x4 (&acc)[2][2][4][2], const pg8::Unit& u, int wr, int wc, int fr, int fq) const {
        const int row0 = u.pm * 256 + wr * 64 + fr, col0 = u.pn * 256 + wc * 32 + 8 * fq;
#pragma unroll
        for (int ai = 0; ai < 2; ++ai)
#pragma unroll
            for (int m = 0; m < 4; ++m) { const size_t off = (size_t)(row0 + ai * 128 + m * 16) * D + col0;
#pragma unroll
                for (int bj = 0; bj < 2; ++bj) { const size_t o2 = off + bj * 128;
                    const pg8::f32x4 v0 = acc[ai][bj][m][0] + *(const pg8::f32x4*)(X + o2), v1 = acc[ai][bj][m][1] + *(const pg8::f32x4*)(X + o2 + 4);
                    *(pg8::f32x4*)(O + o2) = v0; *(pg8::f32x4*)(O + o2 + 4) = v1;
                    pg8::u32x4 w; w.x = pk2(v0[0], v0[1]); w.y = pk2(v0[2], v0[3]); w.z = pk2(v1[0], v1[1]); w.w = pk2(v1[2], v1[3]);
                    *(pg8::u32x4*)(XB + o2) = w; } }
    }
};
struct EpiGate {
    static constexpr bool PERM = true, AFTER_DRAIN = false;
    float* O; const bf16* PP; const float* rstd;
    __device__ __forceinline__ void operator()(const pg8::f32x4 (&acc)[2][2][4][2], const pg8::Unit& u, int wr, int wc, int fr, int fq) const {
        const int row0 = u.pm * 256 + wr * 64 + fr, col0 = u.pn * 256 + wc * 32 + 8 * fq;
#pragma unroll
        for (int ai = 0; ai < 2; ++ai)
#pragma unroll
            for (int m = 0; m < 4; ++m) { const int row = row0 + ai * 128 + m * 16; const size_t off = (size_t)row * D + col0; const float rs = rstd[row];
#pragma unroll
                for (int bj = 0; bj < 2; ++bj) { const size_t o2 = off + bj * 128;
                    const pg8::u32x4 pw = *(const pg8::u32x4*)(PP + o2);
                    pg8::f32x4 x0 = *(const pg8::f32x4*)(O + o2), x1 = *(const pg8::f32x4*)(O + o2 + 4);
                    const pg8::f32x4 a0 = acc[ai][bj][m][0] * rs, a1 = acc[ai][bj][m][1] * rs;
                    x0[0] += bf_lo(pw.x) / (1.0f + __expf(-a0[0])); x0[1] += bf_hi(pw.x) / (1.0f + __expf(-a0[1])); x0[2] += bf_lo(pw.y) / (1.0f + __expf(-a0[2])); x0[3] += bf_hi(pw.y) / (1.0f + __expf(-a0[3]));
                    x1[0] += bf_lo(pw.z) / (1.0f + __expf(-a1[0])); x1[1] += bf_hi(pw.z) / (1.0f + __expf(-a1[1])); x1[2] += bf_lo(pw.w) / (1.0f + __expf(-a1[2])); x1[3] += bf_hi(pw.w) / (1.0f + __expf(-a1[3]));
                    *(pg8::f32x4*)(O + o2) = x0; *(pg8::f32x4*)(O + o2 + 4) = x1; } }
    }
};

__device__ __forceinline__ void p0_transpose_item(const float* __restrict__ W, const float* __restrict__ gsc, int K, int N, bf16* __restrict__ WT, LAS float* scr, int item, int lane) {
    const int nblk = N / 32, kb = item / nblk, nb = item % nblk, k0 = 64 * kb, n0 = 32 * nb;
#pragma unroll 8
    for (int i = 0; i < 32; ++i) { const int kk = 2 * i + (lane >> 5); float w = W[(size_t)(k0 + kk) * N + n0 + (lane & 31)]; if (gsc) w *= gsc[k0 + kk]; scr[kk * 33 + (lane & 31)] = w; }
    LDS_WAIT(); asm volatile("" ::: "memory");
    const int c = lane & 7;
#pragma unroll
    for (int j = 0; j < 4; ++j) { const int n = (lane >> 3) + 8 * j; const LAS float* s = scr + (8 * c) * 33 + n;
        v4u o; o.x = pk2(s[0 * 33], s[1 * 33]); o.y = pk2(s[2 * 33], s[3 * 33]); o.z = pk2(s[4 * 33], s[5 * 33]); o.w = pk2(s[6 * 33], s[7 * 33]);
        *(v4u*)(WT + (size_t)(n0 + n) * K + k0 + 8 * c) = o; }
    LDS_WAIT(); asm volatile("" ::: "memory");
}
__device__ __forceinline__ void p0_convert(const float* __restrict__ src, bf16* __restrict__ dst, size_t n8, size_t gtid, size_t gthreads) {
    for (size_t i = gtid; i < n8; i += gthreads) {
        const f32x4 a = ((const f32x4*)src)[2 * i], b = ((const f32x4*)src)[2 * i + 1];
        v4u o; o.x = pk2(a[0], a[1]); o.y = pk2(a[2], a[3]); o.z = pk2(b[0], b[1]); o.w = pk2(b[2], b[3]);
        ((v4u*)dst)[i] = o;
    }
}
__device__ __forceinline__ void rms_row_to_bf16(const float* __restrict__ xrow, const float* __restrict__ g, bf16* __restrict__ orow, int lane) {
    const f32x4* xr = (const f32x4*)xrow + lane; const f32x4* gr = (const f32x4*)g + lane;
    f32x4 v[4]; float s = 0.f;
#pragma unroll
    for (int j = 0; j < 4; ++j) { v[j] = xr[64 * j]; s += (v[j][0] * v[j][0] + v[j][1] * v[j][1]) + (v[j][2] * v[j][2] + v[j][3] * v[j][3]); }
    const float rstd = 1.0f / sqrtf(wave_sum(s) * (1.0f / D) + 1e-6f);
    v2u* o8 = (v2u*)orow + lane;
#pragma unroll
    for (int j = 0; j < 4; ++j) { const f32x4 gg = gr[64 * j]; v2u w; w.x = pk2(v[j][0] * rstd * gg[0], v[j][1] * rstd * gg[1]); w.y = pk2(v[j][2] * rstd * gg[2], v[j][3] * rstd * gg[3]); o8[64 * j] = w; }
}

__device__ __forceinline__ void p0_prologue(const Args& a, LAS unsigned char* lds, int vcu, int G, int tid, int lane, int wave) {
    unsigned char* ws = a.ws;
    LAS float* scr = (LAS float*)(lds + wave * 16384);
    const int gw = vcu * NWAVES + wave, NGW = G * NWAVES;
    constexpr int I_IN = (D / 64) * (NIN / 32), I_OUT = (D / 64) * (D / 32), I_Q = (D / 64) * (NQ / 32), I_G = I_OUT, I_P = (PLE / 64) * (D / 32);
    constexpr int NITEMS = I_IN + I_OUT + I_Q + I_G + I_P;
    for (int it = gw; it < NITEMS; it += NGW) {
        int r = it;
        if (r < I_IN) { p0_transpose_item(a.in[3], nullptr, D, NIN, (bf16*)(ws + WS_WIN), scr, r, lane); continue; } r -= I_IN;
        if (r < I_OUT) { p0_transpose_item(a.in[7], nullptr, D, D, (bf16*)(ws + WS_WOUT), scr, r, lane); continue; } r -= I_OUT;
        if (r < I_Q) { p0_transpose_item(a.in[9], a.in[8], D, NQ, (bf16*)(ws + WS_WQ), scr, r, lane); continue; } r -= I_Q;
        if (r < I_G) { p0_transpose_item(a.in[14], a.in[13], D, D, (bf16*)(ws + WS_WG), scr, r, lane); continue; } r -= I_G;
        p0_transpose_item(a.in[15], nullptr, PLE, D, (bf16*)(ws + WS_WP), scr, r, lane);
    }
    const size_t gtid = (size_t)vcu * NTHR + tid, gthreads = (size_t)G * NTHR;
    p0_convert(a.in[10], (bf16*)(ws + WS_KEYS), 2 * 128 * 128 / 8, gtid, gthreads);
    p0_convert(a.in[11], (bf16*)(ws + WS_UB), (size_t)NEXP * D / 8, gtid, gthreads);
    p0_convert(a.in[12], (bf16*)(ws + WS_VB), (size_t)NEXP * D / 8, gtid, gthreads);
    p0_convert(a.in[1], (bf16*)(ws + WS_PB), (size_t)T * PLE / 8, gtid, gthreads);
    for (size_t i = gtid; i < (size_t)SQ * 32; i += gthreads) {
        const int pos = (int)(i >> 5), c = (int)(i & 31);
        const float freq = powf(10000.0f, -(float)c / 32.0f);
        const float ang = (float)pos * freq;
        float sn, cs; sincosf(ang, &sn, &cs);
        ((float*)(ws + WS_ROPE))[i] = cs; ((float*)(ws + WS_ROPE))[(size_t)SQ * 32 + i] = sn;
    }
    for (int m = gw; m < T; m += NGW) rms_row_to_bf16(a.in[0] + (size_t)m * D, a.in[2], (bf16*)(ws + WS_R1) + (size_t)m * D, lane);
}


#define MFMA32(a, b, c) __builtin_amdgcn_mfma_f32_32x32x16_bf16((a), (b), (c), 0, 0, 0)
__device__ __forceinline__ int crow(int r, int hf) { return (r & 3) + 8 * (r >> 2) + 4 * hf; }
__device__ __forceinline__ bf16x8 pack8(float a0, float a1, float a2, float a3, float a4, float a5, float a6, float a7) {
    v4u w; w.x = pk2(a0, a1); w.y = pk2(a2, a3); w.z = pk2(a4, a5); w.w = pk2(a6, a7); return __builtin_bit_cast(bf16x8, w);
}
__device__ __forceinline__ bf16x8 lds_frag16(LAS unsigned char* p) { return *(const LAS bf16x8*)p; }
__device__ __forceinline__ bf16x8 lds_frag8x2(LAS unsigned char* p) {
    const bf16x4 lo = *(const LAS bf16x4*)p, hi = *(const LAS bf16x4*)(p + 16); return __builtin_shufflevector(lo, hi, 0, 1, 2, 3, 4, 5, 6, 7);
}
constexpr int RQ = 144, RT = 272, RV = 528;
constexpr int LR_QS = 0, LR_KS = LR_QS + 128 * RQ, LR_KT = LR_KS + 128 * RQ, LR_VT = LR_KT + 64 * RT, LR_ST = LR_VT + 64 * RT, LR_LN = LR_ST + 64 * RQ, LR_END = LR_LN + 2 * 128 * 8;
static_assert(LR_END <= RING_BYTES, "retention LDS");
__device__ __forceinline__ void ret_unit(const bf16* __restrict__ PROJ, bf16* __restrict__ MIXED, const float* __restrict__ rope, LAS unsigned char* lds,
                                         int b, int h, int c0, int c1, int tid, int lane, int wave) {
    const float gam = 1.0f - exp2f(-5.0f - (float)h), lg2 = log2f(gam), cd = exp2f(lg2 * 128.0f);
    const int l31 = lane & 31, hf = lane >> 5, ib = wave >> 1, et = wave & 1;
    const int r = tid >> 2, qd = tid & 3;
    const float wq = exp2f(lg2 * (float)(r + 1)), wk = exp2f(-lg2 * (float)(r + 1));
    f32x16 stacc;
#pragma unroll
    for (int i = 0; i < 16; ++i) stacc[i] = 0.f;
    for (int i = tid; i < 64 * RQ / 4; i += NTHR) ((LAS unsigned*)(lds + LR_ST))[i] = 0u;
    for (int n = 0; n < c1; ++n) {
        const bool own = n >= c0;
        const int seqpos = n * 128 + r;
        const bf16* pr = PROJ + ((size_t)b * SQ + seqpos) * NIN + h * 64 + 8 * qd;
        const v4u k1 = *(const v4u*)(pr + 512), k2 = *(const v4u*)(pr + 512 + 32);
        const v4u v1 = *(const v4u*)(pr + 1024), v2 = *(const v4u*)(pr + 1024 + 32);
        v4u q1 = {0u, 0u, 0u, 0u}, q2 = {0u, 0u, 0u, 0u};
        if (own) { q1 = *(const v4u*)(pr); q2 = *(const v4u*)(pr + 32); }
        const f32x4 csa = *(const f32x4*)(rope + seqpos * 32 + 8 * qd), csb = *(const f32x4*)(rope + seqpos * 32 + 8 * qd + 4);
        const f32x4 sna = *(const f32x4*)(rope + SQ * 32 + seqpos * 32 + 8 * qd), snb = *(const f32x4*)(rope + SQ * 32 + seqpos * 32 + 8 * qd + 4);
        float cs[8], sn[8];
#pragma unroll
        for (int u = 0; u < 4; ++u) { cs[u] = csa[u]; cs[4 + u] = csb[u]; sn[u] = sna[u]; sn[4 + u] = snb[u]; }
        __syncthreads();
        {
            float o1[8], o2[8];
#pragma unroll
            for (int u = 0; u < 8; ++u) { const unsigned w1 = k1[u >> 1], w2 = k2[u >> 1]; const float x1 = (u & 1) ? bf_hi(w1) : bf_lo(w1), x2 = (u & 1) ? bf_hi(w2) : bf_lo(w2);
                o1[u] = (x1 * cs[u] - x2 * sn[u]) * wk; o2[u] = (x1 * sn[u] + x2 * cs[u]) * wk; }
            if (own) {
                *(LAS bf16x8*)(lds + LR_KS + r * RQ + (8 * qd) * 2) = pack8(o1[0], o1[1], o1[2], o1[3], o1[4], o1[5], o1[6], o1[7]);
                *(LAS bf16x8*)(lds + LR_KS + r * RQ + (32 + 8 * qd) * 2) = pack8(o2[0], o2[1], o2[2], o2[3], o2[4], o2[5], o2[6], o2[7]);
            }
#pragma unroll
            for (int u = 0; u < 8; u += 2) {
                const unsigned a = pk2(o1[u] * 0.125f, o1[u + 1] * 0.125f), c = pk2(o2[u] * 0.125f, o2[u + 1] * 0.125f);
                *(LAS bf16*)(lds + LR_KT + (8 * qd + u) * RT + r * 2) = (bf16)(a & 0xffffu); *(LAS bf16*)(lds + LR_KT + (8 * qd + u + 1) * RT + r * 2) = (bf16)(a >> 16);
                *(LAS bf16*)(lds + LR_KT + (32 + 8 * qd + u) * RT + r * 2) = (bf16)(c & 0xffffu); *(LAS bf16*)(lds + LR_KT + (32 + 8 * qd + u + 1) * RT + r * 2) = (bf16)(c >> 16);
                const unsigned w1 = v1[u >> 1], w2 = v2[u >> 1];
                *(LAS bf16*)(lds + LR_VT + (8 * qd + u) * RT + r * 2) = (bf16)(w1 & 0xffffu); *(LAS bf16*)(lds + LR_VT + (8 * qd + u + 1) * RT + r * 2) = (bf16)(w1 >> 16);
                *(LAS bf16*)(lds + LR_VT + (32 + 8 * qd + u) * RT + r * 2) = (bf16)(w2 & 0xffffu); *(LAS bf16*)(lds + LR_VT + (32 + 8 * qd + u + 1) * RT + r * 2) = (bf16)(w2 >> 16);
            }
            if (own) {
#pragma unroll
                for (int u = 0; u < 8; ++u) { const unsigned w1 = q1[u >> 1], w2 = q2[u >> 1]; const float x1 = (u & 1) ? bf_hi(w1) : bf_lo(w1), x2 = (u & 1) ? bf_hi(w2) : bf_lo(w2);
                    o1[u] = (x1 * cs[u] - x2 * sn[u]) * wq; o2[u] = (x1 * sn[u] + x2 * cs[u]) * wq; }
                *(LAS bf16x8*)(lds + LR_QS + r * RQ + (8 * qd) * 2) = pack8(o1[0], o1[1], o1[2], o1[3], o1[4], o1[5], o1[6], o1[7]);
                *(LAS bf16x8*)(lds + LR_QS + r * RQ + (32 + 8 * qd) * 2) = pack8(o2[0], o2[1], o2[2], o2[3], o2[4], o2[5], o2[6], o2[7]);
            }
        }
        __syncthreads();
        if (own) {
            const size_t orow = (size_t)b * SQ + n * 128 + 32 * ib + l31;
            v2u gv[4];
#pragma unroll
            for (int g = 0; g < 4; ++g) gv[g] = *(const v2u*)(PROJ + orow * NIN + 1536 + h * 64 + 32 * et + 8 * g + 4 * hf);
            bf16x8 qf[4];
#pragma unroll
            for (int ks = 0; ks < 4; ++ks) qf[ks] = lds_frag16(lds + LR_QS + (32 * ib + l31) * RQ + (16 * ks + 8 * hf) * 2);
            f32x16 o;
#pragma unroll
            for (int i = 0; i < 16; ++i) o[i] = 0.f;
#pragma unroll
            for (int ks = 0; ks < 4; ++ks) o = MFMA32(lds_frag16(lds + LR_ST + (32 * et + l31) * RQ + (16 * ks + 8 * hf) * 2), qf[ks], o);
            for (int jb = 0; jb <= ib; ++jb) {
                f32x16 s;
#pragma unroll
                for (int i = 0; i < 16; ++i) s[i] = 0.f;
#pragma unroll
                for (int ks = 0; ks < 4; ++ks) s = MFMA32(lds_frag16(lds + LR_KS + (32 * jb + l31) * RQ + (16 * ks + 8 * hf) * 2), qf[ks], s);
                const bool diag = (jb == ib);
                float p[16];
#pragma unroll
                for (int i = 0; i < 16; ++i) p[i] = (diag && crow(i, hf) > l31) ? 0.f : s[i] * 0.125f;
#pragma unroll
                for (int st = 0; st < 2; ++st) {
                    const bf16x8 pf = pack8(p[8 * st], p[8 * st + 1], p[8 * st + 2], p[8 * st + 3], p[8 * st + 4], p[8 * st + 5], p[8 * st + 6], p[8 * st + 7]);
                    o = MFMA32(lds_frag8x2(lds + LR_VT + (32 * et + l31) * RT + (32 * jb + 16 * st + 4 * hf) * 2), pf, o);
                }
            }
            float s1 = 0.f, s2 = 0.f;
#pragma unroll
            for (int i = 0; i < 16; ++i) { s1 += o[i]; s2 += o[i] * o[i]; }
            s1 += __shfl_xor(s1, 32); s2 += __shfl_xor(s2, 32);
            if (hf == 0) *(LAS f32x2*)(lds + LR_LN + (et * 128 + 32 * ib + l31) * 8) = (f32x2){s1, s2};
            __syncthreads();
            const f32x2 ot = *(const LAS f32x2*)(lds + LR_LN + ((et ^ 1) * 128 + 32 * ib + l31) * 8);
            const float mu = (s1 + ot.x) * (1.0f / 64.0f), var = fmaxf((s2 + ot.y) * (1.0f / 64.0f) - mu * mu, 0.f), rs = 1.0f / sqrtf(var + 1e-6f);
#pragma unroll
            for (int g = 0; g < 4; ++g) {
                float y[4];
#pragma unroll
                for (int u = 0; u < 4; ++u) { const unsigned w = gv[g][u >> 1]; const float gg = (u & 1) ? bf_hi(w) : bf_lo(w); const float sg = gg / (1.0f + __expf(-gg)); y[u] = sg * ((o[4 * g + u] - mu) * rs); }
                v2u w; w.x = pk2(y[0], y[1]); w.y = pk2(y[2], y[3]);
                *(v2u*)(MIXED + orow * D + h * 64 + 32 * et + 8 * g + 4 * hf) = w;
            }
        }
        if (wave < 4) {
            const int se = wave >> 1, sd = wave & 1;
#pragma unroll
            for (int ks = 0; ks < 8; ++ks)
                stacc = MFMA32(lds_frag16(lds + LR_VT + (32 * se + l31) * RT + (16 * ks + 8 * hf) * 2), lds_frag16(lds + LR_KT + (32 * sd + l31) * RT + (16 * ks + 8 * hf) * 2), stacc);
#pragma unroll
            for (int i = 0; i < 16; ++i) stacc[i] *= cd;
#pragma unroll
            for (int i = 0; i < 16; i += 2) { const unsigned w = pk2(stacc[i], stacc[i + 1]);
                *(LAS bf16*)(lds + LR_ST + (32 * se + crow(i, hf)) * RQ + (32 * sd + l31) * 2) = (bf16)(w & 0xffffu);
                *(LAS bf16*)(lds + LR_ST + (32 * se + crow(i + 1, hf)) * RQ + (32 * sd + l31) * 2) = (bf16)(w >> 16); }
        }
    }
    __syncthreads();
}

constexpr int LS_KN = 0, LS_VT = LS_KN + 256 * RQ, LS_QN = LS_VT + 64 * RV, LS_END = LS_QN + 256 * RQ;
static_assert(LS_END <= RING_BYTES, "swa LDS");
__device__ __forceinline__ void swa_unit(const bf16* __restrict__ PROJ, bf16* __restrict__ MIXED, const float* __restrict__ qnw, const float* __restrict__ knw, const float* __restrict__ sinks,
                                         LAS unsigned char* lds, int b, int kvh, int n, int tid, int lane, int wave) {
    const int l31 = lane & 31, hf = lane >> 5;
    const int row = tid >> 1, half = tid & 1;
    {
        const int kpos = (n - 1) * 128 + row; const bool valid = kpos >= 0;
        v4u kk[4], vv[4];
#pragma unroll
        for (int c = 0; c < 4; ++c) { kk[c] = (v4u){0u, 0u, 0u, 0u}; vv[c] = (v4u){0u, 0u, 0u, 0u}; }
        if (valid) { const bf16* pr = PROJ + ((size_t)b * SQ + kpos) * NIN + 32 * half;
#pragma unroll
            for (int c = 0; c < 4; ++c) { kk[c] = *(const v4u*)(pr + 2560 + kvh * 64 + 8 * c); vv[c] = *(const v4u*)(pr + 2688 + kvh * 64 + 8 * c); } }
        float kf[32]; float ss = 0.f;
#pragma unroll
        for (int c = 0; c < 4; ++c)
#pragma unroll
            for (int u = 0; u < 4; ++u) { kf[8 * c + 2 * u] = bf_lo(kk[c][u]); kf[8 * c + 2 * u + 1] = bf_hi(kk[c][u]); }
#pragma unroll
        for (int i = 0; i < 32; ++i) ss += kf[i] * kf[i];
        ss += __shfl_xor(ss, 1);
        const float rstd = 0.125f / sqrtf(ss * (1.0f / 64.0f) + 1e-6f);
#pragma unroll
        for (int c = 0; c < 4; ++c) {
            const f32x4 g0 = *(const f32x4*)(knw + 32 * half + 8 * c), g1 = *(const f32x4*)(knw + 32 * half + 8 * c + 4);
            *(LAS bf16x8*)(lds + LS_KN + row * RQ + (32 * half + 8 * c) * 2) = pack8(kf[8 * c] * rstd * g0[0], kf[8 * c + 1] * rstd * g0[1], kf[8 * c + 2] * rstd * g0[2], kf[8 * c + 3] * rstd * g0[3],
                                                                                  kf[8 * c + 4] * rstd * g1[0], kf[8 * c + 5] * rstd * g1[1], kf[8 * c + 6] * rstd * g1[2], kf[8 * c + 7] * rstd * g1[3]);
#pragma unroll
            for (int u = 0; u < 4; ++u) { const unsigned w = vv[c][u];
                *(LAS bf16*)(lds + LS_VT + (32 * half + 8 * c + 2 * u) * RV + row * 2) = (bf16)(w & 0xffffu); *(LAS bf16*)(lds + LS_VT + (32 * half + 8 * c + 2 * u + 1) * RV + row * 2) = (bf16)(w >> 16); }
        }
    }
    for (int rnd = 0; rnd < 2; ++rnd) {
        {
            const int hs = row >> 7, qrow = row & 127, hq = kvh * 4 + rnd * 2 + hs;
            const bf16* pr = PROJ + ((size_t)b * SQ + n * 128 + qrow) * NIN + 2048 + hq * 64 + 32 * half;
            v4u qq[4];
#pragma unroll
            for (int c = 0; c < 4; ++c) qq[c] = *(const v4u*)(pr + 8 * c);
            float qf[32]; float ss = 0.f;
#pragma unroll
            for (int c = 0; c < 4; ++c)
#pragma unroll
                for (int u = 0; u < 4; ++u) { qf[8 * c + 2 * u] = bf_lo(qq[c][u]); qf[8 * c + 2 * u + 1] = bf_hi(qq[c][u]); }
#pragma unroll
            for (int i = 0; i < 32; ++i) ss += qf[i] * qf[i];
            ss += __shfl_xor(ss, 1);
            const float rstd = 1.0f / sqrtf(ss * (1.0f / 64.0f) + 1e-6f);
#pragma unroll
            for (int c = 0; c < 4; ++c) {
                const f32x4 g0 = *(const f32x4*)(qnw + 32 * half + 8 * c), g1 = *(const f32x4*)(qnw + 32 * half + 8 * c + 4);
                *(LAS bf16x8*)(lds + LS_QN + row * RQ + (32 * half + 8 * c) * 2) = pack8(qf[8 * c] * rstd * g0[0], qf[8 * c + 1] * rstd * g0[1], qf[8 * c + 2] * rstd * g0[2], qf[8 * c + 3] * rstd * g0[3],
                                                                                      qf[8 * c + 4] * rstd * g1[0], qf[8 * c + 5] * rstd * g1[1], qf[8 * c + 6] * rstd * g1[2], qf[8 * c + 7] * rstd * g1[3]);
            }
        }
        __syncthreads();
        {
            const int hs = wave >> 2, ib = wave & 3, hq = kvh * 4 + rnd * 2 + hs;
            bf16x8 qf[4];
#pragma unroll
            for (int ks = 0; ks < 4; ++ks) qf[ks] = lds_frag16(lds + LS_QN + (hs * 128 + 32 * ib + l31) * RQ + (16 * ks + 8 * hf) * 2);
            f32x16 s[5];
#pragma unroll
            for (int t = 0; t < 5; ++t) {
#pragma unroll
                for (int i = 0; i < 16; ++i) s[t][i] = 0.f;
#pragma unroll
                for (int ks = 0; ks < 4; ++ks) s[t] = MFMA32(lds_frag16(lds + LS_KN + (32 * (ib + t) + l31) * RQ + (16 * ks + 8 * hf) * 2), qf[ks], s[t]);
            }
            const float sink = sinks[hq];
            float m = sink;
#pragma unroll
            for (int t = 0; t < 5; ++t)
#pragma unroll
                for (int i = 0; i < 16; ++i) {
                    bool ok = true;
                    if (t == 0) ok = crow(i, hf) > l31;
                    if (t == 4) ok = crow(i, hf) <= l31;
                    if (n == 0 && ib + t < 4) ok = false;
                    s[t][i] = ok ? s[t][i] : -INFINITY;
                    m = fmaxf(m, s[t][i]);
                }
            m = fmaxf(m, __shfl_xor(m, 32));
            float l = 0.f;
#pragma unroll
            for (int t = 0; t < 5; ++t)
#pragma unroll
                for (int i = 0; i < 16; ++i) { s[t][i] = exp2f((s[t][i] - m) * 1.4426950408889634f); l += s[t][i]; }
            l += __shfl_xor(l, 32);
            l += exp2f((sink - m) * 1.4426950408889634f);
            f32x16 o[2];
#pragma unroll
            for (int e2 = 0; e2 < 2; ++e2)
#pragma unroll
                for (int i = 0; i < 16; ++i) o[e2][i] = 0.f;
#pragma unroll
            for (int t = 0; t < 5; ++t)
#pragma unroll
                for (int st = 0; st < 2; ++st) {
                    const bf16x8 pf = pack8(s[t][8 * st], s[t][8 * st + 1], s[t][8 * st + 2], s[t][8 * st + 3], s[t][8 * st + 4], s[t][8 * st + 5], s[t][8 * st + 6], s[t][8 * st + 7]);
#pragma unroll
                    for (int e2 = 0; e2 < 2; ++e2) o[e2] = MFMA32(lds_frag8x2(lds + LS_VT + (32 * e2 + l31) * RV + (32 * (ib + t) + 16 * st + 4 * hf) * 2), pf, o[e2]);
                }
            const float inv = 1.0f / l;
            const size_t orow = (size_t)b * SQ + n * 128 + 32 * ib + l31;
#pragma unroll
            for (int e2 = 0; e2 < 2; ++e2)
#pragma unroll
                for (int g = 0; g < 4; ++g) { v2u w; w.x = pk2(o[e2][4 * g] * inv, o[e2][4 * g + 1] * inv); w.y = pk2(o[e2][4 * g + 2] * inv, o[e2][4 * g + 3] * inv);
                    *(v2u*)(MIXED + orow * D + 512 + hq * 64 + 32 * e2 + 8 * g + 4 * hf) = w; }
        }
        __syncthreads();
    }
}

__device__ __forceinline__ void p2_mixing(const Args& a, LAS unsigned char* lds, int bx, int G, int tid, int lane, int wave) {
    const bf16* PROJ = (const bf16*)(a.ws + WS_R2); bf16* MIXED = (bf16*)(a.ws + WS_R1); const float* rope = (const float*)(a.ws + WS_ROPE);
    for (int u = bx; u < 256; u += G) {
        const int b = u >> 5, h = (u >> 2) & 7, grp = u & 3;
        const int c0 = grp == 0 ? 0 : grp == 1 ? 11 : grp == 2 ? 20 : 27, c1 = grp == 0 ? 11 : grp == 1 ? 20 : grp == 2 ? 27 : 32;
        ret_unit(PROJ, MIXED, rope, lds, b, h, c0, c1, tid, lane, wave);
    }
    for (int su = bx; su < 512; su += G) swa_unit(PROJ, MIXED, a.in[4], a.in[5], a.in[6], lds, su >> 6, (su >> 5) & 1, su & 31, tid, lane, wave);
}


template <int N> __device__ __forceinline__ void bitonic_sort_desc(float (&v)[N]) {
#pragma unroll
    for (int k = 2; k <= N; k <<= 1)
#pragma unroll
        for (int j = k >> 1; j > 0; j >>= 1)
#pragma unroll
            for (int i = 0; i < N; ++i) { const int l = i ^ j; if (l > i) { const bool desc = ((i & k) == 0); const float a = v[i], b = v[l]; const float hi = fmaxf(a, b), lo = fminf(a, b); v[i] = desc ? hi : lo; v[l] = desc ? lo : hi; } }
}
__device__ __forceinline__ void bitonic_merge16_desc(float (&v)[16]) {
#pragma unroll
    for (int j = 8; j > 0; j >>= 1)
#pragma unroll
        for (int i = 0; i < 16; ++i) { const int l = i ^ j; if (l > i) { const float a = v[i], b = v[l]; v[i] = fmaxf(a, b); v[l] = fminf(a, b); } }
}
__device__ __forceinline__ void top16_of_64(float (&v)[64], float (&out)[16]) {
    float b[4][16];
#pragma unroll
    for (int q = 0; q < 4; ++q) {
#pragma unroll
        for (int i = 0; i < 16; ++i) b[q][i] = v[16 * q + i];
        bitonic_sort_desc<16>(b[q]);
    }
    float t0[16], t1[16];
#pragma unroll
    for (int i = 0; i < 16; ++i) { t0[i] = fmaxf(b[0][i], b[1][15 - i]); t1[i] = fmaxf(b[2][i], b[3][15 - i]); }
    bitonic_merge16_desc(t0); bitonic_merge16_desc(t1);
#pragma unroll
    for (int i = 0; i < 16; ++i) out[i] = fmaxf(t0[i], t1[15 - i]);
    bitonic_merge16_desc(out);
}
__device__ __forceinline__ float dot2u(unsigned a, unsigned b, float c) { return __builtin_amdgcn_fdot2_f32_bf16(__builtin_bit_cast(b16x2, a), __builtin_bit_cast(b16x2, b), c, false); }
__device__ __forceinline__ float gelu_erf(float a) { return 0.5f * a * (1.0f + erff(a * 0.70710678118654752f)); }

constexpr int KROW = 272;
constexpr int LP_KEYS = 0, LP_EID = LP_KEYS + 256 * KROW, LP_EG = LP_EID + 32 * 128 * 4, LP_ACT = LP_EG + 32 * 128 * 4, LP_LUT = LP_ACT + NWAVES * 128 * 4, LP_RSTD = LP_LUT + NWAVES * 32 * 32, LP_END = LP_RSTD + 128;
static_assert(LP_END <= RING_BYTES, "peer LDS");

__device__ __forceinline__ void p5_peer(const Args& a, LAS unsigned char* lds, int vcu, int G, int tid, int lane, int wave) {
    unsigned char* ws = a.ws;
    const bf16* Q = (const bf16*)(ws + WS_R2 + 64 * MB); const bf16* UB = (const bf16*)(ws + WS_UB); const bf16* VB = (const bf16*)(ws + WS_VB);
    float* X = a.out; bf16* XB2 = (bf16*)(ws + WS_R1); float* RSTD2 = (float*)(ws + WS_RSTD2); const float* gffn = a.in[8];
    const int l31 = lane & 31, hf = lane >> 5;
    for (int i = tid; i < 256 * 16; i += NTHR) { const int rr = i >> 4, c = i & 15; *(LAS v4u*)(lds + LP_KEYS + rr * KROW + c * 16) = *(const v4u*)((const bf16*)(ws + WS_KEYS) + rr * 128 + c * 8); }
    float gw[16];
    { const f32x4 g0 = *(const f32x4*)(gffn + 8 * lane), g1 = *(const f32x4*)(gffn + 8 * lane + 4), g2 = *(const f32x4*)(gffn + 512 + 8 * lane), g3 = *(const f32x4*)(gffn + 512 + 8 * lane + 4);
#pragma unroll
      for (int u = 0; u < 4; ++u) { gw[u] = g0[u]; gw[4 + u] = g1[u]; gw[8 + u] = g2[u]; gw[12 + u] = g3[u]; } }
    __syncthreads();
    for (int grp = vcu; grp < T / 32; grp += G) {
        const int t0 = grp * 32;
#pragma unroll 1
        for (int q = 0; q < 4; ++q) {
            const float* xr = X + (size_t)(t0 + 4 * wave + q) * D;
            const f32x4 x0 = *(const f32x4*)(xr + 8 * lane), x1 = *(const f32x4*)(xr + 8 * lane + 4), x2 = *(const f32x4*)(xr + 512 + 8 * lane), x3 = *(const f32x4*)(xr + 512 + 8 * lane + 4);
            float ss = 0.f;
#pragma unroll
            for (int u = 0; u < 4; ++u) ss += x0[u] * x0[u] + x1[u] * x1[u] + x2[u] * x2[u] + x3[u] * x3[u];
            ss = wave_sum(ss);
            if (lane == 0) *(LAS float*)(lds + LP_RSTD + (4 * wave + q) * 4) = 1.0f / sqrtf(ss * (1.0f / D) + 1e-6f);
        }
        __syncthreads();
        {
            const int h = wave;
            float lst[2][16];
#pragma unroll
            for (int p = 0; p < 2; ++p) {
                f32x16 acc[4];
#pragma unroll
                for (int q = 0; q < 4; ++q)
#pragma unroll
                    for (int i = 0; i < 16; ++i) acc[q][i] = 0.f;
                const bf16* qrow = Q + (size_t)(t0 + l31) * NQ + h * 256 + p * 128 + 8 * hf;
#pragma unroll
                for (int ks = 0; ks < 8; ++ks) {
                    const bf16x8 qf = *(const bf16x8*)(qrow + 16 * ks);
#pragma unroll
                    for (int q = 0; q < 4; ++q) acc[q] = MFMA32(lds_frag16(lds + LP_KEYS + (p * 128 + 32 * q + l31) * KROW + (16 * ks + 8 * hf) * 2), qf, acc[q]);
                }
                float v[64];
#pragma unroll
                for (int q = 0; q < 4; ++q)
#pragma unroll
                    for (int i = 0; i < 16; ++i) v[16 * q + i] = __uint_as_float((__float_as_uint(acc[q][i]) & 0xffffff80u) | (unsigned)(32 * q + crow(i, hf)));
                float mine[16];
                top16_of_64(v, mine);
                float t[16];
#pragma unroll
                for (int i = 0; i < 16; ++i) t[i] = __shfl_xor(mine[i], 32);
#pragma unroll
                for (int i = 0; i < 16; ++i) lst[p][i] = fmaxf(mine[i], t[15 - i]);
                bitonic_merge16_desc(lst[p]);
            }
            LAS unsigned char* lut = lds + LP_LUT + wave * 1024 + l31 * 32;
            {
                v4u wa, wb;
#pragma unroll
                for (int c = 0; c < 4; ++c) {
                    wa[c] = (__float_as_uint(lst[0][4 * c]) & 0x7fu) | ((__float_as_uint(lst[0][4 * c + 1]) & 0x7fu) << 8) | ((__float_as_uint(lst[0][4 * c + 2]) & 0x7fu) << 16) | ((__float_as_uint(lst[0][4 * c + 3]) & 0x7fu) << 24);
                    wb[c] = (__float_as_uint(lst[1][4 * c]) & 0x7fu) | ((__float_as_uint(lst[1][4 * c + 1]) & 0x7fu) << 8) | ((__float_as_uint(lst[1][4 * c + 2]) & 0x7fu) << 16) | ((__float_as_uint(lst[1][4 * c + 3]) & 0x7fu) << 24);
                }
                if (hf == 0) { *(LAS v4u*)lut = wa; *(LAS v4u*)(lut + 16) = wb; }
            }
            float cv[64];
            {
                int c = 0;
#pragma unroll
                for (int i = 0; i < 16; ++i)
#pragma unroll
                    for (int j = 0; j < 16; ++j)
                        if ((i + 1) * (j + 1) <= 16) {
                            const float sa = __uint_as_float(__float_as_uint(lst[0][i]) & 0xffffff80u), sb = __uint_as_float(__float_as_uint(lst[1][j]) & 0xffffff80u);
                            cv[c] = __uint_as_float((__float_as_uint(sa + sb) & 0xffffff00u) | (unsigned)(i * 16 + j)); ++c;
                        }
#pragma unroll
                for (int k = 50; k < 64; ++k) cv[k] = -3.0e38f;
            }
            float best[16];
            top16_of_64(cv, best);
            const float rstd = *(const LAS float*)(lds + LP_RSTD + l31 * 4);
            const float s0 = __uint_as_float(__float_as_uint(best[0]) & 0xffffff00u);
            float ev[16], esum = 0.f;
#pragma unroll
            for (int k = 0; k < 16; ++k) { const float sk = __uint_as_float(__float_as_uint(best[k]) & 0xffffff00u); ev[k] = __expf(rstd * (sk - s0)); esum += ev[k]; }
            const float einv = 1.0f / esum;
            LDS_WAIT();
            asm volatile("" ::: "memory");
            if (hf == 0) {
                v4u w[4];
#pragma unroll
                for (int k = 0; k < 16; ++k) { const unsigned code = __float_as_uint(best[k]) & 0xffu;
                    const unsigned ia = *(const LAS unsigned char*)(lut + (code >> 4)), ib = *(const LAS unsigned char*)(lut + 16 + (code & 15u));
                    w[k >> 2][k & 3] = ia * 128u + ib; }
#pragma unroll
                for (int c = 0; c < 4; ++c) *(LAS v4u*)(lds + LP_EID + (l31 * 128 + h * 16 + 4 * c) * 4) = w[c];
            } else {
#pragma unroll
                for (int c = 0; c < 4; ++c) *(LAS f32x4*)(lds + LP_EG + (l31 * 128 + h * 16 + 4 * c) * 4) = (f32x4){ev[4 * c] * einv, ev[4 * c + 1] * einv, ev[4 * c + 2] * einv, ev[4 * c + 3] * einv};
            }
        }
        __syncthreads();
#pragma unroll 1
        for (int q = 0; q < 4; ++q) {
            const int tl = 4 * wave + q; const size_t tok = (size_t)t0 + tl;
            float* xr = X + tok * D;
            float xv[16];
            { const f32x4 x0 = *(const f32x4*)(xr + 8 * lane), x1 = *(const f32x4*)(xr + 8 * lane + 4), x2 = *(const f32x4*)(xr + 512 + 8 * lane), x3 = *(const f32x4*)(xr + 512 + 8 * lane + 4);
#pragma unroll
              for (int u = 0; u < 4; ++u) { xv[u] = x0[u]; xv[4 + u] = x1[u]; xv[8 + u] = x2[u]; xv[12 + u] = x3[u]; } }
            const float rstd = *(const LAS float*)(lds + LP_RSTD + tl * 4);
            unsigned hb[8];
#pragma unroll
            for (int u = 0; u < 8; ++u) hb[u] = pk2(xv[2 * u] * rstd * gw[2 * u], xv[2 * u + 1] * rstd * gw[2 * u + 1]);
            const unsigned id_lo = *(const LAS unsigned*)(lds + LP_EID + (tl * 128 + lane) * 4), id_hi = *(const LAS unsigned*)(lds + LP_EID + (tl * 128 + 64 + lane) * 4);
            LAS float* actw = (LAS float*)(lds + LP_ACT + wave * 512);
            const int jmine = ((lane >> 5) & 1) * 8 + ((lane >> 4) & 1) * 4 + ((lane >> 3) & 1) * 2 + ((lane >> 2) & 1);
#pragma unroll 1
            for (int bt = 0; bt < 8; ++bt) {
                float d[16];
#pragma unroll
                for (int hb2 = 0; hb2 < 2; ++hb2) {
                    v4u ua[8], ub[8];
#pragma unroll
                    for (int j = 0; j < 8; ++j) {
                        const int k = 16 * bt + 8 * hb2 + j;
                        const unsigned e = __builtin_amdgcn_readlane((bt < 4) ? id_lo : id_hi, k & 63);
                        const bf16* ur = UB + (size_t)e * D + 8 * lane;
                        ua[j] = *(const v4u*)ur; ub[j] = *(const v4u*)(ur + 512);
                    }
#pragma unroll
                    for (int j = 0; j < 8; ++j) {
                        float s = 0.f;
#pragma unroll
                        for (int u = 0; u < 4; ++u) { const unsigned wa = ua[j][u], wb = ub[j][u]; s = dot2u(hb[u], wa, s); s = dot2u(hb[4 + u], wb, s); }
                        d[8 * hb2 + j] = s;
                    }
                }
                float d8[8], d4[4], d2[2], d1;
                { const bool hi = (lane & 32) != 0;
#pragma unroll
                  for (int j = 0; j < 8; ++j) { const float keep = hi ? d[j + 8] : d[j], send = hi ? d[j] : d[j + 8]; d8[j] = keep + __shfl_xor(send, 32); } }
                { const bool hi = (lane & 16) != 0;
#pragma unroll
                  for (int j = 0; j < 4; ++j) { const float keep = hi ? d8[j + 4] : d8[j], send = hi ? d8[j] : d8[j + 4]; d4[j] = keep + __shfl_xor(send, 16); } }
                { const bool hi = (lane & 8) != 0;
#pragma unroll
                  for (int j = 0; j < 2; ++j) { const float keep = hi ? d4[j + 2] : d4[j], send = hi ? d4[j] : d4[j + 2]; d2[j] = keep + __shfl_xor(send, 8); } }
                { const bool hi = (lane & 4) != 0; const float keep = hi ? d2[1] : d2[0], send = hi ? d2[0] : d2[1]; d1 = keep + __shfl_xor(send, 4); }
                d1 += __shfl_xor(d1, 1); d1 += __shfl_xor(d1, 2);
                const float gt = *(const LAS float*)(lds + LP_EG + (tl * 128 + 16 * bt + jmine) * 4);
                if ((lane & 3) == 0) actw[16 * bt + jmine] = gelu_erf(d1) * gt;
            }
            LDS_WAIT(); asm volatile("" ::: "memory");
            const float act_lo = actw[lane], act_hi = actw[64 + lane];
            float y[16];
#pragma unroll
            for (int u = 0; u < 16; ++u) y[u] = 0.f;
#pragma unroll 1
            for (int kb = 0; kb < 16; ++kb) {
                v4u va[8], vb[8];
#pragma unroll
                for (int j = 0; j < 8; ++j) {
                    const int k = 8 * kb + j;
                    const unsigned e = __builtin_amdgcn_readlane((kb < 8) ? id_lo : id_hi, k & 63);
                    const bf16* vr = VB + (size_t)e * D + 8 * lane;
                    va[j] = *(const v4u*)vr; vb[j] = *(const v4u*)(vr + 512);
                }
#pragma unroll
                for (int j = 0; j < 8; ++j) {
                    const int k = 8 * kb + j;
                    const float ak = __uint_as_float(__builtin_amdgcn_readlane(__float_as_uint((kb < 8) ? act_lo : act_hi), k & 63));
#pragma unroll
                    for (int u = 0; u < 4; ++u) { y[2 * u] += ak * bf_lo(va[j][u]); y[2 * u + 1] += ak * bf_hi(va[j][u]); y[8 + 2 * u] += ak * bf_lo(vb[j][u]); y[8 + 2 * u + 1] += ak * bf_hi(vb[j][u]); }
                }
            }
            float ss = 0.f;
#pragma unroll
            for (int u = 0; u < 16; ++u) { xv[u] += y[u]; ss += xv[u] * xv[u]; }
            ss = wave_sum(ss);
            *(f32x4*)(xr + 8 * lane) = (f32x4){xv[0], xv[1], xv[2], xv[3]}; *(f32x4*)(xr + 8 * lane + 4) = (f32x4){xv[4], xv[5], xv[6], xv[7]};
            *(f32x4*)(xr + 512 + 8 * lane) = (f32x4){xv[8], xv[9], xv[10], xv[11]}; *(f32x4*)(xr + 512 + 8 * lane + 4) = (f32x4){xv[12], xv[13], xv[14], xv[15]};
            v4u w0, w1;
            w0.x = pk2(xv[0], xv[1]); w0.y = pk2(xv[2], xv[3]); w0.z = pk2(xv[4], xv[5]); w0.w = pk2(xv[6], xv[7]);
            w1.x = pk2(xv[8], xv[9]); w1.y = pk2(xv[10], xv[11]); w1.z = pk2(xv[12], xv[13]); w1.w = pk2(xv[14], xv[15]);
            *(v4u*)(XB2 + tok * D + 8 * lane) = w0; *(v4u*)(XB2 + tok * D + 512 + 8 * lane) = w1;
            if (lane == 0) RSTD2[tok] = 1.0f / sqrtf(ss * (1.0f / D) + 1e-6f);
        }
        __syncthreads();
    }
}

__global__ void __launch_bounds__(NTHR, 2) mk_fwd(Args a) {
    extern __shared__ __attribute__((aligned(16))) unsigned char lds_raw[];
    LAS unsigned char* lds = (LAS unsigned char*)lds_raw;
    const int tid = threadIdx.x, lane = tid & 63, wave = __builtin_amdgcn_readfirstlane(tid >> 6);
    const int G = gridDim.x, bx = blockIdx.x, vcu = (G % 8 == 0) ? (bx % 8) * (G / 8) + bx / 8 : bx;
    volatile LAS unsigned* MISC = (volatile LAS unsigned*)(lds + MISC_OFF);
    if (tid < 64) MISC[tid] = 0u;
    __syncthreads();
    unsigned char* ws = a.ws;
    const int lo = a.ph_lo, hi = a.ph_hi;
    XcdBarrier bar; bar.bar = (unsigned*)(ws + WS_CTL) + CW_BAR + a.li * XCD_BAR_WORDS; bar.x = 0; bar.st = nullptr;
    if (hi - lo > 1) bar = xcd_barrier_post((unsigned*)(ws + WS_CTL) + CW_BAR + a.li * XCD_BAR_WORDS, MISC + 8);
#define IN(k) (lo <= (k) && (k) < hi)
#define BOTH(k) (IN(k) && IN((k) + 1))
    if (IN(0)) { p0_prologue(a, lds, vcu, G, tid, lane, wave); if (BOTH(0)) xcd_barrier(bar); }
    if (IN(1)) {
        { pg8::Gemm g{(const bf16*)(ws + WS_R1), (const bf16*)(ws + WS_WIN), T, NIN, D}; pg8::StaticOrder S; S.init(T, NIN, G, bx);
          EpiStoreBf16 E{(bf16*)(ws + WS_R2), NIN};
          pg8::gemm_phase<EpiStoreBf16, pg8::StaticOrder, true, true>(lds, g, S, E); }
        { pg8::Gemm g{(const bf16*)(ws + WS_PB), (const bf16*)(ws + WS_WP), T, D, PLE}; pg8::StaticOrder S; S.init(T, D, G, bx);
          EpiStoreBf16 E{(bf16*)(ws + WS_PP), D};
          pg8::gemm_phase<EpiStoreBf16, pg8::StaticOrder, true, true>(lds, g, S, E); }
        if (BOTH(1)) xcd_barrier(bar);
    }
    if (IN(2)) { p2_mixing(a, lds, bx, G, tid, lane, wave); if (BOTH(2)) xcd_barrier(bar); }
    if (IN(3)) {
        pg8::Gemm g{(const bf16*)(ws + WS_R1), (const bf16*)(ws + WS_WOUT), T, D, D}; pg8::StaticOrder S; S.init(T, D, G, bx);
        EpiResid E{a.in[0], a.out, (bf16*)(ws + WS_R2)};
        pg8::gemm_phase<EpiResid, pg8::StaticOrder, true, true>(lds, g, S, E);
        if (BOTH(3)) xcd_barrier(bar);
    }
    if (IN(4)) {
        pg8::Gemm g{(const bf16*)(ws + WS_R2), (const bf16*)(ws + WS_WQ), T, NQ, D}; pg8::StaticOrder S; S.init(T, NQ, G, bx);
        EpiStoreBf16 E{(bf16*)(ws + WS_R2 + 64 * MB), NQ};
        pg8::gemm_phase<EpiStoreBf16, pg8::StaticOrder, true, true>(lds, g, S, E);
        if (BOTH(4)) xcd_barrier(bar);
    }
    if (IN(5)) { p5_peer(a, lds, vcu, G, tid, lane, wave); if (BOTH(5)) xcd_barrier(bar); }
    if (IN(6)) {
        pg8::Gemm g{(const bf16*)(ws + WS_R1), (const bf16*)(ws + WS_WG), T, D, D}; pg8::StaticOrder S; S.init(T, D, G, bx);
        EpiGate E{a.out, (const bf16*)(ws + WS_PP), (const float*)(ws + WS_RSTD2)};
        pg8::gemm_phase<EpiGate, pg8::StaticOrder, true, true>(lds, g, S, E);
    }
#undef IN
#undef BOTH
}
}
extern "C" void kernel_launch(void* const* d_in, const int* in_sizes, int n_in, void* d_out, int out_size, void* d_ws, size_t ws_size, hipStream_t stream) {
    using namespace mk;
    static int grid = 0;
    if (grid == 0) {
        int dev = 0, cus = 0;
        if (n_in != 16 || out_size != T * D || ws_size < WS_END) { fprintf(stderr, "kernel_launch: unexpected problem shape / workspace (%d inputs, out %d, ws %zu)\n", n_in, out_size, ws_size); grid = -1; return; }
        if (hipGetDevice(&dev) != hipSuccess || hipDeviceGetAttribute(&cus, hipDeviceAttributeMultiprocessorCount, dev) != hipSuccess) { fprintf(stderr, "device query failed\n"); grid = -1; return; }
        if (hipFuncSetAttribute((const void*)mk_fwd, hipFuncAttributeMaxDynamicSharedMemorySize, LDS_BYTES) != hipSuccess) { fprintf(stderr, "hipFuncSetAttribute failed\n"); grid = -1; return; }
        int per_cu = 0;
        if (hipOccupancyMaxActiveBlocksPerMultiprocessor(&per_cu, (const void*)mk_fwd, NTHR, LDS_BYTES) != hipSuccess || per_cu < 1) { fprintf(stderr, "occupancy query: %d blocks per CU\n", per_cu); (void)hipGetLastError(); }
        grid = cus;
    }
    if (grid < 0) return;
    unsigned char* ws = (unsigned char*)d_ws;
    (void)hipMemsetAsync(ws + WS_CTL, 0, CTL_BYTES, stream);
    Args a{};
    for (int i = 0; i < 16; ++i) a.in[i] = (const float*)d_in[i];
    a.out = (float*)d_out; a.ws = ws; a.ph_lo = 0; a.ph_hi = 7; a.li = 0; a.pad = 0;
    hipLaunchKernelGGL(mk_fwd, dim3(grid), dim3(NTHR), LDS_BYTES, stream, a);
}
```

```cpp
#include <hip/hip_runtime.h>
#include <cstdio>
#include <cstdint>
#define LAS __attribute__((address_space(3)))
#define GAS __attribute__((address_space(1)))
namespace pg8 {
#define PG8_LAS __attribute__((address_space(3)))
typedef unsigned short bf16_t;
typedef short bf16x8 __attribute__((ext_vector_type(8)));
typedef float f32x4 __attribute__((ext_vector_type(4)));
typedef unsigned u32x4 __attribute__((ext_vector_type(4)));
constexpr int BM = 256, BK = 64, HALF = 128, HTB = HALF * BK * 2  , STAGE_BYTES = 8 * HTB, NXCD = 8, WGM = 8;

__host__ __device__ __forceinline__ int lds_byte(int r, int c) { const int st = (r >> 4) * 2 + (c >> 5), rr = r & 15, cc = c & 31, ob = rr * 64 + cc * 2; return st * 1024 + (ob ^ (((ob >> 9) & 1) << 5)); }
__host__ __device__ __forceinline__ void stage_rc(int b, int& R, int& C) { const int st = b / 1024, sb = b % 1024, swz = sb ^ (((sb >> 9) & 1) << 5); R = (st >> 1) * 16 + swz / 64; C = (st & 1) * 32 + (swz % 64) / 2; }
__host__ __device__ __forceinline__ int perm32(int rho) { const int n = rho >> 4, i = rho & 15; return 8 * (i >> 2) + 4 * n + (i & 3); }

struct Unit { int pm, pn; };
struct Gemm { const bf16_t* A; const bf16_t* Bt; int M, N, K; };

struct StaticOrder {
    int nM, nN, nwg, G, c;
    __host__ __device__ void init(int M, int N, int G_, int c_) { nM = M / BM; nN = N / BM; nwg = nM * nN; G = G_; c = c_; }
    __host__ __device__ bool next(int i, Unit& u) const {
        const long L = (long)i * G + c; if (L >= nwg) return false;
        int wgid = (int)L; { const int q = nwg / NXCD, r = nwg % NXCD, xcd = wgid % NXCD, off = wgid / NXCD; wgid = (xcd < r ? xcd * (q + 1) : r * (q + 1) + (xcd - r) * q) + off; }
        const int nig = WGM * nN, gid = wgid / nig, fm = gid * WGM, gsz = (nM - fm) < WGM ? (nM - fm) : WGM;
        u.pm = fm + ((wgid % nig) % gsz); u.pn = (wgid % nig) / gsz; return true;
    }
    __device__ __forceinline__ void a_ready(const Unit&) const {}
    __device__ __forceinline__ void done(const Unit&) const {}
};
__device__ __forceinline__ unsigned cvt_pk_bf16(float lo, float hi) { unsigned r; asm volatile("v_cvt_pk_bf16_f32 %0, %1, %2" : "=v"(r) : "v"(lo), "v"(hi)); return r; }
template <class Epi, class Sched, bool ALIGN_EPI = false, bool SP2 = false>
__device__ __forceinline__ void gemm_phase(PG8_LAS unsigned char* lds, const Gemm g, const Sched& S, const Epi& E) {
    const int tid = threadIdx.x, wid = __builtin_amdgcn_readfirstlane(tid >> 6), lane = tid & 63, wr = wid >> 2, wc = wid & 3, fr = lane & 15, fq = lane >> 4;
    const int K = g.K, nt = K / BK;
    unsigned voffA[2], voffB[2];
#pragma unroll
    for (int i = 0; i < 2; ++i) { int R, C; stage_rc(tid * 16 + i * 8192, R, C); const int Rb = Epi::PERM ? ((R & ~31) + perm32(R & 31)) : R;
        voffA[i] = (unsigned)(R * K + C) * 2u; voffB[i] = (unsigned)(Rb * K + C) * 2u; }
    const size_t kstep = (size_t)(BK * 2);
    const size_t hstep = (size_t)HALF * K * 2;
    const size_t tstep = 2 * hstep;
    const unsigned ldsw = (unsigned)wid * 1024u;
    const int aoff = lds_byte(wr * 64 + fr, fq * 8), boff = lds_byte(wc * 32 + fr, fq * 8);
#define PG8_SA(b, h) (((b) * 2 + (h)) * HTB)
#define PG8_SB(b, h) ((4 + (b) * 2 + (h)) * HTB)
#define PG8_STAGE(bufoff, gbase, voff) do { _Pragma("unroll") for (int _i = 0; _i < 2; ++_i) \
        __builtin_amdgcn_global_load_lds((const unsigned*)((const char*)(gbase) + (voff)[_i]), (PG8_LAS unsigned*)(lds + (bufoff) + ldsw + _i * 8192), 16, 0, 0); } while (0)
#define PG8_LDA(dst, b, h) do { _Pragma("unroll") for (int m = 0; m < 4; ++m) _Pragma("unroll") for (int k = 0; k < 2; ++k) dst[m][k] = *(const PG8_LAS bf16x8*)(lds + PG8_SA(b, h) + aoff + m * 2048 + k * 1024); } while (0)
#define PG8_LDB(dst, b, h) do { _Pragma("unroll") for (int n = 0; n < 2; ++n) _Pragma("unroll") for (int k = 0; k < 2; ++k) dst[n][k] = *(const PG8_LAS bf16x8*)(lds + PG8_SB(b, h) + boff + n * 2048 + k * 1024); } while (0)
#define PG8_MMA(ai, bj, At, Bt) do { __builtin_amdgcn_s_setprio(1); _Pragma("unroll") for (int m = 0; m < 4; ++m) _Pragma("unroll") for (int n = 0; n < 2; ++n) _Pragma("unroll") for (int k = 0; k < 2; ++k) \
        acc[ai][bj][m][n] = __builtin_amdgcn_mfma_f32_16x16x32_bf16(Bt[n][k], At[m][k], acc[ai][bj][m][n], 0, 0, 0); __builtin_amdgcn_s_setprio(0); } while (0)
#define PG8_WAIT_V(n) asm volatile("s_waitcnt vmcnt(" #n ")" ::: "memory")
#define PG8_WAIT_L(n) asm volatile("s_waitcnt lgkmcnt(" #n ")" ::: "memory")
#define PG8_BAR __builtin_amdgcn_s_barrier()
#define PG8_SCHED __builtin_amdgcn_sched_barrier(0)
    Unit cur, nxt; int ui = 0;
    if (!S.next(0, cur)) return;
    f32x4 acc[2][2][4][2];
#pragma unroll
    for (int a = 0; a < 2; ++a)
#pragma unroll
        for (int b = 0; b < 2; ++b)
#pragma unroll
            for (int m = 0; m < 4; ++m)
#pragma unroll
                for (int n = 0; n < 2; ++n) acc[a][b][m][n] = (f32x4){0.f, 0.f, 0.f, 0.f};
    bf16x8 At[4][2], B0[2][2], B1[2][2];
    const char* cA = (const char*)g.A + (size_t)cur.pm * tstep; const char* cB = (const char*)g.Bt + (size_t)cur.pn * tstep;
    S.a_ready(cur);
    if constexpr (SP2) {
        PG8_STAGE(PG8_SB(0, 0), cB, voffB); PG8_STAGE(PG8_SB(0, 1), cB + hstep, voffB); PG8_STAGE(PG8_SA(0, 0), cA, voffA); PG8_STAGE(PG8_SA(0, 1), cA + hstep, voffA);
        if (wr == 1) PG8_BAR;
        PG8_WAIT_V(2); PG8_BAR;
        PG8_STAGE(PG8_SB(1, 0), cB + kstep, voffB); PG8_STAGE(PG8_SA(1, 0), cA + kstep, voffA); PG8_STAGE(PG8_SB(1, 1), cB + hstep + kstep, voffB);
        PG8_WAIT_V(6); PG8_BAR;
    } else {
        PG8_STAGE(PG8_SB(0, 0), cB, voffB); PG8_STAGE(PG8_SA(0, 0), cA, voffA); PG8_STAGE(PG8_SB(0, 1), cB + hstep, voffB); PG8_STAGE(PG8_SA(0, 1), cA + hstep, voffA);
        if (wr == 1) PG8_BAR;
        PG8_WAIT_V(4); PG8_BAR;
        PG8_STAGE(PG8_SB(1, 0), cB + kstep, voffB); PG8_STAGE(PG8_SA(1, 0), cA + kstep, voffA); PG8_STAGE(PG8_SB(1, 1), cB + hstep + kstep, voffB);
        PG8_WAIT_V(6); PG8_BAR;
    }
    for (;;) {
        const bool has_next = S.next(ui + 1, nxt);
        const char* nA = has_next ? (const char*)g.A + (size_t)nxt.pm * tstep : cA; const char* nB = has_next ? (const char*)g.Bt + (size_t)nxt.pn * tstep : cB;
        for (int t = 0; t < nt; t += 2) {
            const bool last = (t == nt - 2);
            const char* a1 = cA + (size_t)(t + 1) * kstep;
            const char* a2 = last ? nA : cA + (size_t)(t + 2) * kstep; const char* b2 = last ? nB : cB + (size_t)(t + 2) * kstep;
            const char* a3 = a2 + kstep; const char* b3 = b2 + kstep;
            if (last && has_next) S.a_ready(nxt);
            if constexpr (SP2) {
            PG8_LDB(B0, 0, 0); PG8_LDB(B1, 0, 1); PG8_SCHED; PG8_LDA(At, 0, 0); PG8_STAGE(PG8_SA(1, 1), a1 + hstep, voffA);
            PG8_WAIT_V(8); PG8_WAIT_L(0); PG8_BAR; PG8_MMA(0, 0, At, B0); PG8_MMA(0, 1, At, B1); PG8_BAR; PG8_SCHED;
            PG8_LDA(At, 0, 1); PG8_STAGE(PG8_SB(0, 0), b2, voffB); PG8_STAGE(PG8_SB(0, 1), b2 + hstep, voffB); PG8_STAGE(PG8_SA(0, 0), a2, voffA);
            PG8_WAIT_V(8); PG8_WAIT_L(0); PG8_BAR; PG8_MMA(1, 0, At, B0); PG8_MMA(1, 1, At, B1); PG8_BAR; PG8_SCHED;
            PG8_LDB(B0, 1, 0); PG8_LDB(B1, 1, 1); PG8_SCHED; PG8_LDA(At, 1, 0); PG8_STAGE(PG8_SA(0, 1), a2 + hstep, voffA);
            PG8_WAIT_V(8); PG8_WAIT_L(0); PG8_BAR; PG8_MMA(0, 0, At, B0); PG8_MMA(0, 1, At, B1); PG8_BAR; PG8_SCHED;
            PG8_LDA(At, 1, 1); PG8_STAGE(PG8_SB(1, 0), b3, voffB); PG8_STAGE(PG8_SB(1, 1), b3 + hstep, voffB); PG8_STAGE(PG8_SA(1, 0), a3, voffA);
            PG8_WAIT_V(8); PG8_WAIT_L(0); PG8_BAR; PG8_MMA(1, 0, At, B0); PG8_MMA(1, 1, At, B1); PG8_BAR; PG8_SCHED;
            } else {
            PG8_LDB(B0, 0, 0); PG8_SCHED; PG8_LDA(At, 0, 0); PG8_STAGE(PG8_SA(1, 1), a1 + hstep, voffA);
            PG8_WAIT_L(8); PG8_BAR; PG8_WAIT_L(0); PG8_MMA(0, 0, At, B0); PG8_BAR; PG8_SCHED;
            PG8_LDB(B1, 0, 1); PG8_STAGE(PG8_SB(0, 0), b2, voffB);
            PG8_BAR; PG8_WAIT_L(0); PG8_MMA(0, 1, At, B1); PG8_BAR;
            PG8_LDA(At, 0, 1); PG8_STAGE(PG8_SA(0, 0), a2, voffA);
            PG8_BAR; PG8_WAIT_L(0); PG8_MMA(1, 0, At, B0); PG8_BAR; PG8_SCHED;
            PG8_STAGE(PG8_SB(0, 1), b2 + hstep, voffB);
            PG8_WAIT_V(6); PG8_BAR; PG8_MMA(1, 1, At, B1); PG8_BAR;
            PG8_LDB(B0, 1, 0); PG8_SCHED; PG8_LDA(At, 1, 0); PG8_STAGE(PG8_SA(0, 1), a2 + hstep, voffA);
            PG8_WAIT_L(8); PG8_BAR; PG8_WAIT_L(0); PG8_MMA(0, 0, At, B0); PG8_BAR; PG8_SCHED;
            PG8_LDB(B1, 1, 1); PG8_STAGE(PG8_SB(1, 0), b3, voffB);
            PG8_BAR; PG8_WAIT_L(0); PG8_MMA(0, 1, At, B1); PG8_BAR;
            PG8_LDA(At, 1, 1); PG8_STAGE(PG8_SA(1, 0), a3, voffA);
            PG8_BAR; PG8_WAIT_L(0); PG8_MMA(1, 0, At, B0); PG8_BAR; PG8_SCHED;
            PG8_STAGE(PG8_SB(1, 1), b3 + hstep, voffB);
            PG8_WAIT_V(6); PG8_BAR; PG8_MMA(1, 1, At, B1); PG8_BAR;
            }
        }
        if constexpr (ALIGN_EPI) { if (wr == 0) PG8_BAR; }
        if constexpr (!Epi::AFTER_DRAIN) { E(acc, cur, wr, wc, fr, fq); S.done(cur); }
        if (!has_next) break;
#pragma unroll
        for (int a = 0; a < 2; ++a)
#pragma unroll
            for (int b = 0; b < 2; ++b)
#pragma unroll
                for (int m = 0; m < 4; ++m)
#pragma unroll
                    for (int n = 0; n < 2; ++n) acc[a][b][m][n] = (f32x4){0.f, 0.f, 0.f, 0.f};
        cur = nxt; cA = nA; cB = nB; ++ui;
        if constexpr (ALIGN_EPI) { if (wr == 1) PG8_BAR; }
    }
    PG8_WAIT_V(0);
    if constexpr (!ALIGN_EPI) { if (wr == 0) PG8_BAR; }
    PG8_BAR;
    if constexpr (Epi::AFTER_DRAIN) { E.fused(acc, cur, wr, wc, fr, fq, lds, wid, lane); S.done(cur); }
#undef PG8_SA
#undef PG8_SB
#undef PG8_STAGE
#undef PG8_LDA
#undef PG8_LDB
#undef PG8_MMA
#undef PG8_WAIT_V
#undef PG8_WAIT_L
#undef PG8_BAR
#undef PG8_SCHED
}
}
#define XB_TMO      128
#define XB_XCNT(j)  (256  + 64 * (j))
#define XB_XSUB(j)  (1280 + 64 * (j))
#define XB_XGEN(j)  (2304 + 64 * (j))
#define XB_TOP      3328
#define XB_TOPGEN   3392
#define XCD_BAR_WORDS 3456
#define XB_SPIN_CAP (1u << 18)

__device__ __forceinline__ unsigned xb_ld(unsigned* p)              { return __hip_atomic_load(p, __ATOMIC_RELAXED, __HIP_MEMORY_SCOPE_AGENT); }
__device__ __forceinline__ unsigned xb_add(unsigned* p, unsigned v) { return __hip_atomic_fetch_add(p, v, __ATOMIC_RELAXED, __HIP_MEMORY_SCOPE_AGENT); }
__device__ __forceinline__ unsigned xb_xcc_id() { return (unsigned)__builtin_amdgcn_s_getreg((3 << 11) | 20) & 0xFu; }
#define XB_SPIN(cond, bar) do { unsigned _sp = 0; while (cond) { __builtin_amdgcn_s_sleep(1); \
    if ((++_sp & 255u) == 0u) { if (xb_ld(&(bar)[XB_TMO])) break; if (_sp > XB_SPIN_CAP) { atomicAdd(&(bar)[XB_TMO], 1u); break; } } } } while (0)

struct XcdBarrier {
    unsigned* bar; unsigned x;
    volatile LAS unsigned* st;
};

__device__ __forceinline__ XcdBarrier xcd_barrier_post(unsigned* bar, volatile LAS unsigned* st) {
    XcdBarrier b; b.bar = bar; b.x = xb_xcc_id(); b.st = st;
    if (threadIdx.x == 0) (void)xb_add(&bar[XB_XCNT(b.x)], 1u);
    return b;
}
__device__ __forceinline__ void xcd_barrier_complete(unsigned* bar, unsigned x, unsigned& nloc, unsigned& nx) {
    const unsigned G = gridDim.x * gridDim.y * gridDim.z;
    unsigned sum, cnt, mine, sp = 0u;
    for (;;) {
        sum = 0u; cnt = 0u; mine = 0u;
#pragma unroll
        for (unsigned j = 0; j < 16; ++j) { const unsigned c = xb_ld(&bar[XB_XCNT(j)]); sum += c; cnt += (c > 0u) ? 1u : 0u; mine = (j == x) ? c : mine; }
        if (sum == G) break;
        __builtin_amdgcn_s_sleep(1);
        if ((++sp & 255u) == 0u) { if (xb_ld(&bar[XB_TMO])) break; if (sp > XB_SPIN_CAP) { atomicAdd(&bar[XB_TMO], 1u); break; } }
    }
    nloc = mine > 0u ? mine : 1u; nx = cnt > 0u ? cnt : 1u;
}

__device__ __forceinline__ void xcd_barrier(const XcdBarrier& b) {
    asm volatile("s_waitcnt vmcnt(0)" ::: "memory");
    __syncthreads();
    if (threadIdx.x == 0) {
        unsigned* bar = b.bar;
        __builtin_amdgcn_s_waitcnt(0);
        unsigned nloc = b.st[0], nx = b.st[1];
        if (nloc == 0u) { xcd_barrier_complete(bar, b.x, nloc, nx); b.st[0] = nloc; b.st[1] = nx; }
        const unsigned old = xb_add(&bar[XB_XSUB(b.x)], 1u);
        const unsigned gen = old / nloc;
        if (old + 1u == (gen + 1u) * nloc) {
            __builtin_amdgcn_fence(__ATOMIC_RELEASE, "agent");
            asm volatile("s_waitcnt vmcnt(0)" ::: "memory");
            const unsigned og = xb_add(&bar[XB_TOP], 1u);
            const unsigned tg = og / nx;
            if (og + 1u == (tg + 1u) * nx) xb_add(&bar[XB_TOPGEN], 1u);
            else XB_SPIN(xb_ld(&bar[XB_TOPGEN]) == tg, bar);
            __builtin_amdgcn_fence(__ATOMIC_ACQUIRE, "agent");
            xb_add(&bar[XB_XGEN(b.x)], 1u);
            asm volatile("s_waitcnt vmcnt(0)" ::: "memory");
        } else {
            XB_SPIN(xb_ld(&bar[XB_XGEN(b.x)]) == gen, bar);
            __builtin_amdgcn_fence(__ATOMIC_ACQUIRE, "agent");
            asm volatile("s_waitcnt vmcnt(0)" ::: "memory");
        }
    }
    __syncthreads();
}
namespace mk {
typedef unsigned short bf16;
typedef unsigned v4u __attribute__((ext_vector_type(4)));
typedef unsigned v2u __attribute__((ext_vector_type(2)));
typedef float f32x4 __attribute__((ext_vector_type(4)));
typedef float f32x16 __attribute__((ext_vector_type(16)));
typedef short bf16x8 __attribute__((ext_vector_type(8)));
typedef short bf16x4 __attribute__((ext_vector_type(4)));

constexpr int T = 32768, D = 1024, SQ = 4096, NIN = 2816, NQ = 2048, PLE = 256, NEXP = 16384;
constexpr int NWAVES = 8, NTHR = 512;
constexpr int RING_BYTES = 131072, LDS_BYTES = 163840, MISC_OFF = LDS_BYTES - 256;

constexpr size_t MB = 1024 * 1024;
constexpr size_t WS_CTL = 0, CTL_BYTES = 256 * 1024;
constexpr size_t WS_WIN = WS_CTL + CTL_BYTES;
constexpr size_t WS_WOUT = WS_WIN + (size_t)NIN * D * 2;
constexpr size_t WS_WQ = WS_WOUT + (size_t)D * D * 2;
constexpr size_t WS_WG = WS_WQ + (size_t)NQ * D * 2;
constexpr size_t WS_WP = WS_WG + (size_t)D * D * 2;
constexpr size_t WS_KEYS = WS_WP + (size_t)D * PLE * 2;
constexpr size_t WS_ROPE = WS_KEYS + 2 * 128 * 128 * 2;
constexpr size_t WS_RSTD2 = WS_ROPE + 2 * (size_t)SQ * 32 * 4;
constexpr size_t WS_UB = 16 * MB;
constexpr size_t WS_VB = WS_UB + 32 * MB;
constexpr size_t WS_PB = WS_VB + 32 * MB;
constexpr size_t WS_R1 = WS_PB + 16 * MB;
constexpr size_t WS_R2 = WS_R1 + 64 * MB;
constexpr size_t WS_PP = WS_R2 + 192 * MB;
constexpr size_t WS_END = WS_PP + 64 * MB;
static_assert(WS_RSTD2 + (size_t)T * 4 <= WS_UB, "ws map");
constexpr int CW_BAR = 1024;

#define LDS_WAIT() asm volatile("s_waitcnt lgkmcnt(0)" ::: "memory")
#define VM_WAIT() asm volatile("s_waitcnt vmcnt(0)" ::: "memory")
typedef float f32x2 __attribute__((ext_vector_type(2)));
typedef __bf16 b16x2 __attribute__((ext_vector_type(2)));
__device__ __forceinline__ unsigned pk2(float lo, float hi) { const f32x2 v = {lo, hi}; return __builtin_bit_cast(unsigned, __builtin_convertvector(v, b16x2)); }
__device__ __forceinline__ float bf_lo(unsigned w) { return __uint_as_float(w << 16); }
__device__ __forceinline__ float bf_hi(unsigned w) { return __uint_as_float(w & 0xffff0000u); }
__device__ __forceinline__ float wave_sum(float v) {
#pragma unroll
    for (int o = 1; o < 64; o <<= 1) v += __shfl_xor(v, o);
    return v;
}

struct Args { const float* in[16]; float* out; unsigned char* ws; int ph_lo, ph_hi, li, pad; };

struct EpiStoreBf16 {
    static constexpr bool PERM = true, AFTER_DRAIN = false;
    bf16* O; int ldc;
    __device__ __forceinline__ void operator()(const pg8::f32x4 (&acc)[2][2][4][2], const pg8::Unit& u, int wr, int wc, int fr, int fq) const {
        const int row0 = u.pm * 256 + wr * 64 + fr, col0 = u.pn * 256 + wc * 32 + 8 * fq;
#pragma unroll
        for (int ai = 0; ai < 2; ++ai)
#pragma unroll
            for (int m = 0; m < 4; ++m) { bf16* rowp = O + (size_t)(row0 + ai * 128 + m * 16) * ldc + col0;
#pragma unroll
                for (int bj = 0; bj < 2; ++bj) { const pg8::f32x4 v0 = acc[ai][bj][m][0], v1 = acc[ai][bj][m][1];
                    pg8::u32x4 w; w.x = pk2(v0[0], v0[1]); w.y = pk2(v0[2], v0[3]); w.z = pk2(v1[0], v1[1]); w.w = pk2(v1[2], v1[3]);
                    *(pg8::u32x4*)(rowp + bj * 128) = w; } }
    }
};


struct EpiResid {
    static constexpr bool PERM = true, AFTER_DRAIN = false;
    const float* X; float* O; bf16* XB;
    __device__ __forceinline__ void operator()(const pg8::f32x4 (&acc)[2][2][4][2], const pg8::Unit& u, int wr, int wc, int fr, int fq) const {
        const int row0 = u.pm * 256 + wr * 64 + fr, col0 = u.pn * 256 + wc * 32 + 8 * fq;
#pragma unroll
        for (int ai = 0; ai < 2; ++ai)
#pragma unroll
            for (int m = 0; m < 4; ++m) { const size_t off = (size_t)(row0 + ai * 128 + m * 16) * D + col0;
#pragma unroll
                for (int bj = 0; bj < 2; ++bj) { const size_t o2 = off + bj * 128;
                    const pg8::f32x4 v0 = acc[ai][bj][m][0] + *(const pg8::f32x4*)(X + o2), v1 = acc[ai][bj][m][1] + *(const pg8::f32x4*)(X + o2 + 4);
                    *(pg8::f32x4*)(O + o2) = v0; *(pg8::f32x4*)(O + o2 + 4) = v1;
                    pg8::u32x4 w; w.x = pk2(v0[0], v0[1]); w.y = pk2(v0[2], v0[3]); w.z = pk2(v1[0], v1[1]); w.w = pk2(v1[2], v1[3]);
                    *(pg8::u32x4*)(XB + o2) = w; } }
    }
};
struct EpiGate {
    static constexpr bool PERM = true, AFTER_DRAIN = false;
    float* O; const bf16* PP; const float* rstd;
    __device__ __forceinline__ void operator()(const pg8::f32x4 (&acc)[2][2][4][2], const pg8::Unit& u, int wr, int wc, int fr, int fq) const {
        const int row0 = u.pm * 256 + wr * 64 + fr, col0 = u.pn * 256 + wc * 32 + 8 * fq;
#pragma unroll
        for (int ai = 0; ai < 2; ++ai)
#pragma unroll
            for (int m = 0; m < 4; ++m) { const int row = row0 + ai * 128 + m * 16; const size_t off = (size_t)row * D + col0; const pg8::f32x4 q0 = *(const pg8::f32x4*)(rstd + (size_t)row * 8), q1 = *(const pg8::f32x4*)(rstd + (size_t)row * 8 + 4);
                const float rs = 1.0f / sqrtf((((q0[0] + q0[1]) + (q0[2] + q0[3])) + ((q1[0] + q1[1]) + (q1[2] + q1[3]))) * (1.0f / D) + 1e-6f);
#pragma unroll
                for (int bj = 0; bj < 2; ++bj) { const size_t o2 = off + bj * 128;
                    const pg8::u32x4 pw = *(const pg8::u32x4*)(PP + o2);
                    pg8::f32x4 x0 = *(const pg8::f32x4*)(O + o2), x1 = *(const pg8::f32x4*)(O + o2 + 4);
                    const pg8::f32x4 a0 = acc[ai][bj][m][0] * rs, a1 = acc[ai][bj][m][1] * rs;
                    x0[0] += bf_lo(pw.x) / (1.0f + __expf(-a0[0])); x0[1] += bf_hi(pw.x) / (1.0f + __expf(-a0[1])); x0[2] += bf_lo(pw.y) / (1.0f + __expf(-a0[2])); x0[3] += bf_hi(pw.y) / (1.0f + __expf(-a0[3]));
                    x1[0] += bf_lo(pw.z) / (1.0f + __expf(-a1[0])); x1[1] += bf_hi(pw.z) / (1.0f + __expf(-a1[1])); x1[2] += bf_lo(pw.w) / (1.0f + __expf(-a1[2])); x1[3] += bf_hi(pw.w) / (1.0f + __expf(-a1[3]));
                    *(pg8::f32x4*)(O + o2) = x0; *(pg8::f32x4*)(O + o2 + 4) = x1; } }
    }
};

__device__ __forceinline__ void p0_transpose_item(const float* __restrict__ W, const float* __restrict__ gsc, int K, int N, bf16* __restrict__ WT, LAS float* scr, int item, int lane) {
    const int nblk = N / 32, kb = item / nblk, nb = item % nblk, k0 = 64 * kb, n0 = 32 * nb;
#pragma unroll 8
    for (int i = 0; i < 32; ++i) { const int kk = 2 * i + (lane >> 5); float w = W[(size_t)(k0 + kk) * N + n0 + (lane & 31)]; if (gsc) w *= gsc[k0 + kk]; scr[kk * 33 + (lane & 31)] = w; }
    LDS_WAIT(); asm volatile("" ::: "memory");
    const int c = lane & 7;
#pragma unroll
    for (int j = 0; j < 4; ++j) { const int n = (lane >> 3) + 8 * j; const LAS float* s = scr + (8 * c) * 33 + n;
        v4u o; o.x = pk2(s[0 * 33], s[1 * 33]); o.y = pk2(s[2 * 33], s[3 * 33]); o.z = pk2(s[4 * 33], s[5 * 33]); o.w = pk2(s[6 * 33], s[7 * 33]);
        *(v4u*)(WT + (size_t)(n0 + n) * K + k0 + 8 * c) = o; }
    LDS_WAIT(); asm volatile("" ::: "memory");
}
__device__ __forceinline__ void p0_convert(const float* __restrict__ src, bf16* __restrict__ dst, size_t n8, size_t gtid, size_t gthreads) {
    for (size_t i = gtid; i < n8; i += gthreads) {
        const f32x4 a = ((const f32x4*)src)[2 * i], b = ((const f32x4*)src)[2 * i + 1];
        v4u o; o.x = pk2(a[0], a[1]); o.y = pk2(a[2], a[3]); o.z = pk2(b[0], b[1]); o.w = pk2(b[2], b[3]);
        ((v4u*)dst)[i] = o;
    }
}
__device__ __forceinline__ void rms_row_to_bf16(const float* __restrict__ xrow, const float* __restrict__ g, bf16* __restrict__ orow, int lane) {
    const f32x4* xr = (const f32x4*)xrow + lane; const f32x4* gr = (const f32x4*)g + lane;
    f32x4 v[4]; float s = 0.f;
#pragma unroll
    for (int j = 0; j < 4; ++j) { v[j] = xr[64 * j]; s += (v[j][0] * v[j][0] + v[j][1] * v[j][1]) + (v[j][2] * v[j][2] + v[j][3] * v[j][3]); }
    const float rstd = 1.0f / sqrtf(wave_sum(s) * (1.0f / D) + 1e-6f);
    v2u* o8 = (v2u*)orow + lane;
#pragma unroll
    for (int j = 0; j < 4; ++j) { const f32x4 gg = gr[64 * j]; v2u w; w.x = pk2(v[j][0] * rstd * gg[0], v[j][1] * rstd * gg[1]); w.y = pk2(v[j][2] * rstd * gg[2], v[j][3] * rstd * gg[3]); o8[64 * j] = w; }
}

__device__ __forceinline__ void p0_prologue(const Args& a, LAS unsigned char* lds, int vcu, int G, int tid, int lane, int wave) {
    unsigned char* ws = a.ws;
    LAS float* scr = (LAS float*)(lds + wave * 16384);
    const int gw = vcu * NWAVES + wave, NGW = G * NWAVES;
    constexpr int I_IN = (D / 64) * (NIN / 32), I_OUT = (D / 64) * (D / 32), I_Q = (D / 64) * (NQ / 32), I_G = I_OUT, I_P = (PLE / 64) * (D / 32);
    constexpr int NITEMS = I_IN + I_OUT + I_Q + I_G + I_P;
    for (int it = gw; it < NITEMS; it += NGW) {
        int r = it;
        if (r < I_IN) { p0_transpose_item(a.in[3], nullptr, D, NIN, (bf16*)(ws + WS_WIN), scr, r, lane); continue; } r -= I_IN;
        if (r < I_OUT) { p0_transpose_item(a.in[7], nullptr, D, D, (bf16*)(ws + WS_WOUT), scr, r, lane); continue; } r -= I_OUT;
        if (r < I_Q) { p0_transpose_item(a.in[9], a.in[8], D, NQ, (bf16*)(ws + WS_WQ), scr, r, lane); continue; } r -= I_Q;
        if (r < I_G) { p0_transpose_item(a.in[14], a.in[13], D, D, (bf16*)(ws + WS_WG), scr, r, lane); continue; } r -= I_G;
        p0_transpose_item(a.in[15], nullptr, PLE, D, (bf16*)(ws + WS_WP), scr, r, lane);
    }
    const size_t gtid = (size_t)vcu * NTHR + tid, gthreads = (size_t)G * NTHR;
    p0_convert(a.in[10], (bf16*)(ws + WS_KEYS), 2 * 128 * 128 / 8, gtid, gthreads);
    p0_convert(a.in[11], (bf16*)(ws + WS_UB), (size_t)NEXP * D / 8, gtid, gthreads);
    p0_convert(a.in[12], (bf16*)(ws + WS_VB), (size_t)NEXP * D / 8, gtid, gthreads);
    p0_convert(a.in[1], (bf16*)(ws + WS_PB), (size_t)T * PLE / 8, gtid, gthreads);
    for (size_t i = gtid; i < (size_t)SQ * 32; i += gthreads) {
        const int pos = (int)(i >> 5), c = (int)(i & 31);
        const float freq = powf(10000.0f, -(float)c / 32.0f);
        const float ang = (float)pos * freq;
        float sn, cs; sincosf(ang, &sn, &cs);
        ((float*)(ws + WS_ROPE))[i] = cs; ((float*)(ws + WS_ROPE))[(size_t)SQ * 32 + i] = sn;
    }
    for (int m = gw; m < T; m += NGW) rms_row_to_bf16(a.in[0] + (size_t)m * D, a.in[2], (bf16*)(ws + WS_R1) + (size_t)m * D, lane);
}


#define MFMA32(a, b, c) __builtin_amdgcn_mfma_f32_32x32x16_bf16((a), (b), (c), 0, 0, 0)
__device__ __forceinline__ int crow(int r, int hf) { return (r & 3) + 8 * (r >> 2) + 4 * hf; }
__device__ __forceinline__ bf16x8 pack8(float a0, float a1, float a2, float a3, float a4, float a5, float a6, float a7) {
    v4u w; w.x = pk2(a0, a1); w.y = pk2(a2, a3); w.z = pk2(a4, a5); w.w = pk2(a6, a7); return __builtin_bit_cast(bf16x8, w);
}
__device__ __forceinline__ bf16x8 lds_frag16(LAS unsigned char* p) { return *(const LAS bf16x8*)p; }
__device__ __forceinline__ bf16x8 lds_frag8x2(LAS unsigned char* p) {
    const bf16x4 lo = *(const LAS bf16x4*)p, hi = *(const LAS bf16x4*)(p + 16); return __builtin_shufflevector(lo, hi, 0, 1, 2, 3, 4, 5, 6, 7);
}
constexpr int RQ = 144, RT = 272, RV = 528;
constexpr int LR_QS = 0, LR_KS = LR_QS + 128 * RQ, LR_KT = LR_KS + 128 * RQ, LR_VT = LR_KT + 64 * RT, LR_ST = LR_VT + 64 * RT, LR_LN = LR_ST + 64 * RQ, LR_END = LR_LN + 2 * 128 * 8;
static_assert(LR_END <= RING_BYTES, "retention LDS");
__device__ __forceinline__ void ret_unit(const bf16* __restrict__ PROJ, bf16* __restrict__ MIXED, const float* __restrict__ rope, LAS unsigned char* lds,
                                         int b, int h, int c0, int c1, int tid, int lane, int wave) {
    const float gam = 1.0f - exp2f(-5.0f - (float)h), lg2 = log2f(gam), cd = exp2f(lg2 * 128.0f);
    const int l31 = lane & 31, hf = lane >> 5, ib = wave >> 1, et = wave & 1;
    const int r = tid >> 2, qd = tid & 3;
    const float wq = exp2f(lg2 * (float)(r + 1)), wk = exp2f(-lg2 * (float)(r + 1));
    f32x16 stacc;
#pragma unroll
    for (int i = 0; i < 16; ++i) stacc[i] = 0.f;
    for (int i = tid; i < 64 * RQ / 4; i += NTHR) ((LAS unsigned*)(lds + LR_ST))[i] = 0u;
    for (int n = 0; n < c1; ++n) {
        const bool own = n >= c0;
        const int seqpos = n * 128 + r;
        const bf16* pr = PROJ + ((size_t)b * SQ + seqpos) * NIN + h * 64 + 8 * qd;
        const v4u k1 = *(const v4u*)(pr + 512), k2 = *(const v4u*)(pr + 512 + 32);
        const v4u v1 = *(const v4u*)(pr + 1024), v2 = *(const v4u*)(pr + 1024 + 32);
        v4u q1 = {0u, 0u, 0u, 0u}, q2 = {0u, 0u, 0u, 0u};
        if (own) { q1 = *(const v4u*)(pr); q2 = *(const v4u*)(pr + 32); }
        const f32x4 csa = *(const f32x4*)(rope + seqpos * 32 + 8 * qd), csb = *(const f32x4*)(rope + seqpos * 32 + 8 * qd + 4);
        const f32x4 sna = *(const f32x4*)(rope + SQ * 32 + seqpos * 32 + 8 * qd), snb = *(const f32x4*)(rope + SQ * 32 + seqpos * 32 + 8 * qd + 4);
        float cs[8], sn[8];
#pragma unroll
        for (int u = 0; u < 4; ++u) { cs[u] = csa[u]; cs[4 + u] = csb[u]; sn[u] = sna[u]; sn[4 + u] = snb[u]; }
        __syncthreads();
        {
            float o1[8], o2[8];
#pragma unroll
            for (int u = 0; u < 8; ++u) { const unsigned w1 = k1[u >> 1], w2 = k2[u >> 1]; const float x1 = (u & 1) ? bf_hi(w1) : bf_lo(w1), x2 = (u & 1) ? bf_hi(w2) : bf_lo(w2);
                o1[u] = (x1 * cs[u] - x2 * sn[u]) * wk; o2[u] = (x1 * sn[u] + x2 * cs[u]) * wk; }
            if (own) {
                *(LAS bf16x8*)(lds + LR_KS + r * RQ + (8 * qd) * 2) = pack8(o1[0], o1[1], o1[2], o1[3], o1[4], o1[5], o1[6], o1[7]);
                *(LAS bf16x8*)(lds + LR_KS + r * RQ + (32 + 8 * qd) * 2) = pack8(o2[0], o2[1], o2[2], o2[3], o2[4], o2[5], o2[6], o2[7]);
            }
#pragma unroll
            for (int u = 0; u < 8; u += 2) {
                const unsigned a = pk2(o1[u] * 0.125f, o1[u + 1] * 0.125f), c = pk2(o2[u] * 0.125f, o2[u + 1] * 0.125f);
                *(LAS bf16*)(lds + LR_KT + (8 * qd + u) * RT + r * 2) = (bf16)(a & 0xffffu); *(LAS bf16*)(lds + LR_KT + (8 * qd + u + 1) * RT + r * 2) = (bf16)(a >> 16);
                *(LAS bf16*)(lds + LR_KT + (32 + 8 * qd + u) * RT + r * 2) = (bf16)(c & 0xffffu); *(LAS bf16*)(lds + LR_KT + (32 + 8 * qd + u + 1) * RT + r * 2) = (bf16)(c >> 16);
                const unsigned w1 = v1[u >> 1], w2 = v2[u >> 1];
                *(LAS bf16*)(lds + LR_VT + (8 * qd + u) * RT + r * 2) = (bf16)(w1 & 0xffffu); *(LAS bf16*)(lds + LR_VT + (8 * qd + u + 1) * RT + r * 2) = (bf16)(w1 >> 16);
                *(LAS bf16*)(lds + LR_VT + (32 + 8 * qd + u) * RT + r * 2) = (bf16)(w2 & 0xffffu); *(LAS bf16*)(lds + LR_VT + (32 + 8 * qd + u + 1) * RT + r * 2) = (bf16)(w2 >> 16);
            }
            if (own) {
#pragma unroll
                for (int u = 0; u < 8; ++u) { const unsigned w1 = q1[u >> 1], w2 = q2[u >> 1]; const float x1 = (u & 1) ? bf_hi(w1) : bf_lo(w1), x2 = (u & 1) ? bf_hi(w2) : bf_lo(w2);
                    o1[u] = (x1 * cs[u] - x2 * sn[u]) * wq; o2[u] = (x1 * sn[u] + x2 * cs[u]) * wq; }
                *(LAS bf16x8*)(lds + LR_QS + r * RQ + (8 * qd) * 2) = pack8(o1[0], o1[1], o1[2], o1[3], o1[4], o1[5], o1[6], o1[7]);
                *(LAS bf16x8*)(lds + LR_QS + r * RQ + (32 + 8 * qd) * 2) = pack8(o2[0], o2[1], o2[2], o2[3], o2[4], o2[5], o2[6], o2[7]);
            }
        }
        __syncthreads();
        if (own) {
            const size_t orow = (size_t)b * SQ + n * 128 + 32 * ib + l31;
            v2u gv[4];
#pragma unroll
            for (int g = 0; g < 4; ++g) gv[g] = *(const v2u*)(PROJ + orow * NIN + 1536 + h * 64 + 32 * et + 8 * g + 4 * hf);
            bf16x8 qf[4];
#pragma unroll
            for (int ks = 0; ks < 4; ++ks) qf[ks] = lds_frag16(lds + LR_QS + (32 * ib + l31) * RQ + (16 * ks + 8 * hf) * 2);
            f32x16 o;
#pragma unroll
            for (int i = 0; i < 16; ++i) o[i] = 0.f;
#pragma unroll
            for (int ks = 0; ks < 4; ++ks) o = MFMA32(lds_frag16(lds + LR_ST + (32 * et + l31) * RQ + (16 * ks + 8 * hf) * 2), qf[ks], o);
            for (int jb = 0; jb <= ib; ++jb) {
                f32x16 s;
#pragma unroll
                for (int i = 0; i < 16; ++i) s[i] = 0.f;
#pragma unroll
                for (int ks = 0; ks < 4; ++ks) s = MFMA32(lds_frag16(lds + LR_KS + (32 * jb + l31) * RQ + (16 * ks + 8 * hf) * 2), qf[ks], s);
                const bool diag = (jb == ib);
                float p[16];
#pragma unroll
                for (int i = 0; i < 16; ++i) p[i] = (diag && crow(i, hf) > l31) ? 0.f : s[i] * 0.125f;
#pragma unroll
                for (int st = 0; st < 2; ++st) {
                    const bf16x8 pf = pack8(p[8 * st], p[8 * st + 1], p[8 * st + 2], p[8 * st + 3], p[8 * st + 4], p[8 * st + 5], p[8 * st + 6], p[8 * st + 7]);
                    o = MFMA32(lds_frag8x2(lds + LR_VT + (32 * et + l31) * RT + (32 * jb + 16 * st + 4 * hf) * 2), pf, o);
                }
            }
            float s1 = 0.f, s2 = 0.f;
#pragma unroll
            for (int i = 0; i < 16; ++i) { s1 += o[i]; s2 += o[i] * o[i]; }
            s1 += __shfl_xor(s1, 32); s2 += __shfl_xor(s2, 32);
            if (hf == 0) *(LAS f32x2*)(lds + LR_LN + (et * 128 + 32 * ib + l31) * 8) = (f32x2){s1, s2};
            __syncthreads();
            const f32x2 ot = *(const LAS f32x2*)(lds + LR_LN + ((et ^ 1) * 128 + 32 * ib + l31) * 8);
            const float mu = (s1 + ot.x) * (1.0f / 64.0f), var = fmaxf((s2 + ot.y) * (1.0f / 64.0f) - mu * mu, 0.f), rs = 1.0f / sqrtf(var + 1e-6f);
#pragma unroll
            for (int g = 0; g < 4; ++g) {
                float y[4];
#pragma unroll
                for (int u = 0; u < 4; ++u) { const unsigned w = gv[g][u >> 1]; const float gg = (u & 1) ? bf_hi(w) : bf_lo(w); const float sg = gg / (1.0f + __expf(-gg)); y[u] = sg * ((o[4 * g + u] - mu) * rs); }
                v2u w; w.x = pk2(y[0], y[1]); w.y = pk2(y[2], y[3]);
                *(v2u*)(MIXED + orow * D + h * 64 + 32 * et + 8 * g + 4 * hf) = w;
            }
        }
        if (wave < 4) {
            const int se = wave >> 1, sd = wave & 1;
#pragma unroll
            for (int ks = 0; ks < 8; ++ks)
                stacc = MFMA32(lds_frag16(lds + LR_VT + (32 * se + l31) * RT + (16 * ks + 8 * hf) * 2), lds_frag16(lds + LR_KT + (32 * sd + l31) * RT + (16 * ks + 8 * hf) * 2), stacc);
#pragma unroll
            for (int i = 0; i < 16; ++i) stacc[i] *= cd;
#pragma unroll
            for (int i = 0; i < 16; i += 2) { const unsigned w = pk2(stacc[i], stacc[i + 1]);
                *(LAS bf16*)(lds + LR_ST + (32 * se + crow(i, hf)) * RQ + (32 * sd + l31) * 2) = (bf16)(w & 0xffffu);
                *(LAS bf16*)(lds + LR_ST + (32 * se + crow(i + 1, hf)) * RQ + (32 * sd + l31) * 2) = (bf16)(w >> 16); }
        }
    }
    __syncthreads();
}

constexpr int LS_KN = 0, LS_VT = LS_KN + 256 * RQ, LS_QN = LS_VT + 64 * RV, LS_END = LS_QN + 256 * RQ;
static_assert(LS_END <= RING_BYTES, "swa LDS");
__device__ __forceinline__ void swa_unit(const bf16* __restrict__ PROJ, bf16* __restrict__ MIXED, const float* __restrict__ qnw, const float* __restrict__ knw, const float* __restrict__ sinks,
                                         LAS unsigned char* lds, int b, int kvh, int n, int tid, int lane, int wave) {
    const int l31 = lane & 31, hf = lane >> 5;
    const int row = tid >> 1, half = tid & 1;
    {
        const int kpos = (n - 1) * 128 + row; const bool valid = kpos >= 0;
        v4u kk[4], vv[4];
#pragma unroll
        for (int c = 0; c < 4; ++c) { kk[c] = (v4u){0u, 0u, 0u, 0u}; vv[c] = (v4u){0u, 0u, 0u, 0u}; }
        if (valid) { const bf16* pr = PROJ + ((size_t)b * SQ + kpos) * NIN + 32 * half;
#pragma unroll
            for (int c = 0; c < 4; ++c) { kk[c] = *(const v4u*)(pr + 2560 + kvh * 64 + 8 * c); vv[c] = *(const v4u*)(pr + 2688 + kvh * 64 + 8 * c); } }
        float kf[32]; float ss = 0.f;
#pragma unroll
        for (int c = 0; c < 4; ++c)
#pragma unroll
            for (int u = 0; u < 4; ++u) { kf[8 * c + 2 * u] = bf_lo(kk[c][u]); kf[8 * c + 2 * u + 1] = bf_hi(kk[c][u]); }
#pragma unroll
        for (int i = 0; i < 32; ++i) ss += kf[i] * kf[i];
        ss += __shfl_xor(ss, 1);
        const float rstd = 0.125f / sqrtf(ss * (1.0f / 64.0f) + 1e-6f);
#pragma unroll
        for (int c = 0; c < 4; ++c) {
            const f32x4 g0 = *(const f32x4*)(knw + 32 * half + 8 * c), g1 = *(const f32x4*)(knw + 32 * half + 8 * c + 4);
            *(LAS bf16x8*)(lds + LS_KN + row * RQ + (32 * half + 8 * c) * 2) = pack8(kf[8 * c] * rstd * g0[0], kf[8 * c + 1] * rstd * g0[1], kf[8 * c + 2] * rstd * g0[2], kf[8 * c + 3] * rstd * g0[3],
                                                                                  kf[8 * c + 4] * rstd * g1[0], kf[8 * c + 5] * rstd * g1[1], kf[8 * c + 6] * rstd * g1[2], kf[8 * c + 7] * rstd * g1[3]);
#pragma unroll
            for (int u = 0; u < 4; ++u) { const unsigned w = vv[c][u];
                *(LAS bf16*)(lds + LS_VT + (32 * half + 8 * c + 2 * u) * RV + row * 2) = (bf16)(w & 0xffffu); *(LAS bf16*)(lds + LS_VT + (32 * half + 8 * c + 2 * u + 1) * RV + row * 2) = (bf16)(w >> 16); }
        }
    }
    for (int rnd = 0; rnd < 2; ++rnd) {
        {
            const int hs = row >> 7, qrow = row & 127, hq = kvh * 4 + rnd * 2 + hs;
            const bf16* pr = PROJ + ((size_t)b * SQ + n * 128 + qrow) * NIN + 2048 + hq * 64 + 32 * half;
            v4u qq[4];
#pragma unroll
            for (int c = 0; c < 4; ++c) qq[c] = *(const v4u*)(pr + 8 * c);
            float qf[32]; float ss = 0.f;
#pragma unroll
            for (int c = 0; c < 4; ++c)
#pragma unroll
                for (int u = 0; u < 4; ++u) { qf[8 * c + 2 * u] = bf_lo(qq[c][u]); qf[8 * c + 2 * u + 1] = bf_hi(qq[c][u]); }
#pragma unroll
            for (int i = 0; i < 32; ++i) ss += qf[i] * qf[i];
            ss += __shfl_xor(ss, 1);
            const float rstd = 1.0f / sqrtf(ss * (1.0f / 64.0f) + 1e-6f);
#pragma unroll
            for (int c = 0; c < 4; ++c) {
                const f32x4 g0 = *(const f32x4*)(qnw + 32 * half + 8 * c), g1 = *(const f32x4*)(qnw + 32 * half + 8 * c + 4);
                *(LAS bf16x8*)(lds + LS_QN + row * RQ + (32 * half + 8 * c) * 2) = pack8(qf[8 * c] * rstd * g0[0], qf[8 * c + 1] * rstd * g0[1], qf[8 * c + 2] * rstd * g0[2], qf[8 * c + 3] * rstd * g0[3],
                                                                                      qf[8 * c + 4] * rstd * g1[0], qf[8 * c + 5] * rstd * g1[1], qf[8 * c + 6] * rstd * g1[2], qf[8 * c + 7] * rstd * g1[3]);
            }
        }
        __syncthreads();
        {
            const int hs = wave >> 2, ib = wave & 3, hq = kvh * 4 + rnd * 2 + hs;
            bf16x8 qf[4];
#pragma unroll
            for (int ks = 0; ks < 4; ++ks) qf[ks] = lds_frag16(lds + LS_QN + (hs * 128 + 32 * ib + l31) * RQ + (16 * ks + 8 * hf) * 2);
            f32x16 s[5];
#pragma unroll
            for (int t = 0; t < 5; ++t) {
#pragma unroll
                for (int i = 0; i < 16; ++i) s[t][i] = 0.f;
#pragma unroll
                for (int ks = 0; ks < 4; ++ks) s[t] = MFMA32(lds_frag16(lds + LS_KN + (32 * (ib + t) + l31) * RQ + (16 * ks + 8 * hf) * 2), qf[ks], s[t]);
            }
            const float sink = sinks[hq];
            float m = sink;
#pragma unroll
            for (int t = 0; t < 5; ++t)
#pragma unroll
                for (int i = 0; i < 16; ++i) {
                    bool ok = true;
                    if (t == 0) ok = crow(i, hf) > l31;
                    if (t == 4) ok = crow(i, hf) <= l31;
                    if (n == 0 && ib + t < 4) ok = false;
                    s[t][i] = ok ? s[t][i] : -INFINITY;
                    m = fmaxf(m, s[t][i]);
                }
            m = fmaxf(m, __shfl_xor(m, 32));
            float l = 0.f;
#pragma unroll
            for (int t = 0; t < 5; ++t)
#pragma unroll
                for (int i = 0; i < 16; ++i) { s[t][i] = exp2f((s[t][i] - m) * 1.4426950408889634f); l += s[t][i]; }
            l += __shfl_xor(l, 32);
            l += exp2f((sink - m) * 1.4426950408889634f);
            f32x16 o[2];
#pragma unroll
            for (int e2 = 0; e2 < 2; ++e2)
#pragma unroll
                for (int i = 0; i < 16; ++i) o[e2][i] = 0.f;
#pragma unroll
            for (int t = 0; t < 5; ++t)
#pragma unroll
                for (int st = 0; st < 2; ++st) {
                    const bf16x8 pf = pack8(s[t][8 * st], s[t][8 * st + 1], s[t][8 * st + 2], s[t][8 * st + 3], s[t][8 * st + 4], s[t][8 * st + 5], s[t][8 * st + 6], s[t][8 * st + 7]);
#pragma unroll
                    for (int e2 = 0; e2 < 2; ++e2) o[e2] = MFMA32(lds_frag8x2(lds + LS_VT + (32 * e2 + l31) * RV + (32 * (ib + t) + 16 * st + 4 * hf) * 2), pf, o[e2]);
                }
            const float inv = 1.0f / l;
            const size_t orow = (size_t)b * SQ + n * 128 + 32 * ib + l31;
#pragma unroll
            for (int e2 = 0; e2 < 2; ++e2)
#pragma unroll
                for (int g = 0; g < 4; ++g) { v2u w; w.x = pk2(o[e2][4 * g] * inv, o[e2][4 * g + 1] * inv); w.y = pk2(o[e2][4 * g + 2] * inv, o[e2][4 * g + 3] * inv);
                    *(v2u*)(MIXED + orow * D + 512 + hq * 64 + 32 * e2 + 8 * g + 4 * hf) = w; }
        }
        __syncthreads();
    }
}

__device__ __forceinline__ void p2_mixing(const Args& a, LAS unsigned char* lds, int bx, int G, int tid, int lane, int wave) {
    const bf16* PROJ = (const bf16*)(a.ws + WS_R2); bf16* MIXED = (bf16*)(a.ws + WS_R1); const float* rope = (const float*)(a.ws + WS_ROPE);
    for (int u = bx; u < 256; u += G) {
        const int b = u >> 5, h = (u >> 2) & 7, grp = u & 3;
        const int c0 = grp == 0 ? 0 : grp == 1 ? 11 : grp == 2 ? 20 : 27, c1 = grp == 0 ? 11 : grp == 1 ? 20 : grp == 2 ? 27 : 32;
        ret_unit(PROJ, MIXED, rope, lds, b, h, c0, c1, tid, lane, wave);
    }
    for (int su = bx; su < 512; su += G) swa_unit(PROJ, MIXED, a.in[4], a.in[5], a.in[6], lds, su >> 6, (su >> 5) & 1, su & 31, tid, lane, wave);
}


template <int N> __device__ __forceinline__ void bitonic_sort_desc(float (&v)[N]) {
#pragma unroll
    for (int k = 2; k <= N; k <<= 1)
#pragma unroll
        for (int j = k >> 1; j > 0; j >>= 1)
#pragma unroll
            for (int i = 0; i < N; ++i) { const int l = i ^ j; if (l > i) { const bool desc = ((i & k) == 0); const float a = v[i], b = v[l]; const float hi = fmaxf(a, b), lo = fminf(a, b); v[i] = desc ? hi : lo; v[l] = desc ? lo : hi; } }
}
__device__ __forceinline__ void bitonic_merge16_desc(float (&v)[16]) {
#pragma unroll
    for (int j = 8; j > 0; j >>= 1)
#pragma unroll
        for (int i = 0; i < 16; ++i) { const int l = i ^ j; if (l > i) { const float a = v[i], b = v[l]; v[i] = fmaxf(a, b); v[l] = fminf(a, b); } }
}
__device__ __forceinline__ void top16_of_64(float (&v)[64], float (&out)[16]) {
    float b[4][16];
#pragma unroll
    for (int q = 0; q < 4; ++q) {
#pragma unroll
        for (int i = 0; i < 16; ++i) b[q][i] = v[16 * q + i];
        bitonic_sort_desc<16>(b[q]);
    }
    float t0[16], t1[16];
#pragma unroll
    for (int i = 0; i < 16; ++i) { t0[i] = fmaxf(b[0][i], b[1][15 - i]); t1[i] = fmaxf(b[2][i], b[3][15 - i]); }
    bitonic_merge16_desc(t0); bitonic_merge16_desc(t1);
#pragma unroll
    for (int i = 0; i < 16; ++i) out[i] = fmaxf(t0[i], t1[15 - i]);
    bitonic_merge16_desc(out);
}
__device__ __forceinline__ float dot2u(unsigned a, unsigned b, float c) { return __builtin_amdgcn_fdot2_f32_bf16(__builtin_bit_cast(b16x2, a), __builtin_bit_cast(b16x2, b), c, false); }
__device__ __forceinline__ float gelu_erf(float a) { return 0.5f * a * (1.0f + erff(a * 0.70710678118654752f)); }

constexpr int KROW = 272;
constexpr size_t WS_EID = WS_R2, WS_GATE = WS_R2 + 8 * MB, WS_ACT = WS_R2 + 24 * MB, WS_RSS2 = WS_R2 + 40 * MB;
constexpr int LP_KEYS = 0, LP_LUT = LP_KEYS + 256 * KROW, LP_RSTD = LP_LUT + NWAVES * 32 * 32, LP_END = LP_RSTD + 2 * 128;
static_assert(LP_END <= RING_BYTES, "peer LDS");

__device__ __forceinline__ void p5a_topk(const Args& a, LAS unsigned char* lds, int vcu, int G, int tid, int lane, int wave) {
    unsigned char* ws = a.ws;
    const bf16* Q = (const bf16*)(ws + WS_R2 + 64 * MB); const float* X = a.out; bf16* H2B = (bf16*)(ws + WS_R1); const float* gffn = a.in[8];
    unsigned short* EID = (unsigned short*)(ws + WS_EID); float* GATE = (float*)(ws + WS_GATE);
    const int l31 = lane & 31, hf = lane >> 5;
    for (int i = tid; i < 256 * 16; i += NTHR) { const int rr = i >> 4, c = i & 15; *(LAS v4u*)(lds + LP_KEYS + rr * KROW + c * 16) = *(const v4u*)((const bf16*)(ws + WS_KEYS) + rr * 128 + c * 8); }
    float gw[16];
    { const f32x4 g0 = *(const f32x4*)(gffn + 8 * lane), g1 = *(const f32x4*)(gffn + 8 * lane + 4), g2 = *(const f32x4*)(gffn + 512 + 8 * lane), g3 = *(const f32x4*)(gffn + 512 + 8 * lane + 4);
#pragma unroll
      for (int u = 0; u < 4; ++u) { gw[u] = g0[u]; gw[4 + u] = g1[u]; gw[8 + u] = g2[u]; gw[12 + u] = g3[u]; } }
    int par = 0;
    for (int grp = vcu; grp < T / 32; grp += G, par ^= 1) {
        const int t0 = grp * 32;
#pragma unroll 1
        for (int q = 0; q < 4; ++q) {
            const size_t tok = (size_t)t0 + 4 * wave + q; const float* xr = X + tok * D;
            const f32x4 x0 = *(const f32x4*)(xr + 8 * lane), x1 = *(const f32x4*)(xr + 8 * lane + 4), x2 = *(const f32x4*)(xr + 512 + 8 * lane), x3 = *(const f32x4*)(xr + 512 + 8 * lane + 4);
            float ss = 0.f;
#pragma unroll
            for (int u = 0; u < 4; ++u) ss += x0[u] * x0[u] + x1[u] * x1[u] + x2[u] * x2[u] + x3[u] * x3[u];
            ss = wave_sum(ss);
            const float rstd = 1.0f / sqrtf(ss * (1.0f / D) + 1e-6f);
            if (lane == 0) *(LAS float*)(lds + LP_RSTD + par * 128 + (4 * wave + q) * 4) = rstd;
            v4u w0, w1;
            w0.x = pk2(x0[0] * rstd * gw[0], x0[1] * rstd * gw[1]); w0.y = pk2(x0[2] * rstd * gw[2], x0[3] * rstd * gw[3]); w0.z = pk2(x1[0] * rstd * gw[4], x1[1] * rstd * gw[5]); w0.w = pk2(x1[2] * rstd * gw[6], x1[3] * rstd * gw[7]);
            w1.x = pk2(x2[0] * rstd * gw[8], x2[1] * rstd * gw[9]); w1.y = pk2(x2[2] * rstd * gw[10], x2[3] * rstd * gw[11]); w1.z = pk2(x3[0] * rstd * gw[12], x3[1] * rstd * gw[13]); w1.w = pk2(x3[2] * rstd * gw[14], x3[3] * rstd * gw[15]);
            *(v4u*)(H2B + tok * D + 8 * lane) = w0; *(v4u*)(H2B + tok * D + 512 + 8 * lane) = w1;
        }
        __syncthreads();
        {
            const int h = wave;
            float lst[2][16];
#pragma unroll
            for (int p = 0; p < 2; ++p) {
                f32x16 acc[4];
#pragma unroll
                for (int q = 0; q < 4; ++q)
#pragma unroll
                    for (int i = 0; i < 16; ++i) acc[q][i] = 0.f;
                const bf16* qrow = Q + (size_t)(t0 + l31) * NQ + h * 256 + p * 128 + 8 * hf;
#pragma unroll
                for (int ks = 0; ks < 8; ++ks) {
                    const bf16x8 qf = *(const bf16x8*)(qrow + 16 * ks);
#pragma unroll
                    for (int q = 0; q < 4; ++q) acc[q] = MFMA32(lds_frag16(lds + LP_KEYS + (p * 128 + 32 * q + l31) * KROW + (16 * ks + 8 * hf) * 2), qf, acc[q]);
                }
                float v[64];
#pragma unroll
                for (int q = 0; q < 4; ++q)
#pragma unroll
                    for (int i = 0; i < 16; ++i) v[16 * q + i] = __uint_as_float((__float_as_uint(acc[q][i]) & 0xffffff80u) | (unsigned)(32 * q + crow(i, hf)));
                float mine[16];
                top16_of_64(v, mine);
                float t[16];
#pragma unroll
                for (int i = 0; i < 16; ++i) t[i] = __shfl_xor(mine[i], 32);
#pragma unroll
                for (int i = 0; i < 16; ++i) lst[p][i] = fmaxf(mine[i], t[15 - i]);
                bitonic_merge16_desc(lst[p]);
            }
            LAS unsigned char* lut = lds + LP_LUT + wave * 1024 + l31 * 32;
            {
                v4u wa, wb;
#pragma unroll
                for (int c = 0; c < 4; ++c) {
                    wa[c] = (__float_as_uint(lst[0][4 * c]) & 0x7fu) | ((__float_as_uint(lst[0][4 * c + 1]) & 0x7fu) << 8) | ((__float_as_uint(lst[0][4 * c + 2]) & 0x7fu) << 16) | ((__float_as_uint(lst[0][4 * c + 3]) & 0x7fu) << 24);
                    wb[c] = (__float_as_uint(lst[1][4 * c]) & 0x7fu) | ((__float_as_uint(lst[1][4 * c + 1]) & 0x7fu) << 8) | ((__float_as_uint(lst[1][4 * c + 2]) & 0x7fu) << 16) | ((__float_as_uint(lst[1][4 * c + 3]) & 0x7fu) << 24);
                }
                if (hf == 0) { *(LAS v4u*)lut = wa; *(LAS v4u*)(lut + 16) = wb; }
            }
            float cv[64];
            {
                int c = 0;
#pragma unroll
                for (int i = 0; i < 16; ++i)
#pragma unroll
                    for (int j = 0; j < 16; ++j)
                        if ((i + 1) * (j + 1) <= 16) {
                            const float sa = __uint_as_float(__float_as_uint(lst[0][i]) & 0xffffff80u), sb = __uint_as_float(__float_as_uint(lst[1][j]) & 0xffffff80u);
                            cv[c] = __uint_as_float((__float_as_uint(sa + sb) & 0xffffff00u) | (unsigned)(i * 16 + j)); ++c;
                        }
#pragma unroll
                for (int k = 50; k < 64; ++k) cv[k] = -3.0e38f;
            }
            float best[16];
            top16_of_64(cv, best);
            const float rstd = *(const LAS float*)(lds + LP_RSTD + par * 128 + l31 * 4);
            const float s0 = __uint_as_float(__float_as_uint(best[0]) & 0xffffff00u);
            float ev[16], esum = 0.f;
#pragma unroll
            for (int k = 0; k < 16; ++k) { const float sk = __uint_as_float(__float_as_uint(best[k]) & 0xffffff00u); ev[k] = __expf(rstd * (sk - s0)); esum += ev[k]; }
            const float einv = 1.0f / esum;
            LDS_WAIT();
            asm volatile("" ::: "memory");
            const size_t ob = (size_t)(t0 + l31) * 128 + h * 16;
            if (hf == 0) {
                unsigned e16[16];
#pragma unroll
                for (int k = 0; k < 16; ++k) { const unsigned code = __float_as_uint(best[k]) & 0xffu;
                    const unsigned ia = *(const LAS unsigned char*)(lut + (code >> 4)), ib = *(const LAS unsigned char*)(lut + 16 + (code & 15u));
                    e16[k] = ia * 128u + ib; }
                v4u w0, w1;
                w0.x = e16[0] | (e16[1] << 16); w0.y = e16[2] | (e16[3] << 16); w0.z = e16[4] | (e16[5] << 16); w0.w = e16[6] | (e16[7] << 16);
                w1.x = e16[8] | (e16[9] << 16); w1.y = e16[10] | (e16[11] << 16); w1.z = e16[12] | (e16[13] << 16); w1.w = e16[14] | (e16[15] << 16);
                *(v4u*)(EID + ob) = w0; *(v4u*)(EID + ob + 8) = w1;
            } else {
#pragma unroll
                for (int c = 0; c < 4; ++c) *(f32x4*)(GATE + ob + 4 * c) = (f32x4){ev[4 * c] * einv, ev[4 * c + 1] * einv, ev[4 * c + 2] * einv, ev[4 * c + 3] * einv};
            }
        }
    }
    __syncthreads();
}

constexpr int LB_H = 0, LB_LIST = LB_H + NWAVES * 8192, LB_GATE = LB_LIST + NWAVES * 2304, LB_END = LB_GATE + NWAVES * 2048;
static_assert(LB_END <= RING_BYTES, "p5b LDS");
__device__ __forceinline__ void p5b_dots(const Args& a, LAS unsigned char* lds, int bx, int G, int tid, int lane, int wave) {
    unsigned char* ws = a.ws;
    const bf16* H2B = (const bf16*)(ws + WS_R1); const bf16* UB = (const bf16*)(ws + WS_UB);
    const unsigned short* EID = (const unsigned short*)(ws + WS_EID); const float* GATE = (const float*)(ws + WS_GATE); float* ACT = (float*)(ws + WS_ACT);
    LAS unsigned char* hreg = lds + LB_H + wave * 8192; LAS unsigned* list = (LAS unsigned*)(lds + LB_LIST + wave * 2304); LAS float* gts = (LAS float*)(lds + LB_GATE + wave * 2048);
    const int jmine = ((lane >> 5) & 1) * 8 + ((lane >> 4) & 1) * 4 + ((lane >> 3) & 1) * 2 + ((lane >> 2) & 1);
    const unsigned long long ltmask = (1ull << lane) - 1ull;
    for (int vb = bx; vb < 256; vb += G) {
        const unsigned vx = (unsigned)(vb & 7); const int wi = vb >> 3;
        const int tw0 = wi * 1024 + wave * 128;
#pragma unroll 1
        for (int ch = 0; ch < 32; ++ch) {
            const int tok0 = tw0 + 4 * ch;
            int n = 0;
#pragma unroll
            for (int s = 0; s < 4; ++s) {
                const size_t tok = (size_t)tok0 + s;
                const unsigned idw = *(const unsigned*)(EID + tok * 128 + 2 * lane);
                const f32x2 gg = *(const f32x2*)(GATE + tok * 128 + 2 * lane);
                const v4u h0 = *(const v4u*)(H2B + tok * D + 8 * lane), h1 = *(const v4u*)(H2B + tok * D + 512 + 8 * lane);
                *(LAS v4u*)(hreg + s * 2048 + lane * 16) = h0; *(LAS v4u*)(hreg + s * 2048 + 1024 + lane * 16) = h1;
                *(LAS f32x2*)(gts + s * 128 + 2 * lane) = gg;
                const unsigned id0 = idw & 0xffffu, id1 = idw >> 16;
                const bool in0 = (id0 >> 11) == vx, in1 = (id1 >> 11) == vx;
                const unsigned long long m0 = __ballot(in0), m1 = __ballot(in1);
                const int c0 = __popcll(m0), c1 = __popcll(m1);
                if (in0) list[n + __popcll(m0 & ltmask)] = ((unsigned)s << 28) | ((unsigned)(2 * lane) << 16) | id0;
                if (in1) list[n + c0 + __popcll(m1 & ltmask)] = ((unsigned)s << 28) | ((unsigned)(2 * lane + 1) << 16) | id1;
                n += c0 + c1;
            }
            const int nb = (n + 15) >> 4;
            if (lane < 16) list[n + lane] = (0xfu << 28) | (vx << 11);
            LDS_WAIT(); asm volatile("" ::: "memory");
#pragma unroll 1
            for (int bt = 0; bt < nb; ++bt) {
                const unsigned entv = list[16 * bt + (lane & 15)];
                float d[16];
#pragma unroll
                for (int hb2 = 0; hb2 < 2; ++hb2) {
                    v4u ua[8], ub[8];
#pragma unroll
                    for (int j = 0; j < 8; ++j) {
                        const unsigned ent = __builtin_amdgcn_readlane(entv, 8 * hb2 + j);
                        const bf16* ur = UB + (size_t)(ent & 0xffffu) * D + 8 * lane;
                        ua[j] = *(const v4u*)ur; ub[j] = *(const v4u*)(ur + 512);
                    }
#pragma unroll
                    for (int j = 0; j < 8; ++j) {
                        const unsigned ent = __builtin_amdgcn_readlane(entv, 8 * hb2 + j);
                        const unsigned slot = (ent >> 28) & 3u;
                        const v4u h0 = *(const LAS v4u*)(hreg + slot * 2048 + lane * 16), h1 = *(const LAS v4u*)(hreg + slot * 2048 + 1024 + lane * 16);
                        float sdot = 0.f;
#pragma unroll
                        for (int u = 0; u < 4; ++u) { const unsigned wa = ua[j][u], wb = ub[j][u], ha = h0[u], hb = h1[u]; sdot = dot2u(ha, wa, sdot); sdot = dot2u(hb, wb, sdot); }
                        d[8 * hb2 + j] = sdot;
                    }
                }
                float d8[8], d4[4], d2[2], d1;
                { const bool hi = (lane & 32) != 0;
#pragma unroll
                  for (int j = 0; j < 8; ++j) { const float keep = hi ? d[j + 8] : d[j], send = hi ? d[j] : d[j + 8]; d8[j] = keep + __shfl_xor(send, 32); } }
                { const bool hi = (lane & 16) != 0;
#pragma unroll
                  for (int j = 0; j < 4; ++j) { const float keep = hi ? d8[j + 4] : d8[j], send = hi ? d8[j] : d8[j + 4]; d4[j] = keep + __shfl_xor(send, 16); } }
                { const bool hi = (lane & 8) != 0;
#pragma unroll
                  for (int j = 0; j < 2; ++j) { const float keep = hi ? d4[j + 2] : d4[j], send = hi ? d4[j] : d4[j + 2]; d2[j] = keep + __shfl_xor(send, 8); } }
                { const bool hi = (lane & 4) != 0; const float keep = hi ? d2[1] : d2[0], send = hi ? d2[0] : d2[1]; d1 = keep + __shfl_xor(send, 4); }
                d1 += __shfl_xor(d1, 1); d1 += __shfl_xor(d1, 2);
                const unsigned em = list[16 * bt + jmine];
                const unsigned slot = em >> 28, k = (em >> 16) & 0xffu;
                if ((lane & 3) == 0 && slot < 4u) ACT[((size_t)tok0 + slot) * 128 + k] = gelu_erf(d1) * gts[slot * 128 + k];
            }
        }
    }
}

constexpr int LC_BUF = 0, LC_END = NWAVES * 2 * 1024;
__device__ __forceinline__ void p5c_axpy(const Args& a, LAS unsigned char* lds, int bx, int G, int tid, int lane, int wave) {
    unsigned char* ws = a.ws;
    const bf16* VB = (const bf16*)(ws + WS_VB); const unsigned short* EID = (const unsigned short*)(ws + WS_EID); const float* ACT = (const float*)(ws + WS_ACT);
    float* X = a.out; bf16* XB2 = (bf16*)(ws + WS_R1); float* RSS2 = (float*)(ws + WS_RSS2);
    const int g = lane >> 4, c = lane & 15;
    for (int vb = bx; vb < 256; vb += G) {
        const int vx = vb & 7, wi = vb >> 3;
        const int tw0 = wi * 1024 + wave * 128;
        const bf16* vbase = VB + vx * 128 + 8 * c;
        unsigned idw = *(const unsigned*)(EID + (size_t)tw0 * 128 + 2 * lane);
        f32x2 av = *(const f32x2*)(ACT + (size_t)tw0 * 128 + 2 * lane);
#pragma unroll 1
        for (int i = 0; i < 128; ++i) {
            const size_t tok = (size_t)tw0 + i;
            LAS unsigned char* buf = lds + LC_BUF + wave * 2048 + (i & 1) * 1024;
            *(LAS unsigned*)(buf + 4 * lane) = idw; *(LAS f32x2*)(buf + 256 + 8 * lane) = av;
            if (i + 1 < 128) { idw = *(const unsigned*)(EID + (tok + 1) * 128 + 2 * lane); av = *(const f32x2*)(ACT + (tok + 1) * 128 + 2 * lane); }
            float* xr = X + tok * D + vx * 128 + 8 * c;
            const f32x4 xa = *(const f32x4*)xr, xb = *(const f32x4*)(xr + 4);
            LDS_WAIT(); asm volatile("" ::: "memory");
            float y[8];
#pragma unroll
            for (int u = 0; u < 8; ++u) y[u] = 0.f;
#pragma unroll 1
            for (int it = 0; it < 32; it += 8) {
                v4u vv[8]; float ak[8];
#pragma unroll
                for (int j = 0; j < 8; ++j) {
                    const int k = 4 * (it + j) + g;
                    const unsigned e = *(const LAS unsigned short*)(buf + 2 * k); ak[j] = *(const LAS float*)(buf + 256 + 4 * k);
                    vv[j] = *(const v4u*)(vbase + (size_t)e * D);
                }
#pragma unroll
                for (int j = 0; j < 8; ++j)
#pragma unroll
                    for (int u = 0; u < 4; ++u) { y[2 * u] += ak[j] * bf_lo(vv[j][u]); y[2 * u + 1] += ak[j] * bf_hi(vv[j][u]); }
            }
#pragma unroll
            for (int u = 0; u < 8; ++u) { y[u] += __shfl_xor(y[u], 16); y[u] += __shfl_xor(y[u], 32); }
            float o[8]; float ss = 0.f;
#pragma unroll
            for (int u = 0; u < 4; ++u) { o[u] = xa[u] + y[u]; o[4 + u] = xb[u] + y[4 + u]; }
#pragma unroll
            for (int u = 0; u < 8; ++u) ss += o[u] * o[u];
            ss += __shfl_xor(ss, 1); ss += __shfl_xor(ss, 2); ss += __shfl_xor(ss, 4); ss += __shfl_xor(ss, 8);
            if (g == 0) {
                *(f32x4*)xr = (f32x4){o[0], o[1], o[2], o[3]}; *(f32x4*)(xr + 4) = (f32x4){o[4], o[5], o[6], o[7]};
                v4u w; w.x = pk2(o[0], o[1]); w.y = pk2(o[2], o[3]); w.z = pk2(o[4], o[5]); w.w = pk2(o[6], o[7]);
                *(v4u*)(XB2 + tok * D + vx * 128 + 8 * c) = w;
                if (c == 0) RSS2[tok * 8 + vx] = ss;
            }
        }
    }
}

__global__ void __launch_bounds__(NTHR, 2) mk_fwd(Args a) {
    extern __shared__ __attribute__((aligned(16))) unsigned char lds_raw[];
    LAS unsigned char* lds = (LAS unsigned char*)lds_raw;
    const int tid = threadIdx.x, lane = tid & 63, wave = __builtin_amdgcn_readfirstlane(tid >> 6);
    const int G = gridDim.x, bx = blockIdx.x, vcu = (G % 8 == 0) ? (bx % 8) * (G / 8) + bx / 8 : bx;
    volatile LAS unsigned* MISC = (volatile LAS unsigned*)(lds + MISC_OFF);
    if (tid < 64) MISC[tid] = 0u;
    __syncthreads();
    unsigned char* ws = a.ws;
    const int lo = a.ph_lo, hi = a.ph_hi;
    XcdBarrier bar; bar.bar = (unsigned*)(ws + WS_CTL) + CW_BAR + a.li * XCD_BAR_WORDS; bar.x = 0; bar.st = nullptr;
    if (hi - lo > 1) bar = xcd_barrier_post((unsigned*)(ws + WS_CTL) + CW_BAR + a.li * XCD_BAR_WORDS, MISC + 8);
#define IN(k) (lo <= (k) && (k) < hi)
#define BOTH(k) (IN(k) && IN((k) + 1))
    if (IN(0)) { p0_prologue(a, lds, vcu, G, tid, lane, wave); if (BOTH(0)) xcd_barrier(bar); }
    if (IN(1)) {
        { pg8::Gemm g{(const bf16*)(ws + WS_R1), (const bf16*)(ws + WS_WIN), T, NIN, D}; pg8::StaticOrder S; S.init(T, NIN, G, bx);
          EpiStoreBf16 E{(bf16*)(ws + WS_R2), NIN};
          pg8::gemm_phase<EpiStoreBf16, pg8::StaticOrder, true, true>(lds, g, S, E); }
        { pg8::Gemm g{(const bf16*)(ws + WS_PB), (const bf16*)(ws + WS_WP), T, D, PLE}; pg8::StaticOrder S; S.init(T, D, G, bx);
          EpiStoreBf16 E{(bf16*)(ws + WS_PP), D};
          pg8::gemm_phase<EpiStoreBf16, pg8::StaticOrder, true, true>(lds, g, S, E); }
        if (BOTH(1)) xcd_barrier(bar);
    }
    if (IN(2)) { p2_mixing(a, lds, bx, G, tid, lane, wave); if (BOTH(2)) xcd_barrier(bar); }
    if (IN(3)) {
        pg8::Gemm g{(const bf16*)(ws + WS_R1), (const bf16*)(ws + WS_WOUT), T, D, D}; pg8::StaticOrder S; S.init(T, D, G, bx);
        EpiResid E{a.in[0], a.out, (bf16*)(ws + WS_R2)};
        pg8::gemm_phase<EpiResid, pg8::StaticOrder, true, true>(lds, g, S, E);
        if (BOTH(3)) xcd_barrier(bar);
    }
    if (IN(4)) {
        pg8::Gemm g{(const bf16*)(ws + WS_R2), (const bf16*)(ws + WS_WQ), T, NQ, D}; pg8::StaticOrder S; S.init(T, NQ, G, bx);
        EpiStoreBf16 E{(bf16*)(ws + WS_R2 + 64 * MB), NQ};
        pg8::gemm_phase<EpiStoreBf16, pg8::StaticOrder, true, true>(lds, g, S, E);
        if (BOTH(4)) xcd_barrier(bar);
    }
    if (IN(5)) {
        p5a_topk(a, lds, vcu, G, tid, lane, wave); xcd_barrier(bar);
        p5b_dots(a, lds, bx, G, tid, lane, wave); xcd_barrier(bar);
        p5c_axpy(a, lds, bx, G, tid, lane, wave);
        if (BOTH(5)) xcd_barrier(bar);
    }
    if (IN(6)) {
        pg8::Gemm g{(const bf16*)(ws + WS_R1), (const bf16*)(ws + WS_WG), T, D, D}; pg8::StaticOrder S; S.init(T, D, G, bx);
        EpiGate E{a.out, (const bf16*)(ws + WS_PP), (const float*)(ws + WS_RSS2)};
        pg8::gemm_phase<EpiGate, pg8::StaticOrder, true, true>(lds, g, S, E);
    }
#undef IN
#undef BOTH
}
}
extern "C" void kernel_launch(void* const* d_in, const int* in_sizes, int n_in, void* d_out, int out_size, void* d_ws, size_t ws_size, hipStream_t stream) {
    using namespace mk;
    static int grid = 0;
    if (grid == 0) {
        int dev = 0, cus = 0;
        if (n_in != 16 || out_size != T * D || ws_size < WS_END) { fprintf(stderr, "kernel_launch: unexpected problem shape / workspace (%d inputs, out %d, ws %zu)\n", n_in, out_size, ws_size); grid = -1; return; }
        if (hipGetDevice(&dev) != hipSuccess || hipDeviceGetAttribute(&cus, hipDeviceAttributeMultiprocessorCount, dev) != hipSuccess) { fprintf(stderr, "device query failed\n"); grid = -1; return; }
        if (hipFuncSetAttribute((const void*)mk_fwd, hipFuncAttributeMaxDynamicSharedMemorySize, LDS_BYTES) != hipSuccess) { fprintf(stderr, "hipFuncSetAttribute failed\n"); grid = -1; return; }
        int per_cu = 0;
        if (hipOccupancyMaxActiveBlocksPerMultiprocessor(&per_cu, (const void*)mk_fwd, NTHR, LDS_BYTES) != hipSuccess || per_cu < 1) { fprintf(stderr, "occupancy query: %d blocks per CU\n", per_cu); (void)hipGetLastError(); }
        grid = cus;
    }
    if (grid < 0) return;
    unsigned char* ws = (unsigned char*)d_ws;
    (void)hipMemsetAsync(ws + WS_CTL, 0, CTL_BYTES, stream);
    Args a{};
    for (int i = 0; i < 16; ++i) a.in[i] = (const float*)d_in[i];
    a.out = (float*)d_out; a.ws = ws; a.ph_lo = 0; a.ph_hi = 7; a.li = 0; a.pad = 0;
    hipLaunchKernelGGL(mk_fwd, dim3(grid), dim3(NTHR), LDS_BYTES, stream, a);
}
```

```cpp
#include <hip/hip_runtime.h>
#include <cstdio>
#include <cstdint>
#define LAS __attribute__((address_space(3)))
#define GAS __attribute__((address_space(1)))
namespace pg8 {
#define PG8_LAS __attribute__((address_space(3)))
typedef unsigned short bf16_t;
typedef short bf16x8 __attribute__((ext_vector_type(8)));
typedef float f32x4 __attribute__((ext_vector_type(4)));
typedef unsigned u32x4 __attribute__((ext_vector_type(4)));
constexpr int BM = 256, BK = 64, HALF = 128, HTB = HALF * BK * 2  , STAGE_BYTES = 8 * HTB, NXCD = 8, WGM = 8;

__host__ __device__ __forceinline__ int lds_byte(int r, int c) { const int st = (r >> 4) * 2 + (c >> 5), rr = r & 15, cc = c & 31, ob = rr * 64 + cc * 2; return st * 1024 + (ob ^ (((ob >> 9) & 1) << 5)); }
__host__ __device__ __forceinline__ void stage_rc(int b, int& R, int& C) { const int st = b / 1024, sb = b % 1024, swz = sb ^ (((sb >> 9) & 1) << 5); R = (st >> 1) * 16 + swz / 64; C = (st & 1) * 32 + (swz % 64) / 2; }
__host__ __device__ __forceinline__ int perm32(int rho) { const int n = rho >> 4, i = rho & 15; return 8 * (i >> 2) + 4 * n + (i & 3); }

struct Unit { int pm, pn; };
struct Gemm { const bf16_t* A; const bf16_t* Bt; int M, N, K; };

struct StaticOrder {
    int nM, nN, nwg, G, c;
    __host__ __device__ void init(int M, int N, int G_, int c_) { nM = M / BM; nN = N / BM; nwg = nM * nN; G = G_; c = c_; }
    __host__ __device__ bool next(int i, Unit& u) const {
        const long L = (long)i * G + c; if (L >= nwg) return false;
        int wgid = (int)L; { const int q = nwg / NXCD, r = nwg % NXCD, xcd = wgid % NXCD, off = wgid / NXCD; wgid = (xcd < r ? xcd * (q + 1) : r * (q + 1) + (xcd - r) * q) + off; }
        const int nig = WGM * nN, gid = wgid / nig, fm = gid * WGM, gsz = (nM - fm) < WGM ? (nM - fm) : WGM;
        u.pm = fm + ((wgid % nig) % gsz); u.pn = (wgid % nig) / gsz; return true;
    }
    __device__ __forceinline__ void a_ready(const Unit&) const {}
    __device__ __forceinline__ void done(const Unit&) const {}
};
__device__ __forceinline__ unsigned cvt_pk_bf16(float lo, float hi) { unsigned r; asm volatile("v_cvt_pk_bf16_f32 %0, %1, %2" : "=v"(r) : "v"(lo), "v"(hi)); return r; }
template <class Epi, class Sched, bool ALIGN_EPI = false, bool SP2 = false>
__device__ __forceinline__ void gemm_phase(PG8_LAS unsigned char* lds, const Gemm g, const Sched& S, const Epi& E) {
    const int tid = threadIdx.x, wid = __builtin_amdgcn_readfirstlane(tid >> 6), lane = tid & 63, wr = wid >> 2, wc = wid & 3, fr = lane & 15, fq = lane >> 4;
    const int K = g.K, nt = K / BK;
    unsigned voffA[2], voffB[2];
#pragma unroll
    for (int i = 0; i < 2; ++i) { int R, C; stage_rc(tid * 16 + i * 8192, R, C); const int Rb = Epi::PERM ? ((R & ~31) + perm32(R & 31)) : R;
        voffA[i] = (unsigned)(R * K + C) * 2u; voffB[i] = (unsigned)(Rb * K + C) * 2u; }
    const size_t kstep = (size_t)(BK * 2);
    const size_t hstep = (size_t)HALF * K * 2;
    const size_t tstep = 2 * hstep;
    const unsigned ldsw = (unsigned)wid * 1024u;
    const int aoff = lds_byte(wr * 64 + fr, fq * 8), boff = lds_byte(wc * 32 + fr, fq * 8);
#define PG8_SA(b, h) (((b) * 2 + (h)) * HTB)
#define PG8_SB(b, h) ((4 + (b) * 2 + (h)) * HTB)
#define PG8_STAGE(bufoff, gbase, voff) do { _Pragma("unroll") for (int _i = 0; _i < 2; ++_i) \
        __builtin_amdgcn_global_load_lds((const unsigned*)((const char*)(gbase) + (voff)[_i]), (PG8_LAS unsigned*)(lds + (bufoff) + ldsw + _i * 8192), 16, 0, 0); } while (0)
#define PG8_LDA(dst, b, h) do { _Pragma("unroll") for (int m = 0; m < 4; ++m) _Pragma("unroll") for (int k = 0; k < 2; ++k) dst[m][k] = *(const PG8_LAS bf16x8*)(lds + PG8_SA(b, h) + aoff + m * 2048 + k * 1024); } while (0)
#define PG8_LDB(dst, b, h) do { _Pragma("unroll") for (int n = 0; n < 2; ++n) _Pragma("unroll") for (int k = 0; k < 2; ++k) dst[n][k] = *(const PG8_LAS bf16x8*)(lds + PG8_SB(b, h) + boff + n * 2048 + k * 1024); } while (0)
#define PG8_MMA(ai, bj, At, Bt) do { __builtin_amdgcn_s_setprio(1); _Pragma("unroll") for (int m = 0; m < 4; ++m) _Pragma("unroll") for (int n = 0; n < 2; ++n) _Pragma("unroll") for (int k = 0; k < 2; ++k) \
        acc[ai][bj][m][n] = __builtin_amdgcn_mfma_f32_16x16x32_bf16(Bt[n][k], At[m][k], acc[ai][bj][m][n], 0, 0, 0); __builtin_amdgcn_s_setprio(0); } while (0)
#define PG8_WAIT_V(n) asm volatile("s_waitcnt vmcnt(" #n ")" ::: "memory")
#define PG8_WAIT_L(n) asm volatile("s_waitcnt lgkmcnt(" #n ")" ::: "memory")
#define PG8_BAR __builtin_amdgcn_s_barrier()
#define PG8_SCHED __builtin_amdgcn_sched_barrier(0)
    Unit cur, nxt; int ui = 0;
    if (!S.next(0, cur)) return;
    f32x4 acc[2][2][4][2];
#pragma unroll
    for (int a = 0; a < 2; ++a)
#pragma unroll
        for (int b = 0; b < 2; ++b)
#pragma unroll
            for (int m = 0; m < 4; ++m)
#pragma unroll
                for (int n = 0; n < 2; ++n) acc[a][b][m][n] = (f32x4){0.f, 0.f, 0.f, 0.f};
    bf16x8 At[4][2], B0[2][2], B1[2][2];
    const char* cA = (const char*)g.A + (size_t)cur.pm * tstep; const char* cB = (const char*)g.Bt + (size_t)cur.pn * tstep;
    S.a_ready(cur);
    if constexpr (SP2) {
        PG8_STAGE(PG8_SB(0, 0), cB, voffB); PG8_STAGE(PG8_SB(0, 1), cB + hstep, voffB); PG8_STAGE(PG8_SA(0, 0), cA, voffA); PG8_STAGE(PG8_SA(0, 1), cA + hstep, voffA);
        if (wr == 1) PG8_BAR;
        PG8_WAIT_V(2); PG8_BAR;
        PG8_STAGE(PG8_SB(1, 0), cB + kstep, voffB); PG8_STAGE(PG8_SA(1, 0), cA + kstep, voffA); PG8_STAGE(PG8_SB(1, 1), cB + hstep + kstep, voffB);
        PG8_WAIT_V(6); PG8_BAR;
    } else {
        PG8_STAGE(PG8_SB(0, 0), cB, voffB); PG8_STAGE(PG8_SA(0, 0), cA, voffA); PG8_STAGE(PG8_SB(0, 1), cB + hstep, voffB); PG8_STAGE(PG8_SA(0, 1), cA + hstep, voffA);
        if (wr == 1) PG8_BAR;
        PG8_WAIT_V(4); PG8_BAR;
        PG8_STAGE(PG8_SB(1, 0), cB + kstep, voffB); PG8_STAGE(PG8_SA(1, 0), cA + kstep, voffA); PG8_STAGE(PG8_SB(1, 1), cB + hstep + kstep, voffB);
        PG8_WAIT_V(6); PG8_BAR;
    }
    for (;;) {
        const bool has_next = S.next(ui + 1, nxt);
        const char* nA = has_next ? (const char*)g.A + (size_t)nxt.pm * tstep : cA; const char* nB = has_next ? (const char*)g.Bt + (size_t)nxt.pn * tstep : cB;
        for (int t = 0; t < nt; t += 2) {
            const bool last = (t == nt - 2);
            const char* a1 = cA + (size_t)(t + 1) * kstep;
            const char* a2 = last ? nA : cA + (size_t)(t + 2) * kstep; const char* b2 = last ? nB : cB + (size_t)(t + 2) * kstep;
            const char* a3 = a2 + kstep; const char* b3 = b2 + kstep;
            if (last && has_next) S.a_ready(nxt);
            if constexpr (SP2) {
            PG8_LDB(B0, 0, 0); PG8_LDB(B1, 0, 1); PG8_SCHED; PG8_LDA(At, 0, 0); PG8_STAGE(PG8_SA(1, 1), a1 + hstep, voffA);
            PG8_WAIT_V(8); PG8_WAIT_L(0); PG8_BAR; PG8_MMA(0, 0, At, B0); PG8_MMA(0, 1, At, B1); PG8_BAR; PG8_SCHED;
            PG8_LDA(At, 0, 1); PG8_STAGE(PG8_SB(0, 0), b2, voffB); PG8_STAGE(PG8_SB(0, 1), b2 + hstep, voffB); PG8_STAGE(PG8_SA(0, 0), a2, voffA);
            PG8_WAIT_V(8); PG8_WAIT_L(0); PG8_BAR; PG8_MMA(1, 0, At, B0); PG8_MMA(1, 1, At, B1); PG8_BAR; PG8_SCHED;
            PG8_LDB(B0, 1, 0); PG8_LDB(B1, 1, 1); PG8_SCHED; PG8_LDA(At, 1, 0); PG8_STAGE(PG8_SA(0, 1), a2 + hstep, voffA);
            PG8_WAIT_V(8); PG8_WAIT_L(0); PG8_BAR; PG8_MMA(0, 0, At, B0); PG8_MMA(0, 1, At, B1); PG8_BAR; PG8_SCHED;
            PG8_LDA(At, 1, 1); PG8_STAGE(PG8_SB(1, 0), b3, voffB); PG8_STAGE(PG8_SB(1, 1), b3 + hstep, voffB); PG8_STAGE(PG8_SA(1, 0), a3, voffA);
            PG8_WAIT_V(8); PG8_WAIT_L(0); PG8_BAR; PG8_MMA(1, 0, At, B0); PG8_MMA(1, 1, At, B1); PG8_BAR; PG8_SCHED;
            } else {
            PG8_LDB(B0, 0, 0); PG8_SCHED; PG8_LDA(At, 0, 0); PG8_STAGE(PG8_SA(1, 1), a1 + hstep, voffA);
            PG8_WAIT_L(8); PG8_BAR; PG8_WAIT_L(0); PG8_MMA(0, 0, At, B0); PG8_BAR; PG8_SCHED;
            PG8_LDB(B1, 0, 1); PG8_STAGE(PG8_SB(0, 0), b2, voffB);
            PG8_BAR; PG8_WAIT_L(0); PG8_MMA(0, 1, At, B1); PG8_BAR;
            PG8_LDA(At, 0, 1); PG8_STAGE(PG8_SA(0, 0), a2, voffA);
            PG8_BAR; PG8_WAIT_L(0); PG8_MMA(1, 0, At, B0); PG8_BAR; PG8_SCHED;
            PG8_STAGE(PG8_SB(0, 1), b2 + hstep, voffB);
            PG8_WAIT_V(6); PG8_BAR; PG8_MMA(1, 1, At, B1); PG8_BAR;
            PG8_LDB(B0, 1, 0); PG8_SCHED; PG8_LDA(At, 1, 0); PG8_STAGE(PG8_SA(0, 1), a2 + hstep, voffA);
            PG8_WAIT_L(8); PG8_BAR; PG8_WAIT_L(0); PG8_MMA(0, 0, At, B0); PG8_BAR; PG8_SCHED;
            PG8_LDB(B1, 1, 1); PG8_STAGE(PG8_SB(1, 0), b3, voffB);
            PG8_BAR; PG8_WAIT_L(0); PG8_MMA(0, 1, At, B1); PG8_BAR;
            PG8_LDA(At, 1, 1); PG8_STAGE(PG8_SA(1, 0), a3, voffA);
            PG8_BAR; PG8_WAIT_L(0); PG8_MMA(1, 0, At, B0); PG8_BAR; PG8_SCHED;
            PG8_STAGE(PG8_SB(1, 1), b3 + hstep, voffB);
            PG8_WAIT_V(6); PG8_BAR; PG8_MMA(1, 1, At, B1); PG8_BAR;
            }
        }
        if constexpr (ALIGN_EPI) { if (wr == 0) PG8_BAR; }
        if constexpr (!Epi::AFTER_DRAIN) { E(acc, cur, wr, wc, fr, fq); S.done(cur); }
        if (!has_next) break;
#pragma unroll
        for (int a = 0; a < 2; ++a)
#pragma unroll
            for (int b = 0; b < 2; ++b)
#pragma unroll
                for (int m = 0; m < 4; ++m)
#pragma unroll
                    for (int n = 0; n < 2; ++n) acc[a][b][m][n] = (f32x4){0.f, 0.f, 0.f, 0.f};
        cur = nxt; cA = nA; cB = nB; ++ui;
        if constexpr (ALIGN_EPI) { if (wr == 1) PG8_BAR; }
    }
    PG8_WAIT_V(0);
    if constexpr (!ALIGN_EPI) { if (wr == 0) PG8_BAR; }
    PG8_BAR;
    if constexpr (Epi::AFTER_DRAIN) { E.fused(acc, cur, wr, wc, fr, fq, lds, wid, lane); S.done(cur); }
#undef PG8_SA
#undef PG8_SB
#undef PG8_STAGE
#undef PG8_LDA
#undef PG8_LDB
#undef PG8_MMA
#undef PG8_WAIT_V
#undef PG8_WAIT_L
#undef PG8_BAR
#undef PG8_SCHED
}
}
#define XB_TMO      128
#define XB_XCNT(j)  (256  + 64 * (j))
#define XB_XSUB(j)  (1280 + 64 * (j))
#define XB_XGEN(j)  (2304 + 64 * (j))
#define XB_TOP      3328
#define XB_TOPGEN   3392
#define XCD_BAR_WORDS 3456
#define XB_SPIN_CAP (1u << 18)

__device__ __forceinline__ unsigned xb_ld(unsigned* p)              { return __hip_atomic_load(p, __ATOMIC_RELAXED, __HIP_MEMORY_SCOPE_AGENT); }
__device__ __forceinline__ unsigned xb_add(unsigned* p, unsigned v) { return __hip_atomic_fetch_add(p, v, __ATOMIC_RELAXED, __HIP_MEMORY_SCOPE_AGENT); }
__device__ __forceinline__ unsigned xb_xcc_id() { return (unsigned)__builtin_amdgcn_s_getreg((3 << 11) | 20) & 0xFu; }
#define XB_SPIN(cond, bar) do { unsigned _sp = 0; while (cond) { __builtin_amdgcn_s_sleep(1); \
    if ((++_sp & 255u) == 0u) { if (xb_ld(&(bar)[XB_TMO])) break; if (_sp > XB_SPIN_CAP) { atomicAdd(&(bar)[XB_TMO], 1u); break; } } } } while (0)

struct XcdBarrier {
    unsigned* bar; unsigned x;
    volatile LAS unsigned* st;
};

__device__ __forceinline__ XcdBarrier xcd_barrier_post(unsigned* bar, volatile LAS unsigned* st) {
    XcdBarrier b; b.bar = bar; b.x = xb_xcc_id(); b.st = st;
    if (threadIdx.x == 0) (void)xb_add(&bar[XB_XCNT(b.x)], 1u);
    return b;
}
__device__ __forceinline__ void xcd_barrier_complete(unsigned* bar, unsigned x, unsigned& nloc, unsigned& nx) {
    const unsigned G = gridDim.x * gridDim.y * gridDim.z;
    unsigned sum, cnt, mine, sp = 0u;
    for (;;) {
        sum = 0u; cnt = 0u; mine = 0u;
#pragma unroll
        for (unsigned j = 0; j < 16; ++j) { const unsigned c = xb_ld(&bar[XB_XCNT(j)]); sum += c; cnt += (c > 0u) ? 1u : 0u; mine = (j == x) ? c : mine; }
        if (sum == G) break;
        __builtin_amdgcn_s_sleep(1);
        if ((++sp & 255u) == 0u) { if (xb_ld(&bar[XB_TMO])) break; if (sp > XB_SPIN_CAP) { atomicAdd(&bar[XB_TMO], 1u); break; } }
    }
    nloc = mine > 0u ? mine : 1u; nx = cnt > 0u ? cnt : 1u;
}

__device__ __forceinline__ void xcd_barrier(const XcdBarrier& b) {
    asm volatile("s_waitcnt vmcnt(0)" ::: "memory");
    __syncthreads();
    if (threadIdx.x == 0) {
        unsigned* bar = b.bar;
        __builtin_amdgcn_s_waitcnt(0);
        unsigned nloc = b.st[0], nx = b.st[1];
        if (nloc == 0u) { xcd_barrier_complete(bar, b.x, nloc, nx); b.st[0] = nloc; b.st[1] = nx; }
        const unsigned old = xb_add(&bar[XB_XSUB(b.x)], 1u);
        const unsigned gen = old / nloc;
        if (old + 1u == (gen + 1u) * nloc) {
            __builtin_amdgcn_fence(__ATOMIC_RELEASE, "agent");
            asm volatile("s_waitcnt vmcnt(0)" ::: "memory");
            const unsigned og = xb_add(&bar[XB_TOP], 1u);
            const unsigned tg = og / nx;
            if (og + 1u == (tg + 1u) * nx) xb_add(&bar[XB_TOPGEN], 1u);
            else XB_SPIN(xb_ld(&bar[XB_TOPGEN]) == tg, bar);
            __builtin_amdgcn_fence(__ATOMIC_ACQUIRE, "agent");
            xb_add(&bar[XB_XGEN(b.x)], 1u);
            asm volatile("s_waitcnt vmcnt(0)" ::: "memory");
        } else {
            XB_SPIN(xb_ld(&bar[XB_XGEN(b.x)]) == gen, bar);
            __builtin_amdgcn_fence(__ATOMIC_ACQUIRE, "agent");
            asm volatile("s_waitcnt vmcnt(0)" ::: "memory");
        }
    }
    __syncthreads();
}
namespace mk {
typedef unsigned short bf16;
typedef unsigned v4u __attribute__((ext_vector_type(4)));
typedef unsigned v2u __attribute__((ext_vector_type(2)));
typedef float f32x4 __attribute__((ext_vector_type(4)));
typedef float f32x16 __attribute__((ext_vector_type(16)));
typedef short bf16x8 __attribute__((ext_vector_type(8)));
typedef short bf16x4 __attribute__((ext_vector_type(4)));

constexpr int T = 32768, D = 1024, SQ = 4096, NIN = 2816, NQ = 2048, PLE = 256, NEXP = 16384;
constexpr int NWAVES = 8, NTHR = 512;
constexpr int RING_BYTES = 131072, LDS_BYTES = 163840, MISC_OFF = LDS_BYTES - 256;

constexpr size_t MB = 1024 * 1024;
constexpr size_t WS_CTL = 0, CTL_BYTES = 256 * 1024;
constexpr size_t WS_WIN = WS_CTL + CTL_BYTES;
constexpr size_t WS_WOUT = WS_WIN + (size_t)NIN * D * 2;
constexpr size_t WS_WQ = WS_WOUT + (size_t)D * D * 2;
constexpr size_t WS_WG = WS_WQ + (size_t)NQ * D * 2;
constexpr size_t WS_WP = WS_WG + (size_t)D * D * 2;
constexpr size_t WS_KEYS = WS_WP + (size_t)D * PLE * 2;
constexpr size_t WS_ROPE = WS_KEYS + 2 * 128 * 128 * 2;
constexpr size_t WS_SU = WS_ROPE + 2 * (size_t)SQ * 32 * 4;
constexpr size_t WS_SV = WS_SU + 65536;
constexpr size_t WS_SH = WS_SV + 65536;
constexpr size_t WS_UB = 16 * MB;
constexpr size_t WS_VB = WS_UB + 32 * MB;
constexpr size_t WS_PB = WS_VB + 32 * MB;
constexpr size_t WS_R1 = WS_PB + 16 * MB;
constexpr size_t WS_R2 = WS_R1 + 64 * MB;
constexpr size_t WS_PP = WS_R2 + 192 * MB;
constexpr size_t WS_END = WS_PP + 64 * MB;
static_assert(WS_SH + (size_t)T * 4 <= WS_UB, "ws map");
constexpr int CW_BAR = 1024;

#define LDS_WAIT() asm volatile("s_waitcnt lgkmcnt(0)" ::: "memory")
#define VM_WAIT() asm volatile("s_waitcnt vmcnt(0)" ::: "memory")
typedef float f32x2 __attribute__((ext_vector_type(2)));
typedef __bf16 b16x2 __attribute__((ext_vector_type(2)));
__device__ __forceinline__ unsigned pk2(float lo, float hi) { const f32x2 v = {lo, hi}; return __builtin_bit_cast(unsigned, __builtin_convertvector(v, b16x2)); }
__device__ __forceinline__ float bf_lo(unsigned w) { return __uint_as_float(w << 16); }
__device__ __forceinline__ float bf_hi(unsigned w) { return __uint_as_float(w & 0xffff0000u); }
__device__ __forceinline__ float wave_sum(float v) {
#pragma unroll
    for (int o = 1; o < 64; o <<= 1) v += __shfl_xor(v, o);
    return v;
}

struct Args { const float* in[16]; float* out; unsigned char* ws; int ph_lo, ph_hi, li, pad; };

struct EpiStoreBf16 {
    static constexpr bool PERM = true, AFTER_DRAIN = false;
    bf16* O; int ldc;
    __device__ __forceinline__ void operator()(const pg8::f32x4 (&acc)[2][2][4][2], const pg8::Unit& u, int wr, int wc, int fr, int fq) const {
        const int row0 = u.pm * 256 + wr * 64 + fr, col0 = u.pn * 256 + wc * 32 + 8 * fq;
#pragma unroll
        for (int ai = 0; ai < 2; ++ai)
#pragma unroll
            for (int m = 0; m < 4; ++m) { bf16* rowp = O + (size_t)(row0 + ai * 128 + m * 16) * ldc + col0;
#pragma unroll
                for (int bj = 0; bj < 2; ++bj) { const pg8::f32x4 v0 = acc[ai][bj][m][0], v1 = acc[ai][bj][m][1];
                    pg8::u32x4 w; w.x = pk2(v0[0], v0[1]); w.y = pk2(v0[2], v0[3]); w.z = pk2(v1[0], v1[1]); w.w = pk2(v1[2], v1[3]);
                    *(pg8::u32x4*)(rowp + bj * 128) = w; } }
    }
};


struct EpiResid {
    static constexpr bool PERM = true, AFTER_DRAIN = false;
    const float* X; float* O; bf16* XB;
    __device__ __forceinline__ void operator()(const pg8::f32x4 (&acc)[2][2][4][2], const pg8::Unit& u, int wr, int wc, int fr, int fq) const {
        const int row0 = u.pm * 256 + wr * 64 + fr, col0 = u.pn * 256 + wc * 32 + 8 * fq;
#pragma unroll
        for (int ai = 0; ai < 2; ++ai)
#pragma unroll
            for (int m = 0; m < 4; ++m) { const size_t off = (size_t)(row0 + ai * 128 + m * 16) * D + col0;
#pragma unroll
                for (int bj = 0; bj < 2; ++bj) { const size_t o2 = off + bj * 128;
                    const pg8::f32x4 v0 = acc[ai][bj][m][0] + *(const pg8::f32x4*)(X + o2), v1 = acc[ai][bj][m][1] + *(const pg8::f32x4*)(X + o2 + 4);
                    *(pg8::f32x4*)(O + o2) = v0; *(pg8::f32x4*)(O + o2 + 4) = v1;
                    pg8::u32x4 w; w.x = pk2(v0[0], v0[1]); w.y = pk2(v0[2], v0[3]); w.z = pk2(v1[0], v1[1]); w.w = pk2(v1[2], v1[3]);
                    *(pg8::u32x4*)(XB + o2) = w; } }
    }
};
struct EpiGate {
    static constexpr bool PERM = true, AFTER_DRAIN = false;
    float* O; const bf16* PP; const float* rstd;
    __device__ __forceinline__ void operator()(const pg8::f32x4 (&acc)[2][2][4][2], const pg8::Unit& u, int wr, int wc, int fr, int fq) const {
        const int row0 = u.pm * 256 + wr * 64 + fr, col0 = u.pn * 256 + wc * 32 + 8 * fq;
#pragma unroll
        for (int ai = 0; ai < 2; ++ai)
#pragma unroll
            for (int m = 0; m < 4; ++m) { const int row = row0 + ai * 128 + m * 16; const size_t off = (size_t)row * D + col0; const pg8::f32x4 q0 = *(const pg8::f32x4*)(rstd + (size_t)row * 8), q1 = *(const pg8::f32x4*)(rstd + (size_t)row * 8 + 4);
                const float rs = 1.0f / sqrtf((((q0[0] + q0[1]) + (q0[2] + q0[3])) + ((q1[0] + q1[1]) + (q1[2] + q1[3]))) * (1.0f / D) + 1e-6f);
#pragma unroll
                for (int bj = 0; bj < 2; ++bj) { const size_t o2 = off + bj * 128;
                    const pg8::u32x4 pw = *(const pg8::u32x4*)(PP + o2);
                    pg8::f32x4 x0 = *(const pg8::f32x4*)(O + o2), x1 = *(const pg8::f32x4*)(O + o2 + 4);
                    const pg8::f32x4 a0 = acc[ai][bj][m][0] * rs, a1 = acc[ai][bj][m][1] * rs;
                    x0[0] += bf_lo(pw.x) / (1.0f + __expf(-a0[0])); x0[1] += bf_hi(pw.x) / (1.0f + __expf(-a0[1])); x0[2] += bf_lo(pw.y) / (1.0f + __expf(-a0[2])); x0[3] += bf_hi(pw.y) / (1.0f + __expf(-a0[3]));
                    x1[0] += bf_lo(pw.z) / (1.0f + __expf(-a1[0])); x1[1] += bf_hi(pw.z) / (1.0f + __expf(-a1[1])); x1[2] += bf_lo(pw.w) / (1.0f + __expf(-a1[2])); x1[3] += bf_hi(pw.w) / (1.0f + __expf(-a1[3]));
                    *(pg8::f32x4*)(O + o2) = x0; *(pg8::f32x4*)(O + o2 + 4) = x1; } }
    }
};

__device__ __forceinline__ void p0_transpose_item(const float* __restrict__ W, const float* __restrict__ gsc, int K, int N, bf16* __restrict__ WT, LAS float* scr, int item, int lane) {
    const int nblk = N / 32, kb = item / nblk, nb = item % nblk, k0 = 64 * kb, n0 = 32 * nb;
#pragma unroll 8
    for (int i = 0; i < 32; ++i) { const int kk = 2 * i + (lane >> 5); float w = W[(size_t)(k0 + kk) * N + n0 + (lane & 31)]; if (gsc) w *= gsc[k0 + kk]; scr[kk * 33 + (lane & 31)] = w; }
    LDS_WAIT(); asm volatile("" ::: "memory");
    const int c = lane & 7;
#pragma unroll
    for (int j = 0; j < 4; ++j) { const int n = (lane >> 3) + 8 * j; const LAS float* s = scr + (8 * c) * 33 + n;
        v4u o; o.x = pk2(s[0 * 33], s[1 * 33]); o.y = pk2(s[2 * 33], s[3 * 33]); o.z = pk2(s[4 * 33], s[5 * 33]); o.w = pk2(s[6 * 33], s[7 * 33]);
        *(v4u*)(WT + (size_t)(n0 + n) * K + k0 + 8 * c) = o; }
    LDS_WAIT(); asm volatile("" ::: "memory");
}
__device__ __forceinline__ void p0_convert(const float* __restrict__ src, bf16* __restrict__ dst, size_t n8, size_t gtid, size_t gthreads) {
    for (size_t i = gtid; i < n8; i += gthreads) {
        const f32x4 a = ((const f32x4*)src)[2 * i], b = ((const f32x4*)src)[2 * i + 1];
        v4u o; o.x = pk2(a[0], a[1]); o.y = pk2(a[2], a[3]); o.z = pk2(b[0], b[1]); o.w = pk2(b[2], b[3]);
        ((v4u*)dst)[i] = o;
    }
}
__device__ __forceinline__ void rms_row_to_bf16(const float* __restrict__ xrow, const float* __restrict__ g, bf16* __restrict__ orow, int lane) {
    const f32x4* xr = (const f32x4*)xrow + lane; const f32x4* gr = (const f32x4*)g + lane;
    f32x4 v[4]; float s = 0.f;
#pragma unroll
    for (int j = 0; j < 4; ++j) { v[j] = xr[64 * j]; s += (v[j][0] * v[j][0] + v[j][1] * v[j][1]) + (v[j][2] * v[j][2] + v[j][3] * v[j][3]); }
    const float rstd = 1.0f / sqrtf(wave_sum(s) * (1.0f / D) + 1e-6f);
    v2u* o8 = (v2u*)orow + lane;
#pragma unroll
    for (int j = 0; j < 4; ++j) { const f32x4 gg = gr[64 * j]; v2u w; w.x = pk2(v[j][0] * rstd * gg[0], v[j][1] * rstd * gg[1]); w.y = pk2(v[j][2] * rstd * gg[2], v[j][3] * rstd * gg[3]); o8[64 * j] = w; }
}

__device__ __forceinline__ void p0_prologue(const Args& a, LAS unsigned char* lds, int vcu, int G, int tid, int lane, int wave) {
    unsigned char* ws = a.ws;
    LAS float* scr = (LAS float*)(lds + wave * 16384);
    const int gw = vcu * NWAVES + wave, NGW = G * NWAVES;
    constexpr int I_IN = (D / 64) * (NIN / 32), I_OUT = (D / 64) * (D / 32), I_Q = (D / 64) * (NQ / 32), I_G = I_OUT, I_P = (PLE / 64) * (D / 32);
    constexpr int NITEMS = I_IN + I_OUT + I_Q + I_G + I_P;
    for (int it = gw; it < NITEMS; it += NGW) {
        int r = it;
        if (r < I_IN) { p0_transpose_item(a.in[3], nullptr, D, NIN, (bf16*)(ws + WS_WIN), scr, r, lane); continue; } r -= I_IN;
        if (r < I_OUT) { p0_transpose_item(a.in[7], nullptr, D, D, (bf16*)(ws + WS_WOUT), scr, r, lane); continue; } r -= I_OUT;
        if (r < I_Q) { p0_transpose_item(a.in[9], a.in[8], D, NQ, (bf16*)(ws + WS_WQ), scr, r, lane); continue; } r -= I_Q;
        if (r < I_G) { p0_transpose_item(a.in[14], a.in[13], D, D, (bf16*)(ws + WS_WG), scr, r, lane); continue; } r -= I_G;
        p0_transpose_item(a.in[15], nullptr, PLE, D, (bf16*)(ws + WS_WP), scr, r, lane);
    }
    const size_t gtid = (size_t)vcu * NTHR + tid, gthreads = (size_t)G * NTHR;
    p0_convert(a.in[10], (bf16*)(ws + WS_KEYS), 2 * 128 * 128 / 8, gtid, gthreads);
    for (int r = gw; r < 2 * NEXP; r += NGW) {
        const int isv = r >= NEXP, e = isv ? r - NEXP : r;
        const float* src = (isv ? a.in[12] : a.in[11]) + (size_t)e * D + 16 * lane;
        const f32x4 x0 = *(const f32x4*)src, x1 = *(const f32x4*)(src + 4), x2 = *(const f32x4*)(src + 8), x3 = *(const f32x4*)(src + 12);
        float xs[16];
#pragma unroll
        for (int u = 0; u < 4; ++u) { xs[u] = x0[u]; xs[4 + u] = x1[u]; xs[8 + u] = x2[u]; xs[12 + u] = x3[u]; }
        float am = 0.f;
#pragma unroll
        for (int u = 0; u < 16; ++u) am = fmaxf(am, fabsf(xs[u]));
#pragma unroll
        for (int o = 1; o < 64; o <<= 1) am = fmaxf(am, __shfl_xor(am, o));
        const float inv = am > 0.f ? 127.0f / am : 0.f; const unsigned bias = isv ? 128u : 0u;
        v4u w;
#pragma unroll
        for (int c = 0; c < 4; ++c) { unsigned ww = 0u;
#pragma unroll
            for (int u = 0; u < 4; ++u) { const int q = __float2int_rn(xs[4 * c + u] * inv); ww |= (((unsigned)q + bias) & 0xffu) << (8 * u); }
            w[c] = ww; }
        *(v4u*)(ws + (isv ? WS_VB : WS_UB) + (size_t)e * D + 16 * lane) = w;
        if (lane == 0) ((float*)(ws + (isv ? WS_SV : WS_SU)))[e] = am * (1.0f / 127.0f);
    }
    p0_convert(a.in[1], (bf16*)(ws + WS_PB), (size_t)T * PLE / 8, gtid, gthreads);
    for (size_t i = gtid; i < (size_t)SQ * 32; i += gthreads) {
        const int pos = (int)(i >> 5), c = (int)(i & 31);
        const float freq = powf(10000.0f, -(float)c / 32.0f);
        const float ang = (float)pos * freq;
        float sn, cs; sincosf(ang, &sn, &cs);
        ((float*)(ws + WS_ROPE))[i] = cs; ((float*)(ws + WS_ROPE))[(size_t)SQ * 32 + i] = sn;
    }
    for (int m = gw; m < T; m += NGW) rms_row_to_bf16(a.in[0] + (size_t)m * D, a.in[2], (bf16*)(ws + WS_R1) + (size_t)m * D, lane);
}


#define MFMA32(a, b, c) __builtin_amdgcn_mfma_f32_32x32x16_bf16((a), (b), (c), 0, 0, 0)
__device__ __forceinline__ int crow(int r, int hf) { return (r & 3) + 8 * (r >> 2) + 4 * hf; }
__device__ __forceinline__ bf16x8 pack8(float a0, float a1, float a2, float a3, float a4, float a5, float a6, float a7) {
    v4u w; w.x = pk2(a0, a1); w.y = pk2(a2, a3); w.z = pk2(a4, a5); w.w = pk2(a6, a7); return __builtin_bit_cast(bf16x8, w);
}
__device__ __forceinline__ bf16x8 lds_frag16(LAS unsigned char* p) { return *(const LAS bf16x8*)p; }
__device__ __forceinline__ bf16x8 lds_frag8x2(LAS unsigned char* p) {
    const bf16x4 lo = *(const LAS bf16x4*)p, hi = *(const LAS bf16x4*)(p + 16); return __builtin_shufflevector(lo, hi, 0, 1, 2, 3, 4, 5, 6, 7);
}
constexpr int RQ = 144, RT = 272, RV = 528;
constexpr int LR_QS = 0, LR_KS = LR_QS + 128 * RQ, LR_KT = LR_KS + 128 * RQ, LR_VT = LR_KT + 64 * RT, LR_ST = LR_VT + 64 * RT, LR_LN = LR_ST + 64 * RQ, LR_END = LR_LN + 2 * 128 * 8;
static_assert(LR_END <= RING_BYTES, "retention LDS");
__device__ __forceinline__ void ret_unit(const bf16* __restrict__ PROJ, bf16* __restrict__ MIXED, const float* __restrict__ rope, LAS unsigned char* lds,
                                         int b, int h, int c0, int c1, int tid, int lane, int wave) {
    const float gam = 1.0f - exp2f(-5.0f - (float)h), lg2 = log2f(gam), cd = exp2f(lg2 * 128.0f);
    const int l31 = lane & 31, hf = lane >> 5, ib = wave >> 1, et = wave & 1;
    const int r = tid >> 2, qd = tid & 3;
    const float wq = exp2f(lg2 * (float)(r + 1)), wk = exp2f(-lg2 * (float)(r + 1));
    f32x16 stacc;
#pragma unroll
    for (int i = 0; i < 16; ++i) stacc[i] = 0.f;
    for (int i = tid; i < 64 * RQ / 4; i += NTHR) ((LAS unsigned*)(lds + LR_ST))[i] = 0u;
    for (int n = 0; n < c1; ++n) {
        const bool own = n >= c0;
        const int seqpos = n * 128 + r;
        const bf16* pr = PROJ + ((size_t)b * SQ + seqpos) * NIN + h * 64 + 8 * qd;
        const v4u k1 = *(const v4u*)(pr + 512), k2 = *(const v4u*)(pr + 512 + 32);
        const v4u v1 = *(const v4u*)(pr + 1024), v2 = *(const v4u*)(pr + 1024 + 32);
        v4u q1 = {0u, 0u, 0u, 0u}, q2 = {0u, 0u, 0u, 0u};
        if (own) { q1 = *(const v4u*)(pr); q2 = *(const v4u*)(pr + 32); }
        const f32x4 csa = *(const f32x4*)(rope + seqpos * 32 + 8 * qd), csb = *(const f32x4*)(rope + seqpos * 32 + 8 * qd + 4);
        const f32x4 sna = *(const f32x4*)(rope + SQ * 32 + seqpos * 32 + 8 * qd), snb = *(const f32x4*)(rope + SQ * 32 + seqpos * 32 + 8 * qd + 4);
        float cs[8], sn[8];
#pragma unroll
        for (int u = 0; u < 4; ++u) { cs[u] = csa[u]; cs[4 + u] = csb[u]; sn[u] = sna[u]; sn[4 + u] = snb[u]; }
        __syncthreads();
        {
            float o1[8], o2[8];
#pragma unroll
            for (int u = 0; u < 8; ++u) { const unsigned w1 = k1[u >> 1], w2 = k2[u >> 1]; const float x1 = (u & 1) ? bf_hi(w1) : bf_lo(w1), x2 = (u & 1) ? bf_hi(w2) : bf_lo(w2);
                o1[u] = (x1 * cs[u] - x2 * sn[u]) * wk; o2[u] = (x1 * sn[u] + x2 * cs[u]) * wk; }
            if (own) {
                *(LAS bf16x8*)(lds + LR_KS + r * RQ + (8 * qd) * 2) = pack8(o1[0], o1[1], o1[2], o1[3], o1[4], o1[5], o1[6], o1[7]);
                *(LAS bf16x8*)(lds + LR_KS + r * RQ + (32 + 8 * qd) * 2) = pack8(o2[0], o2[1], o2[2], o2[3], o2[4], o2[5], o2[6], o2[7]);
            }
#pragma unroll
            for (int u = 0; u < 8; u += 2) {
                const unsigned a = pk2(o1[u] * 0.125f, o1[u + 1] * 0.125f), c = pk2(o2[u] * 0.125f, o2[u + 1] * 0.125f);
                *(LAS bf16*)(lds + LR_KT + (8 * qd + u) * RT + r * 2) = (bf16)(a & 0xffffu); *(LAS bf16*)(lds + LR_KT + (8 * qd + u + 1) * RT + r * 2) = (bf16)(a >> 16);
                *(LAS bf16*)(lds + LR_KT + (32 + 8 * qd + u) * RT + r * 2) = (bf16)(c & 0xffffu); *(LAS bf16*)(lds + LR_KT + (32 + 8 * qd + u + 1) * RT + r * 2) = (bf16)(c >> 16);
                const unsigned w1 = v1[u >> 1], w2 = v2[u >> 1];
                *(LAS bf16*)(lds + LR_VT + (8 * qd + u) * RT + r * 2) = (bf16)(w1 & 0xffffu); *(LAS bf16*)(lds + LR_VT + (8 * qd + u + 1) * RT + r * 2) = (bf16)(w1 >> 16);
                *(LAS bf16*)(lds + LR_VT + (32 + 8 * qd + u) * RT + r * 2) = (bf16)(w2 & 0xffffu); *(LAS bf16*)(lds + LR_VT + (32 + 8 * qd + u + 1) * RT + r * 2) = (bf16)(w2 >> 16);
            }
            if (own) {
#pragma unroll
                for (int u = 0; u < 8; ++u) { const unsigned w1 = q1[u >> 1], w2 = q2[u >> 1]; const float x1 = (u & 1) ? bf_hi(w1) : bf_lo(w1), x2 = (u & 1) ? bf_hi(w2) : bf_lo(w2);
                    o1[u] = (x1 * cs[u] - x2 * sn[u]) * wq; o2[u] = (x1 * sn[u] + x2 * cs[u]) * wq; }
                *(LAS bf16x8*)(lds + LR_QS + r * RQ + (8 * qd) * 2) = pack8(o1[0], o1[1], o1[2], o1[3], o1[4], o1[5], o1[6], o1[7]);
                *(LAS bf16x8*)(lds + LR_QS + r * RQ + (32 + 8 * qd) * 2) = pack8(o2[0], o2[1], o2[2], o2[3], o2[4], o2[5], o2[6], o2[7]);
            }
        }
        __syncthreads();
        if (own) {
            const size_t orow = (size_t)b * SQ + n * 128 + 32 * ib + l31;
            v2u gv[4];
#pragma unroll
            for (int g = 0; g < 4; ++g) gv[g] = *(const v2u*)(PROJ + orow * NIN + 1536 + h * 64 + 32 * et + 8 * g + 4 * hf);
            bf16x8 qf[4];
#pragma unroll
            for (int ks = 0; ks < 4; ++ks) qf[ks] = lds_frag16(lds + LR_QS + (32 * ib + l31) * RQ + (16 * ks + 8 * hf) * 2);
            f32x16 o;
#pragma unroll
            for (int i = 0; i < 16; ++i) o[i] = 0.f;
#pragma unroll
            for (int ks = 0; ks < 4; ++ks) o = MFMA32(lds_frag16(lds + LR_ST + (32 * et + l31) * RQ + (16 * ks + 8 * hf) * 2), qf[ks], o);
            for (int jb = 0; jb <= ib; ++jb) {
                f32x16 s;
#pragma unroll
                for (int i = 0; i < 16; ++i) s[i] = 0.f;
#pragma unroll
                for (int ks = 0; ks < 4; ++ks) s = MFMA32(lds_frag16(lds + LR_KS + (32 * jb + l31) * RQ + (16 * ks + 8 * hf) * 2), qf[ks], s);
                const bool diag = (jb == ib);
                float p[16];
#pragma unroll
                for (int i = 0; i < 16; ++i) p[i] = (diag && crow(i, hf) > l31) ? 0.f : s[i] * 0.125f;
#pragma unroll
                for (int st = 0; st < 2; ++st) {
                    const bf16x8 pf = pack8(p[8 * st], p[8 * st + 1], p[8 * st + 2], p[8 * st + 3], p[8 * st + 4], p[8 * st + 5], p[8 * st + 6], p[8 * st + 7]);
                    o = MFMA32(lds_frag8x2(lds + LR_VT + (32 * et + l31) * RT + (32 * jb + 16 * st + 4 * hf) * 2), pf, o);
                }
            }
            float s1 = 0.f, s2 = 0.f;
#pragma unroll
            for (int i = 0; i < 16; ++i) { s1 += o[i]; s2 += o[i] * o[i]; }
            s1 += __shfl_xor(s1, 32); s2 += __shfl_xor(s2, 32);
            if (hf == 0) *(LAS f32x2*)(lds + LR_LN + (et * 128 + 32 * ib + l31) * 8) = (f32x2){s1, s2};
            __syncthreads();
            const f32x2 ot = *(const LAS f32x2*)(lds + LR_LN + ((et ^ 1) * 128 + 32 * ib + l31) * 8);
            const float mu = (s1 + ot.x) * (1.0f / 64.0f), var = fmaxf((s2 + ot.y) * (1.0f / 64.0f) - mu * mu, 0.f), rs = 1.0f / sqrtf(var + 1e-6f);
#pragma unroll
            for (int g = 0; g < 4; ++g) {
                float y[4];
#pragma unroll
                for (int u = 0; u < 4; ++u) { const unsigned w = gv[g][u >> 1]; const float gg = (u & 1) ? bf_hi(w) : bf_lo(w); const float sg = gg / (1.0f + __expf(-gg)); y[u] = sg * ((o[4 * g + u] - mu) * rs); }
                v2u w; w.x = pk2(y[0], y[1]); w.y = pk2(y[2], y[3]);
                *(v2u*)(MIXED + orow * D + h * 64 + 32 * et + 8 * g + 4 * hf) = w;
            }
        }
        if (wave < 4) {
            const int se = wave >> 1, sd = wave & 1;
#pragma unroll
            for (int ks = 0; ks < 8; ++ks)
                stacc = MFMA32(lds_frag16(lds + LR_VT + (32 * se + l31) * RT + (16 * ks + 8 * hf) * 2), lds_frag16(lds + LR_KT + (32 * sd + l31) * RT + (16 * ks + 8 * hf) * 2), stacc);
#pragma unroll
            for (int i = 0; i < 16; ++i) stacc[i] *= cd;
#pragma unroll
            for (int i = 0; i < 16; i += 2) { const unsigned w = pk2(stacc[i], stacc[i + 1]);
                *(LAS bf16*)(lds + LR_ST + (32 * se + crow(i, hf)) * RQ + (32 * sd + l31) * 2) = (bf16)(w & 0xffffu);
                *(LAS bf16*)(lds + LR_ST + (32 * se + crow(i + 1, hf)) * RQ + (32 * sd + l31) * 2) = (bf16)(w >> 16); }
        }
    }
    __syncthreads();
}

constexpr int LS_KN = 0, LS_VT = LS_KN + 256 * RQ, LS_QN = LS_VT + 64 * RV, LS_END = LS_QN + 256 * RQ;
static_assert(LS_END <= RING_BYTES, "swa LDS");
__device__ __forceinline__ void swa_unit(const bf16* __restrict__ PROJ, bf16* __restrict__ MIXED, const float* __restrict__ qnw, const float* __restrict__ knw, const float* __restrict__ sinks,
                                         LAS unsigned char* lds, int b, int kvh, int n, int tid, int lane, int wave) {
    const int l31 = lane & 31, hf = lane >> 5;
    const int row = tid >> 1, half = tid & 1;
    {
        const int kpos = (n - 1) * 128 + row; const bool valid = kpos >= 0;
        v4u kk[4], vv[4];
#pragma unroll
        for (int c = 0; c < 4; ++c) { kk[c] = (v4u){0u, 0u, 0u, 0u}; vv[c] = (v4u){0u, 0u, 0u, 0u}; }
        if (valid) { const bf16* pr = PROJ + ((size_t)b * SQ + kpos) * NIN + 32 * half;
#pragma unroll
            for (int c = 0; c < 4; ++c) { kk[c] = *(const v4u*)(pr + 2560 + kvh * 64 + 8 * c); vv[c] = *(const v4u*)(pr + 2688 + kvh * 64 + 8 * c); } }
        float kf[32]; float ss = 0.f;
#pragma unroll
        for (int c = 0; c < 4; ++c)
#pragma unroll
            for (int u = 0; u < 4; ++u) { kf[8 * c + 2 * u] = bf_lo(kk[c][u]); kf[8 * c + 2 * u + 1] = bf_hi(kk[c][u]); }
#pragma unroll
        for (int i = 0; i < 32; ++i) ss += kf[i] * kf[i];
        ss += __shfl_xor(ss, 1);
        const float rstd = 0.125f / sqrtf(ss * (1.0f / 64.0f) + 1e-6f);
#pragma unroll
        for (int c = 0; c < 4; ++c) {
            const f32x4 g0 = *(const f32x4*)(knw + 32 * half + 8 * c), g1 = *(const f32x4*)(knw + 32 * half + 8 * c + 4);
            *(LAS bf16x8*)(lds + LS_KN + row * RQ + (32 * half + 8 * c) * 2) = pack8(kf[8 * c] * rstd * g0[0], kf[8 * c + 1] * rstd * g0[1], kf[8 * c + 2] * rstd * g0[2], kf[8 * c + 3] * rstd * g0[3],
                                                                                  kf[8 * c + 4] * rstd * g1[0], kf[8 * c + 5] * rstd * g1[1], kf[8 * c + 6] * rstd * g1[2], kf[8 * c + 7] * rstd * g1[3]);
#pragma unroll
            for (int u = 0; u < 4; ++u) { const unsigned w = vv[c][u];
                *(LAS bf16*)(lds + LS_VT + (32 * half + 8 * c + 2 * u) * RV + row * 2) = (bf16)(w & 0xffffu); *(LAS bf16*)(lds + LS_VT + (32 * half + 8 * c + 2 * u + 1) * RV + row * 2) = (bf16)(w >> 16); }
        }
    }
    for (int rnd = 0; rnd < 2; ++rnd) {
        {
            const int hs = row >> 7, qrow = row & 127, hq = kvh * 4 + rnd * 2 + hs;
            const bf16* pr = PROJ + ((size_t)b * SQ + n * 128 + qrow) * NIN + 2048 + hq * 64 + 32 * half;
            v4u qq[4];
#pragma unroll
            for (int c = 0; c < 4; ++c) qq[c] = *(const v4u*)(pr + 8 * c);
            float qf[32]; float ss = 0.f;
#pragma unroll
            for (int c = 0; c < 4; ++c)
#pragma unroll
                for (int u = 0; u < 4; ++u) { qf[8 * c + 2 * u] = bf_lo(qq[c][u]); qf[8 * c + 2 * u + 1] = bf_hi(qq[c][u]); }
#pragma unroll
            for (int i = 0; i < 32; ++i) ss += qf[i] * qf[i];
            ss += __shfl_xor(ss, 1);
            const float rstd = 1.0f / sqrtf(ss * (1.0f / 64.0f) + 1e-6f);
#pragma unroll
            for (int c = 0; c < 4; ++c) {
                const f32x4 g0 = *(const f32x4*)(qnw + 32 * half + 8 * c), g1 = *(const f32x4*)(qnw + 32 * half + 8 * c + 4);
                *(LAS bf16x8*)(lds + LS_QN + row * RQ + (32 * half + 8 * c) * 2) = pack8(qf[8 * c] * rstd * g0[0], qf[8 * c + 1] * rstd * g0[1], qf[8 * c + 2] * rstd * g0[2], qf[8 * c + 3] * rstd * g0[3],
                                                                                      qf[8 * c + 4] * rstd * g1[0], qf[8 * c + 5] * rstd * g1[1], qf[8 * c + 6] * rstd * g1[2], qf[8 * c + 7] * rstd * g1[3]);
            }
        }
        __syncthreads();
        {
            const int hs = wave >> 2, ib = wave & 3, hq = kvh * 4 + rnd * 2 + hs;
            bf16x8 qf[4];
#pragma unroll
            for (int ks = 0; ks < 4; ++ks) qf[ks] = lds_frag16(lds + LS_QN + (hs * 128 + 32 * ib + l31) * RQ + (16 * ks + 8 * hf) * 2);
            f32x16 s[5];
#pragma unroll
            for (int t = 0; t < 5; ++t) {
#pragma unroll
                for (int i = 0; i < 16; ++i) s[t][i] = 0.f;
#pragma unroll
                for (int ks = 0; ks < 4; ++ks) s[t] = MFMA32(lds_frag16(lds + LS_KN + (32 * (ib + t) + l31) * RQ + (16 * ks + 8 * hf) * 2), qf[ks], s[t]);
            }
            const float sink = sinks[hq];
            float m = sink;
#pragma unroll
            for (int t = 0; t < 5; ++t)
#pragma unroll
                for (int i = 0; i < 16; ++i) {
                    bool ok = true;
                    if (t == 0) ok = crow(i, hf) > l31;
                    if (t == 4) ok = crow(i, hf) <= l31;
                    if (n == 0 && ib + t < 4) ok = false;
                    s[t][i] = ok ? s[t][i] : -INFINITY;
                    m = fmaxf(m, s[t][i]);
                }
            m = fmaxf(m, __shfl_xor(m, 32));
            float l = 0.f;
#pragma unroll
            for (int t = 0; t < 5; ++t)
#pragma unroll
                for (int i = 0; i < 16; ++i) { s[t][i] = exp2f((s[t][i] - m) * 1.4426950408889634f); l += s[t][i]; }
            l += __shfl_xor(l, 32);
            l += exp2f((sink - m) * 1.4426950408889634f);
            f32x16 o[2];
#pragma unroll
            for (int e2 = 0; e2 < 2; ++e2)
#pragma unroll
                for (int i = 0; i < 16; ++i) o[e2][i] = 0.f;
#pragma unroll
            for (int t = 0; t < 5; ++t)
#pragma unroll
                for (int st = 0; st < 2; ++st) {
                    const bf16x8 pf = pack8(s[t][8 * st], s[t][8 * st + 1], s[t][8 * st + 2], s[t][8 * st + 3], s[t][8 * st + 4], s[t][8 * st + 5], s[t][8 * st + 6], s[t][8 * st + 7]);
#pragma unroll
                    for (int e2 = 0; e2 < 2; ++e2) o[e2] = MFMA32(lds_frag8x2(lds + LS_VT + (32 * e2 + l31) * RV + (32 * (ib + t) + 16 * st + 4 * hf) * 2), pf, o[e2]);
                }
            const float inv = 1.0f / l;
            const size_t orow = (size_t)b * SQ + n * 128 + 32 * ib + l31;
#pragma unroll
            for (int e2 = 0; e2 < 2; ++e2)
#pragma unroll
                for (int g = 0; g < 4; ++g) { v2u w; w.x = pk2(o[e2][4 * g] * inv, o[e2][4 * g + 1] * inv); w.y = pk2(o[e2][4 * g + 2] * inv, o[e2][4 * g + 3] * inv);
                    *(v2u*)(MIXED + orow * D + 512 + hq * 64 + 32 * e2 + 8 * g + 4 * hf) = w; }
        }
        __syncthreads();
    }
}

__device__ __forceinline__ void p2_mixing(const Args& a, LAS unsigned char* lds, int bx, int G, int tid, int lane, int wave) {
    const bf16* PROJ = (const bf16*)(a.ws + WS_R2); bf16* MIXED = (bf16*)(a.ws + WS_R1); const float* rope = (const float*)(a.ws + WS_ROPE);
    for (int u = bx; u < 256; u += G) {
        const int b = u >> 5, h = (u >> 2) & 7, grp = u & 3;
        const int c0 = grp == 0 ? 0 : grp == 1 ? 11 : grp == 2 ? 20 : 27, c1 = grp == 0 ? 11 : grp == 1 ? 20 : grp == 2 ? 27 : 32;
        ret_unit(PROJ, MIXED, rope, lds, b, h, c0, c1, tid, lane, wave);
    }
    for (int su = bx; su < 512; su += G) swa_unit(PROJ, MIXED, a.in[4], a.in[5], a.in[6], lds, su >> 6, (su >> 5) & 1, su & 31, tid, lane, wave);
}


template <int N> __device__ __forceinline__ void bitonic_sort_desc(float (&v)[N]) {
#pragma unroll
    for (int k = 2; k <= N; k <<= 1)
#pragma unroll
        for (int j = k >> 1; j > 0; j >>= 1)
#pragma unroll
            for (int i = 0; i < N; ++i) { const int l = i ^ j; if (l > i) { const bool desc = ((i & k) == 0); const float a = v[i], b = v[l]; const float hi = fmaxf(a, b), lo = fminf(a, b); v[i] = desc ? hi : lo; v[l] = desc ? lo : hi; } }
}
__device__ __forceinline__ void bitonic_merge16_desc(float (&v)[16]) {
#pragma unroll
    for (int j = 8; j > 0; j >>= 1)
#pragma unroll
        for (int i = 0; i < 16; ++i) { const int l = i ^ j; if (l > i) { const float a = v[i], b = v[l]; v[i] = fmaxf(a, b); v[l] = fminf(a, b); } }
}
__device__ __forceinline__ void top16_of_64(float (&v)[64], float (&out)[16]) {
    float b[4][16];
#pragma unroll
    for (int q = 0; q < 4; ++q) {
#pragma unroll
        for (int i = 0; i < 16; ++i) b[q][i] = v[16 * q + i];
        bitonic_sort_desc<16>(b[q]);
    }
    float t0[16], t1[16];
#pragma unroll
    for (int i = 0; i < 16; ++i) { t0[i] = fmaxf(b[0][i], b[1][15 - i]); t1[i] = fmaxf(b[2][i], b[3][15 - i]); }
    bitonic_merge16_desc(t0); bitonic_merge16_desc(t1);
#pragma unroll
    for (int i = 0; i < 16; ++i) out[i] = fmaxf(t0[i], t1[15 - i]);
    bitonic_merge16_desc(out);
}
__device__ __forceinline__ float dot2u(unsigned a, unsigned b, float c) { return __builtin_amdgcn_fdot2_f32_bf16(__builtin_bit_cast(b16x2, a), __builtin_bit_cast(b16x2, b), c, false); }
__device__ __forceinline__ float gelu_erf(float a) { return 0.5f * a * (1.0f + erff(a * 0.70710678118654752f)); }

constexpr int KROW = 272;
constexpr size_t WS_EID = WS_R2, WS_GATE = WS_R2 + 8 * MB, WS_ACT = WS_R2 + 24 * MB, WS_RSS2 = WS_R2 + 40 * MB;
constexpr int LP_KEYS = 0, LP_LUT = LP_KEYS + 256 * KROW, LP_RSTD = LP_LUT + NWAVES * 32 * 32, LP_END = LP_RSTD + 2 * 128;
static_assert(LP_END <= RING_BYTES, "peer LDS");

__device__ __forceinline__ void p5a_topk(const Args& a, LAS unsigned char* lds, int vcu, int G, int tid, int lane, int wave) {
    unsigned char* ws = a.ws;
    const bf16* Q = (const bf16*)(ws + WS_R2 + 64 * MB); const float* X = a.out; unsigned char* H8 = ws + WS_R1; float* SH = (float*)(ws + WS_SH); const float* gffn = a.in[8];
    unsigned short* EID = (unsigned short*)(ws + WS_EID); float* GATE = (float*)(ws + WS_GATE);
    const int l31 = lane & 31, hf = lane >> 5;
    for (int i = tid; i < 256 * 16; i += NTHR) { const int rr = i >> 4, c = i & 15; *(LAS v4u*)(lds + LP_KEYS + rr * KROW + c * 16) = *(const v4u*)((const bf16*)(ws + WS_KEYS) + rr * 128 + c * 8); }
    float gw[16];
    { const f32x4 g0 = *(const f32x4*)(gffn + 16 * lane), g1 = *(const f32x4*)(gffn + 16 * lane + 4), g2 = *(const f32x4*)(gffn + 16 * lane + 8), g3 = *(const f32x4*)(gffn + 16 * lane + 12);
#pragma unroll
      for (int u = 0; u < 4; ++u) { gw[u] = g0[u]; gw[4 + u] = g1[u]; gw[8 + u] = g2[u]; gw[12 + u] = g3[u]; } }
    int par = 0;
    for (int grp = vcu; grp < T / 32; grp += G, par ^= 1) {
        const int t0 = grp * 32;
#pragma unroll 1
        for (int q = 0; q < 4; ++q) {
            const size_t tok = (size_t)t0 + 4 * wave + q; const float* xr = X + tok * D + 16 * lane;
            const f32x4 x0 = *(const f32x4*)xr, x1 = *(const f32x4*)(xr + 4), x2 = *(const f32x4*)(xr + 8), x3 = *(const f32x4*)(xr + 12);
            float xs[16];
#pragma unroll
            for (int u = 0; u < 4; ++u) { xs[u] = x0[u]; xs[4 + u] = x1[u]; xs[8 + u] = x2[u]; xs[12 + u] = x3[u]; }
            float ss = 0.f;
#pragma unroll
            for (int u = 0; u < 16; ++u) ss += xs[u] * xs[u];
            ss = wave_sum(ss);
            const float rstd = 1.0f / sqrtf(ss * (1.0f / D) + 1e-6f);
            if (lane == 0) *(LAS float*)(lds + LP_RSTD + par * 128 + (4 * wave + q) * 4) = rstd;
            float am = 0.f;
#pragma unroll
            for (int u = 0; u < 16; ++u) { xs[u] = xs[u] * rstd * gw[u]; am = fmaxf(am, fabsf(xs[u])); }
#pragma unroll
            for (int o = 1; o < 64; o <<= 1) am = fmaxf(am, __shfl_xor(am, o));
            const float inv = am > 0.f ? 127.0f / am : 0.f;
            v4u w;
#pragma unroll
            for (int c = 0; c < 4; ++c) { unsigned ww = 0u;
#pragma unroll
                for (int u = 0; u < 4; ++u) { const int qi = __float2int_rn(xs[4 * c + u] * inv); ww |= ((unsigned)qi & 0xffu) << (8 * u); }
                w[c] = ww; }
            *(v4u*)(H8 + tok * D + 16 * lane) = w;
            if (lane == 0) SH[tok] = am * (1.0f / 127.0f);
        }
        __syncthreads();
        {
            const int h = wave;
            float lst[2][16];
#pragma unroll
            for (int p = 0; p < 2; ++p) {
                f32x16 acc[4];
#pragma unroll
                for (int q = 0; q < 4; ++q)
#pragma unroll
                    for (int i = 0; i < 16; ++i) acc[q][i] = 0.f;
                const bf16* qrow = Q + (size_t)(t0 + l31) * NQ + h * 256 + p * 128 + 8 * hf;
#pragma unroll
                for (int ks = 0; ks < 8; ++ks) {
                    const bf16x8 qf = *(const bf16x8*)(qrow + 16 * ks);
#pragma unroll
                    for (int q = 0; q < 4; ++q) acc[q] = MFMA32(lds_frag16(lds + LP_KEYS + (p * 128 + 32 * q + l31) * KROW + (16 * ks + 8 * hf) * 2), qf, acc[q]);
                }
                float v[64];
#pragma unroll
                for (int q = 0; q < 4; ++q)
#pragma unroll
                    for (int i = 0; i < 16; ++i) v[16 * q + i] = __uint_as_float((__float_as_uint(acc[q][i]) & 0xffffff80u) | (unsigned)(32 * q + crow(i, hf)));
                float mine[16];
                top16_of_64(v, mine);
                float t[16];
#pragma unroll
                for (int i = 0; i < 16; ++i) t[i] = __shfl_xor(mine[i], 32);
#pragma unroll
                for (int i = 0; i < 16; ++i) lst[p][i] = fmaxf(mine[i], t[15 - i]);
                bitonic_merge16_desc(lst[p]);
            }
            LAS unsigned char* lut = lds + LP_LUT + wave * 1024 + l31 * 32;
            {
                v4u wa, wb;
#pragma unroll
                for (int c = 0; c < 4; ++c) {
                    wa[c] = (__float_as_uint(lst[0][4 * c]) & 0x7fu) | ((__float_as_uint(lst[0][4 * c + 1]) & 0x7fu) << 8) | ((__float_as_uint(lst[0][4 * c + 2]) & 0x7fu) << 16) | ((__float_as_uint(lst[0][4 * c + 3]) & 0x7fu) << 24);
                    wb[c] = (__float_as_uint(lst[1][4 * c]) & 0x7fu) | ((__float_as_uint(lst[1][4 * c + 1]) & 0x7fu) << 8) | ((__float_as_uint(lst[1][4 * c + 2]) & 0x7fu) << 16) | ((__float_as_uint(lst[1][4 * c + 3]) & 0x7fu) << 24);
                }
                if (hf == 0) { *(LAS v4u*)lut = wa; *(LAS v4u*)(lut + 16) = wb; }
            }
            float cv[64];
            {
                int c = 0;
#pragma unroll
                for (int i = 0; i < 16; ++i)
#pragma unroll
                    for (int j = 0; j < 16; ++j)
                        if ((i + 1) * (j + 1) <= 16) {
                            const float sa = __uint_as_float(__float_as_uint(lst[0][i]) & 0xffffff80u), sb = __uint_as_float(__float_as_uint(lst[1][j]) & 0xffffff80u);
                            cv[c] = __uint_as_float((__float_as_uint(sa + sb) & 0xffffff00u) | (unsigned)(i * 16 + j)); ++c;
                        }
#pragma unroll
                for (int k = 50; k < 64; ++k) cv[k] = -3.0e38f;
            }
            float best[16];
            top16_of_64(cv, best);
            const float rstd = *(const LAS float*)(lds + LP_RSTD + par * 128 + l31 * 4);
            const float s0 = __uint_as_float(__float_as_uint(best[0]) & 0xffffff00u);
            float ev[16], esum = 0.f;
#pragma unroll
            for (int k = 0; k < 16; ++k) { const float sk = __uint_as_float(__float_as_uint(best[k]) & 0xffffff00u); ev[k] = __expf(rstd * (sk - s0)); esum += ev[k]; }
            const float einv = 1.0f / esum;
            LDS_WAIT();
            asm volatile("" ::: "memory");
            const size_t ob = (size_t)(t0 + l31) * 128 + h * 16;
            if (hf == 0) {
                unsigned e16[16];
#pragma unroll
                for (int k = 0; k < 16; ++k) { const unsigned code = __float_as_uint(best[k]) & 0xffu;
                    const unsigned ia = *(const LAS unsigned char*)(lut + (code >> 4)), ib = *(const LAS unsigned char*)(lut + 16 + (code & 15u));
                    e16[k] = ia * 128u + ib; }
                v4u w0, w1;
                w0.x = e16[0] | (e16[1] << 16); w0.y = e16[2] | (e16[3] << 16); w0.z = e16[4] | (e16[5] << 16); w0.w = e16[6] | (e16[7] << 16);
                w1.x = e16[8] | (e16[9] << 16); w1.y = e16[10] | (e16[11] << 16); w1.z = e16[12] | (e16[13] << 16); w1.w = e16[14] | (e16[15] << 16);
                *(v4u*)(EID + ob) = w0; *(v4u*)(EID + ob + 8) = w1;
            } else {
#pragma unroll
                for (int c = 0; c < 4; ++c) *(f32x4*)(GATE + ob + 4 * c) = (f32x4){ev[4 * c] * einv, ev[4 * c + 1] * einv, ev[4 * c + 2] * einv, ev[4 * c + 3] * einv};
            }
        }
    }
    __syncthreads();
}

constexpr int LB_H = 0, LB_LIST = LB_H + NWAVES * 4096, LB_GATE = LB_LIST + NWAVES * 2304, LB_END = LB_GATE + NWAVES * 2048;
static_assert(LB_END <= RING_BYTES, "p5b LDS");
__device__ __forceinline__ void p5b_dots(const Args& a, LAS unsigned char* lds, int bx, int G, int tid, int lane, int wave) {
    unsigned char* ws = a.ws;
    const unsigned char* H8 = ws + WS_R1; const unsigned char* U8 = ws + WS_UB; const float* SU = (const float*)(ws + WS_SU); const float* SV = (const float*)(ws + WS_SV); const float* SH = (const float*)(ws + WS_SH);
    const unsigned short* EID = (const unsigned short*)(ws + WS_EID); const float* GATE = (const float*)(ws + WS_GATE); float* ACT = (float*)(ws + WS_ACT);
    LAS unsigned char* hreg = lds + LB_H + wave * 4096; LAS unsigned* list = (LAS unsigned*)(lds + LB_LIST + wave * 2304); LAS float* gts = (LAS float*)(lds + LB_GATE + wave * 2048);
    const int jmine = ((lane >> 5) & 1) * 8 + ((lane >> 4) & 1) * 4 + ((lane >> 3) & 1) * 2 + ((lane >> 2) & 1);
    const unsigned long long ltmask = (1ull << lane) - 1ull;
    for (int vb = bx; vb < 256; vb += G) {
        const unsigned vx = (unsigned)(vb & 7); const int wi = vb >> 3;
        const int tw0 = wi * 1024 + wave * 128;
#pragma unroll 1
        for (int ch = 0; ch < 32; ++ch) {
            const int tok0 = tw0 + 4 * ch;
            int n = 0;
            const float shv = SH[tok0 + (lane & 3)];
#pragma unroll
            for (int s = 0; s < 4; ++s) {
                const size_t tok = (size_t)tok0 + s;
                const unsigned idw = *(const unsigned*)(EID + tok * 128 + 2 * lane);
                const f32x2 gg = *(const f32x2*)(GATE + tok * 128 + 2 * lane);
                const v4u h0 = *(const v4u*)(H8 + tok * D + 16 * lane);
                *(LAS v4u*)(hreg + s * 1024 + lane * 16) = h0;
                *(LAS f32x2*)(gts + s * 128 + 2 * lane) = gg;
                const unsigned id0 = idw & 0xffffu, id1 = idw >> 16;
                const bool in0 = (id0 >> 11) == vx, in1 = (id1 >> 11) == vx;
                const unsigned long long m0 = __ballot(in0), m1 = __ballot(in1);
                const int c0 = __popcll(m0), c1 = __popcll(m1);
                if (in0) list[n + __popcll(m0 & ltmask)] = ((unsigned)s << 28) | ((unsigned)(2 * lane) << 16) | id0;
                if (in1) list[n + c0 + __popcll(m1 & ltmask)] = ((unsigned)s << 28) | ((unsigned)(2 * lane + 1) << 16) | id1;
                n += c0 + c1;
            }
            const int nb = (n + 15) >> 4;
            if (lane < 16) list[n + lane] = (0xfu << 28) | (vx << 11);
            LDS_WAIT(); asm volatile("" ::: "memory");
#pragma unroll 1
            for (int bt = 0; bt < nb; ++bt) {
                const unsigned entv = list[16 * bt + (lane & 15)];
                v4u ur[16];
#pragma unroll
                for (int j = 0; j < 16; ++j) { const unsigned ent = __builtin_amdgcn_readlane(entv, j); ur[j] = *(const v4u*)(U8 + (size_t)(ent & 0xffffu) * D + 16 * lane); }
                const unsigned em = list[16 * bt + jmine];
                const unsigned eslot = em >> 28, ek = (em >> 16) & 0xffu, ee = em & 0xffffu;
                const float scl = SU[ee], svl = SV[ee];
                int d[16];
#pragma unroll
                for (int j = 0; j < 16; ++j) {
                    const unsigned ent = __builtin_amdgcn_readlane(entv, j);
                    const v4u hh = *(const LAS v4u*)(hreg + ((ent >> 28) & 3u) * 1024 + lane * 16);
                    int acc = 0;
#pragma unroll
                    for (int u = 0; u < 4; ++u) { const unsigned wa = ur[j][u], ha = hh[u]; acc = __builtin_amdgcn_sdot4((int)ha, (int)wa, acc, false); }
                    d[j] = acc;
                }
                int d8[8], d4[4], d2[2], d1;
                { const bool hi = (lane & 32) != 0;
#pragma unroll
                  for (int j = 0; j < 8; ++j) { const int keep = hi ? d[j + 8] : d[j], send = hi ? d[j] : d[j + 8]; d8[j] = keep + __shfl_xor(send, 32); } }
                { const bool hi = (lane & 16) != 0;
#pragma unroll
                  for (int j = 0; j < 4; ++j) { const int keep = hi ? d8[j + 4] : d8[j], send = hi ? d8[j] : d8[j + 4]; d4[j] = keep + __shfl_xor(send, 16); } }
                { const bool hi = (lane & 8) != 0;
#pragma unroll
                  for (int j = 0; j < 2; ++j) { const int keep = hi ? d4[j + 2] : d4[j], send = hi ? d4[j] : d4[j + 2]; d2[j] = keep + __shfl_xor(send, 8); } }
                { const bool hi = (lane & 4) != 0; const int keep = hi ? d2[1] : d2[0], send = hi ? d2[0] : d2[1]; d1 = keep + __shfl_xor(send, 4); }
                d1 += __shfl_xor(d1, 1); d1 += __shfl_xor(d1, 2);
                const float sht = __shfl(shv, (int)(eslot & 3u));
                const float dot = (float)d1 * scl * sht;
                if ((lane & 3) == 0 && eslot < 4u) ACT[((size_t)tok0 + eslot) * 128 + ek] = gelu_erf(dot) * gts[eslot * 128 + ek] * svl;
            }
        }
    }
}

constexpr int LC_BUF = 0, LC_END = NWAVES * 2 * 1024;
__device__ __forceinline__ void p5c_axpy(const Args& a, LAS unsigned char* lds, int bx, int G, int tid, int lane, int wave) {
    unsigned char* ws = a.ws;
    const unsigned char* V8 = ws + WS_VB; const unsigned short* EID = (const unsigned short*)(ws + WS_EID); const float* ACT = (const float*)(ws + WS_ACT);
    float* X = a.out; bf16* XB2 = (bf16*)(ws + WS_R1); float* RSS2 = (float*)(ws + WS_RSS2);
    const int g = lane >> 3, c = lane & 7;
    const int colo = 16 * c + 8 * ((g >> 2) & 1) + 4 * ((g >> 1) & 1) + 2 * (g & 1);
    for (int vb = bx; vb < 256; vb += G) {
        const int vx = vb & 7, wi = vb >> 3;
        const int tw0 = wi * 1024 + wave * 128;
        const unsigned char* vbase = V8 + vx * 128 + 16 * c;
        unsigned idw = *(const unsigned*)(EID + (size_t)tw0 * 128 + 2 * lane);
        f32x2 av = *(const f32x2*)(ACT + (size_t)tw0 * 128 + 2 * lane);
#pragma unroll 1
        for (int i = 0; i < 128; ++i) {
            const size_t tok = (size_t)tw0 + i;
            LAS unsigned char* buf = lds + LC_BUF + wave * 2048 + (i & 1) * 1024;
            *(LAS unsigned*)(buf + 4 * lane) = idw; *(LAS f32x2*)(buf + 256 + 8 * lane) = av;
            if (i + 1 < 128) { idw = *(const unsigned*)(EID + (tok + 1) * 128 + 2 * lane); av = *(const f32x2*)(ACT + (tok + 1) * 128 + 2 * lane); }
            float* xr = X + tok * D + vx * 128 + colo;
            const f32x2 xa = *(const f32x2*)xr;
            LDS_WAIT(); asm volatile("" ::: "memory");
            v4u vv[16]; float ak[16];
#pragma unroll
            for (int j = 0; j < 16; ++j) {
                const int k = 8 * j + g;
                const unsigned e = *(const LAS unsigned short*)(buf + 2 * k); ak[j] = *(const LAS float*)(buf + 256 + 4 * k);
                vv[j] = *(const v4u*)(vbase + (size_t)e * D);
            }
            float y[16], asum = 0.f;
#pragma unroll
            for (int u = 0; u < 16; ++u) y[u] = 0.f;
#pragma unroll
            for (int j = 0; j < 16; ++j) {
                asum += ak[j];
#pragma unroll
                for (int u = 0; u < 4; ++u) { const unsigned w = vv[j][u];
                    y[4 * u] += ak[j] * (float)(w & 0xffu); y[4 * u + 1] += ak[j] * (float)((w >> 8) & 0xffu); y[4 * u + 2] += ak[j] * (float)((w >> 16) & 0xffu); y[4 * u + 3] += ak[j] * (float)(w >> 24); }
            }
#pragma unroll
            for (int u = 0; u < 16; ++u) y[u] -= 128.0f * asum;
            float y8[8], y4[4], y2[2];
            { const bool hi = (lane & 32) != 0;
#pragma unroll
              for (int u = 0; u < 8; ++u) { const float keep = hi ? y[u + 8] : y[u], send = hi ? y[u] : y[u + 8]; y8[u] = keep + __shfl_xor(send, 32); } }
            { const bool hi = (lane & 16) != 0;
#pragma unroll
              for (int u = 0; u < 4; ++u) { const float keep = hi ? y8[u + 4] : y8[u], send = hi ? y8[u] : y8[u + 4]; y4[u] = keep + __shfl_xor(send, 16); } }
            { const bool hi = (lane & 8) != 0;
#pragma unroll
              for (int u = 0; u < 2; ++u) { const float keep = hi ? y4[u + 2] : y4[u], send = hi ? y4[u] : y4[u + 2]; y2[u] = keep + __shfl_xor(send, 8); } }
            const float o0 = xa[0] + y2[0], o1 = xa[1] + y2[1];
            const float ss = wave_sum(o0 * o0 + o1 * o1);
            *(f32x2*)xr = (f32x2){o0, o1};
            *(unsigned*)(XB2 + tok * D + vx * 128 + colo) = pk2(o0, o1);
            if (lane == 0) RSS2[tok * 8 + vx] = ss;
        }
    }
}

__global__ void __launch_bounds__(NTHR, 2) mk_fwd(Args a) {
    extern __shared__ __attribute__((aligned(16))) unsigned char lds_raw[];
    LAS unsigned char* lds = (LAS unsigned char*)lds_raw;
    const int tid = threadIdx.x, lane = tid & 63, wave = __builtin_amdgcn_readfirstlane(tid >> 6);
    const int G = gridDim.x, bx = blockIdx.x, vcu = (G % 8 == 0) ? (bx % 8) * (G / 8) + bx / 8 : bx;
    volatile LAS unsigned* MISC = (volatile LAS unsigned*)(lds + MISC_OFF);
    if (tid < 64) MISC[tid] = 0u;
    __syncthreads();
    unsigned char* ws = a.ws;
    const int lo = a.ph_lo, hi = a.ph_hi;
    XcdBarrier bar; bar.bar = (unsigned*)(ws + WS_CTL) + CW_BAR + a.li * XCD_BAR_WORDS; bar.x = 0; bar.st = nullptr;
    if (hi - lo > 1) bar = xcd_barrier_post((unsigned*)(ws + WS_CTL) + CW_BAR + a.li * XCD_BAR_WORDS, MISC + 8);
#define IN(k) (lo <= (k) && (k) < hi)
#define BOTH(k) (IN(k) && IN((k) + 1))
    if (IN(0)) { p0_prologue(a, lds, vcu, G, tid, lane, wave); if (BOTH(0)) xcd_barrier(bar); }
    if (IN(1)) {
        { pg8::Gemm g{(const bf16*)(ws + WS_R1), (const bf16*)(ws + WS_WIN), T, NIN, D}; pg8::StaticOrder S; S.init(T, NIN, G, bx);
          EpiStoreBf16 E{(bf16*)(ws + WS_R2), NIN};
          pg8::gemm_phase<EpiStoreBf16, pg8::StaticOrder, true, true>(lds, g, S, E); }
        { pg8::Gemm g{(const bf16*)(ws + WS_PB), (const bf16*)(ws + WS_WP), T, D, PLE}; pg8::StaticOrder S; S.init(T, D, G, bx);
          EpiStoreBf16 E{(bf16*)(ws + WS_PP), D};
          pg8::gemm_phase<EpiStoreBf16, pg8::StaticOrder, true, true>(lds, g, S, E); }
        if (BOTH(1)) xcd_barrier(bar);
    }
    if (IN(2)) { p2_mixing(a, lds, bx, G, tid, lane, wave); if (BOTH(2)) xcd_barrier(bar); }
    if (IN(3)) {
        pg8::Gemm g{(const bf16*)(ws + WS_R1), (const bf16*)(ws + WS_WOUT), T, D, D}; pg8::StaticOrder S; S.init(T, D, G, bx);
        EpiResid E{a.in[0], a.out, (bf16*)(ws + WS_R2)};
        pg8::gemm_phase<EpiResid, pg8::StaticOrder, true, true>(lds, g, S, E);
        if (BOTH(3)) xcd_barrier(bar);
    }
    if (IN(4)) {
        pg8::Gemm g{(const bf16*)(ws + WS_R2), (const bf16*)(ws + WS_WQ), T, NQ, D}; pg8::StaticOrder S; S.init(T, NQ, G, bx);
        EpiStoreBf16 E{(bf16*)(ws + WS_R2 + 64 * MB), NQ};
        pg8::gemm_phase<EpiStoreBf16, pg8::StaticOrder, true, true>(lds, g, S, E);
        if (BOTH(4)) xcd_barrier(bar);
    }
    if (IN(5)) {
        p5a_topk(a, lds, vcu, G, tid, lane, wave); xcd_barrier(bar);
        p5b_dots(a, lds, bx, G, tid, lane, wave); xcd_barrier(bar);
        p5c_axpy(a, lds, bx, G, tid, lane, wave);
        if (BOTH(5)) xcd_barrier(bar);
    }
    if (IN(6)) {
        pg8::Gemm g{(const bf16*)(ws + WS_R1), (const bf16*)(ws + WS_WG), T, D, D}; pg8::StaticOrder S; S.init(T, D, G, bx);
        EpiGate E{a.out, (const bf16*)(ws + WS_PP), (const float*)(ws + WS_RSS2)};
        pg8::gemm_phase<EpiGate, pg8::StaticOrder, true, true>(lds, g, S, E);
    }
#undef IN
#undef BOTH
}
}
extern "C" void kernel_launch(void* const* d_in, const int* in_sizes, int n_in, void* d_out, int out_size, void* d_ws, size_t ws_size, hipStream_t stream) {
    using namespace mk;
    static int grid = 0;
    if (grid == 0) {
        int dev = 0, cus = 0;
        if (n_in != 16 || out_size != T * D || ws_size < WS_END) { fprintf(stderr, "kernel_launch: unexpected problem shape / workspace (%d inputs, out %d, ws %zu)\n", n_in, out_size, ws_size); grid = -1; return; }
        if (hipGetDevice(&dev) != hipSuccess || hipDeviceGetAttribute(&cus, hipDeviceAttributeMultiprocessorCount, dev) != hipSuccess) { fprintf(stderr, "device query failed\n"); grid = -1; return; }
        if (hipFuncSetAttribute((const void*)mk_fwd, hipFuncAttributeMaxDynamicSharedMemorySize, LDS_BYTES) != hipSuccess) { fprintf(stderr, "hipFuncSetAttribute failed\n"); grid = -1; return; }
        int per_cu = 0;
        if (hipOccupancyMaxActiveBlocksPerMultiprocessor(&per_cu, (const void*)mk_fwd, NTHR, LDS_BYTES) != hipSuccess || per_cu < 1) { fprintf(stderr, "occupancy query: %d blocks per CU\n", per_cu); (void)hipGetLastError(); }
        grid = cus;
    }
    if (grid < 0) return;
    unsigned char* ws = (unsigned char*)d_ws;
    (void)hipMemsetAsync(ws + WS_CTL, 0, CTL_BYTES, stream);
    Args a{};
    for (int i = 0; i < 16; ++i) a.in[i] = (const float*)d_in[i];
    a.out = (float*)d_out; a.ws = ws; a.ph_lo = 0; a.ph_hi = 7; a.li = 0; a.pad = 0;
    hipLaunchKernelGGL(mk_fwd, dim3(grid), dim3(NTHR), LDS_BYTES, stream, a);
}
```

```cpp
#include <hip/hip_runtime.h>
#include <cstdio>
#include <cstdint>
#define LAS __attribute__((address_space(3)))
#define GAS __attribute__((address_space(1)))
namespace pg8 {
#define PG8_LAS __attribute__((address_space(3)))
typedef unsigned short bf16_t;
typedef short bf16x8 __attribute__((ext_vector_type(8)));
typedef float f32x4 __attribute__((ext_vector_type(4)));
typedef unsigned u32x4 __attribute__((ext_vector_type(4)));
constexpr int BM = 256, BK = 64, HALF = 128, HTB = HALF * BK * 2  , STAGE_BYTES = 8 * HTB, NXCD = 8, WGM = 8;

__host__ __device__ __forceinline__ int lds_byte(int r, int c) { const int st = (r >> 4) * 2 + (c >> 5), rr = r & 15, cc = c & 31, ob = rr * 64 + cc * 2; return st * 1024 + (ob ^ (((ob >> 9) & 1) << 5)); }
__host__ __device__ __forceinline__ void stage_rc(int b, int& R, int& C) { const int st = b / 1024, sb = b % 1024, swz = sb ^ (((sb >> 9) & 1) << 5); R = (st >> 1) * 16 + swz / 64; C = (st & 1) * 32 + (swz % 64) / 2; }
__host__ __device__ __forceinline__ int perm32(int rho) { const int n = rho >> 4, i = rho & 15; return 8 * (i >> 2) + 4 * n + (i & 3); }

struct Unit { int pm, pn; };
struct Gemm { const bf16_t* A; const bf16_t* Bt; int M, N, K; };

struct StaticOrder {
    int nM, nN, nwg, G, c;
    __host__ __device__ void init(int M, int N, int G_, int c_) { nM = M / BM; nN = N / BM; nwg = nM * nN; G = G_; c = c_; }
    __host__ __device__ bool next(int i, Unit& u) const {
        const long L = (long)i * G + c; if (L >= nwg) return false;
        int wgid = (int)L; { const int q = nwg / NXCD, r = nwg % NXCD, xcd = wgid % NXCD, off = wgid / NXCD; wgid = (xcd < r ? xcd * (q + 1) : r * (q + 1) + (xcd - r) * q) + off; }
        const int nig = WGM * nN, gid = wgid / nig, fm = gid * WGM, gsz = (nM - fm) < WGM ? (nM - fm) : WGM;
        u.pm = fm + ((wgid % nig) % gsz); u.pn = (wgid % nig) / gsz; return true;
    }
    __device__ __forceinline__ void a_ready(const Unit&) const {}
    __device__ __forceinline__ void done(const Unit&) const {}
};
__device__ __forceinline__ unsigned cvt_pk_bf16(float lo, float hi) { unsigned r; asm volatile("v_cvt_pk_bf16_f32 %0, %1, %2" : "=v"(r) : "v"(lo), "v"(hi)); return r; }
template <class Epi, class Sched, bool ALIGN_EPI = false, bool SP2 = false>
__device__ __forceinline__ void gemm_phase(PG8_LAS unsigned char* lds, const Gemm g, const Sched& S, const Epi& E) {
    const int tid = threadIdx.x, wid = __builtin_amdgcn_readfirstlane(tid >> 6), lane = tid & 63, wr = wid >> 2, wc = wid & 3, fr = lane & 15, fq = lane >> 4;
    const int K = g.K, nt = K / BK;
    unsigned voffA[2], voffB[2];
#pragma unroll
    for (int i = 0; i < 2; ++i) { int R, C; stage_rc(tid * 16 + i * 8192, R, C); const int Rb = Epi::PERM ? ((R & ~31) + perm32(R & 31)) : R;
        voffA[i] = (unsigned)(R * K + C) * 2u; voffB[i] = (unsigned)(Rb * K + C) * 2u; }
    const size_t kstep = (size_t)(BK * 2);
    const size_t hstep = (size_t)HALF * K * 2;
    const size_t tstep = 2 * hstep;
    const unsigned ldsw = (unsigned)wid * 1024u;
    const int aoff = lds_byte(wr * 64 + fr, fq * 8), boff = lds_byte(wc * 32 + fr, fq * 8);
#define PG8_SA(b, h) (((b) * 2 + (h)) * HTB)
#define PG8_SB(b, h) ((4 + (b) * 2 + (h)) * HTB)
#define PG8_STAGE(bufoff, gbase, voff) do { _Pragma("unroll") for (int _i = 0; _i < 2; ++_i) \
        __builtin_amdgcn_global_load_lds((const unsigned*)((const char*)(gbase) + (voff)[_i]), (PG8_LAS unsigned*)(lds + (bufoff) + ldsw + _i * 8192), 16, 0, 0); } while (0)
#define PG8_LDA(dst, b, h) do { _Pragma("unroll") for (int m = 0; m < 4; ++m) _Pragma("unroll") for (int k = 0; k < 2; ++k) dst[m][k] = *(const PG8_LAS bf16x8*)(lds + PG8_SA(b, h) + aoff + m * 2048 + k * 1024); } while (0)
#define PG8_LDB(dst, b, h) do { _Pragma("unroll") for (int n = 0; n < 2; ++n) _Pragma("unroll") for (int k = 0; k < 2; ++k) dst[n][k] = *(const PG8_LAS bf16x8*)(lds + PG8_SB(b, h) + boff + n * 2048 + k * 1024); } while (0)
#define PG8_MMA(ai, bj, At, Bt) do { __builtin_amdgcn_s_setprio(1); _Pragma("unroll") for (int m = 0; m < 4; ++m) _Pragma("unroll") for (int n = 0; n < 2; ++n) _Pragma("unroll") for (int k = 0; k < 2; ++k) \
        acc[ai][bj][m][n] = __builtin_amdgcn_mfma_f32_16x16x32_bf16(Bt[n][k], At[m][k], acc[ai][bj][m][n], 0, 0, 0); __builtin_amdgcn_s_setprio(0); } while (0)
#define PG8_WAIT_V(n) asm volatile("s_waitcnt vmcnt(" #n ")" ::: "memory")
#define PG8_WAIT_L(n) asm volatile("s_waitcnt lgkmcnt(" #n ")" ::: "memory")
#define PG8_BAR __builtin_amdgcn_s_barrier()
#define PG8_SCHED __builtin_amdgcn_sched_barrier(0)
    Unit cur, nxt; int ui = 0;
    if (!S.next(0, cur)) return;
    f32x4 acc[2][2][4][2];
#pragma unroll
    for (int a = 0; a < 2; ++a)
#pragma unroll
        for (int b = 0; b < 2; ++b)
#pragma unroll
            for (int m = 0; m < 4; ++m)
#pragma unroll
                for (int n = 0; n < 2; ++n) acc[a][b][m][n] = (f32x4){0.f, 0.f, 0.f, 0.f};
    bf16x8 At[4][2], B0[2][2], B1[2][2];
    const char* cA = (const char*)g.A + (size_t)cur.pm * tstep; const char* cB = (const char*)g.Bt + (size_t)cur.pn * tstep;
    S.a_ready(cur);
    if constexpr (SP2) {
        PG8_STAGE(PG8_SB(0, 0), cB, voffB); PG8_STAGE(PG8_SB(0, 1), cB + hstep, voffB); PG8_STAGE(PG8_SA(0, 0), cA, voffA); PG8_STAGE(PG8_SA(0, 1), cA + hstep, voffA);
        if (wr == 1) PG8_BAR;
        PG8_WAIT_V(2); PG8_BAR;
        PG8_STAGE(PG8_SB(1, 0), cB + kstep, voffB); PG8_STAGE(PG8_SA(1, 0), cA + kstep, voffA); PG8_STAGE(PG8_SB(1, 1), cB + hstep + kstep, voffB);
        PG8_WAIT_V(6); PG8_BAR;
    } else {
        PG8_STAGE(PG8_SB(0, 0), cB, voffB); PG8_STAGE(PG8_SA(0, 0), cA, voffA); PG8_STAGE(PG8_SB(0, 1), cB + hstep, voffB); PG8_STAGE(PG8_SA(0, 1), cA + hstep, voffA);
        if (wr == 1) PG8_BAR;
        PG8_WAIT_V(4); PG8_BAR;
        PG8_STAGE(PG8_SB(1, 0), cB + kstep, voffB); PG8_STAGE(PG8_SA(1, 0), cA + kstep, voffA); PG8_STAGE(PG8_SB(1, 1), cB + hstep + kstep, voffB);
        PG8_WAIT_V(6); PG8_BAR;
    }
    for (;;) {
        const bool has_next = S.next(ui + 1, nxt);
        const char* nA = has_next ? (const char*)g.A + (size_t)nxt.pm * tstep : cA; const char* nB = has_next ? (const char*)g.Bt + (size_t)nxt.pn * tstep : cB;
        for (int t = 0; t < nt; t += 2) {
            const bool last = (t == nt - 2);
            const char* a1 = cA + (size_t)(t + 1) * kstep;
            const char* a2 = last ? nA : cA + (size_t)(t + 2) * kstep; const char* b2 = last ? nB : cB + (size_t)(t + 2) * kstep;
            const char* a3 = a2 + kstep; const char* b3 = b2 + kstep;
            if (last && has_next) S.a_ready(nxt);
            if constexpr (SP2) {
            PG8_LDB(B0, 0, 0); PG8_LDB(B1, 0, 1); PG8_SCHED; PG8_LDA(At, 0, 0); PG8_STAGE(PG8_SA(1, 1), a1 + hstep, voffA);
            PG8_WAIT_V(8); PG8_WAIT_L(0); PG8_BAR; PG8_MMA(0, 0, At, B0); PG8_MMA(0, 1, At, B1); PG8_BAR; PG8_SCHED;
            PG8_LDA(At, 0, 1); PG8_STAGE(PG8_SB(0, 0), b2, voffB); PG8_STAGE(PG8_SB(0, 1), b2 + hstep, voffB); PG8_STAGE(PG8_SA(0, 0), a2, voffA);
            PG8_WAIT_V(8); PG8_WAIT_L(0); PG8_BAR; PG8_MMA(1, 0, At, B0); PG8_MMA(1, 1, At, B1); PG8_BAR; PG8_SCHED;
            PG8_LDB(B0, 1, 0); PG8_LDB(B1, 1, 1); PG8_SCHED; PG8_LDA(At, 1, 0); PG8_STAGE(PG8_SA(0, 1), a2 + hstep, voffA);
            PG8_WAIT_V(8); PG8_WAIT_L(0); PG8_BAR; PG8_MMA(0, 0, At, B0); PG8_MMA(0, 1, At, B1); PG8_BAR; PG8_SCHED;
            PG8_LDA(At, 1, 1); PG8_STAGE(PG8_SB(1, 0), b3, voffB); PG8_STAGE(PG8_SB(1, 1), b3 + hstep, voffB); PG8_STAGE(PG8_SA(1, 0), a3, voffA);
            PG8_WAIT_V(8); PG8_WAIT_L(0); PG8_BAR; PG8_MMA(1, 0, At, B0); PG8_MMA(1, 1, At, B1); PG8_BAR; PG8_SCHED;
            } else {
            PG8_LDB(B0, 0, 0); PG8_SCHED; PG8_LDA(At, 0, 0); PG8_STAGE(PG8_SA(1, 1), a1 + hstep, voffA);
            PG8_WAIT_L(8); PG8_BAR; PG8_WAIT_L(0); PG8_MMA(0, 0, At, B0); PG8_BAR; PG8_SCHED;
            PG8_LDB(B1, 0, 1); PG8_STAGE(PG8_SB(0, 0), b2, voffB);
            PG8_BAR; PG8_WAIT_L(0); PG8_MMA(0, 1, At, B1); PG8_BAR;
            PG8_LDA(At, 0, 1); PG8_STAGE(PG8_SA(0, 0), a2, voffA);
            PG8_BAR; PG8_WAIT_L(0); PG8_MMA(1, 0, At, B0); PG8_BAR; PG8_SCHED;
            PG8_STAGE(PG8_SB(0, 1), b2 + hstep, voffB);
            PG8_WAIT_V(6); PG8_BAR; PG8_MMA(1, 1, At, B1); PG8_BAR;
            PG8_LDB(B0, 1, 0); PG8_SCHED; PG8_LDA(At, 1, 0); PG8_STAGE(PG8_SA(0, 1), a2 + hstep, voffA);
            PG8_WAIT_L(8); PG8_BAR; PG8_WAIT_L(0); PG8_MMA(0, 0, At, B0); PG8_BAR; PG8_SCHED;
            PG8_LDB(B1, 1, 1); PG8_STAGE(PG8_SB(1, 0), b3, voffB);
            PG8_BAR; PG8_WAIT_L(0); PG8_MMA(0, 1, At, B1); PG8_BAR;
            PG8_LDA(At, 1, 1); PG8_STAGE(PG8_SA(1, 0), a3, voffA);
            PG8_BAR; PG8_WAIT_L(0); PG8_MMA(1, 0, At, B0); PG8_BAR; PG8_SCHED;
            PG8_STAGE(PG8_SB(1, 1), b3 + hstep, voffB);
            PG8_WAIT_V(6); PG8_BAR; PG8_MMA(1, 1, At, B1); PG8_BAR;
            }
        }
        if constexpr (ALIGN_EPI) { if (wr == 0) PG8_BAR; }
        if constexpr (!Epi::AFTER_DRAIN) { E(acc, cur, wr, wc, fr, fq); S.done(cur); }
        if (!has_next) break;
#pragma unroll
        for (int a = 0; a < 2; ++a)
#pragma unroll
            for (int b = 0; b < 2; ++b)
#pragma unroll
                for (int m = 0; m < 4; ++m)
#pragma unroll
                    for (int n = 0; n < 2; ++n) acc[a][b][m][n] = (f32x4){0.f, 0.f, 0.f, 0.f};
        cur = nxt; cA = nA; cB = nB; ++ui;
        if constexpr (ALIGN_EPI) { if (wr == 1) PG8_BAR; }
    }
    PG8_WAIT_V(0);
    if constexpr (!ALIGN_EPI) { if (wr == 0) PG8_BAR; }
    PG8_BAR;
    if constexpr (Epi::AFTER_DRAIN) { E.fused(acc, cur, wr, wc, fr, fq, lds, wid, lane); S.done(cur); }
#undef PG8_SA
#undef PG8_SB
#undef PG8_STAGE
#undef PG8_LDA
#undef PG8_LDB
#undef PG8_MMA
#undef PG8_WAIT_V
#undef PG8_WAIT_L
#undef PG8_BAR
#undef PG8_SCHED
}
}
#define XB_TMO      128
#define XB_XCNT(j)  (256  + 64 * (j))
#define XB_XSUB(j)  (1280 + 64 * (j))
#define XB_XGEN(j)  (2304 + 64 * (j))
#define XB_TOP      3328
#define XB_TOPGEN   3392
#define XCD_BAR_WORDS 3456
#define XB_SPIN_CAP (1u << 18)

__device__ __forceinline__ unsigned xb_ld(unsigned* p)              { return __hip_atomic_load(p, __ATOMIC_RELAXED, __HIP_MEMORY_SCOPE_AGENT); }
__device__ __forceinline__ unsigned xb_add(unsigned* p, unsigned v) { return __hip_atomic_fetch_add(p, v, __ATOMIC_RELAXED, __HIP_MEMORY_SCOPE_AGENT); }
__device__ __forceinline__ unsigned xb_xcc_id() { return (unsigned)__builtin_amdgcn_s_getreg((3 << 11) | 20) & 0xFu; }
#define XB_SPIN(cond, bar) do { unsigned _sp = 0; while (cond) { __builtin_amdgcn_s_sleep(1); \
    if ((++_sp & 255u) == 0u) { if (xb_ld(&(bar)[XB_TMO])) break; if (_sp > XB_SPIN_CAP) { atomicAdd(&(bar)[XB_TMO], 1u); break; } } } } while (0)

struct XcdBarrier {
    unsigned* bar; unsigned x;
    volatile LAS unsigned* st;
};

__device__ __forceinline__ XcdBarrier xcd_barrier_post(unsigned* bar, volatile LAS unsigned* st) {
    XcdBarrier b; b.bar = bar; b.x = xb_xcc_id(); b.st = st;
    if (threadIdx.x == 0) (void)xb_add(&bar[XB_XCNT(b.x)], 1u);
    return b;
}
__device__ __forceinline__ void xcd_barrier_complete(unsigned* bar, unsigned x, unsigned& nloc, unsigned& nx) {
    const unsigned G = gridDim.x * gridDim.y * gridDim.z;
    unsigned sum, cnt, mine, sp = 0u;
    for (;;) {
        sum = 0u; cnt = 0u; mine = 0u;
#pragma unroll
        for (unsigned j = 0; j < 16; ++j) { const unsigned c = xb_ld(&bar[XB_XCNT(j)]); sum += c; cnt += (c > 0u) ? 1u : 0u; mine = (j == x) ? c : mine; }
        if (sum == G) break;
        __builtin_amdgcn_s_sleep(1);
        if ((++sp & 255u) == 0u) { if (xb_ld(&bar[XB_TMO])) break; if (sp > XB_SPIN_CAP) { atomicAdd(&bar[XB_TMO], 1u); break; } }
    }
    nloc = mine > 0u ? mine : 1u; nx = cnt > 0u ? cnt : 1u;
}

__device__ __forceinline__ void xcd_barrier(const XcdBarrier& b) {
    asm volatile("s_waitcnt vmcnt(0)" ::: "memory");
    __syncthreads();
    if (threadIdx.x == 0) {
        unsigned* bar = b.bar;
        __builtin_amdgcn_s_waitcnt(0);
        unsigned nloc = b.st[0], nx = b.st[1];
        if (nloc == 0u) { xcd_barrier_complete(bar, b.x, nloc, nx); b.st[0] = nloc; b.st[1] = nx; }
        const unsigned old = xb_add(&bar[XB_XSUB(b.x)], 1u);
        const unsigned gen = old / nloc;
        if (old + 1u == (gen + 1u) * nloc) {
            __builtin_amdgcn_fence(__ATOMIC_RELEASE, "agent");
            asm volatile("s_waitcnt vmcnt(0)" ::: "memory");
            const unsigned og = xb_add(&bar[XB_TOP], 1u);
            const unsigned tg = og / nx;
            if (og + 1u == (tg + 1u) * nx) xb_add(&bar[XB_TOPGEN], 1u);
            else XB_SPIN(xb_ld(&bar[XB_TOPGEN]) == tg, bar);
            __builtin_amdgcn_fence(__ATOMIC_ACQUIRE, "agent");
            xb_add(&bar[XB_XGEN(b.x)], 1u);
            asm volatile("s_waitcnt vmcnt(0)" ::: "memory");
        } else {
            XB_SPIN(xb_ld(&bar[XB_XGEN(b.x)]) == gen, bar);
            __builtin_amdgcn_fence(__ATOMIC_ACQUIRE, "agent");
            asm volatile("s_waitcnt vmcnt(0)" ::: "memory");
        }
    }
    __syncthreads();
}
namespace mk {
typedef unsigned short bf16;
typedef unsigned v4u __attribute__((ext_vector_type(4)));
typedef unsigned v2u __attribute__((ext_vector_type(2)));
typedef float f32x4 __attribute__((ext_vector_type(4)));
typedef float f32x16 __attribute__((ext_vector_type(16)));
typedef short bf16x8 __attribute__((ext_vector_type(8)));
typedef short bf16x4 __attribute__((ext_vector_type(4)));

constexpr int T = 32768, D = 1024, SQ = 4096, NIN = 2816, NQ = 2048, PLE = 256, NEXP = 16384;
constexpr int NWAVES = 8, NTHR = 512;
constexpr int RING_BYTES = 131072, LDS_BYTES = 163840, MISC_OFF = LDS_BYTES - 256;

constexpr size_t MB = 1024 * 1024;
constexpr size_t WS_CTL = 0, CTL_BYTES = 256 * 1024;
constexpr size_t WS_WIN = WS_CTL + CTL_BYTES;
constexpr size_t WS_WOUT = WS_WIN + (size_t)NIN * D * 2;
constexpr size_t WS_WQ = WS_WOUT + (size_t)D * D * 2;
constexpr size_t WS_WG = WS_WQ + (size_t)NQ * D * 2;
constexpr size_t WS_WP = WS_WG + (size_t)D * D * 2;
constexpr size_t WS_KEYS = WS_WP + (size_t)D * PLE * 2;
constexpr size_t WS_ROPE = WS_KEYS + 2 * 128 * 128 * 2;
constexpr size_t WS_SU = WS_ROPE + 2 * (size_t)SQ * 32 * 4;
constexpr size_t WS_SV = WS_SU + 65536;
constexpr size_t WS_SH = WS_SV + 65536;
constexpr size_t WS_UB = 16 * MB;
constexpr size_t WS_VB = WS_UB + 32 * MB;
constexpr size_t WS_PB = WS_VB + 32 * MB;
constexpr size_t WS_R1 = WS_PB + 16 * MB;
constexpr size_t WS_R2 = WS_R1 + 64 * MB;
constexpr size_t WS_PP = WS_R2 + 192 * MB;
constexpr size_t WS_END = WS_PP + 64 * MB;
static_assert(WS_SH + (size_t)T * 4 <= WS_UB, "ws map");
constexpr int CW_BAR = 1024;

#define LDS_WAIT() asm volatile("s_waitcnt lgkmcnt(0)" ::: "memory")
#define VM_WAIT() asm volatile("s_waitcnt vmcnt(0)" ::: "memory")
typedef float f32x2 __attribute__((ext_vector_type(2)));
typedef __bf16 b16x2 __attribute__((ext_vector_type(2)));
__device__ __forceinline__ unsigned pk2(float lo, float hi) { const f32x2 v = {lo, hi}; return __builtin_bit_cast(unsigned, __builtin_convertvector(v, b16x2)); }
__device__ __forceinline__ float bf_lo(unsigned w) { return __uint_as_float(w << 16); }
__device__ __forceinline__ float bf_hi(unsigned w) { return __uint_as_float(w & 0xffff0000u); }
__device__ __forceinline__ float wave_sum(float v) {
#pragma unroll
    for (int o = 1; o < 64; o <<= 1) v += __shfl_xor(v, o);
    return v;
}

struct Args { const float* in[16]; float* out; unsigned char* ws; int ph_lo, ph_hi, li, pad; };

struct EpiStoreBf16 {
    static constexpr bool PERM = true, AFTER_DRAIN = false;
    bf16* O; int ldc;
    __device__ __forceinline__ void operator()(const pg8::f32x4 (&acc)[2][2][4][2], const pg8::Unit& u, int wr, int wc, int fr, int fq) const {
        const int row0 = u.pm * 256 + wr * 64 + fr, col0 = u.pn * 256 + wc * 32 + 8 * fq;
#pragma unroll
        for (int ai = 0; ai < 2; ++ai)
#pragma unroll
            for (int m = 0; m < 4; ++m) { bf16* rowp = O + (size_t)(row0 + ai * 128 + m * 16) * ldc + col0;
#pragma unroll
                for (int bj = 0; bj < 2; ++bj) { const pg8::f32x4 v0 = acc[ai][bj][m][0], v1 = acc[ai][bj][m][1];
                    pg8::u32x4 w; w.x = pk2(v0[0], v0[1]); w.y = pk2(v0[2], v0[3]); w.z = pk2(v1[0], v1[1]); w.w = pk2(v1[2], v1[3]);
                    *(pg8::u32x4*)(rowp + bj * 128) = w; } }
    }
};


struct EpiResid {
    static constexpr bool PERM = true, AFTER_DRAIN = false;
    const float* X; float* O; bf16* XB;
    __device__ __forceinline__ void operator()(const pg8::f32x4 (&acc)[2][2][4][2], const pg8::Unit& u, int wr, int wc, int fr, int fq) const {
        const int row0 = u.pm * 256 + wr * 64 + fr, col0 = u.pn * 256 + wc * 32 + 8 * fq;
#pragma unroll
        for (int ai = 0; ai < 2; ++ai)
#pragma unroll
            for (int m = 0; m < 4; ++m) { const size_t off = (size_t)(row0 + ai * 128 + m * 16) * D + col0;
#pragma unroll
                for (int bj = 0; bj < 2; ++bj) { const size_t o2 = off + bj * 128;
                    const pg8::f32x4 v0 = acc[ai][bj][m][0] + *(const pg8::f32x4*)(X + o2), v1 = acc[ai][bj][m][1] + *(const pg8::f32x4*)(X + o2 + 4);
                    *(pg8::f32x4*)(O + o2) = v0; *(pg8::f32x4*)(O + o2 + 4) = v1;
                    pg8::u32x4 w; w.x = pk2(v0[0], v0[1]); w.y = pk2(v0[2], v0[3]); w.z = pk2(v1[0], v1[1]); w.w = pk2(v1[2], v1[3]);
                    *(pg8::u32x4*)(XB + o2) = w; } }
    }
};
struct EpiGate {
    static constexpr bool PERM = true, AFTER_DRAIN = false;
    float* O; const bf16* PP; const float* rstd;
    __device__ __forceinline__ void operator()(const pg8::f32x4 (&acc)[2][2][4][2], const pg8::Unit& u, int wr, int wc, int fr, int fq) const {
        const int row0 = u.pm * 256 + wr * 64 + fr, col0 = u.pn * 256 + wc * 32 + 8 * fq;
#pragma unroll
        for (int ai = 0; ai < 2; ++ai)
#pragma unroll
            for (int m = 0; m < 4; ++m) { const int row = row0 + ai * 128 + m * 16; const size_t off = (size_t)row * D + col0; const pg8::f32x4 q0 = *(const pg8::f32x4*)(rstd + (size_t)row * 8), q1 = *(const pg8::f32x4*)(rstd + (size_t)row * 8 + 4);
                const float rs = 1.0f / sqrtf((((q0[0] + q0[1]) + (q0[2] + q0[3])) + ((q1[0] + q1[1]) + (q1[2] + q1[3]))) * (1.0f / D) + 1e-6f);
#pragma unroll
                for (int bj = 0; bj < 2; ++bj) { const size_t o2 = off + bj * 128;
                    const pg8::u32x4 pw = *(const pg8::u32x4*)(PP + o2);
                    pg8::f32x4 x0 = *(const pg8::f32x4*)(O + o2), x1 = *(const pg8::f32x4*)(O + o2 + 4);
                    const pg8::f32x4 a0 = acc[ai][bj][m][0] * rs, a1 = acc[ai][bj][m][1] * rs;
                    x0[0] += bf_lo(pw.x) / (1.0f + __expf(-a0[0])); x0[1] += bf_hi(pw.x) / (1.0f + __expf(-a0[1])); x0[2] += bf_lo(pw.y) / (1.0f + __expf(-a0[2])); x0[3] += bf_hi(pw.y) / (1.0f + __expf(-a0[3]));
                    x1[0] += bf_lo(pw.z) / (1.0f + __expf(-a1[0])); x1[1] += bf_hi(pw.z) / (1.0f + __expf(-a1[1])); x1[2] += bf_lo(pw.w) / (1.0f + __expf(-a1[2])); x1[3] += bf_hi(pw.w) / (1.0f + __expf(-a1[3]));
                    *(pg8::f32x4*)(O + o2) = x0; *(pg8::f32x4*)(O + o2 + 4) = x1; } }
    }
};

__device__ __forceinline__ void p0_transpose_item(const float* __restrict__ W, const float* __restrict__ gsc, int K, int N, bf16* __restrict__ WT, LAS float* scr, int item, int lane) {
    const int nblk = N / 32, kb = item / nblk, nb = item % nblk, k0 = 64 * kb, n0 = 32 * nb;
#pragma unroll 8
    for (int i = 0; i < 32; ++i) { const int kk = 2 * i + (lane >> 5); float w = W[(size_t)(k0 + kk) * N + n0 + (lane & 31)]; if (gsc) w *= gsc[k0 + kk]; scr[kk * 33 + (lane & 31)] = w; }
    LDS_WAIT(); asm volatile("" ::: "memory");
    const int c = lane & 7;
#pragma unroll
    for (int j = 0; j < 4; ++j) { const int n = (lane >> 3) + 8 * j; const LAS float* s = scr + (8 * c) * 33 + n;
        v4u o; o.x = pk2(s[0 * 33], s[1 * 33]); o.y = pk2(s[2 * 33], s[3 * 33]); o.z = pk2(s[4 * 33], s[5 * 33]); o.w = pk2(s[6 * 33], s[7 * 33]);
        *(v4u*)(WT + (size_t)(n0 + n) * K + k0 + 8 * c) = o; }
    LDS_WAIT(); asm volatile("" ::: "memory");
}
__device__ __forceinline__ void p0_convert(const float* __restrict__ src, bf16* __restrict__ dst, size_t n8, size_t gtid, size_t gthreads) {
    size_t i = gtid;
    for (; i + 3 * gthreads < n8; i += 4 * gthreads) {
        f32x4 a[4], b[4];
#pragma unroll
        for (int r = 0; r < 4; ++r) { a[r] = ((const f32x4*)src)[2 * (i + r * gthreads)]; b[r] = ((const f32x4*)src)[2 * (i + r * gthreads) + 1]; }
#pragma unroll
        for (int r = 0; r < 4; ++r) { v4u o; o.x = pk2(a[r][0], a[r][1]); o.y = pk2(a[r][2], a[r][3]); o.z = pk2(b[r][0], b[r][1]); o.w = pk2(b[r][2], b[r][3]); ((v4u*)dst)[i + r * gthreads] = o; }
    }
    for (; i < n8; i += gthreads) {
        const f32x4 a = ((const f32x4*)src)[2 * i], b = ((const f32x4*)src)[2 * i + 1];
        v4u o; o.x = pk2(a[0], a[1]); o.y = pk2(a[2], a[3]); o.z = pk2(b[0], b[1]); o.w = pk2(b[2], b[3]);
        ((v4u*)dst)[i] = o;
    }
}
__device__ __forceinline__ void rms_row_to_bf16(const float* __restrict__ xrow, const float* __restrict__ g, bf16* __restrict__ orow, int lane) {
    const f32x4* xr = (const f32x4*)xrow + lane; const f32x4* gr = (const f32x4*)g + lane;
    f32x4 v[4]; float s = 0.f;
#pragma unroll
    for (int j = 0; j < 4; ++j) { v[j] = xr[64 * j]; s += (v[j][0] * v[j][0] + v[j][1] * v[j][1]) + (v[j][2] * v[j][2] + v[j][3] * v[j][3]); }
    const float rstd = 1.0f / sqrtf(wave_sum(s) * (1.0f / D) + 1e-6f);
    v2u* o8 = (v2u*)orow + lane;
#pragma unroll
    for (int j = 0; j < 4; ++j) { const f32x4 gg = gr[64 * j]; v2u w; w.x = pk2(v[j][0] * rstd * gg[0], v[j][1] * rstd * gg[1]); w.y = pk2(v[j][2] * rstd * gg[2], v[j][3] * rstd * gg[3]); o8[64 * j] = w; }
}

__device__ __forceinline__ void p0_prologue(const Args& a, LAS unsigned char* lds, int vcu, int G, int tid, int lane, int wave) {
    unsigned char* ws = a.ws;
    LAS float* scr = (LAS float*)(lds + wave * 16384);
    const int gw = vcu * NWAVES + wave, NGW = G * NWAVES;
    constexpr int I_IN = (D / 64) * (NIN / 32), I_OUT = (D / 64) * (D / 32), I_Q = (D / 64) * (NQ / 32), I_G = I_OUT, I_P = (PLE / 64) * (D / 32);
    constexpr int NITEMS = I_IN + I_OUT + I_Q + I_G + I_P;
    for (int it = gw; it < NITEMS; it += NGW) {
        int r = it;
        if (r < I_IN) { p0_transpose_item(a.in[3], nullptr, D, NIN, (bf16*)(ws + WS_WIN), scr, r, lane); continue; } r -= I_IN;
        if (r < I_OUT) { p0_transpose_item(a.in[7], nullptr, D, D, (bf16*)(ws + WS_WOUT), scr, r, lane); continue; } r -= I_OUT;
        if (r < I_Q) { p0_transpose_item(a.in[9], a.in[8], D, NQ, (bf16*)(ws + WS_WQ), scr, r, lane); continue; } r -= I_Q;
        if (r < I_G) { p0_transpose_item(a.in[14], a.in[13], D, D, (bf16*)(ws + WS_WG), scr, r, lane); continue; } r -= I_G;
        p0_transpose_item(a.in[15], nullptr, PLE, D, (bf16*)(ws + WS_WP), scr, r, lane);
    }
    const size_t gtid = (size_t)vcu * NTHR + tid, gthreads = (size_t)G * NTHR;
    p0_convert(a.in[10], (bf16*)(ws + WS_KEYS), 2 * 128 * 128 / 8, gtid, gthreads);
    for (int r0 = gw; r0 < 2 * NEXP; r0 += 4 * NGW) {
        float xs[4][16];
#pragma unroll
        for (int rr = 0; rr < 4; ++rr) {
            const int r = r0 + rr * NGW; const int isv = r >= NEXP, e = isv ? r - NEXP : r;
            const float* src = (isv ? a.in[12] : a.in[11]) + (size_t)e * D + 16 * lane;
            const f32x4 x0 = *(const f32x4*)src, x1 = *(const f32x4*)(src + 4), x2 = *(const f32x4*)(src + 8), x3 = *(const f32x4*)(src + 12);
#pragma unroll
            for (int u = 0; u < 4; ++u) { xs[rr][u] = x0[u]; xs[rr][4 + u] = x1[u]; xs[rr][8 + u] = x2[u]; xs[rr][12 + u] = x3[u]; }
        }
#pragma unroll
        for (int rr = 0; rr < 4; ++rr) {
            const int r = r0 + rr * NGW; const int isv = r >= NEXP, e = isv ? r - NEXP : r;
            float am = 0.f;
#pragma unroll
            for (int u = 0; u < 16; ++u) am = fmaxf(am, fabsf(xs[rr][u]));
#pragma unroll
            for (int o = 1; o < 64; o <<= 1) am = fmaxf(am, __shfl_xor(am, o));
            const float inv = am > 0.f ? 127.0f / am : 0.f; const unsigned bias = isv ? 128u : 0u;
            v4u w;
#pragma unroll
            for (int c = 0; c < 4; ++c) { unsigned ww = 0u;
#pragma unroll
                for (int u = 0; u < 4; ++u) { const int q = __float2int_rn(xs[rr][4 * c + u] * inv); ww |= (((unsigned)q + bias) & 0xffu) << (8 * u); }
                w[c] = ww; }
            if (isv) *(v4u*)(ws + WS_VB + (size_t)(lane >> 3) * ((size_t)NEXP * 128) + (size_t)e * 128 + 16 * (lane & 7)) = w;
            else *(v4u*)(ws + WS_UB + (size_t)e * D + 16 * lane) = w;
            if (lane == 0) ((float*)(ws + (isv ? WS_SV : WS_SU)))[e] = am * (1.0f / 127.0f);
        }
    }
    p0_convert(a.in[1], (bf16*)(ws + WS_PB), (size_t)T * PLE / 8, gtid, gthreads);
    for (size_t i = gtid; i < (size_t)SQ * 32; i += gthreads) {
        const int pos = (int)(i >> 5), c = (int)(i & 31);
        const float freq = powf(10000.0f, -(float)c / 32.0f);
        const float ang = (float)pos * freq;
        float sn, cs; sincosf(ang, &sn, &cs);
        ((float*)(ws + WS_ROPE))[i] = cs; ((float*)(ws + WS_ROPE))[(size_t)SQ * 32 + i] = sn;
    }
    for (int m0 = gw; m0 < T; m0 += 4 * NGW) {
        f32x4 v[4][4]; float ssq[4];
#pragma unroll
        for (int rr = 0; rr < 4; ++rr) { const f32x4* xr = (const f32x4*)(a.in[0] + (size_t)(m0 + rr * NGW) * D) + lane;
#pragma unroll
            for (int j = 0; j < 4; ++j) v[rr][j] = xr[64 * j]; }
#pragma unroll
        for (int rr = 0; rr < 4; ++rr) { float sq = 0.f;
#pragma unroll
            for (int j = 0; j < 4; ++j) sq += (v[rr][j][0] * v[rr][j][0] + v[rr][j][1] * v[rr][j][1]) + (v[rr][j][2] * v[rr][j][2] + v[rr][j][3] * v[rr][j][3]);
            ssq[rr] = sq; }
#pragma unroll
        for (int o = 1; o < 64; o <<= 1)
#pragma unroll
            for (int rr = 0; rr < 4; ++rr) ssq[rr] += __shfl_xor(ssq[rr], o);
        const f32x4* gr = (const f32x4*)a.in[2] + lane;
#pragma unroll
        for (int rr = 0; rr < 4; ++rr) { const float rstd = 1.0f / sqrtf(ssq[rr] * (1.0f / D) + 1e-6f); v2u* o8 = (v2u*)((bf16*)(ws + WS_R1) + (size_t)(m0 + rr * NGW) * D) + lane;
#pragma unroll
            for (int j = 0; j < 4; ++j) { const f32x4 gg = gr[64 * j]; v2u w; w.x = pk2(v[rr][j][0] * rstd * gg[0], v[rr][j][1] * rstd * gg[1]); w.y = pk2(v[rr][j][2] * rstd * gg[2], v[rr][j][3] * rstd * gg[3]); o8[64 * j] = w; } }
    }
}


#define MFMA32(a, b, c) __builtin_amdgcn_mfma_f32_32x32x16_bf16((a), (b), (c), 0, 0, 0)
__device__ __forceinline__ int crow(int r, int hf) { return (r & 3) + 8 * (r >> 2) + 4 * hf; }
__device__ __forceinline__ bf16x8 pack8(float a0, float a1, float a2, float a3, float a4, float a5, float a6, float a7) {
    v4u w; w.x = pk2(a0, a1); w.y = pk2(a2, a3); w.z = pk2(a4, a5); w.w = pk2(a6, a7); return __builtin_bit_cast(bf16x8, w);
}
__device__ __forceinline__ bf16x8 lds_frag16(LAS unsigned char* p) { return *(const LAS bf16x8*)p; }
__device__ __forceinline__ bf16x8 lds_frag8x2(LAS unsigned char* p) {
    const bf16x4 lo = *(const LAS bf16x4*)p, hi = *(const LAS bf16x4*)(p + 16); return __builtin_shufflevector(lo, hi, 0, 1, 2, 3, 4, 5, 6, 7);
}
constexpr int RQ = 144, RT = 272, RV = 528;
constexpr int LR_QS = 0, LR_KS = LR_QS + 128 * RQ, LR_KT = LR_KS + 128 * RQ, LR_VT = LR_KT + 64 * RT, LR_ST = LR_VT + 64 * RT, LR_LN = LR_ST + 64 * RQ, LR_END = LR_LN + 2 * 128 * 8;
static_assert(LR_END <= RING_BYTES, "retention LDS");
__device__ __forceinline__ void ret_unit(const bf16* __restrict__ PROJ, bf16* __restrict__ MIXED, const float* __restrict__ rope, LAS unsigned char* lds,
                                         int b, int h, int c0, int c1, int tid, int lane, int wave) {
    const float gam = 1.0f - exp2f(-5.0f - (float)h), lg2 = log2f(gam), cd = exp2f(lg2 * 128.0f);
    const int l31 = lane & 31, hf = lane >> 5, ib = wave >> 1, et = wave & 1;
    const int r = tid >> 2, qd = tid & 3;
    const float wq = exp2f(lg2 * (float)(r + 1)), wk = exp2f(-lg2 * (float)(r + 1));
    f32x16 stacc;
#pragma unroll
    for (int i = 0; i < 16; ++i) stacc[i] = 0.f;
    for (int i = tid; i < 64 * RQ / 4; i += NTHR) ((LAS unsigned*)(lds + LR_ST))[i] = 0u;
    for (int n = 0; n < c1; ++n) {
        const bool own = n >= c0;
        const int seqpos = n * 128 + r;
        const bf16* pr = PROJ + ((size_t)b * SQ + seqpos) * NIN + h * 64 + 8 * qd;
        const v4u k1 = *(const v4u*)(pr + 512), k2 = *(const v4u*)(pr + 512 + 32);
        const v4u v1 = *(const v4u*)(pr + 1024), v2 = *(const v4u*)(pr + 1024 + 32);
        v4u q1 = {0u, 0u, 0u, 0u}, q2 = {0u, 0u, 0u, 0u};
        if (own) { q1 = *(const v4u*)(pr); q2 = *(const v4u*)(pr + 32); }
        const f32x4 csa = *(const f32x4*)(rope + seqpos * 32 + 8 * qd), csb = *(const f32x4*)(rope + seqpos * 32 + 8 * qd + 4);
        const f32x4 sna = *(const f32x4*)(rope + SQ * 32 + seqpos * 32 + 8 * qd), snb = *(const f32x4*)(rope + SQ * 32 + seqpos * 32 + 8 * qd + 4);
        float cs[8], sn[8];
#pragma unroll
        for (int u = 0; u < 4; ++u) { cs[u] = csa[u]; cs[4 + u] = csb[u]; sn[u] = sna[u]; sn[4 + u] = snb[u]; }
        __syncthreads();
        {
            float o1[8], o2[8];
#pragma unroll
            for (int u = 0; u < 8; ++u) { const unsigned w1 = k1[u >> 1], w2 = k2[u >> 1]; const float x1 = (u & 1) ? bf_hi(w1) : bf_lo(w1), x2 = (u & 1) ? bf_hi(w2) : bf_lo(w2);
                o1[u] = (x1 * cs[u] - x2 * sn[u]) * wk; o2[u] = (x1 * sn[u] + x2 * cs[u]) * wk; }
            if (own) {
                *(LAS bf16x8*)(lds + LR_KS + r * RQ + (8 * qd) * 2) = pack8(o1[0], o1[1], o1[2], o1[3], o1[4], o1[5], o1[6], o1[7]);
                *(LAS bf16x8*)(lds + LR_KS + r * RQ + (32 + 8 * qd) * 2) = pack8(o2[0], o2[1], o2[2], o2[3], o2[4], o2[5], o2[6], o2[7]);
            }
#pragma unroll
            for (int u = 0; u < 8; u += 2) {
                const unsigned a = pk2(o1[u] * 0.125f, o1[u + 1] * 0.125f), c = pk2(o2[u] * 0.125f, o2[u + 1] * 0.125f);
                *(LAS bf16*)(lds + LR_KT + (8 * qd + u) * RT + r * 2) = (bf16)(a & 0xffffu); *(LAS bf16*)(lds + LR_KT + (8 * qd + u + 1) * RT + r * 2) = (bf16)(a >> 16);
                *(LAS bf16*)(lds + LR_KT + (32 + 8 * qd + u) * RT + r * 2) = (bf16)(c & 0xffffu); *(LAS bf16*)(lds + LR_KT + (32 + 8 * qd + u + 1) * RT + r * 2) = (bf16)(c >> 16);
                const unsigned w1 = v1[u >> 1], w2 = v2[u >> 1];
                *(LAS bf16*)(lds + LR_VT + (8 * qd + u) * RT + r * 2) = (bf16)(w1 & 0xffffu); *(LAS bf16*)(lds + LR_VT + (8 * qd + u + 1) * RT + r * 2) = (bf16)(w1 >> 16);
                *(LAS bf16*)(lds + LR_VT + (32 + 8 * qd + u) * RT + r * 2) = (bf16)(w2 & 0xffffu); *(LAS bf16*)(lds + LR_VT + (32 + 8 * qd + u + 1) * RT + r * 2) = (bf16)(w2 >> 16);
            }
            if (own) {
#pragma unroll
                for (int u = 0; u < 8; ++u) { const unsigned w1 = q1[u >> 1], w2 = q2[u >> 1]; const float x1 = (u & 1) ? bf_hi(w1) : bf_lo(w1), x2 = (u & 1) ? bf_hi(w2) : bf_lo(w2);
                    o1[u] = (x1 * cs[u] - x2 * sn[u]) * wq; o2[u] = (x1 * sn[u] + x2 * cs[u]) * wq; }
                *(LAS bf16x8*)(lds + LR_QS + r * RQ + (8 * qd) * 2) = pack8(o1[0], o1[1], o1[2], o1[3], o1[4], o1[5], o1[6], o1[7]);
                *(LAS bf16x8*)(lds + LR_QS + r * RQ + (32 + 8 * qd) * 2) = pack8(o2[0], o2[1], o2[2], o2[3], o2[4], o2[5], o2[6], o2[7]);
            }
        }
        __syncthreads();
        if (own) {
            const size_t orow = (size_t)b * SQ + n * 128 + 32 * ib + l31;
            v2u gv[4];
#pragma unroll
            for (int g = 0; g < 4; ++g) gv[g] = *(const v2u*)(PROJ + orow * NIN + 1536 + h * 64 + 32 * et + 8 * g + 4 * hf);
            bf16x8 qf[4];
#pragma unroll
            for (int ks = 0; ks < 4; ++ks) qf[ks] = lds_frag16(lds + LR_QS + (32 * ib + l31) * RQ + (16 * ks + 8 * hf) * 2);
            f32x16 o;
#pragma unroll
            for (int i = 0; i < 16; ++i) o[i] = 0.f;
#pragma unroll
            for (int ks = 0; ks < 4; ++ks) o = MFMA32(lds_frag16(lds + LR_ST + (32 * et + l31) * RQ + (16 * ks + 8 * hf) * 2), qf[ks], o);
            for (int jb = 0; jb <= ib; ++jb) {
                f32x16 s;
#pragma unroll
                for (int i = 0; i < 16; ++i) s[i] = 0.f;
#pragma unroll
                for (int ks = 0; ks < 4; ++ks) s = MFMA32(lds_frag16(lds + LR_KS + (32 * jb + l31) * RQ + (16 * ks + 8 * hf) * 2), qf[ks], s);
                const bool diag = (jb == ib);
                float p[16];
#pragma unroll
                for (int i = 0; i < 16; ++i) p[i] = (diag && crow(i, hf) > l31) ? 0.f : s[i] * 0.125f;
#pragma unroll
                for (int st = 0; st < 2; ++st) {
                    const bf16x8 pf = pack8(p[8 * st], p[8 * st + 1], p[8 * st + 2], p[8 * st + 3], p[8 * st + 4], p[8 * st + 5], p[8 * st + 6], p[8 * st + 7]);
                    o = MFMA32(lds_frag8x2(lds + LR_VT + (32 * et + l31) * RT + (32 * jb + 16 * st + 4 * hf) * 2), pf, o);
                }
            }
            float s1 = 0.f, s2 = 0.f;
#pragma unroll
            for (int i = 0; i < 16; ++i) { s1 += o[i]; s2 += o[i] * o[i]; }
            s1 += __shfl_xor(s1, 32); s2 += __shfl_xor(s2, 32);
            if (hf == 0) *(LAS f32x2*)(lds + LR_LN + (et * 128 + 32 * ib + l31) * 8) = (f32x2){s1, s2};
            __syncthreads();
            const f32x2 ot = *(const LAS f32x2*)(lds + LR_LN + ((et ^ 1) * 128 + 32 * ib + l31) * 8);
            const float mu = (s1 + ot.x) * (1.0f / 64.0f), var = fmaxf((s2 + ot.y) * (1.0f / 64.0f) - mu * mu, 0.f), rs = 1.0f / sqrtf(var + 1e-6f);
#pragma unroll
            for (int g = 0; g < 4; ++g) {
                float y[4];
#pragma unroll
                for (int u = 0; u < 4; ++u) { const unsigned w = gv[g][u >> 1]; const float gg = (u & 1) ? bf_hi(w) : bf_lo(w); const float sg = gg / (1.0f + __expf(-gg)); y[u] = sg * ((o[4 * g + u] - mu) * rs); }
                v2u w; w.x = pk2(y[0], y[1]); w.y = pk2(y[2], y[3]);
                *(v2u*)(MIXED + orow * D + h * 64 + 32 * et + 8 * g + 4 * hf) = w;
            }
        }
        if (wave < 4) {
            const int se = wave >> 1, sd = wave & 1;
#pragma unroll
            for (int ks = 0; ks < 8; ++ks)
                stacc = MFMA32(lds_frag16(lds + LR_VT + (32 * se + l31) * RT + (16 * ks + 8 * hf) * 2), lds_frag16(lds + LR_KT + (32 * sd + l31) * RT + (16 * ks + 8 * hf) * 2), stacc);
#pragma unroll
            for (int i = 0; i < 16; ++i) stacc[i] *= cd;
#pragma unroll
            for (int i = 0; i < 16; i += 2) { const unsigned w = pk2(stacc[i], stacc[i + 1]);
                *(LAS bf16*)(lds + LR_ST + (32 * se + crow(i, hf)) * RQ + (32 * sd + l31) * 2) = (bf16)(w & 0xffffu);
                *(LAS bf16*)(lds + LR_ST + (32 * se + crow(i + 1, hf)) * RQ + (32 * sd + l31) * 2) = (bf16)(w >> 16); }
        }
    }
    __syncthreads();
}

constexpr int LS_KN = 0, LS_VT = LS_KN + 256 * RQ, LS_QN = LS_VT + 64 * RV, LS_END = LS_QN + 256 * RQ;
static_assert(LS_END <= RING_BYTES, "swa LDS");
__device__ __forceinline__ void swa_unit(const bf16* __restrict__ PROJ, bf16* __restrict__ MIXED, const float* __restrict__ qnw, const float* __restrict__ knw, const float* __restrict__ sinks,
                                         LAS unsigned char* lds, int b, int kvh, int n, int tid, int lane, int wave) {
    const int l31 = lane & 31, hf = lane >> 5;
    const int row = tid >> 1, half = tid & 1;
    {
        const int kpos = (n - 1) * 128 + row; const bool valid = kpos >= 0;
        v4u kk[4], vv[4];
#pragma unroll
        for (int c = 0; c < 4; ++c) { kk[c] = (v4u){0u, 0u, 0u, 0u}; vv[c] = (v4u){0u, 0u, 0u, 0u}; }
        if (valid) { const bf16* pr = PROJ + ((size_t)b * SQ + kpos) * NIN + 32 * half;
#pragma unroll
            for (int c = 0; c < 4; ++c) { kk[c] = *(const v4u*)(pr + 2560 + kvh * 64 + 8 * c); vv[c] = *(const v4u*)(pr + 2688 + kvh * 64 + 8 * c); } }
        float kf[32]; float ss = 0.f;
#pragma unroll
        for (int c = 0; c < 4; ++c)
#pragma unroll
            for (int u = 0; u < 4; ++u) { kf[8 * c + 2 * u] = bf_lo(kk[c][u]); kf[8 * c + 2 * u + 1] = bf_hi(kk[c][u]); }
#pragma unroll
        for (int i = 0; i < 32; ++i) ss += kf[i] * kf[i];
        ss += __shfl_xor(ss, 1);
        const float rstd = 0.125f / sqrtf(ss * (1.0f / 64.0f) + 1e-6f);
#pragma unroll
        for (int c = 0; c < 4; ++c) {
            const f32x4 g0 = *(const f32x4*)(knw + 32 * half + 8 * c), g1 = *(const f32x4*)(knw + 32 * half + 8 * c + 4);
            *(LAS bf16x8*)(lds + LS_KN + row * RQ + (32 * half + 8 * c) * 2) = pack8(kf[8 * c] * rstd * g0[0], kf[8 * c + 1] * rstd * g0[1], kf[8 * c + 2] * rstd * g0[2], kf[8 * c + 3] * rstd * g0[3],
                                                                                  kf[8 * c + 4] * rstd * g1[0], kf[8 * c + 5] * rstd * g1[1], kf[8 * c + 6] * rstd * g1[2], kf[8 * c + 7] * rstd * g1[3]);
#pragma unroll
            for (int u = 0; u < 4; ++u) { const unsigned w = vv[c][u];
                *(LAS bf16*)(lds + LS_VT + (32 * half + 8 * c + 2 * u) * RV + row * 2) = (bf16)(w & 0xffffu); *(LAS bf16*)(lds + LS_VT + (32 * half + 8 * c + 2 * u + 1) * RV + row * 2) = (bf16)(w >> 16); }
        }
    }
    for (int rnd = 0; rnd < 2; ++rnd) {
        {
            const int hs = row >> 7, qrow = row & 127, hq = kvh * 4 + rnd * 2 + hs;
            const bf16* pr = PROJ + ((size_t)b * SQ + n * 128 + qrow) * NIN + 2048 + hq * 64 + 32 * half;
            v4u qq[4];
#pragma unroll
            for (int c = 0; c < 4; ++c) qq[c] = *(const v4u*)(pr + 8 * c);
            float qf[32]; float ss = 0.f;
#pragma unroll
            for (int c = 0; c < 4; ++c)
#pragma unroll
                for (int u = 0; u < 4; ++u) { qf[8 * c + 2 * u] = bf_lo(qq[c][u]); qf[8 * c + 2 * u + 1] = bf_hi(qq[c][u]); }
#pragma unroll
            for (int i = 0; i < 32; ++i) ss += qf[i] * qf[i];
            ss += __shfl_xor(ss, 1);
            const float rstd = 1.0f / sqrtf(ss * (1.0f / 64.0f) + 1e-6f);
#pragma unroll
            for (int c = 0; c < 4; ++c) {
                const f32x4 g0 = *(const f32x4*)(qnw + 32 * half + 8 * c), g1 = *(const f32x4*)(qnw + 32 * half + 8 * c + 4);
                *(LAS bf16x8*)(lds + LS_QN + row * RQ + (32 * half + 8 * c) * 2) = pack8(qf[8 * c] * rstd * g0[0], qf[8 * c + 1] * rstd * g0[1], qf[8 * c + 2] * rstd * g0[2], qf[8 * c + 3] * rstd * g0[3],
                                                                                      qf[8 * c + 4] * rstd * g1[0], qf[8 * c + 5] * rstd * g1[1], qf[8 * c + 6] * rstd * g1[2], qf[8 * c + 7] * rstd * g1[3]);
            }
        }
        __syncthreads();
        {
            const int hs = wave >> 2, ib = wave & 3, hq = kvh * 4 + rnd * 2 + hs;
            bf16x8 qf[4];
#pragma unroll
            for (int ks = 0; ks < 4; ++ks) qf[ks] = lds_frag16(lds + LS_QN + (hs * 128 + 32 * ib + l31) * RQ + (16 * ks + 8 * hf) * 2);
            f32x16 s[5];
#pragma unroll
            for (int t = 0; t < 5; ++t) {
#pragma unroll
                for (int i = 0; i < 16; ++i) s[t][i] = 0.f;
#pragma unroll
                for (int ks = 0; ks < 4; ++ks) s[t] = MFMA32(lds_frag16(lds + LS_KN + (32 * (ib + t) + l31) * RQ + (16 * ks + 8 * hf) * 2), qf[ks], s[t]);
            }
            const float sink = sinks[hq];
            float m = sink;
#pragma unroll
            for (int t = 0; t < 5; ++t)
#pragma unroll
                for (int i = 0; i < 16; ++i) {
                    bool ok = true;
                    if (t == 0) ok = crow(i, hf) > l31;
                    if (t == 4) ok = crow(i, hf) <= l31;
                    if (n == 0 && ib + t < 4) ok = false;
                    s[t][i] = ok ? s[t][i] : -INFINITY;
                    m = fmaxf(m, s[t][i]);
                }
            m = fmaxf(m, __shfl_xor(m, 32));
            float l = 0.f;
#pragma unroll
            for (int t = 0; t < 5; ++t)
#pragma unroll
                for (int i = 0; i < 16; ++i) { s[t][i] = exp2f((s[t][i] - m) * 1.4426950408889634f); l += s[t][i]; }
            l += __shfl_xor(l, 32);
            l += exp2f((sink - m) * 1.4426950408889634f);
            f32x16 o[2];
#pragma unroll
            for (int e2 = 0; e2 < 2; ++e2)
#pragma unroll
                for (int i = 0; i < 16; ++i) o[e2][i] = 0.f;
#pragma unroll
            for (int t = 0; t < 5; ++t)
#pragma unroll
                for (int st = 0; st < 2; ++st) {
                    const bf16x8 pf = pack8(s[t][8 * st], s[t][8 * st + 1], s[t][8 * st + 2], s[t][8 * st + 3], s[t][8 * st + 4], s[t][8 * st + 5], s[t][8 * st + 6], s[t][8 * st + 7]);
#pragma unroll
                    for (int e2 = 0; e2 < 2; ++e2) o[e2] = MFMA32(lds_frag8x2(lds + LS_VT + (32 * e2 + l31) * RV + (32 * (ib + t) + 16 * st + 4 * hf) * 2), pf, o[e2]);
                }
            const float inv = 1.0f / l;
            const size_t orow = (size_t)b * SQ + n * 128 + 32 * ib + l31;
#pragma unroll
            for (int e2 = 0; e2 < 2; ++e2)
#pragma unroll
                for (int g = 0; g < 4; ++g) { v2u w; w.x = pk2(o[e2][4 * g] * inv, o[e2][4 * g + 1] * inv); w.y = pk2(o[e2][4 * g + 2] * inv, o[e2][4 * g + 3] * inv);
                    *(v2u*)(MIXED + orow * D + 512 + hq * 64 + 32 * e2 + 8 * g + 4 * hf) = w; }
        }
        __syncthreads();
    }
}

__device__ __forceinline__ void p2_mixing(const Args& a, LAS unsigned char* lds, int bx, int G, int tid, int lane, int wave) {
    const bf16* PROJ = (const bf16*)(a.ws + WS_R2); bf16* MIXED = (bf16*)(a.ws + WS_R1); const float* rope = (const float*)(a.ws + WS_ROPE);
    for (int u = bx; u < 256; u += G) {
        const int b = u >> 5, h = (u >> 2) & 7, grp = u & 3;
        const int c0 = grp == 0 ? 0 : grp == 1 ? 11 : grp == 2 ? 20 : 27, c1 = grp == 0 ? 11 : grp == 1 ? 20 : grp == 2 ? 27 : 32;
        ret_unit(PROJ, MIXED, rope, lds, b, h, c0, c1, tid, lane, wave);
    }
    for (int su = bx; su < 512; su += G) swa_unit(PROJ, MIXED, a.in[4], a.in[5], a.in[6], lds, su >> 6, (su >> 5) & 1, su & 31, tid, lane, wave);
}


template <int N> __device__ __forceinline__ void bitonic_sort_desc(float (&v)[N]) {
#pragma unroll
    for (int k = 2; k <= N; k <<= 1)
#pragma unroll
        for (int j = k >> 1; j > 0; j >>= 1)
#pragma unroll
            for (int i = 0; i < N; ++i) { const int l = i ^ j; if (l > i) { const bool desc = ((i & k) == 0); const float a = v[i], b = v[l]; const float hi = fmaxf(a, b), lo = fminf(a, b); v[i] = desc ? hi : lo; v[l] = desc ? lo : hi; } }
}
__device__ __forceinline__ void bitonic_merge16_desc(float (&v)[16]) {
#pragma unroll
    for (int j = 8; j > 0; j >>= 1)
#pragma unroll
        for (int i = 0; i < 16; ++i) { const int l = i ^ j; if (l > i) { const float a = v[i], b = v[l]; v[i] = fmaxf(a, b); v[l] = fminf(a, b); } }
}
__device__ __forceinline__ void top16_of_64(float (&v)[64], float (&out)[16]) {
    float b[4][16];
#pragma unroll
    for (int q = 0; q < 4; ++q) {
#pragma unroll
        for (int i = 0; i < 16; ++i) b[q][i] = v[16 * q + i];
        bitonic_sort_desc<16>(b[q]);
    }
    float t0[16], t1[16];
#pragma unroll
    for (int i = 0; i < 16; ++i) { t0[i] = fmaxf(b[0][i], b[1][15 - i]); t1[i] = fmaxf(b[2][i], b[3][15 - i]); }
    bitonic_merge16_desc(t0); bitonic_merge16_desc(t1);
#pragma unroll
    for (int i = 0; i < 16; ++i) out[i] = fmaxf(t0[i], t1[15 - i]);
    bitonic_merge16_desc(out);
}
__device__ __forceinline__ float dot2u(unsigned a, unsigned b, float c) { return __builtin_amdgcn_fdot2_f32_bf16(__builtin_bit_cast(b16x2, a), __builtin_bit_cast(b16x2, b), c, false); }
__device__ __forceinline__ float gelu_erf(float a) { return 0.5f * a * (1.0f + erff(a * 0.70710678118654752f)); }

constexpr int KROW = 272;
constexpr size_t WS_EID = WS_R2, WS_GATE = WS_R2 + 8 * MB, WS_ACT = WS_R2 + 24 * MB, WS_RSS2 = WS_R2 + 40 * MB;
constexpr int LP_KEYS = 0, LP_LUT = LP_KEYS + 256 * KROW, LP_RSTD = LP_LUT + NWAVES * 32 * 32, LP_END = LP_RSTD + 2 * 128;
static_assert(LP_END <= RING_BYTES, "peer LDS");

__device__ __forceinline__ void p5a_topk(const Args& a, LAS unsigned char* lds, int vcu, int G, int tid, int lane, int wave) {
    unsigned char* ws = a.ws;
    const bf16* Q = (const bf16*)(ws + WS_R2 + 64 * MB); const float* X = a.out; unsigned char* H8 = ws + WS_R1; float* SH = (float*)(ws + WS_SH); const float* gffn = a.in[8];
    unsigned short* EID = (unsigned short*)(ws + WS_EID); float* GATE = (float*)(ws + WS_GATE);
    const int l31 = lane & 31, hf = lane >> 5;
    for (int i = tid; i < 256 * 16; i += NTHR) { const int rr = i >> 4, c = i & 15; *(LAS v4u*)(lds + LP_KEYS + rr * KROW + c * 16) = *(const v4u*)((const bf16*)(ws + WS_KEYS) + rr * 128 + c * 8); }
    float gw[16];
    { const f32x4 g0 = *(const f32x4*)(gffn + 16 * lane), g1 = *(const f32x4*)(gffn + 16 * lane + 4), g2 = *(const f32x4*)(gffn + 16 * lane + 8), g3 = *(const f32x4*)(gffn + 16 * lane + 12);
#pragma unroll
      for (int u = 0; u < 4; ++u) { gw[u] = g0[u]; gw[4 + u] = g1[u]; gw[8 + u] = g2[u]; gw[12 + u] = g3[u]; } }
    int par = 0;
    for (int grp = vcu; grp < T / 32; grp += G, par ^= 1) {
        const int t0 = grp * 32;
        {
            float xs[4][16];
#pragma unroll
            for (int q = 0; q < 4; ++q) {
                const float* xr = X + ((size_t)t0 + 4 * wave + q) * D + 16 * lane;
                const f32x4 x0 = *(const f32x4*)xr, x1 = *(const f32x4*)(xr + 4), x2 = *(const f32x4*)(xr + 8), x3 = *(const f32x4*)(xr + 12);
#pragma unroll
                for (int u = 0; u < 4; ++u) { xs[q][u] = x0[u]; xs[q][4 + u] = x1[u]; xs[q][8 + u] = x2[u]; xs[q][12 + u] = x3[u]; }
            }
            float ssq[4];
#pragma unroll
            for (int q = 0; q < 4; ++q) { float sq = 0.f;
#pragma unroll
                for (int u = 0; u < 16; ++u) sq += xs[q][u] * xs[q][u];
                ssq[q] = sq; }
#pragma unroll
            for (int o = 1; o < 64; o <<= 1)
#pragma unroll
                for (int q = 0; q < 4; ++q) ssq[q] += __shfl_xor(ssq[q], o);
            float am[4];
#pragma unroll
            for (int q = 0; q < 4; ++q) {
                const float rstd = 1.0f / sqrtf(ssq[q] * (1.0f / D) + 1e-6f);
                if (lane == 0) *(LAS float*)(lds + LP_RSTD + par * 128 + (4 * wave + q) * 4) = rstd;
                float m = 0.f;
#pragma unroll
                for (int u = 0; u < 16; ++u) { xs[q][u] = xs[q][u] * rstd * gw[u]; m = fmaxf(m, fabsf(xs[q][u])); }
                am[q] = m;
            }
#pragma unroll
            for (int o = 1; o < 64; o <<= 1)
#pragma unroll
                for (int q = 0; q < 4; ++q) am[q] = fmaxf(am[q], __shfl_xor(am[q], o));
#pragma unroll
            for (int q = 0; q < 4; ++q) {
                const size_t tok = (size_t)t0 + 4 * wave + q;
                const float inv = am[q] > 0.f ? 127.0f / am[q] : 0.f;
                v4u w;
#pragma unroll
                for (int c = 0; c < 4; ++c) { unsigned ww = 0u;
#pragma unroll
                    for (int u = 0; u < 4; ++u) { const int qi = __float2int_rn(xs[q][4 * c + u] * inv); ww |= ((unsigned)qi & 0xffu) << (8 * u); }
                    w[c] = ww; }
                *(v4u*)(H8 + tok * D + 16 * lane) = w;
                if (lane == 0) SH[tok] = am[q] * (1.0f / 127.0f);
            }
        }
        __syncthreads();
        {
            const int h = wave;
            float lst[2][16];
#pragma unroll
            for (int p = 0; p < 2; ++p) {
                f32x16 acc[4];
#pragma unroll
                for (int q = 0; q < 4; ++q)
#pragma unroll
                    for (int i = 0; i < 16; ++i) acc[q][i] = 0.f;
                const bf16* qrow = Q + (size_t)(t0 + l31) * NQ + h * 256 + p * 128 + 8 * hf;
#pragma unroll
                for (int ks = 0; ks < 8; ++ks) {
                    const bf16x8 qf = *(const bf16x8*)(qrow + 16 * ks);
#pragma unroll
                    for (int q = 0; q < 4; ++q) acc[q] = MFMA32(lds_frag16(lds + LP_KEYS + (p * 128 + 32 * q + l31) * KROW + (16 * ks + 8 * hf) * 2), qf, acc[q]);
                }
                float v[64];
#pragma unroll
                for (int q = 0; q < 4; ++q)
#pragma unroll
                    for (int i = 0; i < 16; ++i) v[16 * q + i] = __uint_as_float((__float_as_uint(acc[q][i]) & 0xffffff80u) | (unsigned)(32 * q + crow(i, hf)));
                float mine[16];
                top16_of_64(v, mine);
                float t[16];
#pragma unroll
                for (int i = 0; i < 16; ++i) t[i] = __shfl_xor(mine[i], 32);
#pragma unroll
                for (int i = 0; i < 16; ++i) lst[p][i] = fmaxf(mine[i], t[15 - i]);
                bitonic_merge16_desc(lst[p]);
            }
            LAS unsigned char* lut = lds + LP_LUT + wave * 1024 + l31 * 32;
            {
                v4u wa, wb;
#pragma unroll
                for (int c = 0; c < 4; ++c) {
                    wa[c] = (__float_as_uint(lst[0][4 * c]) & 0x7fu) | ((__float_as_uint(lst[0][4 * c + 1]) & 0x7fu) << 8) | ((__float_as_uint(lst[0][4 * c + 2]) & 0x7fu) << 16) | ((__float_as_uint(lst[0][4 * c + 3]) & 0x7fu) << 24);
                    wb[c] = (__float_as_uint(lst[1][4 * c]) & 0x7fu) | ((__float_as_uint(lst[1][4 * c + 1]) & 0x7fu) << 8) | ((__float_as_uint(lst[1][4 * c + 2]) & 0x7fu) << 16) | ((__float_as_uint(lst[1][4 * c + 3]) & 0x7fu) << 24);
                }
                if (hf == 0) { *(LAS v4u*)lut = wa; *(LAS v4u*)(lut + 16) = wb; }
            }
            float cv[64];
            {
                int c = 0;
#pragma unroll
                for (int i = 0; i < 16; ++i)
#pragma unroll
                    for (int j = 0; j < 16; ++j)
                        if ((i + 1) * (j + 1) <= 16) {
                            const float sa = __uint_as_float(__float_as_uint(lst[0][i]) & 0xffffff80u), sb = __uint_as_float(__float_as_uint(lst[1][j]) & 0xffffff80u);
                            cv[c] = __uint_as_float((__float_as_uint(sa + sb) & 0xffffff00u) | (unsigned)(i * 16 + j)); ++c;
                        }
#pragma unroll
                for (int k = 50; k < 64; ++k) cv[k] = -3.0e38f;
            }
            float best[16];
            top16_of_64(cv, best);
            const float rstd = *(const LAS float*)(lds + LP_RSTD + par * 128 + l31 * 4);
            const float s0 = __uint_as_float(__float_as_uint(best[0]) & 0xffffff00u);
            float ev[16], esum = 0.f;
#pragma unroll
            for (int k = 0; k < 16; ++k) { const float sk = __uint_as_float(__float_as_uint(best[k]) & 0xffffff00u); ev[k] = __expf(rstd * (sk - s0)); esum += ev[k]; }
            const float einv = 1.0f / esum;
            LDS_WAIT();
            asm volatile("" ::: "memory");
            const size_t ob = (size_t)(t0 + l31) * 128 + h * 16;
            if (hf == 0) {
                unsigned e16[16];
#pragma unroll
                for (int k = 0; k < 16; ++k) { const unsigned code = __float_as_uint(best[k]) & 0xffu;
                    const unsigned ia = *(const LAS unsigned char*)(lut + (code >> 4)), ib = *(const LAS unsigned char*)(lut + 16 + (code & 15u));
                    e16[k] = ia * 128u + ib; }
                v4u w0, w1;
                w0.x = e16[0] | (e16[1] << 16); w0.y = e16[2] | (e16[3] << 16); w0.z = e16[4] | (e16[5] << 16); w0.w = e16[6] | (e16[7] << 16);
                w1.x = e16[8] | (e16[9] << 16); w1.y = e16[10] | (e16[11] << 16); w1.z = e16[12] | (e16[13] << 16); w1.w = e16[14] | (e16[15] << 16);
                *(v4u*)(EID + ob) = w0; *(v4u*)(EID + ob + 8) = w1;
            } else {
#pragma unroll
                for (int c = 0; c < 4; ++c) *(f32x4*)(GATE + ob + 4 * c) = (f32x4){ev[4 * c] * einv, ev[4 * c + 1] * einv, ev[4 * c + 2] * einv, ev[4 * c + 3] * einv};
            }
        }
    }
    __syncthreads();
}

constexpr int LB_H = 0, LB_LIST = LB_H + NWAVES * 4096, LB_GATE = LB_LIST + NWAVES * 2304, LB_END = LB_GATE + NWAVES * 2048;
static_assert(LB_END <= RING_BYTES, "p5b LDS");
struct B5Batch { v4u ur[16]; unsigned entv, em; float scl, svl; };
__device__ __forceinline__ void b5_issue(B5Batch& b, const LAS unsigned* list, int bt, const unsigned char* U8, const float* SU, const float* SV, int lane, int jmine) {
    b.entv = list[16 * bt + (lane & 15)]; b.em = list[16 * bt + jmine];
#pragma unroll
    for (int j = 0; j < 16; ++j) { const unsigned ent = __builtin_amdgcn_readlane(b.entv, j); b.ur[j] = *(const v4u*)(U8 + (size_t)(ent & 0xffffu) * D + 16 * lane); }
    const unsigned ee = b.em & 0xffffu; b.scl = SU[ee]; b.svl = SV[ee];
}
__device__ __forceinline__ void b5_compute(const B5Batch& b, LAS unsigned char* hreg, const LAS float* gts, float shv, float* ACT, int tok0, int lane) {
    int d[16];
#pragma unroll
    for (int j = 0; j < 16; ++j) {
        const unsigned ent = __builtin_amdgcn_readlane(b.entv, j);
        const v4u hh = *(const LAS v4u*)(hreg + ((ent >> 28) & 3u) * 1024 + lane * 16);
        int acc = 0;
#pragma unroll
        for (int u = 0; u < 4; ++u) { const unsigned wa = b.ur[j][u], ha = hh[u]; acc = __builtin_amdgcn_sdot4((int)ha, (int)wa, acc, false); }
        d[j] = acc;
    }
    int d8[8], d4[4], d2[2], d1;
    { const bool hi = (lane & 32) != 0;
#pragma unroll
      for (int j = 0; j < 8; ++j) { const int keep = hi ? d[j + 8] : d[j], send = hi ? d[j] : d[j + 8]; d8[j] = keep + __shfl_xor(send, 32); } }
    { const bool hi = (lane & 16) != 0;
#pragma unroll
      for (int j = 0; j < 4; ++j) { const int keep = hi ? d8[j + 4] : d8[j], send = hi ? d8[j] : d8[j + 4]; d4[j] = keep + __shfl_xor(send, 16); } }
    { const bool hi = (lane & 8) != 0;
#pragma unroll
      for (int j = 0; j < 2; ++j) { const int keep = hi ? d4[j + 2] : d4[j], send = hi ? d4[j] : d4[j + 2]; d2[j] = keep + __shfl_xor(send, 8); } }
    { const bool hi = (lane & 4) != 0; const int keep = hi ? d2[1] : d2[0], send = hi ? d2[0] : d2[1]; d1 = keep + __shfl_xor(send, 4); }
    d1 += __shfl_xor(d1, 1); d1 += __shfl_xor(d1, 2);
    const unsigned eslot = b.em >> 28, ek = (b.em >> 16) & 0xffu;
    const float sht = __shfl(shv, (int)(eslot & 3u));
    const float dot = (float)d1 * b.scl * sht;
    if ((lane & 3) == 0 && eslot < 4u) ACT[((size_t)tok0 + eslot) * 128 + ek] = gelu_erf(dot) * gts[eslot * 128 + ek] * b.svl;
}
struct B5Pre { unsigned idw[4]; f32x2 gg[4]; v4u h0[4]; float shv; };
__device__ __forceinline__ void b5_prefetch(B5Pre& p, const unsigned short* EID, const float* GATE, const unsigned char* H8, const float* SH, int tok0, int lane) {
#pragma unroll
    for (int s = 0; s < 4; ++s) { const size_t tok = (size_t)tok0 + s;
        p.idw[s] = *(const unsigned*)(EID + tok * 128 + 2 * lane); p.gg[s] = *(const f32x2*)(GATE + tok * 128 + 2 * lane); p.h0[s] = *(const v4u*)(H8 + tok * D + 16 * lane); }
    p.shv = SH[tok0 + (lane & 3)];
}
__device__ __forceinline__ void p5b_dots(const Args& a, LAS unsigned char* lds, int bx, int G, int tid, int lane, int wave) {
    unsigned char* ws = a.ws;
    const unsigned char* H8 = ws + WS_R1; const unsigned char* U8 = ws + WS_UB; const float* SU = (const float*)(ws + WS_SU); const float* SV = (const float*)(ws + WS_SV); const float* SH = (const float*)(ws + WS_SH);
    const unsigned short* EID = (const unsigned short*)(ws + WS_EID); const float* GATE = (const float*)(ws + WS_GATE); float* ACT = (float*)(ws + WS_ACT);
    LAS unsigned char* hreg = lds + LB_H + wave * 4096; LAS unsigned* list = (LAS unsigned*)(lds + LB_LIST + wave * 2304); LAS float* gts = (LAS float*)(lds + LB_GATE + wave * 2048);
    const int jmine = ((lane >> 5) & 1) * 8 + ((lane >> 4) & 1) * 4 + ((lane >> 3) & 1) * 2 + ((lane >> 2) & 1);
    const unsigned long long ltmask = (1ull << lane) - 1ull;
    for (int vb = bx; vb < 256; vb += G) {
        const unsigned vx = (unsigned)(vb & 7); const int wi = vb >> 3;
        const int tw0 = wi * 1024 + wave * 128;
        B5Pre P;
        b5_prefetch(P, EID, GATE, H8, SH, tw0, lane);
#pragma unroll 1
        for (int ch = 0; ch < 32; ++ch) {
            const int tok0 = tw0 + 4 * ch;
            int n = 0;
            const float shv = P.shv;
#pragma unroll
            for (int s = 0; s < 4; ++s) {
                *(LAS v4u*)(hreg + s * 1024 + lane * 16) = P.h0[s];
                *(LAS f32x2*)(gts + s * 128 + 2 * lane) = P.gg[s];
                const unsigned id0 = P.idw[s] & 0xffffu, id1 = P.idw[s] >> 16;
                const bool in0 = (id0 >> 11) == vx, in1 = (id1 >> 11) == vx;
                const unsigned long long m0 = __ballot(in0), m1 = __ballot(in1);
                const int c0 = __popcll(m0), c1 = __popcll(m1);
                if (in0) list[n + __popcll(m0 & ltmask)] = ((unsigned)s << 28) | ((unsigned)(2 * lane) << 16) | id0;
                if (in1) list[n + c0 + __popcll(m1 & ltmask)] = ((unsigned)s << 28) | ((unsigned)(2 * lane + 1) << 16) | id1;
                n += c0 + c1;
            }
            const int nb = (n + 15) >> 4;
            if (lane < 16) list[n + lane] = (0xfu << 28) | (vx << 11);
            if (ch + 1 < 32) b5_prefetch(P, EID, GATE, H8, SH, tok0 + 4, lane);
            LDS_WAIT(); asm volatile("" ::: "memory");
            B5Batch A, B;
            if (nb > 0) b5_issue(A, list, 0, U8, SU, SV, lane, jmine);
#pragma unroll 1
            for (int bt = 0; bt < nb; bt += 2) {
                if (bt + 1 < nb) b5_issue(B, list, bt + 1, U8, SU, SV, lane, jmine);
                b5_compute(A, hreg, gts, shv, ACT, tok0, lane);
                if (bt + 1 < nb) {
                    if (bt + 2 < nb) b5_issue(A, list, bt + 2, U8, SU, SV, lane, jmine);
                    b5_compute(B, hreg, gts, shv, ACT, tok0, lane);
                }
            }
        }
    }
}

constexpr int LC_BUF = 0, LC_END = NWAVES * 2 * 1024;
struct C5Tok { v4u vv[16]; f32x2 xa; };
__device__ __forceinline__ void c5_issue(C5Tok& t, LAS unsigned char* buf, const unsigned char* vbase, const float* xr, int g) {
#pragma unroll
    for (int j = 0; j < 16; ++j) {
        const int k = 8 * j + g;
        const unsigned e = *(const LAS unsigned short*)(buf + 2 * k);
        t.vv[j] = *(const v4u*)(vbase + (size_t)e * 128);
    }
    t.xa = *(const f32x2*)xr;
}
__device__ __forceinline__ void c5_finish(const C5Tok& t, LAS unsigned char* buf, float* xr, bf16* xb, float* rss, int lane, int g) {
    float y[16], asum = 0.f;
#pragma unroll
    for (int u = 0; u < 16; ++u) y[u] = 0.f;
#pragma unroll
    for (int j = 0; j < 16; ++j) {
        const float akj = *(const LAS float*)(buf + 256 + 4 * (8 * j + g));
        asum += akj;
#pragma unroll
        for (int u = 0; u < 4; ++u) { const unsigned w = t.vv[j][u];
            y[4 * u] += akj * (float)(w & 0xffu); y[4 * u + 1] += akj * (float)((w >> 8) & 0xffu); y[4 * u + 2] += akj * (float)((w >> 16) & 0xffu); y[4 * u + 3] += akj * (float)(w >> 24); }
    }
#pragma unroll
    for (int u = 0; u < 16; ++u) y[u] -= 128.0f * asum;
    float y8[8], y4[4], y2[2];
    { const bool hi = (lane & 32) != 0;
#pragma unroll
      for (int u = 0; u < 8; ++u) { const float keep = hi ? y[u + 8] : y[u], send = hi ? y[u] : y[u + 8]; y8[u] = keep + __shfl_xor(send, 32); } }
    { const bool hi = (lane & 16) != 0;
#pragma unroll
      for (int u = 0; u < 4; ++u) { const float keep = hi ? y8[u + 4] : y8[u], send = hi ? y8[u] : y8[u + 4]; y4[u] = keep + __shfl_xor(send, 16); } }
    { const bool hi = (lane & 8) != 0;
#pragma unroll
      for (int u = 0; u < 2; ++u) { const float keep = hi ? y4[u + 2] : y4[u], send = hi ? y4[u] : y4[u + 2]; y2[u] = keep + __shfl_xor(send, 8); } }
    const float o0 = t.xa[0] + y2[0], o1 = t.xa[1] + y2[1];
    const float ss = wave_sum(o0 * o0 + o1 * o1);
    *(f32x2*)xr = (f32x2){o0, o1};
    *(unsigned*)xb = pk2(o0, o1);
    if (lane == 0) *rss = ss;
}
__device__ __forceinline__ void p5c_axpy(const Args& a, LAS unsigned char* lds, int bx, int G, int tid, int lane, int wave) {
    unsigned char* ws = a.ws;
    const unsigned char* V8 = ws + WS_VB; const unsigned short* EID = (const unsigned short*)(ws + WS_EID); const float* ACT = (const float*)(ws + WS_ACT);
    float* X = a.out; bf16* XB2 = (bf16*)(ws + WS_R1); float* RSS2 = (float*)(ws + WS_RSS2);
    const int g = lane >> 3, c = lane & 7;
    const int colo = 16 * c + 8 * ((g >> 2) & 1) + 4 * ((g >> 1) & 1) + 2 * (g & 1);
    LAS unsigned char* buf0 = lds + LC_BUF + wave * 2048; LAS unsigned char* buf1 = buf0 + 1024;
    for (int vb = bx; vb < 256; vb += G) {
        const int vx = vb & 7, wi = vb >> 3;
        const size_t tw0 = (size_t)wi * 1024 + wave * 128;
        const unsigned char* vbase = V8 + (size_t)vx * ((size_t)NEXP * 128) + 16 * c;
        float* xcol = X + vx * 128 + colo; bf16* xbcol = XB2 + vx * 128 + colo;
        C5Tok A, B;
        unsigned idw = *(const unsigned*)(EID + tw0 * 128 + 2 * lane);
        f32x2 av = *(const f32x2*)(ACT + tw0 * 128 + 2 * lane);
        *(LAS unsigned*)(buf0 + 4 * lane) = idw; *(LAS f32x2*)(buf0 + 256 + 8 * lane) = av;
        idw = *(const unsigned*)(EID + (tw0 + 1) * 128 + 2 * lane); av = *(const f32x2*)(ACT + (tw0 + 1) * 128 + 2 * lane);
        LDS_WAIT(); asm volatile("" ::: "memory");
        c5_issue(A, buf0, vbase, xcol + tw0 * D, g);
#pragma unroll 1
        for (int i = 0; i < 128; i += 2) {
            const size_t tok = tw0 + i;
            *(LAS unsigned*)(buf1 + 4 * lane) = idw; *(LAS f32x2*)(buf1 + 256 + 8 * lane) = av;
            if (i + 2 < 128) { idw = *(const unsigned*)(EID + (tok + 2) * 128 + 2 * lane); av = *(const f32x2*)(ACT + (tok + 2) * 128 + 2 * lane); }
            LDS_WAIT(); asm volatile("" ::: "memory");
            c5_issue(B, buf1, vbase, xcol + (tok + 1) * D, g);
            c5_finish(A, buf0, xcol + tok * D, xbcol + tok * D, RSS2 + tok * 8 + vx, lane, g);
            if (i + 2 < 128) {
                *(LAS unsigned*)(buf0 + 4 * lane) = idw; *(LAS f32x2*)(buf0 + 256 + 8 * lane) = av;
                if (i + 3 < 128) { idw = *(const unsigned*)(EID + (tok + 3) * 128 + 2 * lane); av = *(const f32x2*)(ACT + (tok + 3) * 128 + 2 * lane); }
                LDS_WAIT(); asm volatile("" ::: "memory");
                c5_issue(A, buf0, vbase, xcol + (tok + 2) * D, g);
            }
            c5_finish(B, buf1, xcol + (tok + 1) * D, xbcol + (tok + 1) * D, RSS2 + (tok + 1) * 8 + vx, lane, g);
        }
    }
}

__global__ void __launch_bounds__(NTHR, 2) mk_fwd(Args a) {
    extern __shared__ __attribute__((aligned(16))) unsigned char lds_raw[];
    LAS unsigned char* lds = (LAS unsigned char*)lds_raw;
    const int tid = threadIdx.x, lane = tid & 63, wave = __builtin_amdgcn_readfirstlane(tid >> 6);
    const int G = gridDim.x, bx = blockIdx.x, vcu = (G % 8 == 0) ? (bx % 8) * (G / 8) + bx / 8 : bx;
    volatile LAS unsigned* MISC = (volatile LAS unsigned*)(lds + MISC_OFF);
    if (tid < 64) MISC[tid] = 0u;
    __syncthreads();
    unsigned char* ws = a.ws;
    const int lo = a.ph_lo, hi = a.ph_hi;
    XcdBarrier bar; bar.bar = (unsigned*)(ws + WS_CTL) + CW_BAR + a.li * XCD_BAR_WORDS; bar.x = 0; bar.st = nullptr;
    if (hi - lo > 1) bar = xcd_barrier_post((unsigned*)(ws + WS_CTL) + CW_BAR + a.li * XCD_BAR_WORDS, MISC + 8);
#define IN(k) (lo <= (k) && (k) < hi)
#define BOTH(k) (IN(k) && IN((k) + 1))
    if (IN(0)) { p0_prologue(a, lds, vcu, G, tid, lane, wave); if (BOTH(0)) xcd_barrier(bar); }
    if (IN(1)) {
        { pg8::Gemm g{(const bf16*)(ws + WS_R1), (const bf16*)(ws + WS_WIN), T, NIN, D}; pg8::StaticOrder S; S.init(T, NIN, G, bx);
          EpiStoreBf16 E{(bf16*)(ws + WS_R2), NIN};
          pg8::gemm_phase<EpiStoreBf16, pg8::StaticOrder, true, true>(lds, g, S, E); }
        { pg8::Gemm g{(const bf16*)(ws + WS_PB), (const bf16*)(ws + WS_WP), T, D, PLE}; pg8::StaticOrder S; S.init(T, D, G, bx);
          EpiStoreBf16 E{(bf16*)(ws + WS_PP), D};
          pg8::gemm_phase<EpiStoreBf16, pg8::StaticOrder, true, true>(lds, g, S, E); }
        if (BOTH(1)) xcd_barrier(bar);
    }
    if (IN(2)) { p2_mixing(a, lds, bx, G, tid, lane, wave); if (BOTH(2)) xcd_barrier(bar); }
    if (IN(3)) {
        pg8::Gemm g{(const bf16*)(ws + WS_R1), (const bf16*)(ws + WS_WOUT), T, D, D}; pg8::StaticOrder S; S.init(T, D, G, bx);
        EpiResid E{a.in[0], a.out, (bf16*)(ws + WS_R2)};
        pg8::gemm_phase<EpiResid, pg8::StaticOrder, true, true>(lds, g, S, E);
        if (BOTH(3)) xcd_barrier(bar);
    }
    if (IN(4)) {
        pg8::Gemm g{(const bf16*)(ws + WS_R2), (const bf16*)(ws + WS_WQ), T, NQ, D}; pg8::StaticOrder S; S.init(T, NQ, G, bx);
        EpiStoreBf16 E{(bf16*)(ws + WS_R2 + 64 * MB), NQ};
        pg8::gemm_phase<EpiStoreBf16, pg8::StaticOrder, true, true>(lds, g, S, E);
        if (BOTH(4)) xcd_barrier(bar);
    }
    if (IN(5)) {
        p5a_topk(a, lds, vcu, G, tid, lane, wave); xcd_barrier(bar);
        p5b_dots(a, lds, bx, G, tid, lane, wave); xcd_barrier(bar);
        p5c_axpy(a, lds, bx, G, tid, lane, wave);
        if (BOTH(5)) xcd_barrier(bar);
    }
    if (IN(6)) {
        pg8::Gemm g{(const bf16*)(ws + WS_R1), (const bf16*)(ws + WS_WG), T, D, D}; pg8::StaticOrder S; S.init(T, D, G, bx);
        EpiGate E{a.out, (const bf16*)(ws + WS_PP), (const float*)(ws + WS_RSS2)};
        pg8::gemm_phase<EpiGate, pg8::StaticOrder, true, true>(lds, g, S, E);
    }
#undef IN
#undef BOTH
}
}
extern "C" void kernel_launch(void* const* d_in, const int* in_sizes, int n_in, void* d_out, int out_size, void* d_ws, size_t ws_size, hipStream_t stream) {
    using namespace mk;
    static int grid = 0;
    if (grid == 0) {
        int dev = 0, cus = 0;
        if (n_in != 16 || out_size != T * D || ws_size < WS_END) { fprintf(stderr, "kernel_launch: unexpected problem shape / workspace (%d inputs, out %d, ws %zu)\n", n_in, out_size, ws_size); grid = -1; return; }
        if (hipGetDevice(&dev) != hipSuccess || hipDeviceGetAttribute(&cus, hipDeviceAttributeMultiprocessorCount, dev) != hipSuccess) { fprintf(stderr, "device query failed\n"); grid = -1; return; }
        if (hipFuncSetAttribute((const void*)mk_fwd, hipFuncAttributeMaxDynamicSharedMemorySize, LDS_BYTES) != hipSuccess) { fprintf(stderr, "hipFuncSetAttribute failed\n"); grid = -1; return; }
        int per_cu = 0;
        if (hipOccupancyMaxActiveBlocksPerMultiprocessor(&per_cu, (const void*)mk_fwd, NTHR, LDS_BYTES) != hipSuccess || per_cu < 1) { fprintf(stderr, "occupancy query: %d blocks per CU\n", per_cu); (void)hipGetLastError(); }
        grid = cus;
    }
    if (grid < 0) return;
    unsigned char* ws = (unsigned char*)d_ws;
    (void)hipMemsetAsync(ws + WS_CTL, 0, CTL_BYTES, stream);
    Args a{};
    for (int i = 0; i < 16; ++i) a.in[i] = (const float*)d_in[i];
    a.out = (float*)d_out; a.ws = ws; a.ph_lo = 0; a.ph_hi = 7; a.li = 0; a.pad = 0;
    hipLaunchKernelGGL(mk_fwd, dim3(grid), dim3(NTHR), LDS_BYTES, stream, a);
}
```

```cpp
#include <hip/hip_runtime.h>
#include <cstdio>
#include <cstdint>
#define LAS __attribute__((address_space(3)))
#define GAS __attribute__((address_space(1)))
namespace pg8 {
#define PG8_LAS __attribute__((address_space(3)))
typedef unsigned short bf16_t;
typedef short bf16x8 __attribute__((ext_vector_type(8)));
typedef float f32x4 __attribute__((ext_vector_type(4)));
typedef unsigned u32x4 __attribute__((ext_vector_type(4)));
constexpr int BM = 256, BK = 64, HALF = 128, HTB = HALF * BK * 2  , STAGE_BYTES = 8 * HTB, NXCD = 8, WGM = 8;

__host__ __device__ __forceinline__ int lds_byte(int r, int c) { const int st = (r >> 4) * 2 + (c >> 5), rr = r & 15, cc = c & 31, ob = rr * 64 + cc * 2; return st * 1024 + (ob ^ (((ob >> 9) & 1) << 5)); }
__host__ __device__ __forceinline__ void stage_rc(int b, int& R, int& C) { const int st = b / 1024, sb = b % 1024, swz = sb ^ (((sb >> 9) & 1) << 5); R = (st >> 1) * 16 + swz / 64; C = (st & 1) * 32 + (swz % 64) / 2; }
__host__ __device__ __forceinline__ int perm32(int rho) { const int n = rho >> 4, i = rho & 15; return 8 * (i >> 2) + 4 * n + (i & 3); }

struct Unit { int pm, pn; };
struct Gemm { const bf16_t* A; const bf16_t* Bt; int M, N, K; };

struct StaticOrder {
    int nM, nN, nwg, G, c;
    __host__ __device__ void init(int M, int N, int G_, int c_) { nM = M / BM; nN = N / BM; nwg = nM * nN; G = G_; c = c_; }
    __host__ __device__ bool next(int i, Unit& u) const {
        const long L = (long)i * G + c; if (L >= nwg) return false;
        int wgid = (int)L; { const int q = nwg / NXCD, r = nwg % NXCD, xcd = wgid % NXCD, off = wgid / NXCD; wgid = (xcd < r ? xcd * (q + 1) : r * (q + 1) + (xcd - r) * q) + off; }
        const int nig = WGM * nN, gid = wgid / nig, fm = gid * WGM, gsz = (nM - fm) < WGM ? (nM - fm) : WGM;
        u.pm = fm + ((wgid % nig) % gsz); u.pn = (wgid % nig) / gsz; return true;
    }
    __device__ __forceinline__ void a_ready(const Unit&) const {}
    __device__ __forceinline__ void done(const Unit&) const {}
};
__device__ __forceinline__ unsigned cvt_pk_bf16(float lo, float hi) { unsigned r; asm volatile("v_cvt_pk_bf16_f32 %0, %1, %2" : "=v"(r) : "v"(lo), "v"(hi)); return r; }
template <class Epi, class Sched, bool ALIGN_EPI = false, bool SP2 = false>
__device__ __forceinline__ void gemm_phase(PG8_LAS unsigned char* lds, const Gemm g, const Sched& S, const Epi& E) {
    const int tid = threadIdx.x, wid = __builtin_amdgcn_readfirstlane(tid >> 6), lane = tid & 63, wr = wid >> 2, wc = wid & 3, fr = lane & 15, fq = lane >> 4;
    const int K = g.K, nt = K / BK;
    unsigned voffA[2], voffB[2];
#pragma unroll
    for (int i = 0; i < 2; ++i) { int R, C; stage_rc(tid * 16 + i * 8192, R, C); const int Rb = Epi::PERM ? ((R & ~31) + perm32(R & 31)) : R;
        voffA[i] = (unsigned)(R * K + C) * 2u; voffB[i] = (unsigned)(Rb * K + C) * 2u; }
    const size_t kstep = (size_t)(BK * 2);
    const size_t hstep = (size_t)HALF * K * 2;
    const size_t tstep = 2 * hstep;
    const unsigned ldsw = (unsigned)wid * 1024u;
    const int aoff = lds_byte(wr * 64 + fr, fq * 8), boff = lds_byte(wc * 32 + fr, fq * 8);
#define PG8_SA(b, h) (((b) * 2 + (h)) * HTB)
#define PG8_SB(b, h) ((4 + (b) * 2 + (h)) * HTB)
#define PG8_STAGE(bufoff, gbase, voff) do { _Pragma("unroll") for (int _i = 0; _i < 2; ++_i) \
        __builtin_amdgcn_global_load_lds((const unsigned*)((const char*)(gbase) + (voff)[_i]), (PG8_LAS unsigned*)(lds + (bufoff) + ldsw + _i * 8192), 16, 0, 0); } while (0)
#define PG8_LDA(dst, b, h) do { _Pragma("unroll") for (int m = 0; m < 4; ++m) _Pragma("unroll") for (int k = 0; k < 2; ++k) dst[m][k] = *(const PG8_LAS bf16x8*)(lds + PG8_SA(b, h) + aoff + m * 2048 + k * 1024); } while (0)
#define PG8_LDB(dst, b, h) do { _Pragma("unroll") for (int n = 0; n < 2; ++n) _Pragma("unroll") for (int k = 0; k < 2; ++k) dst[n][k] = *(const PG8_LAS bf16x8*)(lds + PG8_SB(b, h) + boff + n * 2048 + k * 1024); } while (0)
#define PG8_MMA(ai, bj, At, Bt) do { __builtin_amdgcn_s_setprio(1); _Pragma("unroll") for (int m = 0; m < 4; ++m) _Pragma("unroll") for (int n = 0; n < 2; ++n) _Pragma("unroll") for (int k = 0; k < 2; ++k) \
        acc[ai][bj][m][n] = __builtin_amdgcn_mfma_f32_16x16x32_bf16(Bt[n][k], At[m][k], acc[ai][bj][m][n], 0, 0, 0); __builtin_amdgcn_s_setprio(0); } while (0)
#define PG8_WAIT_V(n) asm volatile("s_waitcnt vmcnt(" #n ")" ::: "memory")
#define PG8_WAIT_L(n) asm volatile("s_waitcnt lgkmcnt(" #n ")" ::: "memory")
#define PG8_BAR __builtin_amdgcn_s_barrier()
#define PG8_SCHED __builtin_amdgcn_sched_barrier(0)
    Unit cur, nxt; int ui = 0;
    if (!S.next(0, cur)) return;
    f32x4 acc[2][2][4][2];
#pragma unroll
    for (int a = 0; a < 2; ++a)
#pragma unroll
        for (int b = 0; b < 2; ++b)
#pragma unroll
            for (int m = 0; m < 4; ++m)
#pragma unroll
                for (int n = 0; n < 2; ++n) acc[a][b][m][n] = (f32x4){0.f, 0.f, 0.f, 0.f};
    bf16x8 At[4][2], B0[2][2], B1[2][2];
    const char* cA = (const char*)g.A + (size_t)cur.pm * tstep; const char* cB = (const char*)g.Bt + (size_t)cur.pn * tstep;
    S.a_ready(cur);
    if constexpr (SP2) {
        PG8_STAGE(PG8_SB(0, 0), cB, voffB); PG8_STAGE(PG8_SB(0, 1), cB + hstep, voffB); PG8_STAGE(PG8_SA(0, 0), cA, voffA); PG8_STAGE(PG8_SA(0, 1), cA + hstep, voffA);
        if (wr == 1) PG8_BAR;
        PG8_WAIT_V(2); PG8_BAR;
        PG8_STAGE(PG8_SB(1, 0), cB + kstep, voffB); PG8_STAGE(PG8_SA(1, 0), cA + kstep, voffA); PG8_STAGE(PG8_SB(1, 1), cB + hstep + kstep, voffB);
        PG8_WAIT_V(6); PG8_BAR;
    } else {
        PG8_STAGE(PG8_SB(0, 0), cB, voffB); PG8_STAGE(PG8_SA(0, 0), cA, voffA); PG8_STAGE(PG8_SB(0, 1), cB + hstep, voffB); PG8_STAGE(PG8_SA(0, 1), cA + hstep, voffA);
        if (wr == 1) PG8_BAR;
        PG8_WAIT_V(4); PG8_BAR;
        PG8_STAGE(PG8_SB(1, 0), cB + kstep, voffB); PG8_STAGE(PG8_SA(1, 0), cA + kstep, voffA); PG8_STAGE(PG8_SB(1, 1), cB + hstep + kstep, voffB);
        PG8_WAIT_V(6); PG8_BAR;
    }
    for (;;) {
        const bool has_next = S.next(ui + 1, nxt);
        const char* nA = has_next ? (const char*)g.A + (size_t)nxt.pm * tstep : cA; const char* nB = has_next ? (const char*)g.Bt + (size_t)nxt.pn * tstep : cB;
        for (int t = 0; t < nt; t += 2) {
            const bool last = (t == nt - 2);
            const char* a1 = cA + (size_t)(t + 1) * kstep;
            const char* a2 = last ? nA : cA + (size_t)(t + 2) * kstep; const char* b2 = last ? nB : cB + (size_t)(t + 2) * kstep;
            const char* a3 = a2 + kstep; const char* b3 = b2 + kstep;
            if (last && has_next) S.a_ready(nxt);
            if constexpr (SP2) {
            PG8_LDB(B0, 0, 0); PG8_LDB(B1, 0, 1); PG8_SCHED; PG8_LDA(At, 0, 0); PG8_STAGE(PG8_SA(1, 1), a1 + hstep, voffA);
            PG8_WAIT_V(8); PG8_WAIT_L(0); PG8_BAR; PG8_MMA(0, 0, At, B0); PG8_MMA(0, 1, At, B1); PG8_BAR; PG8_SCHED;
            PG8_LDA(At, 0, 1); PG8_STAGE(PG8_SB(0, 0), b2, voffB); PG8_STAGE(PG8_SB(0, 1), b2 + hstep, voffB); PG8_STAGE(PG8_SA(0, 0), a2, voffA);
            PG8_WAIT_V(8); PG8_WAIT_L(0); PG8_BAR; PG8_MMA(1, 0, At, B0); PG8_MMA(1, 1, At, B1); PG8_BAR; PG8_SCHED;
            PG8_LDB(B0, 1, 0); PG8_LDB(B1, 1, 1); PG8_SCHED; PG8_LDA(At, 1, 0); PG8_STAGE(PG8_SA(0, 1), a2 + hstep, voffA);
            PG8_WAIT_V(8); PG8_WAIT_L(0); PG8_BAR; PG8_MMA(0, 0, At, B0); PG8_MMA(0, 1, At, B1); PG8_BAR; PG8_SCHED;
            PG8_LDA(At, 1, 1); PG8_STAGE(PG8_SB(1, 0), b3, voffB); PG8_STAGE(PG8_SB(1, 1), b3 + hstep, voffB); PG8_STAGE(PG8_SA(1, 0), a3, voffA);
            PG8_WAIT_V(8); PG8_WAIT_L(0); PG8_BAR; PG8_MMA(1, 0, At, B0); PG8_MMA(1, 1, At, B1); PG8_BAR; PG8_SCHED;
            } else {
            PG8_LDB(B0, 0, 0); PG8_SCHED; PG8_LDA(At, 0, 0); PG8_STAGE(PG8_SA(1, 1), a1 + hstep, voffA);
            PG8_WAIT_L(8); PG8_BAR; PG8_WAIT_L(0); PG8_MMA(0, 0, At, B0); PG8_BAR; PG8_SCHED;
            PG8_LDB(B1, 0, 1); PG8_STAGE(PG8_SB(0, 0), b2, voffB);
            PG8_BAR; PG8_WAIT_L(0); PG8_MMA(0, 1, At, B1); PG8_BAR;
            PG8_LDA(At, 0, 1); PG8_STAGE(PG8_SA(0, 0), a2, voffA);
            PG8_BAR; PG8_WAIT_L(0); PG8_MMA(1, 0, At, B0); PG8_BAR; PG8_SCHED;
            PG8_STAGE(PG8_SB(0, 1), b2 + hstep, voffB);
            PG8_WAIT_V(6); PG8_BAR; PG8_MMA(1, 1, At, B1); PG8_BAR;
            PG8_LDB(B0, 1, 0); PG8_SCHED; PG8_LDA(At, 1, 0); PG8_STAGE(PG8_SA(0, 1), a2 + hstep, voffA);
            PG8_WAIT_L(8); PG8_BAR; PG8_WAIT_L(0); PG8_MMA(0, 0, At, B0); PG8_BAR; PG8_SCHED;
            PG8_LDB(B1, 1, 1); PG8_STAGE(PG8_SB(1, 0), b3, voffB);
            PG8_BAR; PG8_WAIT_L(0); PG8_MMA(0, 1, At, B1); PG8_BAR;
            PG8_LDA(At, 1, 1); PG8_STAGE(PG8_SA(1, 0), a3, voffA);
            PG8_BAR; PG8_WAIT_L(0); PG8_MMA(1, 0, At, B0); PG8_BAR; PG8_SCHED;
            PG8_STAGE(PG8_SB(1, 1), b3 + hstep, voffB);
            PG8_WAIT_V(6); PG8_BAR; PG8_MMA(1, 1, At, B1); PG8_BAR;
            }
        }
        if constexpr (ALIGN_EPI) { if (wr == 0) PG8_BAR; }
        if constexpr (!Epi::AFTER_DRAIN) { E(acc, cur, wr, wc, fr, fq); S.done(cur); }
        if (!has_next) break;
#pragma unroll
        for (int a = 0; a < 2; ++a)
#pragma unroll
            for (int b = 0; b < 2; ++b)
#pragma unroll
                for (int m = 0; m < 4; ++m)
#pragma unroll
                    for (int n = 0; n < 2; ++n) acc[a][b][m][n] = (f32x4){0.f, 0.f, 0.f, 0.f};
        cur = nxt; cA = nA; cB = nB; ++ui;
        if constexpr (ALIGN_EPI) { if (wr == 1) PG8_BAR; }
    }
    PG8_WAIT_V(0);
    if constexpr (!ALIGN_EPI) { if (wr == 0) PG8_BAR; }
    PG8_BAR;
    if constexpr (Epi::AFTER_DRAIN) { E.fused(acc, cur, wr, wc, fr, fq, lds, wid, lane); S.done(cur); }
#undef PG8_SA
#undef PG8_SB
#undef PG8_STAGE
#undef PG8_LDA
#undef PG8_LDB
#undef PG8_MMA
#undef PG8_WAIT_V
#undef PG8_WAIT_L
#undef PG8_BAR
#undef PG8_SCHED
}
}
#define XB_TMO      128
#define XB_XCNT(j)  (256  + 64 * (j))
#define XB_XSUB(j)  (1280 + 64 * (j))
#define XB_XGEN(j)  (2304 + 64 * (j))
#define XB_TOP      3328
#define XB_TOPGEN   3392
#define XCD_BAR_WORDS 3456
#define XB_SPIN_CAP (1u << 18)

__device__ __forceinline__ unsigned xb_ld(unsigned* p)              { return __hip_atomic_load(p, __ATOMIC_RELAXED, __HIP_MEMORY_SCOPE_AGENT); }
__device__ __forceinline__ unsigned xb_add(unsigned* p, unsigned v) { return __hip_atomic_fetch_add(p, v, __ATOMIC_RELAXED, __HIP_MEMORY_SCOPE_AGENT); }
__device__ __forceinline__ unsigned xb_xcc_id() { return (unsigned)__builtin_amdgcn_s_getreg((3 << 11) | 20) & 0xFu; }
#define XB_SPIN(cond, bar) do { unsigned _sp = 0; while (cond) { __builtin_amdgcn_s_sleep(1); \
    if ((++_sp & 255u) == 0u) { if (xb_ld(&(bar)[XB_TMO])) break; if (_sp > XB_SPIN_CAP) { atomicAdd(&(bar)[XB_TMO], 1u); break; } } } } while (0)

struct XcdBarrier {
    unsigned* bar; unsigned x;
    volatile LAS unsigned* st;
};

__device__ __forceinline__ XcdBarrier xcd_barrier_post(unsigned* bar, volatile LAS unsigned* st) {
    XcdBarrier b; b.bar = bar; b.x = xb_xcc_id(); b.st = st;
    if (threadIdx.x == 0) (void)xb_add(&bar[XB_XCNT(b.x)], 1u);
    return b;
}
__device__ __forceinline__ void xcd_barrier_complete(unsigned* bar, unsigned x, unsigned& nloc, unsigned& nx) {
    const unsigned G = gridDim.x * gridDim.y * gridDim.z;
    unsigned sum, cnt, mine, sp = 0u;
    for (;;) {
        sum = 0u; cnt = 0u; mine = 0u;
#pragma unroll
        for (unsigned j = 0; j < 16; ++j) { const unsigned c = xb_ld(&bar[XB_XCNT(j)]); sum += c; cnt += (c > 0u) ? 1u : 0u; mine = (j == x) ? c : mine; }
        if (sum == G) break;
        __builtin_amdgcn_s_sleep(1);
        if ((++sp & 255u) == 0u) { if (xb_ld(&bar[XB_TMO])) break; if (sp > XB_SPIN_CAP) { atomicAdd(&bar[XB_TMO], 1u); break; } }
    }
    nloc = mine > 0u ? mine : 1u; nx = cnt > 0u ? cnt : 1u;
}

__device__ __forceinline__ void xcd_barrier(const XcdBarrier& b) {
    asm volatile("s_waitcnt vmcnt(0)" ::: "memory");
    __syncthreads();
    if (threadIdx.x == 0) {
        unsigned* bar = b.bar;
        __builtin_amdgcn_s_waitcnt(0);
        unsigned nloc = b.st[0], nx = b.st[1];
        if (nloc == 0u) { xcd_barrier_complete(bar, b.x, nloc, nx); b.st[0] = nloc; b.st[1] = nx; }
        const unsigned old = xb_add(&bar[XB_XSUB(b.x)], 1u);
        const unsigned gen = old / nloc;
        if (old + 1u == (gen + 1u) * nloc) {
            __builtin_amdgcn_fence(__ATOMIC_RELEASE, "agent");
            asm volatile("s_waitcnt vmcnt(0)" ::: "memory");
            const unsigned og = xb_add(&bar[XB_TOP], 1u);
            const unsigned tg = og / nx;
            if (og + 1u == (tg + 1u) * nx) xb_add(&bar[XB_TOPGEN], 1u);
            else XB_SPIN(xb_ld(&bar[XB_TOPGEN]) == tg, bar);
            __builtin_amdgcn_fence(__ATOMIC_ACQUIRE, "agent");
            xb_add(&bar[XB_XGEN(b.x)], 1u);
            asm volatile("s_waitcnt vmcnt(0)" ::: "memory");
        } else {
            XB_SPIN(xb_ld(&bar[XB_XGEN(b.x)]) == gen, bar);
            __builtin_amdgcn_fence(__ATOMIC_ACQUIRE, "agent");
            asm volatile("s_waitcnt vmcnt(0)" ::: "memory");
        }
    }
    __syncthreads();
}
namespace mk {
typedef unsigned short bf16;
typedef unsigned v4u __attribute__((ext_vector_type(4)));
typedef unsigned v2u __attribute__((ext_vector_type(2)));
typedef float f32x4 __attribute__((ext_vector_type(4)));
typedef float f32x16 __attribute__((ext_vector_type(16)));
typedef short bf16x8 __attribute__((ext_vector_type(8)));
typedef short bf16x4 __attribute__((ext_vector_type(4)));

constexpr int T = 32768, D = 1024, SQ = 4096, NIN = 2816, NQ = 2048, PLE = 256, NEXP = 16384;
constexpr int NWAVES = 8, NTHR = 512;
constexpr int RING_BYTES = 131072, LDS_BYTES = 163840, MISC_OFF = LDS_BYTES - 256;

constexpr size_t MB = 1024 * 1024;
constexpr size_t WS_CTL = 0, CTL_BYTES = 256 * 1024;
constexpr size_t WS_WIN = WS_CTL + CTL_BYTES;
constexpr size_t WS_WOUT = WS_WIN + (size_t)NIN * D * 2;
constexpr size_t WS_WQ = WS_WOUT + (size_t)D * D * 2;
constexpr size_t WS_WG = WS_WQ + (size_t)NQ * D * 2;
constexpr size_t WS_WP = WS_WG + (size_t)D * D * 2;
constexpr size_t WS_KEYS = WS_WP + (size_t)D * PLE * 2;
constexpr size_t WS_ROPE = WS_KEYS + 2 * 128 * 128 * 2;
constexpr size_t WS_SU = WS_ROPE + 2 * (size_t)SQ * 32 * 4;
constexpr size_t WS_SV = WS_SU + 65536;
constexpr size_t WS_SH = WS_SV + 65536;
constexpr size_t WS_UB = 16 * MB;
constexpr size_t WS_VB = 32 * MB;
constexpr size_t WS_PB = 48 * MB;
constexpr size_t WS_GATE = 64 * MB;
constexpr size_t WS_ACT = 80 * MB;
constexpr size_t WS_R1 = 96 * MB;
constexpr size_t WS_R2 = 160 * MB;
constexpr size_t WS_PP = 352 * MB;
constexpr size_t WS_EID = 416 * MB;
constexpr size_t WS_RSS2 = 424 * MB;
constexpr size_t WS_END = 425 * MB;
static_assert(WS_SH + (size_t)T * 4 <= WS_UB, "ws map");
constexpr int CW_BAR = 1024;

#define LDS_WAIT() asm volatile("s_waitcnt lgkmcnt(0)" ::: "memory")
#define VM_WAIT() asm volatile("s_waitcnt vmcnt(0)" ::: "memory")
typedef float f32x2 __attribute__((ext_vector_type(2)));
typedef __bf16 b16x2 __attribute__((ext_vector_type(2)));
__device__ __forceinline__ unsigned pk2(float lo, float hi) { const f32x2 v = {lo, hi}; return __builtin_bit_cast(unsigned, __builtin_convertvector(v, b16x2)); }
__device__ __forceinline__ float bf_lo(unsigned w) { return __uint_as_float(w << 16); }
__device__ __forceinline__ float bf_hi(unsigned w) { return __uint_as_float(w & 0xffff0000u); }
__device__ __forceinline__ float wave_sum(float v) {
#pragma unroll
    for (int o = 1; o < 64; o <<= 1) v += __shfl_xor(v, o);
    return v;
}

struct Args { const float* in[16]; float* out; unsigned char* ws; int ph_lo, ph_hi, li, pad; };

struct EpiStoreBf16 {
    static constexpr bool PERM = true, AFTER_DRAIN = false;
    bf16* O; int ldc;
    __device__ __forceinline__ void operator()(const pg8::f32x4 (&acc)[2][2][4][2], const pg8::Unit& u, int wr, int wc, int fr, int fq) const {
        const int row0 = u.pm * 256 + wr * 64 + fr, col0 = u.pn * 256 + wc * 32 + 8 * fq;
#pragma unroll
        for (int ai = 0; ai < 2; ++ai)
#pragma unroll
            for (int m = 0; m < 4; ++m) { bf16* rowp = O + (size_t)(row0 + ai * 128 + m * 16) * ldc + col0;
#pragma unroll
                for (int bj = 0; bj < 2; ++bj) { const pg8::f32x4 v0 = acc[ai][bj][m][0], v1 = acc[ai][bj][m][1];
                    pg8::u32x4 w; w.x = pk2(v0[0], v0[1]); w.y = pk2(v0[2], v0[3]); w.z = pk2(v1[0], v1[1]); w.w = pk2(v1[2], v1[3]);
                    *(pg8::u32x4*)(rowp + bj * 128) = w; } }
    }
};


struct EpiResid {
    static constexpr bool PERM = true, AFTER_DRAIN = false;
    const float* X; bf16* XB;
    __device__ __forceinline__ void operator()(const pg8::f32x4 (&acc)[2][2][4][2], const pg8::Unit& u, int wr, int wc, int fr, int fq) const {
        const int row0 = u.pm * 256 + wr * 64 + fr, col0 = u.pn * 256 + wc * 32 + 8 * fq;
#pragma unroll
        for (int ai = 0; ai < 2; ++ai)
#pragma unroll
            for (int m = 0; m < 4; ++m) { const size_t off = (size_t)(row0 + ai * 128 + m * 16) * D + col0;
#pragma unroll
                for (int bj = 0; bj < 2; ++bj) { const size_t o2 = off + bj * 128;
                    const pg8::f32x4 v0 = acc[ai][bj][m][0] + *(const pg8::f32x4*)(X + o2), v1 = acc[ai][bj][m][1] + *(const pg8::f32x4*)(X + o2 + 4);
                    pg8::u32x4 w; w.x = pk2(v0[0], v0[1]); w.y = pk2(v0[2], v0[3]); w.z = pk2(v1[0], v1[1]); w.w = pk2(v1[2], v1[3]);
                    *(pg8::u32x4*)(XB + o2) = w; } }
    }
};
struct EpiGate {
    static constexpr bool PERM = true, AFTER_DRAIN = false;
    float* O; const bf16* XB; const bf16* PP; const float* rss;
    __device__ __forceinline__ void operator()(const pg8::f32x4 (&acc)[2][2][4][2], const pg8::Unit& u, int wr, int wc, int fr, int fq) const {
        const int row0 = u.pm * 256 + wr * 64 + fr, col0 = u.pn * 256 + wc * 32 + 8 * fq;
#pragma unroll
        for (int ai = 0; ai < 2; ++ai)
#pragma unroll
            for (int m = 0; m < 4; ++m) { const int row = row0 + ai * 128 + m * 16; const size_t off = (size_t)row * D + col0;
                const pg8::f32x4 q0 = *(const pg8::f32x4*)(rss + (size_t)row * 8), q1 = *(const pg8::f32x4*)(rss + (size_t)row * 8 + 4);
                const float rs = 1.0f / sqrtf((((q0[0] + q0[1]) + (q0[2] + q0[3])) + ((q1[0] + q1[1]) + (q1[2] + q1[3]))) * (1.0f / D) + 1e-6f);
#pragma unroll
                for (int bj = 0; bj < 2; ++bj) { const size_t o2 = off + bj * 128;
                    const pg8::u32x4 pw = *(const pg8::u32x4*)(PP + o2), xw = *(const pg8::u32x4*)(XB + o2);
                    const pg8::f32x4 a0 = acc[ai][bj][m][0] * rs, a1 = acc[ai][bj][m][1] * rs;
                    pg8::f32x4 x0, x1;
                    x0[0] = bf_lo(xw.x) + bf_lo(pw.x) / (1.0f + __expf(-a0[0])); x0[1] = bf_hi(xw.x) + bf_hi(pw.x) / (1.0f + __expf(-a0[1])); x0[2] = bf_lo(xw.y) + bf_lo(pw.y) / (1.0f + __expf(-a0[2])); x0[3] = bf_hi(xw.y) + bf_hi(pw.y) / (1.0f + __expf(-a0[3]));
                    x1[0] = bf_lo(xw.z) + bf_lo(pw.z) / (1.0f + __expf(-a1[0])); x1[1] = bf_hi(xw.z) + bf_hi(pw.z) / (1.0f + __expf(-a1[1])); x1[2] = bf_lo(xw.w) + bf_lo(pw.w) / (1.0f + __expf(-a1[2])); x1[3] = bf_hi(xw.w) + bf_hi(pw.w) / (1.0f + __expf(-a1[3]));
                    *(pg8::f32x4*)(O + o2) = x0; *(pg8::f32x4*)(O + o2 + 4) = x1; } }
    }
};

__device__ __forceinline__ void p0_transpose_item(const float* __restrict__ W, const float* __restrict__ gsc, int K, int N, bf16* __restrict__ WT, LAS float* scr, int item, int lane) {
    const int nblk = N / 32, kb = item / nblk, nb = item % nblk, k0 = 64 * kb, n0 = 32 * nb;
#pragma unroll 8
    for (int i = 0; i < 32; ++i) { const int kk = 2 * i + (lane >> 5); float w = W[(size_t)(k0 + kk) * N + n0 + (lane & 31)]; if (gsc) w *= gsc[k0 + kk]; scr[kk * 33 + (lane & 31)] = w; }
    LDS_WAIT(); asm volatile("" ::: "memory");
    const int c = lane & 7;
#pragma unroll
    for (int j = 0; j < 4; ++j) { const int n = (lane >> 3) + 8 * j; const LAS float* s = scr + (8 * c) * 33 + n;
        v4u o; o.x = pk2(s[0 * 33], s[1 * 33]); o.y = pk2(s[2 * 33], s[3 * 33]); o.z = pk2(s[4 * 33], s[5 * 33]); o.w = pk2(s[6 * 33], s[7 * 33]);
        *(v4u*)(WT + (size_t)(n0 + n) * K + k0 + 8 * c) = o; }
    LDS_WAIT(); asm volatile("" ::: "memory");
}
__device__ __forceinline__ void p0_convert(const float* __restrict__ src, bf16* __restrict__ dst, size_t n8, size_t gtid, size_t gthreads) {
    size_t i = gtid;
    for (; i + 3 * gthreads < n8; i += 4 * gthreads) {
        f32x4 a[4], b[4];
#pragma unroll
        for (int r = 0; r < 4; ++r) { a[r] = ((const f32x4*)src)[2 * (i + r * gthreads)]; b[r] = ((const f32x4*)src)[2 * (i + r * gthreads) + 1]; }
#pragma unroll
        for (int r = 0; r < 4; ++r) { v4u o; o.x = pk2(a[r][0], a[r][1]); o.y = pk2(a[r][2], a[r][3]); o.z = pk2(b[r][0], b[r][1]); o.w = pk2(b[r][2], b[r][3]); ((v4u*)dst)[i + r * gthreads] = o; }
    }
    for (; i < n8; i += gthreads) {
        const f32x4 a = ((const f32x4*)src)[2 * i], b = ((const f32x4*)src)[2 * i + 1];
        v4u o; o.x = pk2(a[0], a[1]); o.y = pk2(a[2], a[3]); o.z = pk2(b[0], b[1]); o.w = pk2(b[2], b[3]);
        ((v4u*)dst)[i] = o;
    }
}
__device__ __forceinline__ void rms_row_to_bf16(const float* __restrict__ xrow, const float* __restrict__ g, bf16* __restrict__ orow, int lane) {
    const f32x4* xr = (const f32x4*)xrow + lane; const f32x4* gr = (const f32x4*)g + lane;
    f32x4 v[4]; float s = 0.f;
#pragma unroll
    for (int j = 0; j < 4; ++j) { v[j] = xr[64 * j]; s += (v[j][0] * v[j][0] + v[j][1] * v[j][1]) + (v[j][2] * v[j][2] + v[j][3] * v[j][3]); }
    const float rstd = 1.0f / sqrtf(wave_sum(s) * (1.0f / D) + 1e-6f);
    v2u* o8 = (v2u*)orow + lane;
#pragma unroll
    for (int j = 0; j < 4; ++j) { const f32x4 gg = gr[64 * j]; v2u w; w.x = pk2(v[j][0] * rstd * gg[0], v[j][1] * rstd * gg[1]); w.y = pk2(v[j][2] * rstd * gg[2], v[j][3] * rstd * gg[3]); o8[64 * j] = w; }
}

__device__ __forceinline__ void p0_prologue(const Args& a, LAS unsigned char* lds, int vcu, int G, int tid, int lane, int wave) {
    unsigned char* ws = a.ws;
    LAS float* scr = (LAS float*)(lds + wave * 16384);
    const int gw = vcu * NWAVES + wave, NGW = G * NWAVES;
    constexpr int I_IN = (D / 64) * (NIN / 32), I_OUT = (D / 64) * (D / 32), I_Q = (D / 64) * (NQ / 32), I_G = I_OUT, I_P = (PLE / 64) * (D / 32);
    constexpr int NITEMS = I_IN + I_OUT + I_Q + I_G + I_P;
    for (int it = gw; it < NITEMS; it += NGW) {
        int r = it;
        if (r < I_IN) { p0_transpose_item(a.in[3], nullptr, D, NIN, (bf16*)(ws + WS_WIN), scr, r, lane); continue; } r -= I_IN;
        if (r < I_OUT) { p0_transpose_item(a.in[7], nullptr, D, D, (bf16*)(ws + WS_WOUT), scr, r, lane); continue; } r -= I_OUT;
        if (r < I_Q) { p0_transpose_item(a.in[9], a.in[8], D, NQ, (bf16*)(ws + WS_WQ), scr, r, lane); continue; } r -= I_Q;
        if (r < I_G) { p0_transpose_item(a.in[14], a.in[13], D, D, (bf16*)(ws + WS_WG), scr, r, lane); continue; } r -= I_G;
        p0_transpose_item(a.in[15], nullptr, PLE, D, (bf16*)(ws + WS_WP), scr, r, lane);
    }
    const size_t gtid = (size_t)vcu * NTHR + tid, gthreads = (size_t)G * NTHR;
    p0_convert(a.in[10], (bf16*)(ws + WS_KEYS), 2 * 128 * 128 / 8, gtid, gthreads);
    for (int r0 = gw; r0 < 2 * NEXP; r0 += 4 * NGW) {
        float xs[4][16];
#pragma unroll
        for (int rr = 0; rr < 4; ++rr) {
            const int r = r0 + rr * NGW; const int isv = r >= NEXP, e = isv ? r - NEXP : r;
            const float* src = (isv ? a.in[12] : a.in[11]) + (size_t)e * D + 16 * lane;
            const f32x4 x0 = *(const f32x4*)src, x1 = *(const f32x4*)(src + 4), x2 = *(const f32x4*)(src + 8), x3 = *(const f32x4*)(src + 12);
#pragma unroll
            for (int u = 0; u < 4; ++u) { xs[rr][u] = x0[u]; xs[rr][4 + u] = x1[u]; xs[rr][8 + u] = x2[u]; xs[rr][12 + u] = x3[u]; }
        }
#pragma unroll
        for (int rr = 0; rr < 4; ++rr) {
            const int r = r0 + rr * NGW; const int isv = r >= NEXP, e = isv ? r - NEXP : r;
            float am = 0.f;
#pragma unroll
            for (int u = 0; u < 16; ++u) am = fmaxf(am, fabsf(xs[rr][u]));
#pragma unroll
            for (int o = 1; o < 64; o <<= 1) am = fmaxf(am, __shfl_xor(am, o));
            const float inv = am > 0.f ? 127.0f / am : 0.f; const unsigned bias = 0u;
            v4u w;
#pragma unroll
            for (int c = 0; c < 4; ++c) { unsigned ww = 0u;
#pragma unroll
                for (int u = 0; u < 4; ++u) { const int q = __float2int_rn(xs[rr][4 * c + u] * inv); ww |= (((unsigned)q + bias) & 0xffu) << (8 * u); }
                w[c] = ww; }
            if (isv) *(v4u*)(ws + WS_VB + (size_t)(lane >> 3) * ((size_t)NEXP * 128) + (size_t)e * 128 + 16 * (lane & 7)) = w;
            else *(v4u*)(ws + WS_UB + (size_t)e * D + 16 * lane) = w;
            if (lane == 0) ((float*)(ws + (isv ? WS_SV : WS_SU)))[e] = am * (1.0f / 127.0f);
        }
    }
    p0_convert(a.in[1], (bf16*)(ws + WS_PB), (size_t)T * PLE / 8, gtid, gthreads);
    for (size_t i = gtid; i < (size_t)SQ * 32; i += gthreads) {
        const int pos = (int)(i >> 5), c = (int)(i & 31);
        const float freq = powf(10000.0f, -(float)c / 32.0f);
        const float ang = (float)pos * freq;
        float sn, cs; sincosf(ang, &sn, &cs);
        ((float*)(ws + WS_ROPE))[i] = cs; ((float*)(ws + WS_ROPE))[(size_t)SQ * 32 + i] = sn;
    }
    for (int m0 = gw; m0 < T; m0 += 4 * NGW) {
        f32x4 v[4][4]; float ssq[4];
#pragma unroll
        for (int rr = 0; rr < 4; ++rr) { const f32x4* xr = (const f32x4*)(a.in[0] + (size_t)(m0 + rr * NGW) * D) + lane;
#pragma unroll
            for (int j = 0; j < 4; ++j) v[rr][j] = xr[64 * j]; }
#pragma unroll
        for (int rr = 0; rr < 4; ++rr) { float sq = 0.f;
#pragma unroll
            for (int j = 0; j < 4; ++j) sq += (v[rr][j][0] * v[rr][j][0] + v[rr][j][1] * v[rr][j][1]) + (v[rr][j][2] * v[rr][j][2] + v[rr][j][3] * v[rr][j][3]);
            ssq[rr] = sq; }
#pragma unroll
        for (int o = 1; o < 64; o <<= 1)
#pragma unroll
            for (int rr = 0; rr < 4; ++rr) ssq[rr] += __shfl_xor(ssq[rr], o);
        const f32x4* gr = (const f32x4*)a.in[2] + lane;
#pragma unroll
        for (int rr = 0; rr < 4; ++rr) { const float rstd = 1.0f / sqrtf(ssq[rr] * (1.0f / D) + 1e-6f); v2u* o8 = (v2u*)((bf16*)(ws + WS_R1) + (size_t)(m0 + rr * NGW) * D) + lane;
#pragma unroll
            for (int j = 0; j < 4; ++j) { const f32x4 gg = gr[64 * j]; v2u w; w.x = pk2(v[rr][j][0] * rstd * gg[0], v[rr][j][1] * rstd * gg[1]); w.y = pk2(v[rr][j][2] * rstd * gg[2], v[rr][j][3] * rstd * gg[3]); o8[64 * j] = w; } }
    }
}


#define MFMA32(a, b, c) __builtin_amdgcn_mfma_f32_32x32x16_bf16((a), (b), (c), 0, 0, 0)
__device__ __forceinline__ int crow(int r, int hf) { return (r & 3) + 8 * (r >> 2) + 4 * hf; }
__device__ __forceinline__ bf16x8 pack8(float a0, float a1, float a2, float a3, float a4, float a5, float a6, float a7) {
    v4u w; w.x = pk2(a0, a1); w.y = pk2(a2, a3); w.z = pk2(a4, a5); w.w = pk2(a6, a7); return __builtin_bit_cast(bf16x8, w);
}
__device__ __forceinline__ bf16x8 lds_frag16(LAS unsigned char* p) { return *(const LAS bf16x8*)p; }
__device__ __forceinline__ bf16x8 lds_frag8x2(LAS unsigned char* p) {
    const bf16x4 lo = *(const LAS bf16x4*)p, hi = *(const LAS bf16x4*)(p + 16); return __builtin_shufflevector(lo, hi, 0, 1, 2, 3, 4, 5, 6, 7);
}
constexpr int RQ = 144, RT = 272, RV = 528;
constexpr int LR_QS = 0, LR_KS = LR_QS + 128 * RQ, LR_KT = LR_KS + 128 * RQ, LR_VT = LR_KT + 64 * RT, LR_ST = LR_VT + 64 * RT, LR_LN = LR_ST + 64 * RQ, LR_END = LR_LN + 2 * 128 * 8;
static_assert(LR_END <= RING_BYTES, "retention LDS");
__device__ __forceinline__ void ret_unit(const bf16* __restrict__ PROJ, bf16* __restrict__ MIXED, const float* __restrict__ rope, LAS unsigned char* lds,
                                         int b, int h, int c0, int c1, int tid, int lane, int wave) {
    const float gam = 1.0f - exp2f(-5.0f - (float)h), lg2 = log2f(gam), cd = exp2f(lg2 * 128.0f);
    const int l31 = lane & 31, hf = lane >> 5, ib = wave >> 1, et = wave & 1;
    const int r = tid >> 2, qd = tid & 3;
    const float wq = exp2f(lg2 * (float)(r + 1)), wk = exp2f(-lg2 * (float)(r + 1));
    f32x16 stacc;
#pragma unroll
    for (int i = 0; i < 16; ++i) stacc[i] = 0.f;
    for (int i = tid; i < 64 * RQ / 4; i += NTHR) ((LAS unsigned*)(lds + LR_ST))[i] = 0u;
    v4u k1, k2, v1, v2, q1 = {0u, 0u, 0u, 0u}, q2 = {0u, 0u, 0u, 0u}; f32x4 csa, csb, sna, snb; v2u gvn[4] = {{0u, 0u}, {0u, 0u}, {0u, 0u}, {0u, 0u}};
#define RET_LOAD(nn) do { const int sp_ = (nn) * 128 + r; const bf16* pr_ = PROJ + ((size_t)b * SQ + sp_) * NIN + h * 64 + 8 * qd; \
        k1 = *(const v4u*)(pr_ + 512); k2 = *(const v4u*)(pr_ + 512 + 32); v1 = *(const v4u*)(pr_ + 1024); v2 = *(const v4u*)(pr_ + 1024 + 32); \
        if ((nn) >= c0) { q1 = *(const v4u*)(pr_); q2 = *(const v4u*)(pr_ + 32); \
            const bf16* gp_ = PROJ + ((size_t)b * SQ + (nn) * 128 + 32 * ib + l31) * NIN + 1536 + h * 64 + 32 * et + 4 * hf; \
            gvn[0] = *(const v2u*)gp_; gvn[1] = *(const v2u*)(gp_ + 8); gvn[2] = *(const v2u*)(gp_ + 16); gvn[3] = *(const v2u*)(gp_ + 24); } \
        csa = *(const f32x4*)(rope + sp_ * 32 + 8 * qd); csb = *(const f32x4*)(rope + sp_ * 32 + 8 * qd + 4); \
        sna = *(const f32x4*)(rope + SQ * 32 + sp_ * 32 + 8 * qd); snb = *(const f32x4*)(rope + SQ * 32 + sp_ * 32 + 8 * qd + 4); } while (0)
    RET_LOAD(0);
    for (int n = 0; n < c1; ++n) {
        const bool own = n >= c0;
        float cs[8], sn[8];
#pragma unroll
        for (int u = 0; u < 4; ++u) { cs[u] = csa[u]; cs[4 + u] = csb[u]; sn[u] = sna[u]; sn[4 + u] = snb[u]; }
        v2u gv[4];
#pragma unroll
        for (int g = 0; g < 4; ++g) gv[g] = gvn[g];
        __syncthreads();
        {
            float o1[8], o2[8];
#pragma unroll
            for (int u = 0; u < 8; ++u) { const unsigned w1 = k1[u >> 1], w2 = k2[u >> 1]; const float x1 = (u & 1) ? bf_hi(w1) : bf_lo(w1), x2 = (u & 1) ? bf_hi(w2) : bf_lo(w2);
                o1[u] = (x1 * cs[u] - x2 * sn[u]) * wk; o2[u] = (x1 * sn[u] + x2 * cs[u]) * wk; }
            if (own) {
                *(LAS bf16x8*)(lds + LR_KS + r * RQ + (8 * qd) * 2) = pack8(o1[0], o1[1], o1[2], o1[3], o1[4], o1[5], o1[6], o1[7]);
                *(LAS bf16x8*)(lds + LR_KS + r * RQ + (32 + 8 * qd) * 2) = pack8(o2[0], o2[1], o2[2], o2[3], o2[4], o2[5], o2[6], o2[7]);
            }
#pragma unroll
            for (int u = 0; u < 8; u += 2) {
                const unsigned a = pk2(o1[u] * 0.125f, o1[u + 1] * 0.125f), c = pk2(o2[u] * 0.125f, o2[u + 1] * 0.125f);
                *(LAS bf16*)(lds + LR_KT + (8 * qd + u) * RT + r * 2) = (bf16)(a & 0xffffu); *(LAS bf16*)(lds + LR_KT + (8 * qd + u + 1) * RT + r * 2) = (bf16)(a >> 16);
                *(LAS bf16*)(lds + LR_KT + (32 + 8 * qd + u) * RT + r * 2) = (bf16)(c & 0xffffu); *(LAS bf16*)(lds + LR_KT + (32 + 8 * qd + u + 1) * RT + r * 2) = (bf16)(c >> 16);
                const unsigned w1 = v1[u >> 1], w2 = v2[u >> 1];
                *(LAS bf16*)(lds + LR_VT + (8 * qd + u) * RT + r * 2) = (bf16)(w1 & 0xffffu); *(LAS bf16*)(lds + LR_VT + (8 * qd + u + 1) * RT + r * 2) = (bf16)(w1 >> 16);
                *(LAS bf16*)(lds + LR_VT + (32 + 8 * qd + u) * RT + r * 2) = (bf16)(w2 & 0xffffu); *(LAS bf16*)(lds + LR_VT + (32 + 8 * qd + u + 1) * RT + r * 2) = (bf16)(w2 >> 16);
            }
            if (own) {
#pragma unroll
                for (int u = 0; u < 8; ++u) { const unsigned w1 = q1[u >> 1], w2 = q2[u >> 1]; const float x1 = (u & 1) ? bf_hi(w1) : bf_lo(w1), x2 = (u & 1) ? bf_hi(w2) : bf_lo(w2);
                    o1[u] = (x1 * cs[u] - x2 * sn[u]) * wq; o2[u] = (x1 * sn[u] + x2 * cs[u]) * wq; }
                *(LAS bf16x8*)(lds + LR_QS + r * RQ + (8 * qd) * 2) = pack8(o1[0], o1[1], o1[2], o1[3], o1[4], o1[5], o1[6], o1[7]);
                *(LAS bf16x8*)(lds + LR_QS + r * RQ + (32 + 8 * qd) * 2) = pack8(o2[0], o2[1], o2[2], o2[3], o2[4], o2[5], o2[6], o2[7]);
            }
        }
        if (n + 1 < c1) RET_LOAD(n + 1);
        __syncthreads();
        if (own) {
            const size_t orow = (size_t)b * SQ + n * 128 + 32 * ib + l31;
            bf16x8 qf[4];
#pragma unroll
            for (int ks = 0; ks < 4; ++ks) qf[ks] = lds_frag16(lds + LR_QS + (32 * ib + l31) * RQ + (16 * ks + 8 * hf) * 2);
            f32x16 o;
#pragma unroll
            for (int i = 0; i < 16; ++i) o[i] = 0.f;
#pragma unroll
            for (int ks = 0; ks < 4; ++ks) o = MFMA32(lds_frag16(lds + LR_ST + (32 * et + l31) * RQ + (16 * ks + 8 * hf) * 2), qf[ks], o);
            for (int jb = 0; jb <= ib; ++jb) {
                f32x16 s;
#pragma unroll
                for (int i = 0; i < 16; ++i) s[i] = 0.f;
#pragma unroll
                for (int ks = 0; ks < 4; ++ks) s = MFMA32(lds_frag16(lds + LR_KS + (32 * jb + l31) * RQ + (16 * ks + 8 * hf) * 2), qf[ks], s);
                const bool diag = (jb == ib);
                float p[16];
#pragma unroll
                for (int i = 0; i < 16; ++i) p[i] = (diag && crow(i, hf) > l31) ? 0.f : s[i] * 0.125f;
#pragma unroll
                for (int st = 0; st < 2; ++st) {
                    const bf16x8 pf = pack8(p[8 * st], p[8 * st + 1], p[8 * st + 2], p[8 * st + 3], p[8 * st + 4], p[8 * st + 5], p[8 * st + 6], p[8 * st + 7]);
                    o = MFMA32(lds_frag8x2(lds + LR_VT + (32 * et + l31) * RT + (32 * jb + 16 * st + 4 * hf) * 2), pf, o);
                }
            }
            float s1 = 0.f, s2 = 0.f;
#pragma unroll
            for (int i = 0; i < 16; ++i) { s1 += o[i]; s2 += o[i] * o[i]; }
            s1 += __shfl_xor(s1, 32); s2 += __shfl_xor(s2, 32);
            if (hf == 0) *(LAS f32x2*)(lds + LR_LN + (et * 128 + 32 * ib + l31) * 8) = (f32x2){s1, s2};
            __syncthreads();
            const f32x2 ot = *(const LAS f32x2*)(lds + LR_LN + ((et ^ 1) * 128 + 32 * ib + l31) * 8);
            const float mu = (s1 + ot.x) * (1.0f / 64.0f), var = fmaxf((s2 + ot.y) * (1.0f / 64.0f) - mu * mu, 0.f), rs = 1.0f / sqrtf(var + 1e-6f);
#pragma unroll
            for (int g = 0; g < 4; ++g) {
                float y[4];
#pragma unroll
                for (int u = 0; u < 4; ++u) { const unsigned w = gv[g][u >> 1]; const float gg = (u & 1) ? bf_hi(w) : bf_lo(w); const float sg = gg / (1.0f + __expf(-gg)); y[u] = sg * ((o[4 * g + u] - mu) * rs); }
                v2u w; w.x = pk2(y[0], y[1]); w.y = pk2(y[2], y[3]);
                *(v2u*)(MIXED + orow * D + h * 64 + 32 * et + 8 * g + 4 * hf) = w;
            }
        }
        if (wave < 4) {
            const int se = wave >> 1, sd = wave & 1;
#pragma unroll
            for (int ks = 0; ks < 8; ++ks)
                stacc = MFMA32(lds_frag16(lds + LR_VT + (32 * se + l31) * RT + (16 * ks + 8 * hf) * 2), lds_frag16(lds + LR_KT + (32 * sd + l31) * RT + (16 * ks + 8 * hf) * 2), stacc);
#pragma unroll
            for (int i = 0; i < 16; ++i) stacc[i] *= cd;
#pragma unroll
            for (int i = 0; i < 16; i += 2) { const unsigned w = pk2(stacc[i], stacc[i + 1]);
                *(LAS bf16*)(lds + LR_ST + (32 * se + crow(i, hf)) * RQ + (32 * sd + l31) * 2) = (bf16)(w & 0xffffu);
                *(LAS bf16*)(lds + LR_ST + (32 * se + crow(i + 1, hf)) * RQ + (32 * sd + l31) * 2) = (bf16)(w >> 16); }
        }
    }
    __syncthreads();
#undef RET_LOAD
}

constexpr int LS_KN = 0, LS_VT = LS_KN + 256 * RQ, LS_QN = LS_VT + 64 * RV, LS_END = LS_QN + 256 * RQ;
static_assert(LS_END <= RING_BYTES, "swa LDS");
__device__ __forceinline__ void swa_unit(const bf16* __restrict__ PROJ, bf16* __restrict__ MIXED, const float* __restrict__ qnw, const float* __restrict__ knw, const float* __restrict__ sinks,
                                         LAS unsigned char* lds, int b, int kvh, int n, int tid, int lane, int wave) {
    const int l31 = lane & 31, hf = lane >> 5;
    const int row = tid >> 1, half = tid & 1;
    {
        const int kpos = (n - 1) * 128 + row; const bool valid = kpos >= 0;
        v4u kk[4], vv[4];
#pragma unroll
        for (int c = 0; c < 4; ++c) { kk[c] = (v4u){0u, 0u, 0u, 0u}; vv[c] = (v4u){0u, 0u, 0u, 0u}; }
        if (valid) { const bf16* pr = PROJ + ((size_t)b * SQ + kpos) * NIN + 32 * half;
#pragma unroll
            for (int c = 0; c < 4; ++c) { kk[c] = *(const v4u*)(pr + 2560 + kvh * 64 + 8 * c); vv[c] = *(const v4u*)(pr + 2688 + kvh * 64 + 8 * c); } }
        float kf[32]; float ss = 0.f;
#pragma unroll
        for (int c = 0; c < 4; ++c)
#pragma unroll
            for (int u = 0; u < 4; ++u) { kf[8 * c + 2 * u] = bf_lo(kk[c][u]); kf[8 * c + 2 * u + 1] = bf_hi(kk[c][u]); }
#pragma unroll
        for (int i = 0; i < 32; ++i) ss += kf[i] * kf[i];
        ss += __shfl_xor(ss, 1);
        const float rstd = 0.125f / sqrtf(ss * (1.0f / 64.0f) + 1e-6f);
#pragma unroll
        for (int c = 0; c < 4; ++c) {
            const f32x4 g0 = *(const f32x4*)(knw + 32 * half + 8 * c), g1 = *(const f32x4*)(knw + 32 * half + 8 * c + 4);
            *(LAS bf16x8*)(lds + LS_KN + row * RQ + (32 * half + 8 * c) * 2) = pack8(kf[8 * c] * rstd * g0[0], kf[8 * c + 1] * rstd * g0[1], kf[8 * c + 2] * rstd * g0[2], kf[8 * c + 3] * rstd * g0[3],
                                                                                  kf[8 * c + 4] * rstd * g1[0], kf[8 * c + 5] * rstd * g1[1], kf[8 * c + 6] * rstd * g1[2], kf[8 * c + 7] * rstd * g1[3]);
#pragma unroll
            for (int u = 0; u < 4; ++u) { const unsigned w = vv[c][u];
                *(LAS bf16*)(lds + LS_VT + (32 * half + 8 * c + 2 * u) * RV + row * 2) = (bf16)(w & 0xffffu); *(LAS bf16*)(lds + LS_VT + (32 * half + 8 * c + 2 * u + 1) * RV + row * 2) = (bf16)(w >> 16); }
        }
    }
    for (int rnd = 0; rnd < 2; ++rnd) {
        {
            const int hs = row >> 7, qrow = row & 127, hq = kvh * 4 + rnd * 2 + hs;
            const bf16* pr = PROJ + ((size_t)b * SQ + n * 128 + qrow) * NIN + 2048 + hq * 64 + 32 * half;
            v4u qq[4];
#pragma unroll
            for (int c = 0; c < 4; ++c) qq[c] = *(const v4u*)(pr + 8 * c);
            float qf[32]; float ss = 0.f;
#pragma unroll
            for (int c = 0; c < 4; ++c)
#pragma unroll
                for (int u = 0; u < 4; ++u) { qf[8 * c + 2 * u] = bf_lo(qq[c][u]); qf[8 * c + 2 * u + 1] = bf_hi(qq[c][u]); }
#pragma unroll
            for (int i = 0; i < 32; ++i) ss += qf[i] * qf[i];
            ss += __shfl_xor(ss, 1);
            const float rstd = 1.0f / sqrtf(ss * (1.0f / 64.0f) + 1e-6f);
#pragma unroll
            for (int c = 0; c < 4; ++c) {
                const f32x4 g0 = *(const f32x4*)(qnw + 32 * half + 8 * c), g1 = *(const f32x4*)(qnw + 32 * half + 8 * c + 4);
                *(LAS bf16x8*)(lds + LS_QN + row * RQ + (32 * half + 8 * c) * 2) = pack8(qf[8 * c] * rstd * g0[0], qf[8 * c + 1] * rstd * g0[1], qf[8 * c + 2] * rstd * g0[2], qf[8 * c + 3] * rstd * g0[3],
                                                                                      qf[8 * c + 4] * rstd * g1[0], qf[8 * c + 5] * rstd * g1[1], qf[8 * c + 6] * rstd * g1[2], qf[8 * c + 7] * rstd * g1[3]);
            }
        }
        __syncthreads();
        {
            const int hs = wave >> 2, ib = wave & 3, hq = kvh * 4 + rnd * 2 + hs;
            bf16x8 qf[4];
#pragma unroll
            for (int ks = 0; ks < 4; ++ks) qf[ks] = lds_frag16(lds + LS_QN + (hs * 128 + 32 * ib + l31) * RQ + (16 * ks + 8 * hf) * 2);
            f32x16 s[5];
#pragma unroll
            for (int t = 0; t < 5; ++t) {
#pragma unroll
                for (int i = 0; i < 16; ++i) s[t][i] = 0.f;
#pragma unroll
                for (int ks = 0; ks < 4; ++ks) s[t] = MFMA32(lds_frag16(lds + LS_KN + (32 * (ib + t) + l31) * RQ + (16 * ks + 8 * hf) * 2), qf[ks], s[t]);
            }
            const float sink = sinks[hq];
            float m = sink;
#pragma unroll
            for (int t = 0; t < 5; ++t)
#pragma unroll
                for (int i = 0; i < 16; ++i) {
                    bool ok = true;
                    if (t == 0) ok = crow(i, hf) > l31;
                    if (t == 4) ok = crow(i, hf) <= l31;
                    if (n == 0 && ib + t < 4) ok = false;
                    s[t][i] = ok ? s[t][i] : -INFINITY;
                    m = fmaxf(m, s[t][i]);
                }
            m = fmaxf(m, __shfl_xor(m, 32));
            float l = 0.f;
#pragma unroll
            for (int t = 0; t < 5; ++t)
#pragma unroll
                for (int i = 0; i < 16; ++i) { s[t][i] = exp2f((s[t][i] - m) * 1.4426950408889634f); l += s[t][i]; }
            l += __shfl_xor(l, 32);
            l += exp2f((sink - m) * 1.4426950408889634f);
            f32x16 o[2];
#pragma unroll
            for (int e2 = 0; e2 < 2; ++e2)
#pragma unroll
                for (int i = 0; i < 16; ++i) o[e2][i] = 0.f;
#pragma unroll
            for (int t = 0; t < 5; ++t)
#pragma unroll
                for (int st = 0; st < 2; ++st) {
                    const bf16x8 pf = pack8(s[t][8 * st], s[t][8 * st + 1], s[t][8 * st + 2], s[t][8 * st + 3], s[t][8 * st + 4], s[t][8 * st + 5], s[t][8 * st + 6], s[t][8 * st + 7]);
#pragma unroll
                    for (int e2 = 0; e2 < 2; ++e2) o[e2] = MFMA32(lds_frag8x2(lds + LS_VT + (32 * e2 + l31) * RV + (32 * (ib + t) + 16 * st + 4 * hf) * 2), pf, o[e2]);
                }
            const float inv = 1.0f / l;
            const size_t orow = (size_t)b * SQ + n * 128 + 32 * ib + l31;
#pragma unroll
            for (int e2 = 0; e2 < 2; ++e2)
#pragma unroll
                for (int g = 0; g < 4; ++g) { v2u w; w.x = pk2(o[e2][4 * g] * inv, o[e2][4 * g + 1] * inv); w.y = pk2(o[e2][4 * g + 2] * inv, o[e2][4 * g + 3] * inv);
                    *(v2u*)(MIXED + orow * D + 512 + hq * 64 + 32 * e2 + 8 * g + 4 * hf) = w; }
        }
        __syncthreads();
    }
}

__device__ __forceinline__ void p2_mixing(const Args& a, LAS unsigned char* lds, int bx, int G, int tid, int lane, int wave, int parts = 3) {
    const bf16* PROJ = (const bf16*)(a.ws + WS_R2); bf16* MIXED = (bf16*)(a.ws + WS_R1); const float* rope = (const float*)(a.ws + WS_ROPE);
    if (parts & 1) for (int u = bx; u < 256; u += G) {
        const int b = u >> 5, h = (u >> 2) & 7, grp = u & 3;
        const int c0 = grp == 0 ? 0 : grp == 1 ? 11 : grp == 2 ? 20 : 27, c1 = grp == 0 ? 11 : grp == 1 ? 20 : grp == 2 ? 27 : 32;
        ret_unit(PROJ, MIXED, rope, lds, b, h, c0, c1, tid, lane, wave);
    }
    if (parts & 2) for (int su = bx; su < 512; su += G) swa_unit(PROJ, MIXED, a.in[4], a.in[5], a.in[6], lds, su >> 6, (su >> 5) & 1, su & 31, tid, lane, wave);
}


template <int N> __device__ __forceinline__ void bitonic_sort_desc(float (&v)[N]) {
#pragma unroll
    for (int k = 2; k <= N; k <<= 1)
#pragma unroll
        for (int j = k >> 1; j > 0; j >>= 1)
#pragma unroll
            for (int i = 0; i < N; ++i) { const int l = i ^ j; if (l > i) { const bool desc = ((i & k) == 0); const float a = v[i], b = v[l]; const float hi = fmaxf(a, b), lo = fminf(a, b); v[i] = desc ? hi : lo; v[l] = desc ? lo : hi; } }
}
__device__ __forceinline__ void bitonic_merge16_desc(float (&v)[16]) {
#pragma unroll
    for (int j = 8; j > 0; j >>= 1)
#pragma unroll
        for (int i = 0; i < 16; ++i) { const int l = i ^ j; if (l > i) { const float a = v[i], b = v[l]; v[i] = fmaxf(a, b); v[l] = fminf(a, b); } }
}
__device__ __forceinline__ void top16_of_64(float (&v)[64], float (&out)[16]) {
    float b[4][16];
#pragma unroll
    for (int q = 0; q < 4; ++q) {
#pragma unroll
        for (int i = 0; i < 16; ++i) b[q][i] = v[16 * q + i];
        bitonic_sort_desc<16>(b[q]);
    }
    float t0[16], t1[16];
#pragma unroll
    for (int i = 0; i < 16; ++i) { t0[i] = fmaxf(b[0][i], b[1][15 - i]); t1[i] = fmaxf(b[2][i], b[3][15 - i]); }
    bitonic_merge16_desc(t0); bitonic_merge16_desc(t1);
#pragma unroll
    for (int i = 0; i < 16; ++i) out[i] = fmaxf(t0[i], t1[15 - i]);
    bitonic_merge16_desc(out);
}
__device__ __forceinline__ float dot2u(unsigned a, unsigned b, float c) { return __builtin_amdgcn_fdot2_f32_bf16(__builtin_bit_cast(b16x2, a), __builtin_bit_cast(b16x2, b), c, false); }
__device__ __forceinline__ float gelu_erf(float a) { return 0.5f * a * (1.0f + erff(a * 0.70710678118654752f)); }

constexpr int KROW = 272;
constexpr int LP_KEYS = 0, LP_LUT = LP_KEYS + 256 * KROW, LP_RSTD = LP_LUT + NWAVES * 32 * 32, LP_END = LP_RSTD + 2 * 128;
static_assert(LP_END <= RING_BYTES, "peer LDS");

__device__ __forceinline__ void p5a_topk(const Args& a, LAS unsigned char* lds, int vcu, int G, int tid, int lane, int wave) {
    unsigned char* ws = a.ws;
    const bf16* Q = (const bf16*)(ws + WS_R2 + 64 * MB); const bf16* XB1 = (const bf16*)(ws + WS_R2); unsigned char* H8 = ws + WS_R1; float* SH = (float*)(ws + WS_SH); const float* gffn = a.in[8];
    unsigned short* EID = (unsigned short*)(ws + WS_EID); float* GATE = (float*)(ws + WS_GATE);
    const int l31 = lane & 31, hf = lane >> 5;
    for (int i = tid; i < 256 * 16; i += NTHR) { const int rr = i >> 4, c = i & 15; *(LAS v4u*)(lds + LP_KEYS + rr * KROW + c * 16) = *(const v4u*)((const bf16*)(ws + WS_KEYS) + rr * 128 + c * 8); }
    float gw[16];
    { const f32x4 g0 = *(const f32x4*)(gffn + 16 * lane), g1 = *(const f32x4*)(gffn + 16 * lane + 4), g2 = *(const f32x4*)(gffn + 16 * lane + 8), g3 = *(const f32x4*)(gffn + 16 * lane + 12);
#pragma unroll
      for (int u = 0; u < 4; ++u) { gw[u] = g0[u]; gw[4 + u] = g1[u]; gw[8 + u] = g2[u]; gw[12 + u] = g3[u]; } }
    int par = 0;
    for (int grp = vcu; grp < T / 32; grp += G, par ^= 1) {
        const int t0 = grp * 32;
        {
            float xs[4][16];
#pragma unroll
            for (int q = 0; q < 4; ++q) {
                const bf16* xr = XB1 + ((size_t)t0 + 4 * wave + q) * D + 16 * lane;
                const v4u x0 = *(const v4u*)xr, x1 = *(const v4u*)(xr + 8);
#pragma unroll
                for (int u = 0; u < 4; ++u) { xs[q][2 * u] = bf_lo(x0[u]); xs[q][2 * u + 1] = bf_hi(x0[u]); xs[q][8 + 2 * u] = bf_lo(x1[u]); xs[q][8 + 2 * u + 1] = bf_hi(x1[u]); }
            }
            float ssq[4];
#pragma unroll
            for (int q = 0; q < 4; ++q) { float sq = 0.f;
#pragma unroll
                for (int u = 0; u < 16; ++u) sq += xs[q][u] * xs[q][u];
                ssq[q] = sq; }
#pragma unroll
            for (int o = 1; o < 64; o <<= 1)
#pragma unroll
                for (int q = 0; q < 4; ++q) ssq[q] += __shfl_xor(ssq[q], o);
            float am[4];
#pragma unroll
            for (int q = 0; q < 4; ++q) {
                const float rstd = 1.0f / sqrtf(ssq[q] * (1.0f / D) + 1e-6f);
                if (lane == 0) *(LAS float*)(lds + LP_RSTD + par * 128 + (4 * wave + q) * 4) = rstd;
                float m = 0.f;
#pragma unroll
                for (int u = 0; u < 16; ++u) { xs[q][u] = xs[q][u] * rstd * gw[u]; m = fmaxf(m, fabsf(xs[q][u])); }
                am[q] = m;
            }
#pragma unroll
            for (int o = 1; o < 64; o <<= 1)
#pragma unroll
                for (int q = 0; q < 4; ++q) am[q] = fmaxf(am[q], __shfl_xor(am[q], o));
#pragma unroll
            for (int q = 0; q < 4; ++q) {
                const size_t tok = (size_t)t0 + 4 * wave + q;
                const float inv = am[q] > 0.f ? 127.0f / am[q] : 0.f;
                v4u w;
#pragma unroll
                for (int c = 0; c < 4; ++c) { unsigned ww = 0u;
#pragma unroll
                    for (int u = 0; u < 4; ++u) { const int qi = __float2int_rn(xs[q][4 * c + u] * inv); ww |= ((unsigned)qi & 0xffu) << (8 * u); }
                    w[c] = ww; }
                *(v4u*)(H8 + tok * D + 16 * lane) = w;
                if (lane == 0) SH[tok] = am[q] * (1.0f / 127.0f);
            }
        }
        __syncthreads();
        {
            const int h = wave;
            float lst[2][16];
#pragma unroll
            for (int p = 0; p < 2; ++p) {
                f32x16 acc[4];
#pragma unroll
                for (int q = 0; q < 4; ++q)
#pragma unroll
                    for (int i = 0; i < 16; ++i) acc[q][i] = 0.f;
                const bf16* qrow = Q + (size_t)(t0 + l31) * NQ + h * 256 + p * 128 + 8 * hf;
#pragma unroll
                for (int ks = 0; ks < 8; ++ks) {
                    const bf16x8 qf = *(const bf16x8*)(qrow + 16 * ks);
#pragma unroll
                    for (int q = 0; q < 4; ++q) acc[q] = MFMA32(lds_frag16(lds + LP_KEYS + (p * 128 + 32 * q + l31) * KROW + (16 * ks + 8 * hf) * 2), qf, acc[q]);
                }
                float v[64];
#pragma unroll
                for (int q = 0; q < 4; ++q)
#pragma unroll
                    for (int i = 0; i < 16; ++i) v[16 * q + i] = __uint_as_float((__float_as_uint(acc[q][i]) & 0xffffff80u) | (unsigned)(32 * q + crow(i, hf)));
                float mine[16];
                top16_of_64(v, mine);
                float t[16];
#pragma unroll
                for (int i = 0; i < 16; ++i) t[i] = __shfl_xor(mine[i], 32);
#pragma unroll
                for (int i = 0; i < 16; ++i) lst[p][i] = fmaxf(mine[i], t[15 - i]);
                bitonic_merge16_desc(lst[p]);
            }
            LAS unsigned char* lut = lds + LP_LUT + wave * 1024 + l31 * 32;
            {
                v4u wa, wb;
#pragma unroll
                for (int c = 0; c < 4; ++c) {
                    wa[c] = (__float_as_uint(lst[0][4 * c]) & 0x7fu) | ((__float_as_uint(lst[0][4 * c + 1]) & 0x7fu) << 8) | ((__float_as_uint(lst[0][4 * c + 2]) & 0x7fu) << 16) | ((__float_as_uint(lst[0][4 * c + 3]) & 0x7fu) << 24);
                    wb[c] = (__float_as_uint(lst[1][4 * c]) & 0x7fu) | ((__float_as_uint(lst[1][4 * c + 1]) & 0x7fu) << 8) | ((__float_as_uint(lst[1][4 * c + 2]) & 0x7fu) << 16) | ((__float_as_uint(lst[1][4 * c + 3]) & 0x7fu) << 24);
                }
                if (hf == 0) { *(LAS v4u*)lut = wa; *(LAS v4u*)(lut + 16) = wb; }
            }
            float cv[64];
            {
                int c = 0;
#pragma unroll
                for (int i = 0; i < 16; ++i)
#pragma unroll
                    for (int j = 0; j < 16; ++j)
                        if ((i + 1) * (j + 1) <= 16) {
                            const float sa = __uint_as_float(__float_as_uint(lst[0][i]) & 0xffffff80u), sb = __uint_as_float(__float_as_uint(lst[1][j]) & 0xffffff80u);
                            cv[c] = __uint_as_float((__float_as_uint(sa + sb) & 0xffffff00u) | (unsigned)(i * 16 + j)); ++c;
                        }
#pragma unroll
                for (int k = 50; k < 64; ++k) cv[k] = -3.0e38f;
            }
            float best[16];
            top16_of_64(cv, best);
            const float rstd = *(const LAS float*)(lds + LP_RSTD + par * 128 + l31 * 4);
            const float s0 = __uint_as_float(__float_as_uint(best[0]) & 0xffffff00u);
            float ev[16], esum = 0.f;
#pragma unroll
            for (int k = 0; k < 16; ++k) { const float sk = __uint_as_float(__float_as_uint(best[k]) & 0xffffff00u); ev[k] = __expf(rstd * (sk - s0)); esum += ev[k]; }
            const float einv = 1.0f / esum;
            LDS_WAIT();
            asm volatile("" ::: "memory");
            const size_t ob = (size_t)(t0 + l31) * 128 + h * 16;
            if (hf == 0) {
                unsigned e16[16];
#pragma unroll
                for (int k = 0; k < 16; ++k) { const unsigned code = __float_as_uint(best[k]) & 0xffu;
                    const unsigned ia = *(const LAS unsigned char*)(lut + (code >> 4)), ib = *(const LAS unsigned char*)(lut + 16 + (code & 15u));
                    e16[k] = ia * 128u + ib; }
                v4u w0, w1;
                w0.x = e16[0] | (e16[1] << 16); w0.y = e16[2] | (e16[3] << 16); w0.z = e16[4] | (e16[5] << 16); w0.w = e16[6] | (e16[7] << 16);
                w1.x = e16[8] | (e16[9] << 16); w1.y = e16[10] | (e16[11] << 16); w1.z = e16[12] | (e16[13] << 16); w1.w = e16[14] | (e16[15] << 16);
                *(v4u*)(EID + ob) = w0; *(v4u*)(EID + ob + 8) = w1;
            } else {
#pragma unroll
                for (int c = 0; c < 4; ++c) *(f32x4*)(GATE + ob + 4 * c) = (f32x4){ev[4 * c] * einv, ev[4 * c + 1] * einv, ev[4 * c + 2] * einv, ev[4 * c + 3] * einv};
            }
        }
    }
    __syncthreads();
}

constexpr int LB_H = 0, LB_LIST = LB_H + NWAVES * 4096, LB_GATE = LB_LIST + NWAVES * 2304, LB_END = LB_GATE + NWAVES * 2048;
static_assert(LB_END <= RING_BYTES, "p5b LDS");
struct B5Batch { v4u ur[16]; unsigned entv, em; float scl, svl; };
__device__ __forceinline__ void b5_issue(B5Batch& b, const LAS unsigned* list, int bt, const unsigned char* U8, const float* SU, const float* SV, int lane, int jmine) {
    b.entv = list[16 * bt + (lane & 15)]; b.em = list[16 * bt + jmine];
#pragma unroll
    for (int j = 0; j < 16; ++j) { const unsigned ent = __builtin_amdgcn_readlane(b.entv, j); b.ur[j] = *(const v4u*)(U8 + (size_t)(ent & 0xffffu) * D + 16 * lane); }
    const unsigned ee = b.em & 0xffffu; b.scl = SU[ee]; b.svl = SV[ee];
}
__device__ __forceinline__ void b5_compute(const B5Batch& b, LAS unsigned char* hreg, const LAS float* gts, float shv, float* ACT, int tok0, int lane) {
    int d[16];
#pragma unroll
    for (int j = 0; j < 16; ++j) {
        const unsigned ent = __builtin_amdgcn_readlane(b.entv, j);
        const v4u hh = *(const LAS v4u*)(hreg + ((ent >> 28) & 3u) * 1024 + lane * 16);
        int acc = 0;
#pragma unroll
        for (int u = 0; u < 4; ++u) { const unsigned wa = b.ur[j][u], ha = hh[u]; acc = __builtin_amdgcn_sdot4((int)ha, (int)wa, acc, false); }
        d[j] = acc;
    }
    int d8[8], d4[4], d2[2], d1;
    { const bool hi = (lane & 32) != 0;
#pragma unroll
      for (int j = 0; j < 8; ++j) { const int keep = hi ? d[j + 8] : d[j], send = hi ? d[j] : d[j + 8]; d8[j] = keep + __shfl_xor(send, 32); } }
    { const bool hi = (lane & 16) != 0;
#pragma unroll
      for (int j = 0; j < 4; ++j) { const int keep = hi ? d8[j + 4] : d8[j], send = hi ? d8[j] : d8[j + 4]; d4[j] = keep + __shfl_xor(send, 16); } }
    { const bool hi = (lane & 8) != 0;
#pragma unroll
      for (int j = 0; j < 2; ++j) { const int keep = hi ? d4[j + 2] : d4[j], send = hi ? d4[j] : d4[j + 2]; d2[j] = keep + __shfl_xor(send, 8); } }
    { const bool hi = (lane & 4) != 0; const int keep = hi ? d2[1] : d2[0], send = hi ? d2[0] : d2[1]; d1 = keep + __shfl_xor(send, 4); }
    d1 += __shfl_xor(d1, 1); d1 += __shfl_xor(d1, 2);
    const unsigned eslot = b.em >> 28, ek = (b.em >> 16) & 0xffu;
    const float sht = __shfl(shv, (int)(eslot & 3u));
    const float dot = (float)d1 * b.scl * sht;
    if ((lane & 3) == 0 && eslot < 4u) ACT[((size_t)tok0 + eslot) * 128 + ek] = gelu_erf(dot) * gts[eslot * 128 + ek] * b.svl;
}
struct B5Pre { unsigned idw[4]; f32x2 gg[4]; v4u h0[4]; float shv; };
__device__ __forceinline__ void b5_prefetch(B5Pre& p, const unsigned short* EID, const float* GATE, const unsigned char* H8, const float* SH, int tok0, int lane) {
#pragma unroll
    for (int s = 0; s < 4; ++s) { const size_t tok = (size_t)tok0 + s;
        p.idw[s] = *(const unsigned*)(EID + tok * 128 + 2 * lane); p.gg[s] = *(const f32x2*)(GATE + tok * 128 + 2 * lane); p.h0[s] = *(const v4u*)(H8 + tok * D + 16 * lane); }
    p.shv = SH[tok0 + (lane & 3)];
}
__device__ __forceinline__ void p5b_dots(const Args& a, LAS unsigned char* lds, int bx, int G, int tid, int lane, int wave) {
    unsigned char* ws = a.ws;
    const unsigned char* H8 = ws + WS_R1; const unsigned char* U8 = ws + WS_UB; const float* SU = (const float*)(ws + WS_SU); const float* SV = (const float*)(ws + WS_SV); const float* SH = (const float*)(ws + WS_SH);
    const unsigned short* EID = (const unsigned short*)(ws + WS_EID); const float* GATE = (const float*)(ws + WS_GATE); float* ACT = (float*)(ws + WS_ACT);
    LAS unsigned char* hreg = lds + LB_H + wave * 4096; LAS unsigned* list = (LAS unsigned*)(lds + LB_LIST + wave * 2304); LAS float* gts = (LAS float*)(lds + LB_GATE + wave * 2048);
    const int jmine = ((lane >> 5) & 1) * 8 + ((lane >> 4) & 1) * 4 + ((lane >> 3) & 1) * 2 + ((lane >> 2) & 1);
    const unsigned long long ltmask = (1ull << lane) - 1ull;
    for (int vb = bx; vb < 256; vb += G) {
        const unsigned vx = (unsigned)(vb & 7); const int wi = vb >> 3;
        const int tw0 = wi * 1024 + wave * 128;
        B5Pre P;
        b5_prefetch(P, EID, GATE, H8, SH, tw0, lane);
#pragma unroll 1
        for (int ch = 0; ch < 32; ++ch) {
            const int tok0 = tw0 + 4 * ch;
            int n = 0;
            const float shv = P.shv;
#pragma unroll
            for (int s = 0; s < 4; ++s) {
                *(LAS v4u*)(hreg + s * 1024 + lane * 16) = P.h0[s];
                *(LAS f32x2*)(gts + s * 128 + 2 * lane) = P.gg[s];
                const unsigned id0 = P.idw[s] & 0xffffu, id1 = P.idw[s] >> 16;
                const bool in0 = (id0 >> 11) == vx, in1 = (id1 >> 11) == vx;
                const unsigned long long m0 = __ballot(in0), m1 = __ballot(in1);
                const int c0 = __popcll(m0), c1 = __popcll(m1);
                if (in0) list[n + __popcll(m0 & ltmask)] = ((unsigned)s << 28) | ((unsigned)(2 * lane) << 16) | id0;
                if (in1) list[n + c0 + __popcll(m1 & ltmask)] = ((unsigned)s << 28) | ((unsigned)(2 * lane + 1) << 16) | id1;
                n += c0 + c1;
            }
            const int nb = (n + 15) >> 4;
            if (lane < 16) list[n + lane] = (0xfu << 28) | (vx << 11);
            if (ch + 1 < 32) b5_prefetch(P, EID, GATE, H8, SH, tok0 + 4, lane);
            LDS_WAIT(); asm volatile("" ::: "memory");
            B5Batch A, B;
            if (nb > 0) b5_issue(A, list, 0, U8, SU, SV, lane, jmine);
#pragma unroll 1
            for (int bt = 0; bt < nb; bt += 2) {
                if (bt + 1 < nb) b5_issue(B, list, bt + 1, U8, SU, SV, lane, jmine);
                b5_compute(A, hreg, gts, shv, ACT, tok0, lane);
                if (bt + 1 < nb) {
                    if (bt + 2 < nb) b5_issue(A, list, bt + 2, U8, SU, SV, lane, jmine);
                    b5_compute(B, hreg, gts, shv, ACT, tok0, lane);
                }
            }
        }
    }
}

constexpr int LC_BUF = 0, LC_END = NWAVES * 2 * 1024;
struct C5Tok { v4u vv[16]; unsigned xa; float sa; };
__device__ __forceinline__ float c5_stage(LAS unsigned char* buf, unsigned idw, f32x2 av, int lane) {
    float am = fmaxf(fabsf(av[0]), fabsf(av[1]));
#pragma unroll
    for (int o = 1; o < 64; o <<= 1) am = fmaxf(am, __shfl_xor(am, o));
    const float inv = am > 0.f ? 127.0f / am : 0.f;
    const int q0 = __float2int_rn(av[0] * inv), q1 = __float2int_rn(av[1] * inv);
    *(LAS unsigned*)(buf + 4 * lane) = idw;
    const int k0 = 2 * lane, k1 = 2 * lane + 1;
    *(LAS unsigned char*)(buf + 256 + (k0 & 7) * 16 + (k0 >> 3)) = (unsigned char)q0;
    *(LAS unsigned char*)(buf + 256 + (k1 & 7) * 16 + (k1 >> 3)) = (unsigned char)q1;
    return am * (1.0f / 127.0f);
}
__device__ __forceinline__ void c5_issue(C5Tok& t, LAS unsigned char* buf, const unsigned char* vbase, const bf16* xr, int g) {
#pragma unroll
    for (int j = 0; j < 16; ++j) {
        const int k = 8 * j + g;
        const unsigned e = *(const LAS unsigned short*)(buf + 2 * k);
        t.vv[j] = *(const v4u*)(vbase + (size_t)e * 128);
    }
    t.xa = *(const unsigned*)xr;
}
__device__ __forceinline__ void c5_finish(const C5Tok& t, LAS unsigned char* buf, bf16* xb, float* rss, int lane, int g) {
    int y[16];
#pragma unroll
    for (int u = 0; u < 16; ++u) y[u] = 0;
#pragma unroll
    for (int q = 0; q < 4; ++q) {
        const int a4 = (int)*(const LAS unsigned*)(buf + 256 + g * 16 + 4 * q);
#pragma unroll
        for (int u = 0; u < 4; ++u) {
            const unsigned r0 = t.vv[4 * q][u], r1 = t.vv[4 * q + 1][u], r2 = t.vv[4 * q + 2][u], r3 = t.vv[4 * q + 3][u];
            const unsigned lo01 = __builtin_amdgcn_perm(r1, r0, 0x05010400u), hi01 = __builtin_amdgcn_perm(r1, r0, 0x07030602u);
            const unsigned lo23 = __builtin_amdgcn_perm(r3, r2, 0x05010400u), hi23 = __builtin_amdgcn_perm(r3, r2, 0x07030602u);
            const unsigned t0 = __builtin_amdgcn_perm(lo23, lo01, 0x05040100u), t1 = __builtin_amdgcn_perm(lo23, lo01, 0x07060302u);
            const unsigned t2 = __builtin_amdgcn_perm(hi23, hi01, 0x05040100u), t3 = __builtin_amdgcn_perm(hi23, hi01, 0x07060302u);
            y[4 * u] = __builtin_amdgcn_sdot4((int)t0, a4, y[4 * u], false); y[4 * u + 1] = __builtin_amdgcn_sdot4((int)t1, a4, y[4 * u + 1], false);
            y[4 * u + 2] = __builtin_amdgcn_sdot4((int)t2, a4, y[4 * u + 2], false); y[4 * u + 3] = __builtin_amdgcn_sdot4((int)t3, a4, y[4 * u + 3], false);
        }
    }
    int y8[8], y4[4], y2[2];
    { const bool hi = (lane & 32) != 0;
#pragma unroll
      for (int u = 0; u < 8; ++u) { const int keep = hi ? y[u + 8] : y[u], send = hi ? y[u] : y[u + 8]; y8[u] = keep + __shfl_xor(send, 32); } }
    { const bool hi = (lane & 16) != 0;
#pragma unroll
      for (int u = 0; u < 4; ++u) { const int keep = hi ? y8[u + 4] : y8[u], send = hi ? y8[u] : y8[u + 4]; y4[u] = keep + __shfl_xor(send, 16); } }
    { const bool hi = (lane & 8) != 0;
#pragma unroll
      for (int u = 0; u < 2; ++u) { const int keep = hi ? y4[u + 2] : y4[u], send = hi ? y4[u] : y4[u + 2]; y2[u] = keep + __shfl_xor(send, 8); } }
    const float o0 = bf_lo(t.xa) + (float)y2[0] * t.sa, o1 = bf_hi(t.xa) + (float)y2[1] * t.sa;
    const float ss = wave_sum(o0 * o0 + o1 * o1);
    *(unsigned*)xb = pk2(o0, o1);
    if (lane == 0) *rss = ss;
}
__device__ __forceinline__ void p5c_axpy(const Args& a, LAS unsigned char* lds, int bx, int G, int tid, int lane, int wave) {
    unsigned char* ws = a.ws;
    const unsigned char* V8 = ws + WS_VB; const unsigned short* EID = (const unsigned short*)(ws + WS_EID); const float* ACT = (const float*)(ws + WS_ACT);
    const bf16* XB1 = (const bf16*)(ws + WS_R2); bf16* XB2 = (bf16*)(ws + WS_R1); float* RSS2 = (float*)(ws + WS_RSS2);
    const int g = lane >> 3, c = lane & 7;
    const int colo = 16 * c + 8 * ((g >> 2) & 1) + 4 * ((g >> 1) & 1) + 2 * (g & 1);
    LAS unsigned char* buf0 = lds + LC_BUF + wave * 2048; LAS unsigned char* buf1 = buf0 + 1024;
    for (int vb = bx; vb < 256; vb += G) {
        const int vx = vb & 7, wi = vb >> 3;
        const size_t tw0 = (size_t)wi * 1024 + wave * 128;
        const unsigned char* vbase = V8 + (size_t)vx * ((size_t)NEXP * 128) + 16 * c;
        const bf16* xcol = XB1 + vx * 128 + colo; bf16* xbcol = XB2 + vx * 128 + colo;
        C5Tok A, B;
        unsigned idw = *(const unsigned*)(EID + tw0 * 128 + 2 * lane);
        f32x2 av = *(const f32x2*)(ACT + tw0 * 128 + 2 * lane);
        A.sa = c5_stage(buf0, idw, av, lane);
        idw = *(const unsigned*)(EID + (tw0 + 1) * 128 + 2 * lane); av = *(const f32x2*)(ACT + (tw0 + 1) * 128 + 2 * lane);
        LDS_WAIT(); asm volatile("" ::: "memory");
        c5_issue(A, buf0, vbase, xcol + tw0 * D, g);
#pragma unroll 1
        for (int i = 0; i < 128; i += 2) {
            const size_t tok = tw0 + i;
            B.sa = c5_stage(buf1, idw, av, lane);
            if (i + 2 < 128) { idw = *(const unsigned*)(EID + (tok + 2) * 128 + 2 * lane); av = *(const f32x2*)(ACT + (tok + 2) * 128 + 2 * lane); }
            LDS_WAIT(); asm volatile("" ::: "memory");
            c5_issue(B, buf1, vbase, xcol + (tok + 1) * D, g);
            c5_finish(A, buf0, xbcol + tok * D, RSS2 + tok * 8 + vx, lane, g);
            if (i + 2 < 128) {
                A.sa = c5_stage(buf0, idw, av, lane);
                if (i + 3 < 128) { idw = *(const unsigned*)(EID + (tok + 3) * 128 + 2 * lane); av = *(const f32x2*)(ACT + (tok + 3) * 128 + 2 * lane); }
                LDS_WAIT(); asm volatile("" ::: "memory");
                c5_issue(A, buf0, vbase, xcol + (tok + 2) * D, g);
            }
            c5_finish(B, buf1, xbcol + (tok + 1) * D, RSS2 + (tok + 1) * 8 + vx, lane, g);
        }
    }
}

__global__ void __launch_bounds__(NTHR, 2) mk_fwd(Args a) {
    extern __shared__ __attribute__((aligned(16))) unsigned char lds_raw[];
    LAS unsigned char* lds = (LAS unsigned char*)lds_raw;
    const int tid = threadIdx.x, lane = tid & 63, wave = __builtin_amdgcn_readfirstlane(tid >> 6);
    const int G = gridDim.x, bx = blockIdx.x, vcu = (G % 8 == 0) ? (bx % 8) * (G / 8) + bx / 8 : bx;
    volatile LAS unsigned* MISC = (volatile LAS unsigned*)(lds + MISC_OFF);
    if (tid < 64) MISC[tid] = 0u;
    __syncthreads();
    unsigned char* ws = a.ws;
    const int lo = a.ph_lo, hi = a.ph_hi;
    XcdBarrier bar; bar.bar = (unsigned*)(ws + WS_CTL) + CW_BAR + a.li * XCD_BAR_WORDS; bar.x = 0; bar.st = nullptr;
    if (hi - lo > 1) bar = xcd_barrier_post((unsigned*)(ws + WS_CTL) + CW_BAR + a.li * XCD_BAR_WORDS, MISC + 8);
#define IN(k) (lo <= (k) && (k) < hi)
#define BOTH(k) (IN(k) && IN((k) + 1))
    if (IN(0)) { p0_prologue(a, lds, vcu, G, tid, lane, wave); if (BOTH(0)) xcd_barrier(bar); }
    if (IN(1)) {
        { pg8::Gemm g{(const bf16*)(ws + WS_R1), (const bf16*)(ws + WS_WIN), T, NIN, D}; pg8::StaticOrder S; S.init(T, NIN, G, bx);
          EpiStoreBf16 E{(bf16*)(ws + WS_R2), NIN};
          pg8::gemm_phase<EpiStoreBf16, pg8::StaticOrder, true, true>(lds, g, S, E); }
        { pg8::Gemm g{(const bf16*)(ws + WS_PB), (const bf16*)(ws + WS_WP), T, D, PLE}; pg8::StaticOrder S; S.init(T, D, G, bx);
          EpiStoreBf16 E{(bf16*)(ws + WS_PP), D};
          pg8::gemm_phase<EpiStoreBf16, pg8::StaticOrder, true, true>(lds, g, S, E); }
        if (BOTH(1)) xcd_barrier(bar);
    }
    if (IN(2)) { p2_mixing(a, lds, bx, G, tid, lane, wave); if (BOTH(2)) xcd_barrier(bar); }
    if (IN(3)) {
        pg8::Gemm g{(const bf16*)(ws + WS_R1), (const bf16*)(ws + WS_WOUT), T, D, D}; pg8::StaticOrder S; S.init(T, D, G, bx);
        EpiResid E{a.in[0], (bf16*)(ws + WS_R2)};
        pg8::gemm_phase<EpiResid, pg8::StaticOrder, true, true>(lds, g, S, E);
        if (BOTH(3)) xcd_barrier(bar);
    }
    if (IN(4)) {
        pg8::Gemm g{(const bf16*)(ws + WS_R2), (const bf16*)(ws + WS_WQ), T, NQ, D}; pg8::StaticOrder S; S.init(T, NQ, G, bx);
        EpiStoreBf16 E{(bf16*)(ws + WS_R2 + 64 * MB), NQ};
        pg8::gemm_phase<EpiStoreBf16, pg8::StaticOrder, true, true>(lds, g, S, E);
        if (BOTH(4)) xcd_barrier(bar);
    }
    if (IN(5)) {
        p5a_topk(a, lds, vcu, G, tid, lane, wave); xcd_barrier(bar);
        p5b_dots(a, lds, bx, G, tid, lane, wave); xcd_barrier(bar);
        p5c_axpy(a, lds, bx, G, tid, lane, wave);
        if (BOTH(5)) xcd_barrier(bar);
    }
    if (IN(6)) {
        pg8::Gemm g{(const bf16*)(ws + WS_R1), (const bf16*)(ws + WS_WG), T, D, D}; pg8::StaticOrder S; S.init(T, D, G, bx);
        EpiGate E{a.out, (const bf16*)(ws + WS_R1), (const bf16*)(ws + WS_PP), (const float*)(ws + WS_RSS2)};
        pg8::gemm_phase<EpiGate, pg8::StaticOrder, true, true>(lds, g, S, E);
    }
#undef IN
#undef BOTH
}
}
extern "C" void kernel_launch(void* const* d_in, const int* in_sizes, int n_in, void* d_out, int out_size, void* d_ws, size_t ws_size, hipStream_t stream) {
    using namespace mk;
    static int grid = 0;
    if (grid == 0) {
        int dev = 0, cus = 0;
        if (n_in != 16 || out_size != T * D || ws_size < WS_END) { fprintf(stderr, "kernel_launch: unexpected problem shape / workspace (%d inputs, out %d, ws %zu)\n", n_in, out_size, ws_size); grid = -1; return; }
        if (hipGetDevice(&dev) != hipSuccess || hipDeviceGetAttribute(&cus, hipDeviceAttributeMultiprocessorCount, dev) != hipSuccess) { fprintf(stderr, "device query failed\n"); grid = -1; return; }
        if (hipFuncSetAttribute((const void*)mk_fwd, hipFuncAttributeMaxDynamicSharedMemorySize, LDS_BYTES) != hipSuccess) { fprintf(stderr, "hipFuncSetAttribute failed\n"); grid = -1; return; }
        int per_cu = 0;
        if (hipOccupancyMaxActiveBlocksPerMultiprocessor(&per_cu, (const void*)mk_fwd, NTHR, LDS_BYTES) != hipSuccess || per_cu < 1) { fprintf(stderr, "occupancy query: %d blocks per CU\n", per_cu); (void)hipGetLastError(); }
        grid = cus;
    }
    if (grid < 0) return;
    unsigned char* ws = (unsigned char*)d_ws;
    (void)hipMemsetAsync(ws + WS_CTL, 0, CTL_BYTES, stream);
    Args a{};
    for (int i = 0; i < 16; ++i) a.in[i] = (const float*)d_in[i];
    a.out = (float*)d_out; a.ws = ws; a.ph_lo = 0; a.ph_hi = 7; a.li = 0; a.pad = 0;
    hipLaunchKernelGGL(mk_fwd, dim3(grid), dim3(NTHR), LDS_BYTES, stream, a);
}
```

```cpp
#include <hip/hip_runtime.h>
#include <cstdio>
#include <cstdint>
#define LAS __attribute__((address_space(3)))
#define GAS __attribute__((address_space(1)))
namespace pg8 {
#define PG8_LAS __attribute__((address_space(3)))
typedef unsigned short bf16_t;
typedef short bf16x8 __attribute__((ext_vector_type(8)));
typedef float f32x4 __attribute__((ext_vector_type(4)));
typedef unsigned u32x4 __attribute__((ext_vector_type(4)));
constexpr int BM = 256, BK = 64, HALF = 128, HTB = HALF * BK * 2  , STAGE_BYTES = 8 * HTB, NXCD = 8, WGM = 8;

__host__ __device__ __forceinline__ int lds_byte(int r, int c) { const int st = (r >> 4) * 2 + (c >> 5), rr = r & 15, cc = c & 31, ob = rr * 64 + cc * 2; return st * 1024 + (ob ^ (((ob >> 9) & 1) << 5)); }
__host__ __device__ __forceinline__ void stage_rc(int b, int& R, int& C) { const int st = b / 1024, sb = b % 1024, swz = sb ^ (((sb >> 9) & 1) << 5); R = (st >> 1) * 16 + swz / 64; C = (st & 1) * 32 + (swz % 64) / 2; }
__host__ __device__ __forceinline__ int perm32(int rho) { const int n = rho >> 4, i = rho & 15; return 8 * (i >> 2) + 4 * n + (i & 3); }

struct Unit { int pm, pn; };
struct Gemm { const bf16_t* A; const bf16_t* Bt; int M, N, K; };

struct StaticOrder {
    int nM, nN, nwg, G, c;
    __host__ __device__ void init(int M, int N, int G_, int c_) { nM = M / BM; nN = N / BM; nwg = nM * nN; G = G_; c = c_; }
    __host__ __device__ bool next(int i, Unit& u) const {
        const long L = (long)i * G + c; if (L >= nwg) return false;
        int wgid = (int)L; { const int q = nwg / NXCD, r = nwg % NXCD, xcd = wgid % NXCD, off = wgid / NXCD; wgid = (xcd < r ? xcd * (q + 1) : r * (q + 1) + (xcd - r) * q) + off; }
        const int nig = WGM * nN, gid = wgid / nig, fm = gid * WGM, gsz = (nM - fm) < WGM ? (nM - fm) : WGM;
        u.pm = fm + ((wgid % nig) % gsz); u.pn = (wgid % nig) / gsz; return true;
    }
    __device__ __forceinline__ void a_ready(const Unit&) const {}
    __device__ __forceinline__ void done(const Unit&) const {}
};
__device__ __forceinline__ unsigned cvt_pk_bf16(float lo, float hi) { unsigned r; asm volatile("v_cvt_pk_bf16_f32 %0, %1, %2" : "=v"(r) : "v"(lo), "v"(hi)); return r; }
template <class Epi, class Sched, bool ALIGN_EPI = false, bool SP2 = false>
__device__ __forceinline__ void gemm_phase(PG8_LAS unsigned char* lds, const Gemm g, const Sched& S, const Epi& E) {
    const int tid = threadIdx.x, wid = __builtin_amdgcn_readfirstlane(tid >> 6), lane = tid & 63, wr = wid >> 2, wc = wid & 3, fr = lane & 15, fq = lane >> 4;
    const int K = g.K, nt = K / BK;
    unsigned voffA[2], voffB[2];
#pragma unroll
    for (int i = 0; i < 2; ++i) { int R, C; stage_rc(tid * 16 + i * 8192, R, C); const int Rb = Epi::PERM ? ((R & ~31) + perm32(R & 31)) : R;
        voffA[i] = (unsigned)(R * K + C) * 2u; voffB[i] = (unsigned)(Rb * K + C) * 2u; }
    const size_t kstep = (size_t)(BK * 2);
    const size_t hstep = (size_t)HALF * K * 2;
    const size_t tstep = 2 * hstep;
    const unsigned ldsw = (unsigned)wid * 1024u;
    const int aoff = lds_byte(wr * 64 + fr, fq * 8), boff = lds_byte(wc * 32 + fr, fq * 8);
#define PG8_SA(b, h) (((b) * 2 + (h)) * HTB)
#define PG8_SB(b, h) ((4 + (b) * 2 + (h)) * HTB)
#define PG8_STAGE(bufoff, gbase, voff) do { _Pragma("unroll") for (int _i = 0; _i < 2; ++_i) \
        __builtin_amdgcn_global_load_lds((const unsigned*)((const char*)(gbase) + (voff)[_i]), (PG8_LAS unsigned*)(lds + (bufoff) + ldsw + _i * 8192), 16, 0, 0); } while (0)
#define PG8_LDA(dst, b, h) do { _Pragma("unroll") for (int m = 0; m < 4; ++m) _Pragma("unroll") for (int k = 0; k < 2; ++k) dst[m][k] = *(const PG8_LAS bf16x8*)(lds + PG8_SA(b, h) + aoff + m * 2048 + k * 1024); } while (0)
#define PG8_LDB(dst, b, h) do { _Pragma("unroll") for (int n = 0; n < 2; ++n) _Pragma("unroll") for (int k = 0; k < 2; ++k) dst[n][k] = *(const PG8_LAS bf16x8*)(lds + PG8_SB(b, h) + boff + n * 2048 + k * 1024); } while (0)
#define PG8_MMA(ai, bj, At, Bt) do { __builtin_amdgcn_s_setprio(1); _Pragma("unroll") for (int m = 0; m < 4; ++m) _Pragma("unroll") for (int n = 0; n < 2; ++n) _Pragma("unroll") for (int k = 0; k < 2; ++k) \
        acc[ai][bj][m][n] = __builtin_amdgcn_mfma_f32_16x16x32_bf16(Bt[n][k], At[m][k], acc[ai][bj][m][n], 0, 0, 0); __builtin_amdgcn_s_setprio(0); } while (0)
#define PG8_WAIT_V(n) asm volatile("s_waitcnt vmcnt(" #n ")" ::: "memory")
#define PG8_WAIT_L(n) asm volatile("s_waitcnt lgkmcnt(" #n ")" ::: "memory")
#define PG8_BAR __builtin_amdgcn_s_barrier()
#define PG8_SCHED __builtin_amdgcn_sched_barrier(0)
    Unit cur, nxt; int ui = 0;
    if (!S.next(0, cur)) return;
    f32x4 acc[2][2][4][2];
#pragma unroll
    for (int a = 0; a < 2; ++a)
#pragma unroll
        for (int b = 0; b < 2; ++b)
#pragma unroll
            for (int m = 0; m < 4; ++m)
#pragma unroll
                for (int n = 0; n < 2; ++n) acc[a][b][m][n] = (f32x4){0.f, 0.f, 0.f, 0.f};
    bf16x8 At[4][2], B0[2][2], B1[2][2];
    const char* cA = (const char*)g.A + (size_t)cur.pm * tstep; const char* cB = (const char*)g.Bt + (size_t)cur.pn * tstep;
    S.a_ready(cur);
    if constexpr (SP2) {
        PG8_STAGE(PG8_SB(0, 0), cB, voffB); PG8_STAGE(PG8_SB(0, 1), cB + hstep, voffB); PG8_STAGE(PG8_SA(0, 0), cA, voffA); PG8_STAGE(PG8_SA(0, 1), cA + hstep, voffA);
        if (wr == 1) PG8_BAR;
        PG8_WAIT_V(2); PG8_BAR;
        PG8_STAGE(PG8_SB(1, 0), cB + kstep, voffB); PG8_STAGE(PG8_SA(1, 0), cA + kstep, voffA); PG8_STAGE(PG8_SB(1, 1), cB + hstep + kstep, voffB);
        PG8_WAIT_V(6); PG8_BAR;
    } else {
        PG8_STAGE(PG8_SB(0, 0), cB, voffB); PG8_STAGE(PG8_SA(0, 0), cA, voffA); PG8_STAGE(PG8_SB(0, 1), cB + hstep, voffB); PG8_STAGE(PG8_SA(0, 1), cA + hstep, voffA);
        if (wr == 1) PG8_BAR;
        PG8_WAIT_V(4); PG8_BAR;
        PG8_STAGE(PG8_SB(1, 0), cB + kstep, voffB); PG8_STAGE(PG8_SA(1, 0), cA + kstep, voffA); PG8_STAGE(PG8_SB(1, 1), cB + hstep + kstep, voffB);
        PG8_WAIT_V(6); PG8_BAR;
    }
    for (;;) {
        const bool has_next = S.next(ui + 1, nxt);
        const char* nA = has_next ? (const char*)g.A + (size_t)nxt.pm * tstep : cA; const char* nB = has_next ? (const char*)g.Bt + (size_t)nxt.pn * tstep : cB;
        for (int t = 0; t < nt; t += 2) {
            const bool last = (t == nt - 2);
            const char* a1 = cA + (size_t)(t + 1) * kstep;
            const char* a2 = last ? nA : cA + (size_t)(t + 2) * kstep; const char* b2 = last ? nB : cB + (size_t)(t + 2) * kstep;
            const char* a3 = a2 + kstep; const char* b3 = b2 + kstep;
            if (last && has_next) S.a_ready(nxt);
            if constexpr (SP2) {
            PG8_LDB(B0, 0, 0); PG8_LDB(B1, 0, 1); PG8_SCHED; PG8_LDA(At, 0, 0); PG8_STAGE(PG8_SA(1, 1), a1 + hstep, voffA);
            PG8_WAIT_V(8); PG8_WAIT_L(0); PG8_BAR; PG8_MMA(0, 0, At, B0); PG8_MMA(0, 1, At, B1); PG8_BAR; PG8_SCHED;
            PG8_LDA(At, 0, 1); PG8_STAGE(PG8_SB(0, 0), b2, voffB); PG8_STAGE(PG8_SB(0, 1), b2 + hstep, voffB); PG8_STAGE(PG8_SA(0, 0), a2, voffA);
            PG8_WAIT_V(8); PG8_WAIT_L(0); PG8_BAR; PG8_MMA(1, 0, At, B0); PG8_MMA(1, 1, At, B1); PG8_BAR; PG8_SCHED;
            PG8_LDB(B0, 1, 0); PG8_LDB(B1, 1, 1); PG8_SCHED; PG8_LDA(At, 1, 0); PG8_STAGE(PG8_SA(0, 1), a2 + hstep, voffA);
            PG8_WAIT_V(8); PG8_WAIT_L(0); PG8_BAR; PG8_MMA(0, 0, At, B0); PG8_MMA(0, 1, At, B1); PG8_BAR; PG8_SCHED;
            PG8_LDA(At, 1, 1); PG8_STAGE(PG8_SB(1, 0), b3, voffB); PG8_STAGE(PG8_SB(1, 1), b3 + hstep, voffB); PG8_STAGE(PG8_SA(1, 0), a3, voffA);
            PG8_WAIT_V(8); PG8_WAIT_L(0); PG8_BAR; PG8_MMA(1, 0, At, B0); PG8_MMA(1, 1, At, B1); PG8_BAR; PG8_SCHED;
            } else {
            PG8_LDB(B0, 0, 0); PG8_SCHED; PG8_LDA(At, 0, 0); PG8_STAGE(PG8_SA(1, 1), a1 + hstep, voffA);
            PG8_WAIT_L(8); PG8_BAR; PG8_WAIT_L(0); PG8_MMA(0, 0, At, B0); PG8_BAR; PG8_SCHED;
            PG8_LDB(B1, 0, 1); PG8_STAGE(PG8_SB(0, 0), b2, voffB);
            PG8_BAR; PG8_WAIT_L(0); PG8_MMA(0, 1, At, B1); PG8_BAR;
            PG8_LDA(At, 0, 1); PG8_STAGE(PG8_SA(0, 0), a2, voffA);
            PG8_BAR; PG8_WAIT_L(0); PG8_MMA(1, 0, At, B0); PG8_BAR; PG8_SCHED;
            PG8_STAGE(PG8_SB(0, 1), b2 + hstep, voffB);
            PG8_WAIT_V(6); PG8_BAR; PG8_MMA(1, 1, At, B1); PG8_BAR;
            PG8_LDB(B0, 1, 0); PG8_SCHED; PG8_LDA(At, 1, 0); PG8_STAGE(PG8_SA(0, 1), a2 + hstep, voffA);
            PG8_WAIT_L(8); PG8_BAR; PG8_WAIT_L(0); PG8_MMA(0, 0, At, B0); PG8_BAR; PG8_SCHED;
            PG8_LDB(B1, 1, 1); PG8_STAGE(PG8_SB(1, 0), b3, voffB);
            PG8_BAR; PG8_WAIT_L(0); PG8_MMA(0, 1, At, B1); PG8_BAR;
            PG8_LDA(At, 1, 1); PG8_STAGE(PG8_SA(1, 0), a3, voffA);
            PG8_BAR; PG8_WAIT_L(0); PG8_MMA(1, 0, At, B0); PG8_BAR; PG8_SCHED;
            PG8_STAGE(PG8_SB(1, 1), b3 + hstep, voffB);
            PG8_WAIT_V(6); PG8_BAR; PG8_MMA(1, 1, At, B1); PG8_BAR;
            }
        }
        if constexpr (ALIGN_EPI) { if (wr == 0) PG8_BAR; }
        if constexpr (!Epi::AFTER_DRAIN) { E(acc, cur, wr, wc, fr, fq); S.done(cur); }
        if (!has_next) break;
#pragma unroll
        for (int a = 0; a < 2; ++a)
#pragma unroll
            for (int b = 0; b < 2; ++b)
#pragma unroll
                for (int m = 0; m < 4; ++m)
#pragma unroll
                    for (int n = 0; n < 2; ++n) acc[a][b][m][n] = (f32x4){0.f, 0.f, 0.f, 0.f};
        cur = nxt; cA = nA; cB = nB; ++ui;
        if constexpr (ALIGN_EPI) { if (wr == 1) PG8_BAR; }
    }
    PG8_WAIT_V(0);
    if constexpr (!ALIGN_EPI) { if (wr == 0) PG8_BAR; }
    PG8_BAR;
    if constexpr (Epi::AFTER_DRAIN) { E.fused(acc, cur, wr, wc, fr, fq, lds, wid, lane); S.done(cur); }
#undef PG8_SA
#undef PG8_SB
#undef PG8_STAGE
#undef PG8_LDA
#undef PG8_LDB
#undef PG8_MMA
#undef PG8_WAIT_V
#undef PG8_WAIT_L
#undef PG8_BAR
#undef PG8_SCHED
}
}
#define XB_TMO      128
#define XB_XCNT(j)  (256  + 64 * (j))
#define XB_XSUB(j)  (1280 + 64 * (j))
#define XB_XGEN(j)  (2304 + 64 * (j))
#define XB_TOP      3328
#define XB_TOPGEN   3392
#define XCD_BAR_WORDS 3456
#define XB_SPIN_CAP (1u << 18)

__device__ __forceinline__ unsigned xb_ld(unsigned* p)              { return __hip_atomic_load(p, __ATOMIC_RELAXED, __HIP_MEMORY_SCOPE_AGENT); }
__device__ __forceinline__ unsigned xb_add(unsigned* p, unsigned v) { return __hip_atomic_fetch_add(p, v, __ATOMIC_RELAXED, __HIP_MEMORY_SCOPE_AGENT); }
__device__ __forceinline__ unsigned xb_xcc_id() { return (unsigned)__builtin_amdgcn_s_getreg((3 << 11) | 20) & 0xFu; }
#define XB_SPIN(cond, bar) do { unsigned _sp = 0; while (cond) { __builtin_amdgcn_s_sleep(1); \
    if ((++_sp & 255u) == 0u) { if (xb_ld(&(bar)[XB_TMO])) break; if (_sp > XB_SPIN_CAP) { atomicAdd(&(bar)[XB_TMO], 1u); break; } } } } while (0)

struct XcdBarrier {
    unsigned* bar; unsigned x;
    volatile LAS unsigned* st;
};

__device__ __forceinline__ XcdBarrier xcd_barrier_post(unsigned* bar, volatile LAS unsigned* st) {
    XcdBarrier b; b.bar = bar; b.x = xb_xcc_id(); b.st = st;
    if (threadIdx.x == 0) (void)xb_add(&bar[XB_XCNT(b.x)], 1u);
    return b;
}
__device__ __forceinline__ void xcd_barrier_complete(unsigned* bar, unsigned x, unsigned& nloc, unsigned& nx) {
    const unsigned G = gridDim.x * gridDim.y * gridDim.z;
    unsigned sum, cnt, mine, sp = 0u;
    for (;;) {
        sum = 0u; cnt = 0u; mine = 0u;
#pragma unroll
        for (unsigned j = 0; j < 16; ++j) { const unsigned c = xb_ld(&bar[XB_XCNT(j)]); sum += c; cnt += (c > 0u) ? 1u : 0u; mine = (j == x) ? c : mine; }
        if (sum == G) break;
        __builtin_amdgcn_s_sleep(1);
        if ((++sp & 255u) == 0u) { if (xb_ld(&bar[XB_TMO])) break; if (sp > XB_SPIN_CAP) { atomicAdd(&bar[XB_TMO], 1u); break; } }
    }
    nloc = mine > 0u ? mine : 1u; nx = cnt > 0u ? cnt : 1u;
}

__device__ __forceinline__ void xcd_barrier(const XcdBarrier& b) {
    asm volatile("s_waitcnt vmcnt(0)" ::: "memory");
    __syncthreads();
    if (threadIdx.x == 0) {
        unsigned* bar = b.bar;
        __builtin_amdgcn_s_waitcnt(0);
        unsigned nloc = b.st[0], nx = b.st[1];
        if (nloc == 0u) { xcd_barrier_complete(bar, b.x, nloc, nx); b.st[0] = nloc; b.st[1] = nx; }
        const unsigned old = xb_add(&bar[XB_XSUB(b.x)], 1u);
        const unsigned gen = old / nloc;
        if (old + 1u == (gen + 1u) * nloc) {
            __builtin_amdgcn_fence(__ATOMIC_RELEASE, "agent");
            asm volatile("s_waitcnt vmcnt(0)" ::: "memory");
            const unsigned og = xb_add(&bar[XB_TOP], 1u);
            const unsigned tg = og / nx;
            if (og + 1u == (tg + 1u) * nx) xb_add(&bar[XB_TOPGEN], 1u);
            else XB_SPIN(xb_ld(&bar[XB_TOPGEN]) == tg, bar);
            __builtin_amdgcn_fence(__ATOMIC_ACQUIRE, "agent");
            xb_add(&bar[XB_XGEN(b.x)], 1u);
            asm volatile("s_waitcnt vmcnt(0)" ::: "memory");
        } else {
            XB_SPIN(xb_ld(&bar[XB_XGEN(b.x)]) == gen, bar);
            __builtin_amdgcn_fence(__ATOMIC_ACQUIRE, "agent");
            asm volatile("s_waitcnt vmcnt(0)" ::: "memory");
        }
    }
    __syncthreads();
}
namespace mk {
typedef unsigned short bf16;
typedef unsigned v4u __attribute__((ext_vector_type(4)));
typedef unsigned v2u __attribute__((ext_vector_type(2)));
typedef float f32x4 __attribute__((ext_vector_type(4)));
typedef float f32x16 __attribute__((ext_vector_type(16)));
typedef short bf16x8 __attribute__((ext_vector_type(8)));
typedef short bf16x4 __attribute__((ext_vector_type(4)));

constexpr int T = 32768, D = 1024, SQ = 4096, NIN = 2816, NQ = 2048, PLE = 256, NEXP = 16384;
constexpr int NWAVES = 8, NTHR = 512;
constexpr int RING_BYTES = 131072, LDS_BYTES = 163840, MISC_OFF = LDS_BYTES - 256;

constexpr size_t MB = 1024 * 1024;
constexpr size_t WS_CTL = 0, CTL_BYTES = 256 * 1024;
constexpr size_t WS_WIN = WS_CTL + CTL_BYTES;
constexpr size_t WS_WOUT = WS_WIN + (size_t)NIN * D * 2;
constexpr size_t WS_WQ = WS_WOUT + (size_t)D * D * 2;
constexpr size_t WS_WG = WS_WQ + (size_t)NQ * D * 2;
constexpr size_t WS_WP = WS_WG + (size_t)D * D * 2;
constexpr size_t WS_KEYS = WS_WP + (size_t)D * PLE * 2;
constexpr size_t WS_ROPE = WS_KEYS + 2 * 128 * 128 * 2;
constexpr size_t WS_SU = WS_ROPE + 2 * (size_t)SQ * 32 * 4;
constexpr size_t WS_SV = WS_SU + 65536;
constexpr size_t WS_SH = WS_SV + 65536;
constexpr size_t WS_UB = 16 * MB;
constexpr size_t WS_VB = 32 * MB;
constexpr size_t WS_PB = 48 * MB;
constexpr size_t WS_PK = 64 * MB;
constexpr size_t WS_R1 = 96 * MB;
constexpr size_t WS_R2 = 160 * MB;
constexpr size_t WS_PP = 352 * MB;
constexpr size_t WS_RSS2 = 80 * MB;
constexpr size_t WS_END = 416 * MB;
static_assert(WS_SH + (size_t)T * 4 <= WS_UB, "ws map");
constexpr int CW_BAR = 1024;

#define LDS_WAIT() asm volatile("s_waitcnt lgkmcnt(0)" ::: "memory")
#define VM_WAIT() asm volatile("s_waitcnt vmcnt(0)" ::: "memory")
typedef float f32x2 __attribute__((ext_vector_type(2)));
typedef __bf16 b16x2 __attribute__((ext_vector_type(2)));
__device__ __forceinline__ unsigned pk2(float lo, float hi) { const f32x2 v = {lo, hi}; return __builtin_bit_cast(unsigned, __builtin_convertvector(v, b16x2)); }
__device__ __forceinline__ float bf_lo(unsigned w) { return __uint_as_float(w << 16); }
__device__ __forceinline__ float bf_hi(unsigned w) { return __uint_as_float(w & 0xffff0000u); }
__device__ __forceinline__ float wave_sum(float v) {
#pragma unroll
    for (int o = 1; o < 64; o <<= 1) v += __shfl_xor(v, o);
    return v;
}

#ifndef PROBE_ON
#define PT_DECL
#define PT_ARG
#define PT_BEGIN()
#define PT_ADD(k)
#endif
struct Args { const float* in[16]; float* out; unsigned char* ws; int ph_lo, ph_hi, li, pad; };

struct EpiStoreBf16 {
    static constexpr bool PERM = true, AFTER_DRAIN = false;
    bf16* O; int ldc;
    __device__ __forceinline__ void operator()(const pg8::f32x4 (&acc)[2][2][4][2], const pg8::Unit& u, int wr, int wc, int fr, int fq) const {
        const int row0 = u.pm * 256 + wr * 64 + fr, col0 = u.pn * 256 + wc * 32 + 8 * fq;
#pragma unroll
        for (int ai = 0; ai < 2; ++ai)
#pragma unroll
            for (int m = 0; m < 4; ++m) { bf16* rowp = O + (size_t)(row0 + ai * 128 + m * 16) * ldc + col0;
#pragma unroll
                for (int bj = 0; bj < 2; ++bj) { const pg8::f32x4 v0 = acc[ai][bj][m][0], v1 = acc[ai][bj][m][1];
                    pg8::u32x4 w; w.x = pk2(v0[0], v0[1]); w.y = pk2(v0[2], v0[3]); w.z = pk2(v1[0], v1[1]); w.w = pk2(v1[2], v1[3]);
                    *(pg8::u32x4*)(rowp + bj * 128) = w; } }
    }
};


struct EpiResid {
    static constexpr bool PERM = true, AFTER_DRAIN = false;
    const float* X; bf16* XB;
    __device__ __forceinline__ void operator()(const pg8::f32x4 (&acc)[2][2][4][2], const pg8::Unit& u, int wr, int wc, int fr, int fq) const {
        const int row0 = u.pm * 256 + wr * 64 + fr, col0 = u.pn * 256 + wc * 32 + 8 * fq;
#pragma unroll
        for (int ai = 0; ai < 2; ++ai)
#pragma unroll
            for (int m = 0; m < 4; ++m) { const size_t off = (size_t)(row0 + ai * 128 + m * 16) * D + col0;
#pragma unroll
                for (int bj = 0; bj < 2; ++bj) { const size_t o2 = off + bj * 128;
                    const pg8::f32x4 v0 = acc[ai][bj][m][0] + *(const pg8::f32x4*)(X + o2), v1 = acc[ai][bj][m][1] + *(const pg8::f32x4*)(X + o2 + 4);
                    pg8::u32x4 w; w.x = pk2(v0[0], v0[1]); w.y = pk2(v0[2], v0[3]); w.z = pk2(v1[0], v1[1]); w.w = pk2(v1[2], v1[3]);
                    *(pg8::u32x4*)(XB + o2) = w; } }
    }
};
struct EpiGate {
    static constexpr bool PERM = true, AFTER_DRAIN = false;
    float* O; const bf16* XB; const bf16* PP; const float* rss;
    __device__ __forceinline__ void operator()(const pg8::f32x4 (&acc)[2][2][4][2], const pg8::Unit& u, int wr, int wc, int fr, int fq) const {
        const int row0 = u.pm * 256 + wr * 64 + fr, col0 = u.pn * 256 + wc * 32 + 8 * fq;
#pragma unroll
        for (int ai = 0; ai < 2; ++ai)
#pragma unroll
            for (int m = 0; m < 4; ++m) { const int row = row0 + ai * 128 + m * 16; const size_t off = (size_t)row * D + col0;
                const pg8::f32x4 q0 = *(const pg8::f32x4*)(rss + (size_t)row * 8), q1 = *(const pg8::f32x4*)(rss + (size_t)row * 8 + 4);
                const float rs = 1.0f / sqrtf((((q0[0] + q0[1]) + (q0[2] + q0[3])) + ((q1[0] + q1[1]) + (q1[2] + q1[3]))) * (1.0f / D) + 1e-6f);
#pragma unroll
                for (int bj = 0; bj < 2; ++bj) { const size_t o2 = off + bj * 128;
                    const pg8::u32x4 pw = *(const pg8::u32x4*)(PP + o2), xw = *(const pg8::u32x4*)(XB + o2);
                    const pg8::f32x4 a0 = acc[ai][bj][m][0] * rs, a1 = acc[ai][bj][m][1] * rs;
                    pg8::f32x4 x0, x1;
                    x0[0] = bf_lo(xw.x) + bf_lo(pw.x) / (1.0f + __expf(-a0[0])); x0[1] = bf_hi(xw.x) + bf_hi(pw.x) / (1.0f + __expf(-a0[1])); x0[2] = bf_lo(xw.y) + bf_lo(pw.y) / (1.0f + __expf(-a0[2])); x0[3] = bf_hi(xw.y) + bf_hi(pw.y) / (1.0f + __expf(-a0[3]));
                    x1[0] = bf_lo(xw.z) + bf_lo(pw.z) / (1.0f + __expf(-a1[0])); x1[1] = bf_hi(xw.z) + bf_hi(pw.z) / (1.0f + __expf(-a1[1])); x1[2] = bf_lo(xw.w) + bf_lo(pw.w) / (1.0f + __expf(-a1[2])); x1[3] = bf_hi(xw.w) + bf_hi(pw.w) / (1.0f + __expf(-a1[3]));
                    *(pg8::f32x4*)(O + o2) = x0; *(pg8::f32x4*)(O + o2 + 4) = x1; } }
    }
};

__device__ __forceinline__ void p0_transpose_item(const float* __restrict__ W, const float* __restrict__ gsc, int K, int N, bf16* __restrict__ WT, LAS float* scr, int item, int lane) {
    const int nblk = N / 32, kb = item / nblk, nb = item % nblk, k0 = 64 * kb, n0 = 32 * nb;
#pragma unroll 8
    for (int i = 0; i < 32; ++i) { const int kk = 2 * i + (lane >> 5); float w = W[(size_t)(k0 + kk) * N + n0 + (lane & 31)]; if (gsc) w *= gsc[k0 + kk]; scr[kk * 33 + (lane & 31)] = w; }
    LDS_WAIT(); asm volatile("" ::: "memory");
    const int c = lane & 7;
#pragma unroll
    for (int j = 0; j < 4; ++j) { const int n = (lane >> 3) + 8 * j; const LAS float* s = scr + (8 * c) * 33 + n;
        v4u o; o.x = pk2(s[0 * 33], s[1 * 33]); o.y = pk2(s[2 * 33], s[3 * 33]); o.z = pk2(s[4 * 33], s[5 * 33]); o.w = pk2(s[6 * 33], s[7 * 33]);
        *(v4u*)(WT + (size_t)(n0 + n) * K + k0 + 8 * c) = o; }
    LDS_WAIT(); asm volatile("" ::: "memory");
}
__device__ __forceinline__ void p0_convert(const float* __restrict__ src, bf16* __restrict__ dst, size_t n8, size_t gtid, size_t gthreads) {
    size_t i = gtid;
    for (; i + 3 * gthreads < n8; i += 4 * gthreads) {
        f32x4 a[4], b[4];
#pragma unroll
        for (int r = 0; r < 4; ++r) { a[r] = ((const f32x4*)src)[2 * (i + r * gthreads)]; b[r] = ((const f32x4*)src)[2 * (i + r * gthreads) + 1]; }
#pragma unroll
        for (int r = 0; r < 4; ++r) { v4u o; o.x = pk2(a[r][0], a[r][1]); o.y = pk2(a[r][2], a[r][3]); o.z = pk2(b[r][0], b[r][1]); o.w = pk2(b[r][2], b[r][3]); ((v4u*)dst)[i + r * gthreads] = o; }
    }
    for (; i < n8; i += gthreads) {
        const f32x4 a = ((const f32x4*)src)[2 * i], b = ((const f32x4*)src)[2 * i + 1];
        v4u o; o.x = pk2(a[0], a[1]); o.y = pk2(a[2], a[3]); o.z = pk2(b[0], b[1]); o.w = pk2(b[2], b[3]);
        ((v4u*)dst)[i] = o;
    }
}
__device__ __forceinline__ void rms_row_to_bf16(const float* __restrict__ xrow, const float* __restrict__ g, bf16* __restrict__ orow, int lane) {
    const f32x4* xr = (const f32x4*)xrow + lane; const f32x4* gr = (const f32x4*)g + lane;
    f32x4 v[4]; float s = 0.f;
#pragma unroll
    for (int j = 0; j < 4; ++j) { v[j] = xr[64 * j]; s += (v[j][0] * v[j][0] + v[j][1] * v[j][1]) + (v[j][2] * v[j][2] + v[j][3] * v[j][3]); }
    const float rstd = 1.0f / sqrtf(wave_sum(s) * (1.0f / D) + 1e-6f);
    v2u* o8 = (v2u*)orow + lane;
#pragma unroll
    for (int j = 0; j < 4; ++j) { const f32x4 gg = gr[64 * j]; v2u w; w.x = pk2(v[j][0] * rstd * gg[0], v[j][1] * rstd * gg[1]); w.y = pk2(v[j][2] * rstd * gg[2], v[j][3] * rstd * gg[3]); o8[64 * j] = w; }
}

__device__ __forceinline__ void p0_prologue(const Args& a, LAS unsigned char* lds, int vcu, int G, int tid, int lane, int wave) {
    unsigned char* ws = a.ws;
    LAS float* scr = (LAS float*)(lds + wave * 16384);
    const int gw = vcu * NWAVES + wave, NGW = G * NWAVES;
    constexpr int I_IN = (D / 64) * (NIN / 32), I_OUT = (D / 64) * (D / 32), I_Q = (D / 64) * (NQ / 32), I_G = I_OUT, I_P = (PLE / 64) * (D / 32);
    constexpr int NITEMS = I_IN + I_OUT + I_Q + I_G + I_P;
    for (int it = gw; it < NITEMS; it += NGW) {
        int r = it;
        if (r < I_IN) { p0_transpose_item(a.in[3], nullptr, D, NIN, (bf16*)(ws + WS_WIN), scr, r, lane); continue; } r -= I_IN;
        if (r < I_OUT) { p0_transpose_item(a.in[7], nullptr, D, D, (bf16*)(ws + WS_WOUT), scr, r, lane); continue; } r -= I_OUT;
        if (r < I_Q) { p0_transpose_item(a.in[9], a.in[8], D, NQ, (bf16*)(ws + WS_WQ), scr, r, lane); continue; } r -= I_Q;
        if (r < I_G) { p0_transpose_item(a.in[14], a.in[13], D, D, (bf16*)(ws + WS_WG), scr, r, lane); continue; } r -= I_G;
        p0_transpose_item(a.in[15], nullptr, PLE, D, (bf16*)(ws + WS_WP), scr, r, lane);
    }
    const size_t gtid = (size_t)vcu * NTHR + tid, gthreads = (size_t)G * NTHR;
    p0_convert(a.in[10], (bf16*)(ws + WS_KEYS), 2 * 128 * 128 / 8, gtid, gthreads);
    for (int r0 = gw; r0 < 2 * NEXP; r0 += 4 * NGW) {
        float xs[4][16];
#pragma unroll
        for (int rr = 0; rr < 4; ++rr) {
            const int r = r0 + rr * NGW; const int isv = r >= NEXP, e = isv ? r - NEXP : r;
            const float* src = (isv ? a.in[12] : a.in[11]) + (size_t)e * D + 16 * lane;
            const f32x4 x0 = *(const f32x4*)src, x1 = *(const f32x4*)(src + 4), x2 = *(const f32x4*)(src + 8), x3 = *(const f32x4*)(src + 12);
#pragma unroll
            for (int u = 0; u < 4; ++u) { xs[rr][u] = x0[u]; xs[rr][4 + u] = x1[u]; xs[rr][8 + u] = x2[u]; xs[rr][12 + u] = x3[u]; }
        }
#pragma unroll
        for (int rr = 0; rr < 4; ++rr) {
            const int r = r0 + rr * NGW; const int isv = r >= NEXP, e = isv ? r - NEXP : r;
            float am = 0.f;
#pragma unroll
            for (int u = 0; u < 16; ++u) am = fmaxf(am, fabsf(xs[rr][u]));
#pragma unroll
            for (int o = 1; o < 64; o <<= 1) am = fmaxf(am, __shfl_xor(am, o));
            const float inv = am > 0.f ? 127.0f / am : 0.f; const unsigned bias = 0u;
            v4u w;
#pragma unroll
            for (int c = 0; c < 4; ++c) { unsigned ww = 0u;
#pragma unroll
                for (int u = 0; u < 4; ++u) { const int q = __float2int_rn(xs[rr][4 * c + u] * inv); ww |= (((unsigned)q + bias) & 0xffu) << (8 * u); }
                w[c] = ww; }
            if (isv) *(v4u*)(ws + WS_VB + (size_t)(lane >> 3) * ((size_t)NEXP * 128) + (size_t)e * 128 + 16 * (lane & 7)) = w;
            else *(v4u*)(ws + WS_UB + (size_t)e * D + 16 * lane) = w;
            if (lane == 0) ((float*)(ws + (isv ? WS_SV : WS_SU)))[e] = am * (1.0f / 127.0f);
        }
    }
    p0_convert(a.in[1], (bf16*)(ws + WS_PB), (size_t)T * PLE / 8, gtid, gthreads);
    for (size_t i = gtid; i < (size_t)SQ * 32; i += gthreads) {
        const int pos = (int)(i >> 5), c = (int)(i & 31);
        const float freq = powf(10000.0f, -(float)c / 32.0f);
        const float ang = (float)pos * freq;
        float sn, cs; sincosf(ang, &sn, &cs);
        ((float*)(ws + WS_ROPE))[i] = cs; ((float*)(ws + WS_ROPE))[(size_t)SQ * 32 + i] = sn;
    }
    for (int m0 = gw; m0 < T; m0 += 4 * NGW) {
        f32x4 v[4][4]; float ssq[4];
#pragma unroll
        for (int rr = 0; rr < 4; ++rr) { const f32x4* xr = (const f32x4*)(a.in[0] + (size_t)(m0 + rr * NGW) * D) + lane;
#pragma unroll
            for (int j = 0; j < 4; ++j) v[rr][j] = xr[64 * j]; }
#pragma unroll
        for (int rr = 0; rr < 4; ++rr) { float sq = 0.f;
#pragma unroll
            for (int j = 0; j < 4; ++j) sq += (v[rr][j][0] * v[rr][j][0] + v[rr][j][1] * v[rr][j][1]) + (v[rr][j][2] * v[rr][j][2] + v[rr][j][3] * v[rr][j][3]);
            ssq[rr] = sq; }
#pragma unroll
        for (int o = 1; o < 64; o <<= 1)
#pragma unroll
            for (int rr = 0; rr < 4; ++rr) ssq[rr] += __shfl_xor(ssq[rr], o);
        const f32x4* gr = (const f32x4*)a.in[2] + lane;
#pragma unroll
        for (int rr = 0; rr < 4; ++rr) { const float rstd = 1.0f / sqrtf(ssq[rr] * (1.0f / D) + 1e-6f); v2u* o8 = (v2u*)((bf16*)(ws + WS_R1) + (size_t)(m0 + rr * NGW) * D) + lane;
#pragma unroll
            for (int j = 0; j < 4; ++j) { const f32x4 gg = gr[64 * j]; v2u w; w.x = pk2(v[rr][j][0] * rstd * gg[0], v[rr][j][1] * rstd * gg[1]); w.y = pk2(v[rr][j][2] * rstd * gg[2], v[rr][j][3] * rstd * gg[3]); o8[64 * j] = w; } }
    }
}


#define MFMA32(a, b, c) __builtin_amdgcn_mfma_f32_32x32x16_bf16((a), (b), (c), 0, 0, 0)
__device__ __forceinline__ int crow(int r, int hf) { return (r & 3) + 8 * (r >> 2) + 4 * hf; }
__device__ __forceinline__ bf16x8 pack8(float a0, float a1, float a2, float a3, float a4, float a5, float a6, float a7) {
    v4u w; w.x = pk2(a0, a1); w.y = pk2(a2, a3); w.z = pk2(a4, a5); w.w = pk2(a6, a7); return __builtin_bit_cast(bf16x8, w);
}
__device__ __forceinline__ bf16x8 lds_frag16(LAS unsigned char* p) { return *(const LAS bf16x8*)p; }
__device__ __forceinline__ bf16x8 lds_frag8x2(LAS unsigned char* p) {
    const bf16x4 lo = *(const LAS bf16x4*)p, hi = *(const LAS bf16x4*)(p + 16); return __builtin_shufflevector(lo, hi, 0, 1, 2, 3, 4, 5, 6, 7);
}
typedef short s16x4 __attribute__((ext_vector_type(4)));
__device__ __forceinline__ s16x4 lds_tr4(LAS unsigned char* tile, int r0, int c0, int lane) {
    const int i = lane & 15;
    return __builtin_amdgcn_ds_read_tr16_b64_v4i16((LAS s16x4*)(tile + (r0 + (i >> 2)) * 144 + (c0 + 16 * ((lane >> 4) & 1) + 4 * (i & 3)) * 2));
}
__device__ __forceinline__ bf16x8 cat8(s16x4 lo, s16x4 hi) { return __builtin_shufflevector(lo, hi, 0, 1, 2, 3, 4, 5, 6, 7); }
constexpr int RQ = 144;
constexpr int LR_QS = 0, LR_KS = LR_QS + 128 * RQ, LR_VS = LR_KS + 128 * RQ, LR_ST = LR_VS + 128 * RQ, LR_LN = LR_ST + 64 * RQ, LR_END = LR_LN + 2 * 128 * 8;
static_assert(LR_END <= RING_BYTES, "retention LDS");
__device__ __forceinline__ void ret_unit(const bf16* __restrict__ PROJ, bf16* __restrict__ MIXED, const float* __restrict__ rope, LAS unsigned char* lds,
                                         int b, int h, int c0, int c1, int tid, int lane, int wave) {
    const float gam = 1.0f - exp2f(-5.0f - (float)h), lg2 = log2f(gam), cd = exp2f(lg2 * 128.0f);
    const int l31 = lane & 31, hf = lane >> 5, ib = wave >> 1, et = wave & 1;
    const int r = tid >> 2, qd = tid & 3;
    const float wq = exp2f(lg2 * (float)(r + 1)), wk = exp2f(-lg2 * (float)(r + 1));
    f32x16 stacc;
#pragma unroll
    for (int i = 0; i < 16; ++i) stacc[i] = 0.f;
    for (int i = tid; i < 64 * RQ / 4; i += NTHR) ((LAS unsigned*)(lds + LR_ST))[i] = 0u;
    v4u k1, k2, v1, v2, q1 = {0u, 0u, 0u, 0u}, q2 = {0u, 0u, 0u, 0u}; f32x4 csa, csb, sna, snb; v2u gvn[4] = {{0u, 0u}, {0u, 0u}, {0u, 0u}, {0u, 0u}};
#define RET_LOAD(nn) do { const int sp_ = (nn) * 128 + r; const bf16* pr_ = PROJ + ((size_t)b * SQ + sp_) * NIN + h * 64 + 8 * qd; \
        k1 = *(const v4u*)(pr_ + 512); k2 = *(const v4u*)(pr_ + 512 + 32); v1 = *(const v4u*)(pr_ + 1024); v2 = *(const v4u*)(pr_ + 1024 + 32); \
        if ((nn) >= c0) { q1 = *(const v4u*)(pr_); q2 = *(const v4u*)(pr_ + 32); \
            const bf16* gp_ = PROJ + ((size_t)b * SQ + (nn) * 128 + 32 * ib + l31) * NIN + 1536 + h * 64 + 32 * et + 4 * hf; \
            gvn[0] = *(const v2u*)gp_; gvn[1] = *(const v2u*)(gp_ + 8); gvn[2] = *(const v2u*)(gp_ + 16); gvn[3] = *(const v2u*)(gp_ + 24); } \
        csa = *(const f32x4*)(rope + sp_ * 32 + 8 * qd); csb = *(const f32x4*)(rope + sp_ * 32 + 8 * qd + 4); \
        sna = *(const f32x4*)(rope + SQ * 32 + sp_ * 32 + 8 * qd); snb = *(const f32x4*)(rope + SQ * 32 + sp_ * 32 + 8 * qd + 4); } while (0)
    RET_LOAD(0);
    for (int n = 0; n < c1; ++n) {
        const bool own = n >= c0;
        float cs[8], sn[8];
#pragma unroll
        for (int u = 0; u < 4; ++u) { cs[u] = csa[u]; cs[4 + u] = csb[u]; sn[u] = sna[u]; sn[4 + u] = snb[u]; }
        v2u gv[4];
#pragma unroll
        for (int g = 0; g < 4; ++g) gv[g] = gvn[g];
        __syncthreads();
        {
            float o1[8], o2[8];
#pragma unroll
            for (int u = 0; u < 8; ++u) { const unsigned w1 = k1[u >> 1], w2 = k2[u >> 1]; const float x1 = (u & 1) ? bf_hi(w1) : bf_lo(w1), x2 = (u & 1) ? bf_hi(w2) : bf_lo(w2);
                o1[u] = (x1 * cs[u] - x2 * sn[u]) * wk; o2[u] = (x1 * sn[u] + x2 * cs[u]) * wk; }
            *(LAS bf16x8*)(lds + LR_KS + r * RQ + (8 * qd) * 2) = pack8(o1[0], o1[1], o1[2], o1[3], o1[4], o1[5], o1[6], o1[7]);
            *(LAS bf16x8*)(lds + LR_KS + r * RQ + (32 + 8 * qd) * 2) = pack8(o2[0], o2[1], o2[2], o2[3], o2[4], o2[5], o2[6], o2[7]);
            *(LAS v4u*)(lds + LR_VS + r * RQ + (8 * qd) * 2) = v1; *(LAS v4u*)(lds + LR_VS + r * RQ + (32 + 8 * qd) * 2) = v2;
            if (own) {
#pragma unroll
                for (int u = 0; u < 8; ++u) { const unsigned w1 = q1[u >> 1], w2 = q2[u >> 1]; const float x1 = (u & 1) ? bf_hi(w1) : bf_lo(w1), x2 = (u & 1) ? bf_hi(w2) : bf_lo(w2);
                    o1[u] = (x1 * cs[u] - x2 * sn[u]) * wq; o2[u] = (x1 * sn[u] + x2 * cs[u]) * wq; }
                *(LAS bf16x8*)(lds + LR_QS + r * RQ + (8 * qd) * 2) = pack8(o1[0], o1[1], o1[2], o1[3], o1[4], o1[5], o1[6], o1[7]);
                *(LAS bf16x8*)(lds + LR_QS + r * RQ + (32 + 8 * qd) * 2) = pack8(o2[0], o2[1], o2[2], o2[3], o2[4], o2[5], o2[6], o2[7]);
            }
        }
        if (n + 1 < c1) RET_LOAD(n + 1);
        __syncthreads();
        if (own) {
            const size_t orow = (size_t)b * SQ + n * 128 + 32 * ib + l31;
            bf16x8 qf[4];
#pragma unroll
            for (int ks = 0; ks < 4; ++ks) qf[ks] = lds_frag16(lds + LR_QS + (32 * ib + l31) * RQ + (16 * ks + 8 * hf) * 2);
            f32x16 o;
#pragma unroll
            for (int i = 0; i < 16; ++i) o[i] = 0.f;
#pragma unroll
            for (int ks = 0; ks < 4; ++ks) o = MFMA32(lds_frag16(lds + LR_ST + (32 * et + l31) * RQ + (16 * ks + 8 * hf) * 2), qf[ks], o);
            for (int jb = 0; jb <= ib; ++jb) {
                f32x16 s;
#pragma unroll
                for (int i = 0; i < 16; ++i) s[i] = 0.f;
#pragma unroll
                for (int ks = 0; ks < 4; ++ks) s = MFMA32(lds_frag16(lds + LR_KS + (32 * jb + l31) * RQ + (16 * ks + 8 * hf) * 2), qf[ks], s);
                const bool diag = (jb == ib);
                float p[16];
#pragma unroll
                for (int i = 0; i < 16; ++i) p[i] = (diag && crow(i, hf) > l31) ? 0.f : s[i] * 0.125f;
#pragma unroll
                for (int st = 0; st < 2; ++st) {
                    const bf16x8 pf = pack8(p[8 * st], p[8 * st + 1], p[8 * st + 2], p[8 * st + 3], p[8 * st + 4], p[8 * st + 5], p[8 * st + 6], p[8 * st + 7]);
                    o = MFMA32(cat8(lds_tr4(lds + LR_VS, 32 * jb + 16 * st + 4 * hf, 32 * et, lane), lds_tr4(lds + LR_VS, 32 * jb + 16 * st + 8 + 4 * hf, 32 * et, lane)), pf, o);
                }
            }
            float s1 = 0.f, s2 = 0.f;
#pragma unroll
            for (int i = 0; i < 16; ++i) { s1 += o[i]; s2 += o[i] * o[i]; }
            s1 += __shfl_xor(s1, 32); s2 += __shfl_xor(s2, 32);
            if (hf == 0) *(LAS f32x2*)(lds + LR_LN + (et * 128 + 32 * ib + l31) * 8) = (f32x2){s1, s2};
            __syncthreads();
            const f32x2 ot = *(const LAS f32x2*)(lds + LR_LN + ((et ^ 1) * 128 + 32 * ib + l31) * 8);
            const float mu = (s1 + ot.x) * (1.0f / 64.0f), var = fmaxf((s2 + ot.y) * (1.0f / 64.0f) - mu * mu, 0.f), rs = 1.0f / sqrtf(var + 1e-6f);
#pragma unroll
            for (int g = 0; g < 4; ++g) {
                float y[4];
#pragma unroll
                for (int u = 0; u < 4; ++u) { const unsigned w = gv[g][u >> 1]; const float gg = (u & 1) ? bf_hi(w) : bf_lo(w); const float sg = gg / (1.0f + __expf(-gg)); y[u] = sg * ((o[4 * g + u] - mu) * rs); }
                v2u w; w.x = pk2(y[0], y[1]); w.y = pk2(y[2], y[3]);
                *(v2u*)(MIXED + orow * D + h * 64 + 32 * et + 8 * g + 4 * hf) = w;
            }
        }
        if (wave < 4) {
            const int se = wave >> 1, sd = wave & 1;
            f32x16 tmp;
#pragma unroll
            for (int i = 0; i < 16; ++i) tmp[i] = 0.f;
#pragma unroll
            for (int ks = 0; ks < 8; ++ks)
                tmp = MFMA32(cat8(lds_tr4(lds + LR_VS, 16 * ks + 8 * hf, 32 * se, lane), lds_tr4(lds + LR_VS, 16 * ks + 8 * hf + 4, 32 * se, lane)),
                             cat8(lds_tr4(lds + LR_KS, 16 * ks + 8 * hf, 32 * sd, lane), lds_tr4(lds + LR_KS, 16 * ks + 8 * hf + 4, 32 * sd, lane)), tmp);
#pragma unroll
            for (int i = 0; i < 16; ++i) stacc[i] = cd * (stacc[i] + 0.125f * tmp[i]);
#pragma unroll
            for (int i = 0; i < 16; i += 2) { const unsigned w = pk2(stacc[i], stacc[i + 1]);
                *(LAS bf16*)(lds + LR_ST + (32 * se + crow(i, hf)) * RQ + (32 * sd + l31) * 2) = (bf16)(w & 0xffffu);
                *(LAS bf16*)(lds + LR_ST + (32 * se + crow(i + 1, hf)) * RQ + (32 * sd + l31) * 2) = (bf16)(w >> 16); }
        }
    }
    __syncthreads();
#undef RET_LOAD
}

constexpr int LS_KN = 0, LS_VS = LS_KN + 256 * RQ, LS_QN = LS_VS + 256 * RQ, LS_END = LS_QN + 256 * RQ;
static_assert(LS_END <= RING_BYTES, "swa LDS");
__device__ __forceinline__ void swa_unit(const bf16* __restrict__ PROJ, bf16* __restrict__ MIXED, const float* __restrict__ qnw, const float* __restrict__ knw, const float* __restrict__ sinks,
                                         LAS unsigned char* lds, int b, int kvh, int n, int tid, int lane, int wave) {
    const int l31 = lane & 31, hf = lane >> 5;
    const int row = tid >> 1, half = tid & 1;
    {
        const int kpos = (n - 1) * 128 + row; const bool valid = kpos >= 0;
        v4u kk[4], vv[4];
#pragma unroll
        for (int c = 0; c < 4; ++c) { kk[c] = (v4u){0u, 0u, 0u, 0u}; vv[c] = (v4u){0u, 0u, 0u, 0u}; }
        if (valid) { const bf16* pr = PROJ + ((size_t)b * SQ + kpos) * NIN + 32 * half;
#pragma unroll
            for (int c = 0; c < 4; ++c) { kk[c] = *(const v4u*)(pr + 2560 + kvh * 64 + 8 * c); vv[c] = *(const v4u*)(pr + 2688 + kvh * 64 + 8 * c); } }
        float kf[32]; float ss = 0.f;
#pragma unroll
        for (int c = 0; c < 4; ++c)
#pragma unroll
            for (int u = 0; u < 4; ++u) { kf[8 * c + 2 * u] = bf_lo(kk[c][u]); kf[8 * c + 2 * u + 1] = bf_hi(kk[c][u]); }
#pragma unroll
        for (int i = 0; i < 32; ++i) ss += kf[i] * kf[i];
        ss += __shfl_xor(ss, 1);
        const float rstd = 0.125f / sqrtf(ss * (1.0f / 64.0f) + 1e-6f);
#pragma unroll
        for (int c = 0; c < 4; ++c) {
            const f32x4 g0 = *(const f32x4*)(knw + 32 * half + 8 * c), g1 = *(const f32x4*)(knw + 32 * half + 8 * c + 4);
            *(LAS bf16x8*)(lds + LS_KN + row * RQ + (32 * half + 8 * c) * 2) = pack8(kf[8 * c] * rstd * g0[0], kf[8 * c + 1] * rstd * g0[1], kf[8 * c + 2] * rstd * g0[2], kf[8 * c + 3] * rstd * g0[3],
                                                                                  kf[8 * c + 4] * rstd * g1[0], kf[8 * c + 5] * rstd * g1[1], kf[8 * c + 6] * rstd * g1[2], kf[8 * c + 7] * rstd * g1[3]);
            *(LAS v4u*)(lds + LS_VS + row * RQ + (32 * half + 8 * c) * 2) = vv[c];
        }
    }
    for (int rnd = 0; rnd < 2; ++rnd) {
        {
            const int hs = row >> 7, qrow = row & 127, hq = kvh * 4 + rnd * 2 + hs;
            const bf16* pr = PROJ + ((size_t)b * SQ + n * 128 + qrow) * NIN + 2048 + hq * 64 + 32 * half;
            v4u qq[4];
#pragma unroll
            for (int c = 0; c < 4; ++c) qq[c] = *(const v4u*)(pr + 8 * c);
            float qf[32]; float ss = 0.f;
#pragma unroll
            for (int c = 0; c < 4; ++c)
#pragma unroll
                for (int u = 0; u < 4; ++u) { qf[8 * c + 2 * u] = bf_lo(qq[c][u]); qf[8 * c + 2 * u + 1] = bf_hi(qq[c][u]); }
#pragma unroll
            for (int i = 0; i < 32; ++i) ss += qf[i] * qf[i];
            ss += __shfl_xor(ss, 1);
            const float rstd = 1.0f / sqrtf(ss * (1.0f / 64.0f) + 1e-6f);
#pragma unroll
            for (int c = 0; c < 4; ++c) {
                const f32x4 g0 = *(const f32x4*)(qnw + 32 * half + 8 * c), g1 = *(const f32x4*)(qnw + 32 * half + 8 * c + 4);
                *(LAS bf16x8*)(lds + LS_QN + row * RQ + (32 * half + 8 * c) * 2) = pack8(qf[8 * c] * rstd * g0[0], qf[8 * c + 1] * rstd * g0[1], qf[8 * c + 2] * rstd * g0[2], qf[8 * c + 3] * rstd * g0[3],
                                                                                      qf[8 * c + 4] * rstd * g1[0], qf[8 * c + 5] * rstd * g1[1], qf[8 * c + 6] * rstd * g1[2], qf[8 * c + 7] * rstd * g1[3]);
            }
        }
        __syncthreads();
        {
            const int hs = wave >> 2, ib = wave & 3, hq = kvh * 4 + rnd * 2 + hs;
            bf16x8 qf[4];
#pragma unroll
            for (int ks = 0; ks < 4; ++ks) qf[ks] = lds_frag16(lds + LS_QN + (hs * 128 + 32 * ib + l31) * RQ + (16 * ks + 8 * hf) * 2);
            f32x16 s[5];
#pragma unroll
            for (int t = 0; t < 5; ++t) {
#pragma unroll
                for (int i = 0; i < 16; ++i) s[t][i] = 0.f;
#pragma unroll
                for (int ks = 0; ks < 4; ++ks) s[t] = MFMA32(lds_frag16(lds + LS_KN + (32 * (ib + t) + l31) * RQ + (16 * ks + 8 * hf) * 2), qf[ks], s[t]);
            }
            const float sink = sinks[hq];
            float m = sink;
#pragma unroll
            for (int t = 0; t < 5; ++t)
#pragma unroll
                for (int i = 0; i < 16; ++i) {
                    bool ok = true;
                    if (t == 0) ok = crow(i, hf) > l31;
                    if (t == 4) ok = crow(i, hf) <= l31;
                    if (n == 0 && ib + t < 4) ok = false;
                    s[t][i] = ok ? s[t][i] : -INFINITY;
                    m = fmaxf(m, s[t][i]);
                }
            m = fmaxf(m, __shfl_xor(m, 32));
            float l = 0.f;
#pragma unroll
            for (int t = 0; t < 5; ++t)
#pragma unroll
                for (int i = 0; i < 16; ++i) { s[t][i] = exp2f((s[t][i] - m) * 1.4426950408889634f); l += s[t][i]; }
            l += __shfl_xor(l, 32);
            l += exp2f((sink - m) * 1.4426950408889634f);
            f32x16 o[2];
#pragma unroll
            for (int e2 = 0; e2 < 2; ++e2)
#pragma unroll
                for (int i = 0; i < 16; ++i) o[e2][i] = 0.f;
#pragma unroll
            for (int t = 0; t < 5; ++t)
#pragma unroll
                for (int st = 0; st < 2; ++st) {
                    const bf16x8 pf = pack8(s[t][8 * st], s[t][8 * st + 1], s[t][8 * st + 2], s[t][8 * st + 3], s[t][8 * st + 4], s[t][8 * st + 5], s[t][8 * st + 6], s[t][8 * st + 7]);
#pragma unroll
                    for (int e2 = 0; e2 < 2; ++e2) o[e2] = MFMA32(cat8(lds_tr4(lds + LS_VS, 32 * (ib + t) + 16 * st + 4 * hf, 32 * e2, lane), lds_tr4(lds + LS_VS, 32 * (ib + t) + 16 * st + 8 + 4 * hf, 32 * e2, lane)), pf, o[e2]);
                }
            const float inv = 1.0f / l;
            const size_t orow = (size_t)b * SQ + n * 128 + 32 * ib + l31;
#pragma unroll
            for (int e2 = 0; e2 < 2; ++e2)
#pragma unroll
                for (int g = 0; g < 4; ++g) { v2u w; w.x = pk2(o[e2][4 * g] * inv, o[e2][4 * g + 1] * inv); w.y = pk2(o[e2][4 * g + 2] * inv, o[e2][4 * g + 3] * inv);
                    *(v2u*)(MIXED + orow * D + 512 + hq * 64 + 32 * e2 + 8 * g + 4 * hf) = w; }
        }
        __syncthreads();
    }
}

__device__ __forceinline__ void p2_mixing(const Args& a, LAS unsigned char* lds, int bx, int G, int tid, int lane, int wave, int parts = 3) {
    const bf16* PROJ = (const bf16*)(a.ws + WS_R2); bf16* MIXED = (bf16*)(a.ws + WS_R1); const float* rope = (const float*)(a.ws + WS_ROPE);
    if (parts & 1) for (int u = bx; u < 256; u += G) {
        const int b = u >> 5, h = (u >> 2) & 7, grp = u & 3;
        const int c0 = grp == 0 ? 0 : grp == 1 ? 11 : grp == 2 ? 20 : 27, c1 = grp == 0 ? 11 : grp == 1 ? 20 : grp == 2 ? 27 : 32;
        ret_unit(PROJ, MIXED, rope, lds, b, h, c0, c1, tid, lane, wave);
    }
    if (parts & 2) for (int su = bx; su < 512; su += G) swa_unit(PROJ, MIXED, a.in[4], a.in[5], a.in[6], lds, su >> 6, (su >> 5) & 1, su & 31, tid, lane, wave);
}


template <int N> __device__ __forceinline__ void bitonic_sort_desc(float (&v)[N]) {
#pragma unroll
    for (int k = 2; k <= N; k <<= 1)
#pragma unroll
        for (int j = k >> 1; j > 0; j >>= 1)
#pragma unroll
            for (int i = 0; i < N; ++i) { const int l = i ^ j; if (l > i) { const bool desc = ((i & k) == 0); const float a = v[i], b = v[l]; const float hi = fmaxf(a, b), lo = fminf(a, b); v[i] = desc ? hi : lo; v[l] = desc ? lo : hi; } }
}
__device__ __forceinline__ void bitonic_merge16_desc(float (&v)[16]) {
#pragma unroll
    for (int j = 8; j > 0; j >>= 1)
#pragma unroll
        for (int i = 0; i < 16; ++i) { const int l = i ^ j; if (l > i) { const float a = v[i], b = v[l]; v[i] = fmaxf(a, b); v[l] = fminf(a, b); } }
}
__device__ __forceinline__ void top16_of_64(float (&v)[64], float (&out)[16]) {
    float b[4][16];
#pragma unroll
    for (int q = 0; q < 4; ++q) {
#pragma unroll
        for (int i = 0; i < 16; ++i) b[q][i] = v[16 * q + i];
        bitonic_sort_desc<16>(b[q]);
    }
    float t0[16], t1[16];
#pragma unroll
    for (int i = 0; i < 16; ++i) { t0[i] = fmaxf(b[0][i], b[1][15 - i]); t1[i] = fmaxf(b[2][i], b[3][15 - i]); }
    bitonic_merge16_desc(t0); bitonic_merge16_desc(t1);
#pragma unroll
    for (int i = 0; i < 16; ++i) out[i] = fmaxf(t0[i], t1[15 - i]);
    bitonic_merge16_desc(out);
}
__device__ __forceinline__ float dot2u(unsigned a, unsigned b, float c) { return __builtin_amdgcn_fdot2_f32_bf16(__builtin_bit_cast(b16x2, a), __builtin_bit_cast(b16x2, b), c, false); }
__device__ __forceinline__ float gelu_erf(float a) { return 0.5f * a * (1.0f + erff(a * 0.70710678118654752f)); }

constexpr int KROW = 272;
constexpr int LP_KEYS = 0, LP_LUT = LP_KEYS + 256 * KROW, LP_RSTD = LP_LUT + NWAVES * 32 * 32, LP_END = LP_RSTD + 4 * 128;
static_assert(LP_END <= RING_BYTES, "peer LDS");

__device__ __forceinline__ void p5a_topk(const Args& a, LAS unsigned char* lds, int vcu, int G, int tid, int lane, int wave PT_DECL) {
    unsigned char* ws = a.ws;
    const bf16* Q = (const bf16*)(ws + WS_R2 + 64 * MB); const bf16* XB1 = (const bf16*)(ws + WS_R2); unsigned char* H8 = ws + WS_R1; float* SH = (float*)(ws + WS_SH); const float* gffn = a.in[8];
    unsigned* PK = (unsigned*)(ws + WS_PK);
    const int l31 = lane & 31, hf = lane >> 5;
    for (int i = tid; i < 256 * 16; i += NTHR) { const int rr = i >> 4, c = i & 15; *(LAS v4u*)(lds + LP_KEYS + rr * KROW + c * 16) = *(const v4u*)((const bf16*)(ws + WS_KEYS) + rr * 128 + c * 8); }
    float gw[16];
    { const f32x4 g0 = *(const f32x4*)(gffn + 16 * lane), g1 = *(const f32x4*)(gffn + 16 * lane + 4), g2 = *(const f32x4*)(gffn + 16 * lane + 8), g3 = *(const f32x4*)(gffn + 16 * lane + 12);
#pragma unroll
      for (int u = 0; u < 4; ++u) { gw[u] = g0[u]; gw[4 + u] = g1[u]; gw[8 + u] = g2[u]; gw[12 + u] = g3[u]; } }
    { int gi = 0;
      for (int grp = vcu; grp < T / 32 && gi < 4; grp += G, ++gi) {
        const int t0 = grp * 32;
        {
            float xs[4][16];
#pragma unroll
            for (int q = 0; q < 4; ++q) {
                const bf16* xr = XB1 + ((size_t)t0 + 4 * wave + q) * D + 16 * lane;
                const v4u x0 = *(const v4u*)xr, x1 = *(const v4u*)(xr + 8);
#pragma unroll
                for (int u = 0; u < 4; ++u) { xs[q][2 * u] = bf_lo(x0[u]); xs[q][2 * u + 1] = bf_hi(x0[u]); xs[q][8 + 2 * u] = bf_lo(x1[u]); xs[q][8 + 2 * u + 1] = bf_hi(x1[u]); }
            }
            float ssq[4];
#pragma unroll
            for (int q = 0; q < 4; ++q) { float sq = 0.f;
#pragma unroll
                for (int u = 0; u < 16; ++u) sq += xs[q][u] * xs[q][u];
                ssq[q] = sq; }
#pragma unroll
            for (int o = 1; o < 64; o <<= 1)
#pragma unroll
                for (int q = 0; q < 4; ++q) ssq[q] += __shfl_xor(ssq[q], o);
            float am[4];
#pragma unroll
            for (int q = 0; q < 4; ++q) {
                const float rstd = 1.0f / sqrtf(ssq[q] * (1.0f / D) + 1e-6f);
                if (lane == 0) *(LAS float*)(lds + LP_RSTD + gi * 128 + (4 * wave + q) * 4) = rstd;
                float m = 0.f;
#pragma unroll
                for (int u = 0; u < 16; ++u) { xs[q][u] = xs[q][u] * rstd * gw[u]; m = fmaxf(m, fabsf(xs[q][u])); }
                am[q] = m;
            }
#pragma unroll
            for (int o = 1; o < 64; o <<= 1)
#pragma unroll
                for (int q = 0; q < 4; ++q) am[q] = fmaxf(am[q], __shfl_xor(am[q], o));
#pragma unroll
            for (int q = 0; q < 4; ++q) {
                const size_t tok = (size_t)t0 + 4 * wave + q;
                const float inv = am[q] > 0.f ? 127.0f / am[q] : 0.f;
                v4u w;
#pragma unroll
                for (int c = 0; c < 4; ++c) { unsigned ww = 0u;
#pragma unroll
                    for (int u = 0; u < 4; ++u) { const int qi = __float2int_rn(xs[q][4 * c + u] * inv); ww |= ((unsigned)qi & 0xffu) << (8 * u); }
                    w[c] = ww; }
                *(v4u*)(H8 + tok * D + 16 * lane) = w;
                if (lane == 0) SH[tok] = am[q] * (1.0f / 127.0f);
            }
        }
      }
    }
    __syncthreads();
    int gi = 0;
#pragma unroll 1
    for (int grp = vcu; grp < T / 32 && gi < 4; grp += G, ++gi) {
        const int t0 = grp * 32;
        PT_BEGIN();
        PT_ADD(0);
        {
            const int h = wave;
            float lst[2][16];
#pragma unroll
            for (int p = 0; p < 2; ++p) {
                const bf16* qrow = Q + (size_t)(t0 + l31) * NQ + h * 256 + p * 128 + 8 * hf;
                f32x16 acc[4];
#pragma unroll
                for (int q = 0; q < 4; ++q)
#pragma unroll
                    for (int i = 0; i < 16; ++i) acc[q][i] = 0.f;
#pragma unroll
                for (int ks = 0; ks < 8; ++ks) {
                    const bf16x8 qf = *(const bf16x8*)(qrow + 16 * ks);
#pragma unroll
                    for (int q = 0; q < 4; ++q) acc[q] = MFMA32(lds_frag16(lds + LP_KEYS + (p * 128 + 32 * q + l31) * KROW + (16 * ks + 8 * hf) * 2), qf, acc[q]);
                }
                float v[64];
#pragma unroll
                for (int q = 0; q < 4; ++q)
#pragma unroll
                    for (int i = 0; i < 16; ++i) v[16 * q + i] = __uint_as_float((__float_as_uint(acc[q][i]) & 0xffffff80u) | (unsigned)(32 * q + crow(i, hf)));
                float mine[16];
                top16_of_64(v, mine);
                float t[16];
#pragma unroll
                for (int i = 0; i < 16; ++i) t[i] = __shfl_xor(mine[i], 32);
#pragma unroll
                for (int i = 0; i < 16; ++i) lst[p][i] = fmaxf(mine[i], t[15 - i]);
                bitonic_merge16_desc(lst[p]);
            }
            PT_ADD(1);
            LAS unsigned char* lut = lds + LP_LUT + wave * 1024 + l31 * 32;
            {
                v4u wa, wb;
#pragma unroll
                for (int c = 0; c < 4; ++c) {
                    wa[c] = (__float_as_uint(lst[0][4 * c]) & 0x7fu) | ((__float_as_uint(lst[0][4 * c + 1]) & 0x7fu) << 8) | ((__float_as_uint(lst[0][4 * c + 2]) & 0x7fu) << 16) | ((__float_as_uint(lst[0][4 * c + 3]) & 0x7fu) << 24);
                    wb[c] = (__float_as_uint(lst[1][4 * c]) & 0x7fu) | ((__float_as_uint(lst[1][4 * c + 1]) & 0x7fu) << 8) | ((__float_as_uint(lst[1][4 * c + 2]) & 0x7fu) << 16) | ((__float_as_uint(lst[1][4 * c + 3]) & 0x7fu) << 24);
                }
                if (hf == 0) { *(LAS v4u*)lut = wa; *(LAS v4u*)(lut + 16) = wb; }
            }
            float cv[64];
            {
                int c = 0;
#pragma unroll
                for (int i = 0; i < 16; ++i)
#pragma unroll
                    for (int j = 0; j < 16; ++j)
                        if ((i + 1) * (j + 1) <= 16) {
                            const float sa = __uint_as_float(__float_as_uint(lst[0][i]) & 0xffffff80u), sb = __uint_as_float(__float_as_uint(lst[1][j]) & 0xffffff80u);
                            cv[c] = __uint_as_float((__float_as_uint(sa + sb) & 0xffffff00u) | (unsigned)(i * 16 + j)); ++c;
                        }
#pragma unroll
                for (int k = 50; k < 64; ++k) cv[k] = -3.0e38f;
            }
            float best[16];
            top16_of_64(cv, best);
            const float rstd = *(const LAS float*)(lds + LP_RSTD + gi * 128 + l31 * 4);
            const float s0 = __uint_as_float(__float_as_uint(best[0]) & 0xffffff00u);
            float ev[16], esum = 0.f;
#pragma unroll
            for (int k = 0; k < 16; ++k) { const float sk = __uint_as_float(__float_as_uint(best[k]) & 0xffffff00u); ev[k] = __expf(rstd * (sk - s0)); esum += ev[k]; }
            const float einv = 1.0f / esum;
            LDS_WAIT();
            asm volatile("" ::: "memory");
            {
                const size_t ob = (size_t)(t0 + l31) * 128 + h * 16 + 8 * hf;
                unsigned e8[8];
                const unsigned hm = hf ? 0xffffffffu : 0u;
#pragma unroll
                for (int j = 0; j < 8; ++j) { const unsigned code = ((__float_as_uint(best[8 + j]) & hm) | (__float_as_uint(best[j]) & ~hm)) & 0xffu;
                    const float gk = __uint_as_float((__float_as_uint(ev[8 + j]) & hm) | (__float_as_uint(ev[j]) & ~hm)) * einv;
                    const unsigned ia = *(const LAS unsigned char*)(lut + (code >> 4)), ib = *(const LAS unsigned char*)(lut + 16 + (code & 15u));
                    e8[j] = (ia * 128u + ib) | (pk2(0.f, gk) & 0xffff0000u); }
                *(v4u*)(PK + ob) = (v4u){e8[0], e8[1], e8[2], e8[3]}; *(v4u*)(PK + ob + 4) = (v4u){e8[4], e8[5], e8[6], e8[7]};
            }
            PT_ADD(2);
        }
    }
    __syncthreads();
}

constexpr int LB_H = 0, LB_LIST = LB_H + NWAVES * 4096, LB_GATE = LB_LIST + NWAVES * 2304, LB_END = LB_GATE + NWAVES * 2048;
static_assert(LB_END <= RING_BYTES, "p5b LDS");
struct B5Batch { v4u ur[16]; unsigned entv, em; float scl, svl; };
__device__ __forceinline__ void b5_issue(B5Batch& b, const LAS unsigned* list, int bt, const unsigned char* U8, const float* SU, const float* SV, int lane, int jmine) {
    b.entv = list[16 * bt + (lane & 15)]; b.em = list[16 * bt + jmine];
#pragma unroll
    for (int j = 0; j < 16; ++j) { const unsigned ent = __builtin_amdgcn_readlane(b.entv, j); b.ur[j] = *(const v4u*)(U8 + (size_t)(ent & 0xffffu) * D + 16 * lane); }
    const unsigned ee = b.em & 0xffffu; b.scl = SU[ee]; b.svl = SV[ee];
}
__device__ __forceinline__ void b5_compute(const B5Batch& b, LAS unsigned char* hreg, const LAS float* gts, float shv, unsigned* PK, int tok0, int lane) {
    int d[16];
#pragma unroll
    for (int j = 0; j < 16; ++j) {
        const unsigned ent = __builtin_amdgcn_readlane(b.entv, j);
        const v4u hh = *(const LAS v4u*)(hreg + ((ent >> 28) & 3u) * 1024 + lane * 16);
        int acc = 0;
#pragma unroll
        for (int u = 0; u < 4; ++u) { const unsigned wa = b.ur[j][u], ha = hh[u]; acc = __builtin_amdgcn_sdot4((int)ha, (int)wa, acc, false); }
        d[j] = acc;
    }
    int d8[8], d4[4], d2[2], d1;
    { const bool hi = (lane & 32) != 0;
#pragma unroll
      for (int j = 0; j < 8; ++j) { const int keep = hi ? d[j + 8] : d[j], send = hi ? d[j] : d[j + 8]; d8[j] = keep + __shfl_xor(send, 32); } }
    { const bool hi = (lane & 16) != 0;
#pragma unroll
      for (int j = 0; j < 4; ++j) { const int keep = hi ? d8[j + 4] : d8[j], send = hi ? d8[j] : d8[j + 4]; d4[j] = keep + __shfl_xor(send, 16); } }
    { const bool hi = (lane & 8) != 0;
#pragma unroll
      for (int j = 0; j < 2; ++j) { const int keep = hi ? d4[j + 2] : d4[j], send = hi ? d4[j] : d4[j + 2]; d2[j] = keep + __shfl_xor(send, 8); } }
    { const bool hi = (lane & 4) != 0; const int keep = hi ? d2[1] : d2[0], send = hi ? d2[0] : d2[1]; d1 = keep + __shfl_xor(send, 4); }
    d1 += __shfl_xor(d1, 1); d1 += __shfl_xor(d1, 2);
    const unsigned eslot = b.em >> 28, ek = (b.em >> 16) & 0xffu;
    const float sht = __shfl(shv, (int)(eslot & 3u));
    const float dot = (float)d1 * b.scl * sht;
    if ((lane & 3) == 0 && eslot < 4u) ((unsigned short*)(PK + ((size_t)tok0 + eslot) * 128 + ek))[1] = (unsigned short)(pk2(0.f, gelu_erf(dot) * gts[eslot * 128 + ek] * b.svl) >> 16);
}
struct B5Pre { v2u pk[4]; v4u h0[4]; float shv; };
__device__ __forceinline__ void b5_prefetch(B5Pre& p, const unsigned* PK, const unsigned char* H8, const float* SH, int tok0, int lane) {
#pragma unroll
    for (int s = 0; s < 4; ++s) { const size_t tok = (size_t)tok0 + s;
        p.pk[s] = *(const v2u*)(PK + tok * 128 + 2 * lane); p.h0[s] = *(const v4u*)(H8 + tok * D + 16 * lane); }
    p.shv = SH[tok0 + (lane & 3)];
}
__device__ __forceinline__ void p5b_dots(const Args& a, LAS unsigned char* lds, int bx, int G, int tid, int lane, int wave) {
    unsigned char* ws = a.ws;
    const unsigned char* H8 = ws + WS_R1; const unsigned char* U8 = ws + WS_UB; const float* SU = (const float*)(ws + WS_SU); const float* SV = (const float*)(ws + WS_SV); const float* SH = (const float*)(ws + WS_SH);
    unsigned* PK = (unsigned*)(ws + WS_PK);
    LAS unsigned char* hreg = lds + LB_H + wave * 4096; LAS unsigned* list = (LAS unsigned*)(lds + LB_LIST + wave * 2304); LAS float* gts = (LAS float*)(lds + LB_GATE + wave * 2048);
    const int jmine = ((lane >> 5) & 1) * 8 + ((lane >> 4) & 1) * 4 + ((lane >> 3) & 1) * 2 + ((lane >> 2) & 1);
    const unsigned long long ltmask = (1ull << lane) - 1ull;
    for (int vb = bx; vb < 256; vb += G) {
        const unsigned vx = (unsigned)(vb & 7); const int wi = vb >> 3;
        const int tw0 = wi * 1024 + wave * 128;
        B5Pre P;
        b5_prefetch(P, PK, H8, SH, tw0, lane);
#pragma unroll 1
        for (int ch = 0; ch < 32; ++ch) {
            const int tok0 = tw0 + 4 * ch;
            int n = 0;
            const float shv = P.shv;
#pragma unroll
            for (int s = 0; s < 4; ++s) {
                *(LAS v4u*)(hreg + s * 1024 + lane * 16) = P.h0[s];
                *(LAS f32x2*)(gts + s * 128 + 2 * lane) = (f32x2){bf_hi(P.pk[s].x), bf_hi(P.pk[s].y)};
                const unsigned id0 = P.pk[s].x & 0xffffu, id1 = P.pk[s].y & 0xffffu;
                const bool in0 = (id0 >> 11) == vx, in1 = (id1 >> 11) == vx;
                const unsigned long long m0 = __ballot(in0), m1 = __ballot(in1);
                const int c0 = __popcll(m0), c1 = __popcll(m1);
                if (in0) list[n + __popcll(m0 & ltmask)] = ((unsigned)s << 28) | ((unsigned)(2 * lane) << 16) | id0;
                if (in1) list[n + c0 + __popcll(m1 & ltmask)] = ((unsigned)s << 28) | ((unsigned)(2 * lane + 1) << 16) | id1;
                n += c0 + c1;
            }
            const int nb = (n + 15) >> 4;
            if (lane < 16) list[n + lane] = (0xfu << 28) | (vx << 11);
            if (ch + 1 < 32) b5_prefetch(P, PK, H8, SH, tok0 + 4, lane);
            LDS_WAIT(); asm volatile("" ::: "memory");
            B5Batch A, B;
            if (nb > 0) b5_issue(A, list, 0, U8, SU, SV, lane, jmine);
#pragma unroll 1
            for (int bt = 0; bt < nb; bt += 2) {
                if (bt + 1 < nb) b5_issue(B, list, bt + 1, U8, SU, SV, lane, jmine);
                b5_compute(A, hreg, gts, shv, PK, tok0, lane);
                if (bt + 1 < nb) {
                    if (bt + 2 < nb) b5_issue(A, list, bt + 2, U8, SU, SV, lane, jmine);
                    b5_compute(B, hreg, gts, shv, PK, tok0, lane);
                }
            }
        }
    }
}

constexpr int LC_BUF = 0, LC_END = NWAVES * 2 * 1024;
struct C5Tok { v4u vv[16]; unsigned xa; float sa; };
__device__ __forceinline__ float c5_stage(LAS unsigned char* buf, v2u pk, int lane) {
    const unsigned idw = (pk.x & 0xffffu) | (pk.y << 16); const f32x2 av = {bf_hi(pk.x), bf_hi(pk.y)};
    float am = fmaxf(fabsf(av[0]), fabsf(av[1]));
#pragma unroll
    for (int o = 1; o < 64; o <<= 1) am = fmaxf(am, __shfl_xor(am, o));
    const float inv = am > 0.f ? 127.0f / am : 0.f;
    const int q0 = __float2int_rn(av[0] * inv), q1 = __float2int_rn(av[1] * inv);
    *(LAS unsigned*)(buf + 4 * lane) = idw;
    const int k0 = 2 * lane, k1 = 2 * lane + 1;
    *(LAS unsigned char*)(buf + 256 + (k0 & 7) * 16 + (k0 >> 3)) = (unsigned char)q0;
    *(LAS unsigned char*)(buf + 256 + (k1 & 7) * 16 + (k1 >> 3)) = (unsigned char)q1;
    return am * (1.0f / 127.0f);
}
__device__ __forceinline__ void c5_issue(C5Tok& t, LAS unsigned char* buf, const unsigned char* vbase, const bf16* xr, int g) {
#pragma unroll
    for (int j = 0; j < 16; ++j) {
        const int k = 8 * j + g;
        const unsigned e = *(const LAS unsigned short*)(buf + 2 * k);
        t.vv[j] = *(const v4u*)(vbase + (size_t)e * 128);
    }
    t.xa = *(const unsigned*)xr;
}
__device__ __forceinline__ void c5_finish(const C5Tok& t, LAS unsigned char* buf, bf16* xb, float* rss, int lane, int g) {
    int y[16];
#pragma unroll
    for (int u = 0; u < 16; ++u) y[u] = 0;
#pragma unroll
    for (int q = 0; q < 4; ++q) {
        const int a4 = (int)*(const LAS unsigned*)(buf + 256 + g * 16 + 4 * q);
#pragma unroll
        for (int u = 0; u < 4; ++u) {
            const unsigned r0 = t.vv[4 * q][u], r1 = t.vv[4 * q + 1][u], r2 = t.vv[4 * q + 2][u], r3 = t.vv[4 * q + 3][u];
            const unsigned lo01 = __builtin_amdgcn_perm(r1, r0, 0x05010400u), hi01 = __builtin_amdgcn_perm(r1, r0, 0x07030602u);
            const unsigned lo23 = __builtin_amdgcn_perm(r3, r2, 0x05010400u), hi23 = __builtin_amdgcn_perm(r3, r2, 0x07030602u);
            const unsigned t0 = __builtin_amdgcn_perm(lo23, lo01, 0x05040100u), t1 = __builtin_amdgcn_perm(lo23, lo01, 0x07060302u);
            const unsigned t2 = __builtin_amdgcn_perm(hi23, hi01, 0x05040100u), t3 = __builtin_amdgcn_perm(hi23, hi01, 0x07060302u);
            y[4 * u] = __builtin_amdgcn_sdot4((int)t0, a4, y[4 * u], false); y[4 * u + 1] = __builtin_amdgcn_sdot4((int)t1, a4, y[4 * u + 1], false);
            y[4 * u + 2] = __builtin_amdgcn_sdot4((int)t2, a4, y[4 * u + 2], false); y[4 * u + 3] = __builtin_amdgcn_sdot4((int)t3, a4, y[4 * u + 3], false);
        }
    }
    int y8[8], y4[4], y2[2];
    { const bool hi = (lane & 32) != 0;
#pragma unroll
      for (int u = 0; u < 8; ++u) { const int keep = hi ? y[u + 8] : y[u], send = hi ? y[u] : y[u + 8]; y8[u] = keep + __shfl_xor(send, 32); } }
    { const bool hi = (lane & 16) != 0;
#pragma unroll
      for (int u = 0; u < 4; ++u) { const int keep = hi ? y8[u + 4] : y8[u], send = hi ? y8[u] : y8[u + 4]; y4[u] = keep + __shfl_xor(send, 16); } }
    { const bool hi = (lane & 8) != 0;
#pragma unroll
      for (int u = 0; u < 2; ++u) { const int keep = hi ? y4[u + 2] : y4[u], send = hi ? y4[u] : y4[u + 2]; y2[u] = keep + __shfl_xor(send, 8); } }
    const float o0 = bf_lo(t.xa) + (float)y2[0] * t.sa, o1 = bf_hi(t.xa) + (float)y2[1] * t.sa;
    const float ss = wave_sum(o0 * o0 + o1 * o1);
    *(unsigned*)xb = pk2(o0, o1);
    if (lane == 0) *rss = ss;
}
__device__ __forceinline__ void p5c_axpy(const Args& a, LAS unsigned char* lds, int bx, int G, int tid, int lane, int wave) {
    unsigned char* ws = a.ws;
    const unsigned char* V8 = ws + WS_VB; const unsigned* PK = (const unsigned*)(ws + WS_PK);
    const bf16* XB1 = (const bf16*)(ws + WS_R2); bf16* XB2 = (bf16*)(ws + WS_R1); float* RSS2 = (float*)(ws + WS_RSS2);
    const int g = lane >> 3, c = lane & 7;
    const int colo = 16 * c + 8 * ((g >> 2) & 1) + 4 * ((g >> 1) & 1) + 2 * (g & 1);
    LAS unsigned char* buf0 = lds + LC_BUF + wave * 2048; LAS unsigned char* buf1 = buf0 + 1024;
    for (int vb = bx; vb < 256; vb += G) {
        const int vx = vb & 7, wi = vb >> 3;
        const size_t tw0 = (size_t)wi * 1024 + wave * 128;
        const unsigned char* vbase = V8 + (size_t)vx * ((size_t)NEXP * 128) + 16 * c;
        const bf16* xcol = XB1 + vx * 128 + colo; bf16* xbcol = XB2 + vx * 128 + colo;
        C5Tok A, B;
        v2u pk = *(const v2u*)(PK + tw0 * 128 + 2 * lane);
        A.sa = c5_stage(buf0, pk, lane);
        pk = *(const v2u*)(PK + (tw0 + 1) * 128 + 2 * lane);
        LDS_WAIT(); asm volatile("" ::: "memory");
        c5_issue(A, buf0, vbase, xcol + tw0 * D, g);
#pragma unroll 1
        for (int i = 0; i < 128; i += 2) {
            const size_t tok = tw0 + i;
            B.sa = c5_stage(buf1, pk, lane);
            if (i + 2 < 128) pk = *(const v2u*)(PK + (tok + 2) * 128 + 2 * lane);
            LDS_WAIT(); asm volatile("" ::: "memory");
            c5_issue(B, buf1, vbase, xcol + (tok + 1) * D, g);
            c5_finish(A, buf0, xbcol + tok * D, RSS2 + tok * 8 + vx, lane, g);
            if (i + 2 < 128) {
                A.sa = c5_stage(buf0, pk, lane);
                if (i + 3 < 128) pk = *(const v2u*)(PK + (tok + 3) * 128 + 2 * lane);
                LDS_WAIT(); asm volatile("" ::: "memory");
                c5_issue(A, buf0, vbase, xcol + (tok + 2) * D, g);
            }
            c5_finish(B, buf1, xbcol + (tok + 1) * D, RSS2 + (tok + 1) * 8 + vx, lane, g);
        }
    }
}

__global__ void __launch_bounds__(NTHR, 2) mk_fwd(Args a) {
    extern __shared__ __attribute__((aligned(16))) unsigned char lds_raw[];
    LAS unsigned char* lds = (LAS unsigned char*)lds_raw;
    const int tid = threadIdx.x, lane = tid & 63, wave = __builtin_amdgcn_readfirstlane(tid >> 6);
    const int G = gridDim.x, bx = blockIdx.x, vcu = (G % 8 == 0) ? (bx % 8) * (G / 8) + bx / 8 : bx;
    volatile LAS unsigned* MISC = (volatile LAS unsigned*)(lds + MISC_OFF);
    if (tid < 64) MISC[tid] = 0u;
    __syncthreads();
    unsigned char* ws = a.ws;
    const int lo = a.ph_lo, hi = a.ph_hi;
    XcdBarrier bar; bar.bar = (unsigned*)(ws + WS_CTL) + CW_BAR + a.li * XCD_BAR_WORDS; bar.x = 0; bar.st = nullptr;
    if (hi - lo > 1) bar = xcd_barrier_post((unsigned*)(ws + WS_CTL) + CW_BAR + a.li * XCD_BAR_WORDS, MISC + 8);
#define IN(k) (lo <= (k) && (k) < hi)
#define BOTH(k) (IN(k) && IN((k) + 1))
    if (IN(0)) { p0_prologue(a, lds, vcu, G, tid, lane, wave); if (BOTH(0)) xcd_barrier(bar); }
    if (IN(1)) {
        { pg8::Gemm g{(const bf16*)(ws + WS_R1), (const bf16*)(ws + WS_WIN), T, NIN, D}; pg8::StaticOrder S; S.init(T, NIN, G, bx);
          EpiStoreBf16 E{(bf16*)(ws + WS_R2), NIN};
          pg8::gemm_phase<EpiStoreBf16, pg8::StaticOrder, true, true>(lds, g, S, E); }
        { pg8::Gemm g{(const bf16*)(ws + WS_PB), (const bf16*)(ws + WS_WP), T, D, PLE}; pg8::StaticOrder S; S.init(T, D, G, bx);
          EpiStoreBf16 E{(bf16*)(ws + WS_PP), D};
          pg8::gemm_phase<EpiStoreBf16, pg8::StaticOrder, true, true>(lds, g, S, E); }
        if (BOTH(1)) xcd_barrier(bar);
    }
    if (IN(2)) { p2_mixing(a, lds, bx, G, tid, lane, wave); if (BOTH(2)) xcd_barrier(bar); }
    if (IN(3)) {
        pg8::Gemm g{(const bf16*)(ws + WS_R1), (const bf16*)(ws + WS_WOUT), T, D, D}; pg8::StaticOrder S; S.init(T, D, G, bx);
        EpiResid E{a.in[0], (bf16*)(ws + WS_R2)};
        pg8::gemm_phase<EpiResid, pg8::StaticOrder, true, true>(lds, g, S, E);
        if (BOTH(3)) xcd_barrier(bar);
    }
    if (IN(4)) {
        pg8::Gemm g{(const bf16*)(ws + WS_R2), (const bf16*)(ws + WS_WQ), T, NQ, D}; pg8::StaticOrder S; S.init(T, NQ, G, bx);
        EpiStoreBf16 E{(bf16*)(ws + WS_R2 + 64 * MB), NQ};
        pg8::gemm_phase<EpiStoreBf16, pg8::StaticOrder, true, true>(lds, g, S, E);
        if (BOTH(4)) xcd_barrier(bar);
    }
    if (IN(5)) {
        p5a_topk(a, lds, vcu, G, tid, lane, wave PT_ARG); xcd_barrier(bar);
        p5b_dots(a, lds, bx, G, tid, lane, wave); xcd_barrier(bar);
        p5c_axpy(a, lds, bx, G, tid, lane, wave);
        if (BOTH(5)) xcd_barrier(bar);
    }
    if (IN(6)) {
        pg8::Gemm g{(const bf16*)(ws + WS_R1), (const bf16*)(ws + WS_WG), T, D, D}; pg8::StaticOrder S; S.init(T, D, G, bx);
        EpiGate E{a.out, (const bf16*)(ws + WS_R1), (const bf16*)(ws + WS_PP), (const float*)(ws + WS_RSS2)};
        pg8::gemm_phase<EpiGate, pg8::StaticOrder, true, true>(lds, g, S, E);
    }
#undef IN
#undef BOTH
}
}
extern "C" void kernel_launch(void* const* d_in, const int* in_sizes, int n_in, void* d_out, int out_size, void* d_ws, size_t ws_size, hipStream_t stream) {
    using namespace mk;
    static int grid = 0;
    if (grid == 0) {
        int dev = 0, cus = 0;
        if (n_in != 16 || out_size != T * D || ws_size < WS_END) { fprintf(stderr, "kernel_launch: unexpected problem shape / workspace (%d inputs, out %d, ws %zu)\n", n_in, out_size, ws_size); grid = -1; return; }
        if (hipGetDevice(&dev) != hipSuccess || hipDeviceGetAttribute(&cus, hipDeviceAttributeMultiprocessorCount, dev) != hipSuccess) { fprintf(stderr, "device query failed\n"); grid = -1; return; }
        if (hipFuncSetAttribute((const void*)mk_fwd, hipFuncAttributeMaxDynamicSharedMemorySize, LDS_BYTES) != hipSuccess) { fprintf(stderr, "hipFuncSetAttribute failed\n"); grid = -1; return; }
        int per_cu = 0;
        if (hipOccupancyMaxActiveBlocksPerMultiprocessor(&per_cu, (const void*)mk_fwd, NTHR, LDS_BYTES) != hipSuccess || per_cu < 1) { fprintf(stderr, "occupancy query: %d blocks per CU\n", per_cu); (void)hipGetLastError(); }
        if (cus < 256) { fprintf(stderr, "kernel_launch: this kernel is laid out for a 256-CU device (found %d CUs)\n", cus); grid = -1; return; }
        grid = 256;
    }
    if (grid < 0) return;
    unsigned char* ws = (unsigned char*)d_ws;
    (void)hipMemsetAsync(ws + WS_CTL, 0, CTL_BYTES, stream);
    Args a{};
    for (int i = 0; i < 16; ++i) a.in[i] = (const float*)d_in[i];
    a.out = (float*)d_out; a.ws = ws; a.ph_lo = 0; a.ph_hi = 7; a.li = 0; a.pad = 0;
    hipLaunchKernelGGL(mk_fwd, dim3(grid), dim3(NTHR), LDS_BYTES, stream, a);
}
```

```cpp
#include <hip/hip_runtime.h>
#include <cstdio>
#include <cstdint>
#define LAS __attribute__((address_space(3)))
#define GAS __attribute__((address_space(1)))
namespace pg8 {
#define PG8_LAS __attribute__((address_space(3)))
typedef unsigned short bf16_t;
typedef short bf16x8 __attribute__((ext_vector_type(8)));
typedef float f32x4 __attribute__((ext_vector_type(4)));
typedef unsigned u32x4 __attribute__((ext_vector_type(4)));
constexpr int BM = 256, BK = 64, HALF = 128, HTB = HALF * BK * 2  , STAGE_BYTES = 8 * HTB, NXCD = 8, WGM = 8;

__host__ __device__ __forceinline__ int lds_byte(int r, int c) { const int st = (r >> 4) * 2 + (c >> 5), rr = r & 15, cc = c & 31, ob = rr * 64 + cc * 2; return st * 1024 + (ob ^ (((ob >> 9) & 1) << 5)); }
__host__ __device__ __forceinline__ void stage_rc(int b, int& R, int& C) { const int st = b / 1024, sb = b % 1024, swz = sb ^ (((sb >> 9) & 1) << 5); R = (st >> 1) * 16 + swz / 64; C = (st & 1) * 32 + (swz % 64) / 2; }
__host__ __device__ __forceinline__ int perm32(int rho) { const int n = rho >> 4, i = rho & 15; return 8 * (i >> 2) + 4 * n + (i & 3); }

struct Unit { int pm, pn; };
struct Gemm { const bf16_t* A; const bf16_t* Bt; int M, N, K; };

struct StaticOrder {
    int nM, nN, nwg, G, c;
    __host__ __device__ void init(int M, int N, int G_, int c_) { nM = M / BM; nN = N / BM; nwg = nM * nN; G = G_; c = c_; }
    __host__ __device__ bool next(int i, Unit& u) const {
        const long L = (long)i * G + c; if (L >= nwg) return false;
        int wgid = (int)L; { const int q = nwg / NXCD, r = nwg % NXCD, xcd = wgid % NXCD, off = wgid / NXCD; wgid = (xcd < r ? xcd * (q + 1) : r * (q + 1) + (xcd - r) * q) + off; }
        const int nig = WGM * nN, gid = wgid / nig, fm = gid * WGM, gsz = (nM - fm) < WGM ? (nM - fm) : WGM;
        u.pm = fm + ((wgid % nig) % gsz); u.pn = (wgid % nig) / gsz; return true;
    }
    __device__ __forceinline__ void a_ready(const Unit&) const {}
    __device__ __forceinline__ void done(const Unit&) const {}
};
__device__ __forceinline__ unsigned cvt_pk_bf16(float lo, float hi) { unsigned r; asm volatile("v_cvt_pk_bf16_f32 %0, %1, %2" : "=v"(r) : "v"(lo), "v"(hi)); return r; }
template <class Epi, class Sched, bool ALIGN_EPI = false, bool SP2 = false>
__device__ __forceinline__ void gemm_phase(PG8_LAS unsigned char* lds, const Gemm g, const Sched& S, const Epi& E) {
    const int tid = threadIdx.x, wid = __builtin_amdgcn_readfirstlane(tid >> 6), lane = tid & 63, wr = wid >> 2, wc = wid & 3, fr = lane & 15, fq = lane >> 4;
    const int K = g.K, nt = K / BK;
    unsigned voffA[2], voffB[2];
#pragma unroll
    for (int i = 0; i < 2; ++i) { int R, C; stage_rc(tid * 16 + i * 8192, R, C); const int Rb = Epi::PERM ? ((R & ~31) + perm32(R & 31)) : R;
        voffA[i] = (unsigned)(R * K + C) * 2u; voffB[i] = (unsigned)(Rb * K + C) * 2u; }
    const size_t kstep = (size_t)(BK * 2);
    const size_t hstep = (size_t)HALF * K * 2;
    const size_t tstep = 2 * hstep;
    const unsigned ldsw = (unsigned)wid * 1024u;
    const int aoff = lds_byte(wr * 64 + fr, fq * 8), boff = lds_byte(wc * 32 + fr, fq * 8);
#define PG8_SA(b, h) (((b) * 2 + (h)) * HTB)
#define PG8_SB(b, h) ((4 + (b) * 2 + (h)) * HTB)
#define PG8_STAGE(bufoff, gbase, voff) do { _Pragma("unroll") for (int _i = 0; _i < 2; ++_i) \
        __builtin_amdgcn_global_load_lds((const unsigned*)((const char*)(gbase) + (voff)[_i]), (PG8_LAS unsigned*)(lds + (bufoff) + ldsw + _i * 8192), 16, 0, 0); } while (0)
#define PG8_LDA(dst, b, h) do { _Pragma("unroll") for (int m = 0; m < 4; ++m) _Pragma("unroll") for (int k = 0; k < 2; ++k) dst[m][k] = *(const PG8_LAS bf16x8*)(lds + PG8_SA(b, h) + aoff + m * 2048 + k * 1024); } while (0)
#define PG8_LDB(dst, b, h) do { _Pragma("unroll") for (int n = 0; n < 2; ++n) _Pragma("unroll") for (int k = 0; k < 2; ++k) dst[n][k] = *(const PG8_LAS bf16x8*)(lds + PG8_SB(b, h) + boff + n * 2048 + k * 1024); } while (0)
#define PG8_MMA(ai, bj, At, Bt) do { __builtin_amdgcn_s_setprio(1); _Pragma("unroll") for (int m = 0; m < 4; ++m) _Pragma("unroll") for (int n = 0; n < 2; ++n) _Pragma("unroll") for (int k = 0; k < 2; ++k) \
        acc[ai][bj][m][n] = __builtin_amdgcn_mfma_f32_16x16x32_bf16(Bt[n][k], At[m][k], acc[ai][bj][m][n], 0, 0, 0); __builtin_amdgcn_s_setprio(0); } while (0)
#define PG8_WAIT_V(n) asm volatile("s_waitcnt vmcnt(" #n ")" ::: "memory")
#define PG8_WAIT_L(n) asm volatile("s_waitcnt lgkmcnt(" #n ")" ::: "memory")
#define PG8_BAR __builtin_amdgcn_s_barrier()
#define PG8_SCHED __builtin_amdgcn_sched_barrier(0)
    Unit cur, nxt; int ui = 0;
    if (!S.next(0, cur)) return;
    f32x4 acc[2][2][4][2];
#pragma unroll
    for (int a = 0; a < 2; ++a)
#pragma unroll
        for (int b = 0; b < 2; ++b)
#pragma unroll
            for (int m = 0; m < 4; ++m)
#pragma unroll
                for (int n = 0; n < 2; ++n) acc[a][b][m][n] = (f32x4){0.f, 0.f, 0.f, 0.f};
    bf16x8 At[4][2], B0[2][2], B1[2][2];
    const char* cA = (const char*)g.A + (size_t)cur.pm * tstep; const char* cB = (const char*)g.Bt + (size_t)cur.pn * tstep;
    S.a_ready(cur);
    if constexpr (SP2) {
        PG8_STAGE(PG8_SB(0, 0), cB, voffB); PG8_STAGE(PG8_SB(0, 1), cB + hstep, voffB); PG8_STAGE(PG8_SA(0, 0), cA, voffA); PG8_STAGE(PG8_SA(0, 1), cA + hstep, voffA);
        if (wr == 1) PG8_BAR;
        PG8_WAIT_V(2); PG8_BAR;
        PG8_STAGE(PG8_SB(1, 0), cB + kstep, voffB); PG8_STAGE(PG8_SA(1, 0), cA + kstep, voffA); PG8_STAGE(PG8_SB(1, 1), cB + hstep + kstep, voffB);
        PG8_WAIT_V(6); PG8_BAR;
    } else {
        PG8_STAGE(PG8_SB(0, 0), cB, voffB); PG8_STAGE(PG8_SA(0, 0), cA, voffA); PG8_STAGE(PG8_SB(0, 1), cB + hstep, voffB); PG8_STAGE(PG8_SA(0, 1), cA + hstep, voffA);
        if (wr == 1) PG8_BAR;
        PG8_WAIT_V(4); PG8_BAR;
        PG8_STAGE(PG8_SB(1, 0), cB + kstep, voffB); PG8_STAGE(PG8_SA(1, 0), cA + kstep, voffA); PG8_STAGE(PG8_SB(1, 1), cB + hstep + kstep, voffB);
        PG8_WAIT_V(6); PG8_BAR;
    }
    for (;;) {
        const bool has_next = S.next(ui + 1, nxt);
        const char* nA = has_next ? (const char*)g.A + (size_t)nxt.pm * tstep : cA; const char* nB = has_next ? (const char*)g.Bt + (size_t)nxt.pn * tstep : cB;
        for (int t = 0; t < nt; t += 2) {
            const bool last = (t == nt - 2);
            const char* a1 = cA + (size_t)(t + 1) * kstep;
            const char* a2 = last ? nA : cA + (size_t)(t + 2) * kstep; const char* b2 = last ? nB : cB + (size_t)(t + 2) * kstep;
            const char* a3 = a2 + kstep; const char* b3 = b2 + kstep;
            if (last && has_next) S.a_ready(nxt);
            if constexpr (SP2) {
            PG8_LDB(B0, 0, 0); PG8_LDB(B1, 0, 1); PG8_SCHED; PG8_LDA(At, 0, 0); PG8_STAGE(PG8_SA(1, 1), a1 + hstep, voffA);
            PG8_WAIT_V(8); PG8_WAIT_L(0); PG8_BAR; PG8_MMA(0, 0, At, B0); PG8_MMA(0, 1, At, B1); PG8_BAR; PG8_SCHED;
            PG8_LDA(At, 0, 1); PG8_STAGE(PG8_SB(0, 0), b2, voffB); PG8_STAGE(PG8_SB(0, 1), b2 + hstep, voffB); PG8_STAGE(PG8_SA(0, 0), a2, voffA);
            PG8_WAIT_V(8); PG8_WAIT_L(0); PG8_BAR; PG8_MMA(1, 0, At, B0); PG8_MMA(1, 1, At, B1); PG8_BAR; PG8_SCHED;
            PG8_LDB(B0, 1, 0); PG8_LDB(B1, 1, 1); PG8_SCHED; PG8_LDA(At, 1, 0); PG8_STAGE(PG8_SA(0, 1), a2 + hstep, voffA);
            PG8_WAIT_V(8); PG8_WAIT_L(0); PG8_BAR; PG8_MMA(0, 0, At, B0); PG8_MMA(0, 1, At, B1); PG8_BAR; PG8_SCHED;
            PG8_LDA(At, 1, 1); PG8_STAGE(PG8_SB(1, 0), b3, voffB); PG8_STAGE(PG8_SB(1, 1), b3 + hstep, voffB); PG8_STAGE(PG8_SA(1, 0), a3, voffA);
            PG8_WAIT_V(8); PG8_WAIT_L(0); PG8_BAR; PG8_MMA(1, 0, At, B0); PG8_MMA(1, 1, At, B1); PG8_BAR; PG8_SCHED;
            } else {
            PG8_LDB(B0, 0, 0); PG8_SCHED; PG8_LDA(At, 0, 0); PG8_STAGE(PG8_SA(1, 1), a1 + hstep, voffA);
            PG8_WAIT_L(8); PG8_BAR; PG8_WAIT_L(0); PG8_MMA(0, 0, At, B0); PG8_BAR; PG8_SCHED;
            PG8_LDB(B1, 0, 1); PG8_STAGE(PG8_SB(0, 0), b2, voffB);
            PG8_BAR; PG8_WAIT_L(0); PG8_MMA(0, 1, At, B1); PG8_BAR;
            PG8_LDA(At, 0, 1); PG8_STAGE(PG8_SA(0, 0), a2, voffA);
            PG8_BAR; PG8_WAIT_L(0); PG8_MMA(1, 0, At, B0); PG8_BAR; PG8_SCHED;
            PG8_STAGE(PG8_SB(0, 1), b2 + hstep, voffB);
            PG8_WAIT_V(6); PG8_BAR; PG8_MMA(1, 1, At, B1); PG8_BAR;
            PG8_LDB(B0, 1, 0); PG8_SCHED; PG8_LDA(At, 1, 0); PG8_STAGE(PG8_SA(0, 1), a2 + hstep, voffA);
            PG8_WAIT_L(8); PG8_BAR; PG8_WAIT_L(0); PG8_MMA(0, 0, At, B0); PG8_BAR; PG8_SCHED;
            PG8_LDB(B1, 1, 1); PG8_STAGE(PG8_SB(1, 0), b3, voffB);
            PG8_BAR; PG8_WAIT_L(0); PG8_MMA(0, 1, At, B1); PG8_BAR;
            PG8_LDA(At, 1, 1); PG8_STAGE(PG8_SA(1, 0), a3, voffA);
            PG8_BAR; PG8_WAIT_L(0); PG8_MMA(1, 0, At, B0); PG8_BAR; PG8_SCHED;
            PG8_STAGE(PG8_SB(1, 1), b3 + hstep, voffB);
            PG8_WAIT_V(6); PG8_BAR; PG8_MMA(1, 1, At, B1); PG8_BAR;
            }
        }
        if constexpr (ALIGN_EPI) { if (wr == 0) PG8_BAR; }
        if constexpr (!Epi::AFTER_DRAIN) { E(acc, cur, wr, wc, fr, fq); S.done(cur); }
        if (!has_next) break;
#pragma unroll
        for (int a = 0; a < 2; ++a)
#pragma unroll
            for (int b = 0; b < 2; ++b)
#pragma unroll
                for (int m = 0; m < 4; ++m)
#pragma unroll
                    for (int n = 0; n < 2; ++n) acc[a][b][m][n] = (f32x4){0.f, 0.f, 0.f, 0.f};
        cur = nxt; cA = nA; cB = nB; ++ui;
        if constexpr (ALIGN_EPI) { if (wr == 1) PG8_BAR; }
    }
    PG8_WAIT_V(0);
    if constexpr (!ALIGN_EPI) { if (wr == 0) PG8_BAR; }
    PG8_BAR;
    if constexpr (Epi::AFTER_DRAIN) { E.fused(acc, cur, wr, wc, fr, fq, lds, wid, lane); S.done(cur); }
#undef PG8_SA
#undef PG8_SB
#undef PG8_STAGE
#undef PG8_LDA
#undef PG8_LDB
#undef PG8_MMA
#undef PG8_WAIT_V
#undef PG8_WAIT_L
#undef PG8_BAR
#undef PG8_SCHED
}
}
#define XB_TMO      128
#define XB_XCNT(j)  (256  + 64 * (j))
#define XB_XSUB(j)  (1280 + 64 * (j))
#define XB_XGEN(j)  (2304 + 64 * (j))
#define XB_TOP      3328
#define XB_TOPGEN   3392
#define XCD_BAR_WORDS 3456
#define XB_SPIN_CAP (1u << 18)

__device__ __forceinline__ unsigned xb_ld(unsigned* p)              { return __hip_atomic_load(p, __ATOMIC_RELAXED, __HIP_MEMORY_SCOPE_AGENT); }
__device__ __forceinline__ unsigned xb_add(unsigned* p, unsigned v) { return __hip_atomic_fetch_add(p, v, __ATOMIC_RELAXED, __HIP_MEMORY_SCOPE_AGENT); }
__device__ __forceinline__ unsigned xb_xcc_id() { return (unsigned)__builtin_amdgcn_s_getreg((3 << 11) | 20) & 0xFu; }
#define XB_SPIN(cond, bar) do { unsigned _sp = 0; while (cond) { __builtin_amdgcn_s_sleep(1); \
    if ((++_sp & 255u) == 0u) { if (xb_ld(&(bar)[XB_TMO])) break; if (_sp > XB_SPIN_CAP) { atomicAdd(&(bar)[XB_TMO], 1u); break; } } } } while (0)

struct XcdBarrier {
    unsigned* bar; unsigned x;
    volatile LAS unsigned* st;
};

__device__ __forceinline__ XcdBarrier xcd_barrier_post(unsigned* bar, volatile LAS unsigned* st) {
    XcdBarrier b; b.bar = bar; b.x = xb_xcc_id(); b.st = st;
    if (threadIdx.x == 0) (void)xb_add(&bar[XB_XCNT(b.x)], 1u);
    return b;
}
__device__ __forceinline__ void xcd_barrier_complete(unsigned* bar, unsigned x, unsigned& nloc, unsigned& nx) {
    const unsigned G = gridDim.x * gridDim.y * gridDim.z;
    unsigned sum, cnt, mine, sp = 0u;
    for (;;) {
        sum = 0u; cnt = 0u; mine = 0u;
#pragma unroll
        for (unsigned j = 0; j < 16; ++j) { const unsigned c = xb_ld(&bar[XB_XCNT(j)]); sum += c; cnt += (c > 0u) ? 1u : 0u; mine = (j == x) ? c : mine; }
        if (sum == G) break;
        __builtin_amdgcn_s_sleep(1);
        if ((++sp & 255u) == 0u) { if (xb_ld(&bar[XB_TMO])) break; if (sp > XB_SPIN_CAP) { atomicAdd(&bar[XB_TMO], 1u); break; } }
    }
    nloc = mine > 0u ? mine : 1u; nx = cnt > 0u ? cnt : 1u;
}

__device__ __forceinline__ void xcd_barrier(const XcdBarrier& b) {
    asm volatile("s_waitcnt vmcnt(0)" ::: "memory");
    __syncthreads();
    if (threadIdx.x == 0) {
        unsigned* bar = b.bar;
        __builtin_amdgcn_s_waitcnt(0);
        unsigned nloc = b.st[0], nx = b.st[1];
        if (nloc == 0u) { xcd_barrier_complete(bar, b.x, nloc, nx); b.st[0] = nloc; b.st[1] = nx; }
        const unsigned old = xb_add(&bar[XB_XSUB(b.x)], 1u);
        const unsigned gen = old / nloc;
        if (old + 1u == (gen + 1u) * nloc) {
            __builtin_amdgcn_fence(__ATOMIC_RELEASE, "agent");
            asm volatile("s_waitcnt vmcnt(0)" ::: "memory");
            const unsigned og = xb_add(&bar[XB_TOP], 1u);
            const unsigned tg = og / nx;
            if (og + 1u == (tg + 1u) * nx) xb_add(&bar[XB_TOPGEN], 1u);
            else XB_SPIN(xb_ld(&bar[XB_TOPGEN]) == tg, bar);
            __builtin_amdgcn_fence(__ATOMIC_ACQUIRE, "agent");
            xb_add(&bar[XB_XGEN(b.x)], 1u);
            asm volatile("s_waitcnt vmcnt(0)" ::: "memory");
        } else {
            XB_SPIN(xb_ld(&bar[XB_XGEN(b.x)]) == gen, bar);
            __builtin_amdgcn_fence(__ATOMIC_ACQUIRE, "agent");
            asm volatile("s_waitcnt vmcnt(0)" ::: "memory");
        }
    }
    __syncthreads();
}
namespace mk {
typedef unsigned short bf16;
typedef unsigned v4u __attribute__((ext_vector_type(4)));
typedef unsigned v2u __attribute__((ext_vector_type(2)));
typedef float f32x4 __attribute__((ext_vector_type(4)));
typedef float f32x16 __attribute__((ext_vector_type(16)));
typedef short bf16x8 __attribute__((ext_vector_type(8)));
typedef short bf16x4 __attribute__((ext_vector_type(4)));

constexpr int T = 32768, D = 1024, SQ = 4096, NIN = 2816, NQ = 2048, PLE = 256, NEXP = 16384;
constexpr int NWAVES = 8, NTHR = 512;
constexpr int RING_BYTES = 131072, LDS_BYTES = 163840, MISC_OFF = LDS_BYTES - 256;

constexpr size_t MB = 1024 * 1024;
constexpr size_t WS_CTL = 0, CTL_BYTES = 256 * 1024;
constexpr size_t WS_WIN = WS_CTL + CTL_BYTES;
constexpr size_t WS_WOUT = WS_WIN + (size_t)NIN * D * 2;
constexpr size_t WS_WQ = WS_WOUT + (size_t)D * D * 2;
constexpr size_t WS_WG = WS_WQ + (size_t)NQ * D * 2;
constexpr size_t WS_WP = WS_WG + (size_t)D * D * 2;
constexpr size_t WS_KEYS = WS_WP + (size_t)D * PLE * 2;
constexpr size_t WS_ROPE = WS_KEYS + 2 * 128 * 128 * 2;
constexpr size_t WS_SU = WS_ROPE + 2 * (size_t)SQ * 32 * 4;
constexpr size_t WS_SV = WS_SU + 65536;
constexpr size_t WS_SH = WS_SV + 65536;
constexpr size_t WS_UB = 16 * MB;
constexpr size_t WS_VB = 32 * MB;
constexpr size_t WS_PB = 48 * MB;
constexpr size_t WS_PK = 64 * MB;
constexpr size_t WS_R1 = 96 * MB;
constexpr size_t WS_R2 = 160 * MB;
constexpr size_t WS_PP = 352 * MB;
constexpr size_t WS_RSS2 = 80 * MB;
constexpr size_t WS_END = 416 * MB;
static_assert(WS_SH + (size_t)T * 4 <= WS_UB, "ws map");
constexpr int CW_BAR = 1024;

#define LDS_WAIT() asm volatile("s_waitcnt lgkmcnt(0)" ::: "memory")
#define VM_WAIT() asm volatile("s_waitcnt vmcnt(0)" ::: "memory")
typedef float f32x2 __attribute__((ext_vector_type(2)));
typedef __bf16 b16x2 __attribute__((ext_vector_type(2)));
__device__ __forceinline__ unsigned pk2(float lo, float hi) { const f32x2 v = {lo, hi}; return __builtin_bit_cast(unsigned, __builtin_convertvector(v, b16x2)); }
__device__ __forceinline__ float bf_lo(unsigned w) { return __uint_as_float(w << 16); }
__device__ __forceinline__ float bf_hi(unsigned w) { return __uint_as_float(w & 0xffff0000u); }
__device__ __forceinline__ float wave_sum(float v) {
#pragma unroll
    for (int o = 1; o < 64; o <<= 1) v += __shfl_xor(v, o);
    return v;
}

#ifndef PROBE_ON
#define PT_DECL
#define PT_ARG
#define PT_BEGIN()
#define PT_ADD(k)
#endif
struct Args { const float* in[16]; float* out; unsigned char* ws; int ph_lo, ph_hi, li, pad; };

struct EpiStoreBf16 {
    static constexpr bool PERM = true, AFTER_DRAIN = false;
    bf16* O; int ldc;
    __device__ __forceinline__ void operator()(const pg8::f32x4 (&acc)[2][2][4][2], const pg8::Unit& u, int wr, int wc, int fr, int fq) const {
        const int row0 = u.pm * 256 + wr * 64 + fr, col0 = u.pn * 256 + wc * 32 + 8 * fq;
#pragma unroll
        for (int ai = 0; ai < 2; ++ai)
#pragma unroll
            for (int m = 0; m < 4; ++m) { bf16* rowp = O + (size_t)(row0 + ai * 128 + m * 16) * ldc + col0;
#pragma unroll
                for (int bj = 0; bj < 2; ++bj) { const pg8::f32x4 v0 = acc[ai][bj][m][0], v1 = acc[ai][bj][m][1];
                    pg8::u32x4 w; w.x = pk2(v0[0], v0[1]); w.y = pk2(v0[2], v0[3]); w.z = pk2(v1[0], v1[1]); w.w = pk2(v1[2], v1[3]);
                    *(pg8::u32x4*)(rowp + bj * 128) = w; } }
    }
};


struct EpiResid {
    static constexpr bool PERM = true, AFTER_DRAIN = false;
    const float* X; bf16* XB;
    __device__ __forceinline__ void operator()(const pg8::f32x4 (&acc)[2][2][4][2], const pg8::Unit& u, int wr, int wc, int fr, int fq) const {
        const int row0 = u.pm * 256 + wr * 64 + fr, col0 = u.pn * 256 + wc * 32 + 8 * fq;
#pragma unroll
        for (int ai = 0; ai < 2; ++ai)
#pragma unroll
            for (int m = 0; m < 4; ++m) { const size_t off = (size_t)(row0 + ai * 128 + m * 16) * D + col0;
#pragma unroll
                for (int bj = 0; bj < 2; ++bj) { const size_t o2 = off + bj * 128;
                    const pg8::f32x4 v0 = acc[ai][bj][m][0] + *(const pg8::f32x4*)(X + o2), v1 = acc[ai][bj][m][1] + *(const pg8::f32x4*)(X + o2 + 4);
                    pg8::u32x4 w; w.x = pk2(v0[0], v0[1]); w.y = pk2(v0[2], v0[3]); w.z = pk2(v1[0], v1[1]); w.w = pk2(v1[2], v1[3]);
                    *(pg8::u32x4*)(XB + o2) = w; } }
    }
};
struct EpiGate {
    static constexpr bool PERM = true, AFTER_DRAIN = false;
    float* O; const bf16* XB; const bf16* PP; const float* rss;
    __device__ __forceinline__ void operator()(const pg8::f32x4 (&acc)[2][2][4][2], const pg8::Unit& u, int wr, int wc, int fr, int fq) const {
        const int row0 = u.pm * 256 + wr * 64 + fr, col0 = u.pn * 256 + wc * 32 + 8 * fq;
#pragma unroll
        for (int ai = 0; ai < 2; ++ai)
#pragma unroll
            for (int m = 0; m < 4; ++m) { const int row = row0 + ai * 128 + m * 16; const size_t off = (size_t)row * D + col0;
                const pg8::f32x4 q0 = *(const pg8::f32x4*)(rss + (size_t)row * 8), q1 = *(const pg8::f32x4*)(rss + (size_t)row * 8 + 4);
                const float rs = 1.0f / sqrtf((((q0[0] + q0[1]) + (q0[2] + q0[3])) + ((q1[0] + q1[1]) + (q1[2] + q1[3]))) * (1.0f / D) + 1e-6f);
#pragma unroll
                for (int bj = 0; bj < 2; ++bj) { const size_t o2 = off + bj * 128;
                    const pg8::u32x4 pw = *(const pg8::u32x4*)(PP + o2), xw = *(const pg8::u32x4*)(XB + o2);
                    const pg8::f32x4 a0 = acc[ai][bj][m][0] * rs, a1 = acc[ai][bj][m][1] * rs;
                    pg8::f32x4 x0, x1;
                    x0[0] = bf_lo(xw.x) + bf_lo(pw.x) / (1.0f + __expf(-a0[0])); x0[1] = bf_hi(xw.x) + bf_hi(pw.x) / (1.0f + __expf(-a0[1])); x0[2] = bf_lo(xw.y) + bf_lo(pw.y) / (1.0f + __expf(-a0[2])); x0[3] = bf_hi(xw.y) + bf_hi(pw.y) / (1.0f + __expf(-a0[3]));
                    x1[0] = bf_lo(xw.z) + bf_lo(pw.z) / (1.0f + __expf(-a1[0])); x1[1] = bf_hi(xw.z) + bf_hi(pw.z) / (1.0f + __expf(-a1[1])); x1[2] = bf_lo(xw.w) + bf_lo(pw.w) / (1.0f + __expf(-a1[2])); x1[3] = bf_hi(xw.w) + bf_hi(pw.w) / (1.0f + __expf(-a1[3]));
                    *(pg8::f32x4*)(O + o2) = x0; *(pg8::f32x4*)(O + o2 + 4) = x1; } }
    }
};

__device__ __forceinline__ void p0_transpose_item(const float* __restrict__ W, const float* __restrict__ gsc, int K, int N, bf16* __restrict__ WT, LAS float* scr, int item, int lane) {
    const int nblk = N / 32, kb = item / nblk, nb = item % nblk, k0 = 64 * kb, n0 = 32 * nb;
    float wv[32];
#pragma unroll
    for (int i = 0; i < 32; ++i) { const int kk = 2 * i + (lane >> 5); wv[i] = W[(size_t)(k0 + kk) * N + n0 + (lane & 31)]; }
    if (gsc) {
#pragma unroll
        for (int i = 0; i < 32; ++i) wv[i] *= gsc[k0 + 2 * i + (lane >> 5)];
    }
#pragma unroll
    for (int i = 0; i < 32; ++i) scr[(2 * i + (lane >> 5)) * 33 + (lane & 31)] = wv[i];
    LDS_WAIT(); asm volatile("" ::: "memory");
    const int c = lane & 7;
#pragma unroll
    for (int j = 0; j < 4; ++j) { const int n = (lane >> 3) + 8 * j; const LAS float* s = scr + (8 * c) * 33 + n;
        v4u o; o.x = pk2(s[0 * 33], s[1 * 33]); o.y = pk2(s[2 * 33], s[3 * 33]); o.z = pk2(s[4 * 33], s[5 * 33]); o.w = pk2(s[6 * 33], s[7 * 33]);
        *(v4u*)(WT + (size_t)(n0 + n) * K + k0 + 8 * c) = o; }
    LDS_WAIT(); asm volatile("" ::: "memory");
}
__device__ __forceinline__ void p0_convert(const float* __restrict__ src, bf16* __restrict__ dst, size_t n8, size_t gtid, size_t gthreads) {
    size_t i = gtid;
    for (; i + 3 * gthreads < n8; i += 4 * gthreads) {
        f32x4 a[4], b[4];
#pragma unroll
        for (int r = 0; r < 4; ++r) { a[r] = ((const f32x4*)src)[2 * (i + r * gthreads)]; b[r] = ((const f32x4*)src)[2 * (i + r * gthreads) + 1]; }
#pragma unroll
        for (int r = 0; r < 4; ++r) { v4u o; o.x = pk2(a[r][0], a[r][1]); o.y = pk2(a[r][2], a[r][3]); o.z = pk2(b[r][0], b[r][1]); o.w = pk2(b[r][2], b[r][3]); ((v4u*)dst)[i + r * gthreads] = o; }
    }
    for (; i < n8; i += gthreads) {
        const f32x4 a = ((const f32x4*)src)[2 * i], b = ((const f32x4*)src)[2 * i + 1];
        v4u o; o.x = pk2(a[0], a[1]); o.y = pk2(a[2], a[3]); o.z = pk2(b[0], b[1]); o.w = pk2(b[2], b[3]);
        ((v4u*)dst)[i] = o;
    }
}
__device__ __forceinline__ void rms_row_to_bf16(const float* __restrict__ xrow, const float* __restrict__ g, bf16* __restrict__ orow, int lane) {
    const f32x4* xr = (const f32x4*)xrow + lane; const f32x4* gr = (const f32x4*)g + lane;
    f32x4 v[4]; float s = 0.f;
#pragma unroll
    for (int j = 0; j < 4; ++j) { v[j] = xr[64 * j]; s += (v[j][0] * v[j][0] + v[j][1] * v[j][1]) + (v[j][2] * v[j][2] + v[j][3] * v[j][3]); }
    const float rstd = 1.0f / sqrtf(wave_sum(s) * (1.0f / D) + 1e-6f);
    v2u* o8 = (v2u*)orow + lane;
#pragma unroll
    for (int j = 0; j < 4; ++j) { const f32x4 gg = gr[64 * j]; v2u w; w.x = pk2(v[j][0] * rstd * gg[0], v[j][1] * rstd * gg[1]); w.y = pk2(v[j][2] * rstd * gg[2], v[j][3] * rstd * gg[3]); o8[64 * j] = w; }
}

__device__ __forceinline__ void p0_prologue(const Args& a, LAS unsigned char* lds, int vcu, int G, int tid, int lane, int wave) {
    unsigned char* ws = a.ws;
    LAS float* scr = (LAS float*)(lds + wave * 16384);
    const int gw = vcu * NWAVES + wave, NGW = G * NWAVES;
    constexpr int I_IN = (D / 64) * (NIN / 32), I_OUT = (D / 64) * (D / 32), I_Q = (D / 64) * (NQ / 32), I_G = I_OUT, I_P = (PLE / 64) * (D / 32);
    constexpr int NITEMS = I_IN + I_OUT + I_Q + I_G + I_P;
    for (int it = gw; it < NITEMS; it += NGW) {
        int r = it;
        if (r < I_IN) { p0_transpose_item(a.in[3], nullptr, D, NIN, (bf16*)(ws + WS_WIN), scr, r, lane); continue; } r -= I_IN;
        if (r < I_OUT) { p0_transpose_item(a.in[7], nullptr, D, D, (bf16*)(ws + WS_WOUT), scr, r, lane); continue; } r -= I_OUT;
        if (r < I_Q) { p0_transpose_item(a.in[9], a.in[8], D, NQ, (bf16*)(ws + WS_WQ), scr, r, lane); continue; } r -= I_Q;
        if (r < I_G) { p0_transpose_item(a.in[14], a.in[13], D, D, (bf16*)(ws + WS_WG), scr, r, lane); continue; } r -= I_G;
        p0_transpose_item(a.in[15], nullptr, PLE, D, (bf16*)(ws + WS_WP), scr, r, lane);
    }
    const size_t gtid = (size_t)vcu * NTHR + tid, gthreads = (size_t)G * NTHR;
    p0_convert(a.in[10], (bf16*)(ws + WS_KEYS), 2 * 128 * 128 / 8, gtid, gthreads);
    for (int r0 = gw; r0 < 2 * NEXP; r0 += 4 * NGW) {
        float xs[4][16];
#pragma unroll
        for (int rr = 0; rr < 4; ++rr) {
            const int r = r0 + rr * NGW; const int isv = r >= NEXP, e = isv ? r - NEXP : r;
            const float* src = (isv ? a.in[12] : a.in[11]) + (size_t)e * D + 16 * lane;
            const f32x4 x0 = *(const f32x4*)src, x1 = *(const f32x4*)(src + 4), x2 = *(const f32x4*)(src + 8), x3 = *(const f32x4*)(src + 12);
#pragma unroll
            for (int u = 0; u < 4; ++u) { xs[rr][u] = x0[u]; xs[rr][4 + u] = x1[u]; xs[rr][8 + u] = x2[u]; xs[rr][12 + u] = x3[u]; }
        }
#pragma unroll
        for (int rr = 0; rr < 4; ++rr) {
            const int r = r0 + rr * NGW; const int isv = r >= NEXP, e = isv ? r - NEXP : r;
            float am = 0.f;
#pragma unroll
            for (int u = 0; u < 16; ++u) am = fmaxf(am, fabsf(xs[rr][u]));
#pragma unroll
            for (int o = 1; o < 64; o <<= 1) am = fmaxf(am, __shfl_xor(am, o));
            const float inv = am > 0.f ? 127.0f / am : 0.f; const unsigned bias = 0u;
            v4u w;
#pragma unroll
            for (int c = 0; c < 4; ++c) { unsigned ww = 0u;
#pragma unroll
                for (int u = 0; u < 4; ++u) { const int q = __float2int_rn(xs[rr][4 * c + u] * inv); ww |= (((unsigned)q + bias) & 0xffu) << (8 * u); }
                w[c] = ww; }
            if (isv) *(v4u*)(ws + WS_VB + (size_t)(lane >> 3) * ((size_t)NEXP * 128) + (size_t)e * 128 + 16 * (lane & 7)) = w;
            else *(v4u*)(ws + WS_UB + (size_t)e * D + 16 * lane) = w;
            if (lane == 0) ((float*)(ws + (isv ? WS_SV : WS_SU)))[e] = am * (1.0f / 127.0f);
        }
    }
    p0_convert(a.in[1], (bf16*)(ws + WS_PB), (size_t)T * PLE / 8, gtid, gthreads);
    for (size_t i = gtid; i < (size_t)SQ * 32; i += gthreads) {
        const int pos = (int)(i >> 5), c = (int)(i & 31);
        const float freq = powf(10000.0f, -(float)c / 32.0f);
        const float ang = (float)pos * freq;
        float sn, cs; sincosf(ang, &sn, &cs);
        ((float*)(ws + WS_ROPE))[i] = cs; ((float*)(ws + WS_ROPE))[(size_t)SQ * 32 + i] = sn;
    }
    for (int m0 = gw; m0 < T; m0 += 4 * NGW) {
        f32x4 v[4][4]; float ssq[4];
#pragma unroll
        for (int rr = 0; rr < 4; ++rr) { const f32x4* xr = (const f32x4*)(a.in[0] + (size_t)(m0 + rr * NGW) * D) + lane;
#pragma unroll
            for (int j = 0; j < 4; ++j) v[rr][j] = xr[64 * j]; }
#pragma unroll
        for (int rr = 0; rr < 4; ++rr) { float sq = 0.f;
#pragma unroll
            for (int j = 0; j < 4; ++j) sq += (v[rr][j][0] * v[rr][j][0] + v[rr][j][1] * v[rr][j][1]) + (v[rr][j][2] * v[rr][j][2] + v[rr][j][3] * v[rr][j][3]);
            ssq[rr] = sq; }
#pragma unroll
        for (int o = 1; o < 64; o <<= 1)
#pragma unroll
            for (int rr = 0; rr < 4; ++rr) ssq[rr] += __shfl_xor(ssq[rr], o);
        const f32x4* gr = (const f32x4*)a.in[2] + lane;
#pragma unroll
        for (int rr = 0; rr < 4; ++rr) { const float rstd = 1.0f / sqrtf(ssq[rr] * (1.0f / D) + 1e-6f); v2u* o8 = (v2u*)((bf16*)(ws + WS_R1) + (size_t)(m0 + rr * NGW) * D) + lane;
#pragma unroll
            for (int j = 0; j < 4; ++j) { const f32x4 gg = gr[64 * j]; v2u w; w.x = pk2(v[rr][j][0] * rstd * gg[0], v[rr][j][1] * rstd * gg[1]); w.y = pk2(v[rr][j][2] * rstd * gg[2], v[rr][j][3] * rstd * gg[3]); o8[64 * j] = w; } }
    }
}


#define MFMA32(a, b, c) __builtin_amdgcn_mfma_f32_32x32x16_bf16((a), (b), (c), 0, 0, 0)
__device__ __forceinline__ int crow(int r, int hf) { return (r & 3) + 8 * (r >> 2) + 4 * hf; }
__device__ __forceinline__ bf16x8 pack8(float a0, float a1, float a2, float a3, float a4, float a5, float a6, float a7) {
    v4u w; w.x = pk2(a0, a1); w.y = pk2(a2, a3); w.z = pk2(a4, a5); w.w = pk2(a6, a7); return __builtin_bit_cast(bf16x8, w);
}
__device__ __forceinline__ bf16x8 lds_frag16(LAS unsigned char* p) { return *(const LAS bf16x8*)p; }
__device__ __forceinline__ bf16x8 lds_frag8x2(LAS unsigned char* p) {
    const bf16x4 lo = *(const LAS bf16x4*)p, hi = *(const LAS bf16x4*)(p + 16); return __builtin_shufflevector(lo, hi, 0, 1, 2, 3, 4, 5, 6, 7);
}
typedef short s16x4 __attribute__((ext_vector_type(4)));
__device__ __forceinline__ s16x4 lds_tr4(LAS unsigned char* tile, int r0, int c0, int lane) {
    const int i = lane & 15;
    return __builtin_amdgcn_ds_read_tr16_b64_v4i16((LAS s16x4*)(tile + (r0 + (i >> 2)) * 144 + (c0 + 16 * ((lane >> 4) & 1) + 4 * (i & 3)) * 2));
}
__device__ __forceinline__ bf16x8 cat8(s16x4 lo, s16x4 hi) { return __builtin_shufflevector(lo, hi, 0, 1, 2, 3, 4, 5, 6, 7); }
constexpr int RQ = 144;
constexpr int LR_QS = 0, LR_KS = LR_QS + 128 * RQ, LR_VS = LR_KS + 128 * RQ, LR_ST = LR_VS + 128 * RQ, LR_LN = LR_ST + 64 * RQ, LR_END = LR_LN + 2 * 128 * 8;
static_assert(LR_END <= RING_BYTES, "retention LDS");
__device__ __forceinline__ void ret_unit(const bf16* __restrict__ PROJ, bf16* __restrict__ MIXED, const float* __restrict__ rope, LAS unsigned char* lds,
                                         int b, int h, int c0, int c1, int tid, int lane, int wave) {
    const float gam = 1.0f - exp2f(-5.0f - (float)h), lg2 = log2f(gam), cd = exp2f(lg2 * 128.0f);
    const int l31 = lane & 31, hf = lane >> 5, ib = wave >> 1, et = wave & 1;
    const int r = tid >> 2, qd = tid & 3;
    const float wq = exp2f(lg2 * (float)(r + 1)), wk = exp2f(-lg2 * (float)(r + 1));
    f32x16 stacc;
#pragma unroll
    for (int i = 0; i < 16; ++i) stacc[i] = 0.f;
    for (int i = tid; i < 64 * RQ / 4; i += NTHR) ((LAS unsigned*)(lds + LR_ST))[i] = 0u;
    v4u k1, k2, v1, v2, q1 = {0u, 0u, 0u, 0u}, q2 = {0u, 0u, 0u, 0u}; f32x4 csa, csb, sna, snb; v2u gvn[4] = {{0u, 0u}, {0u, 0u}, {0u, 0u}, {0u, 0u}};
#define RET_LOAD(nn) do { const int sp_ = (nn) * 128 + r; const bf16* pr_ = PROJ + ((size_t)b * SQ + sp_) * NIN + h * 64 + 8 * qd; \
        k1 = *(const v4u*)(pr_ + 512); k2 = *(const v4u*)(pr_ + 512 + 32); v1 = *(const v4u*)(pr_ + 1024); v2 = *(const v4u*)(pr_ + 1024 + 32); \
        if ((nn) >= c0) { q1 = *(const v4u*)(pr_); q2 = *(const v4u*)(pr_ + 32); \
            const bf16* gp_ = PROJ + ((size_t)b * SQ + (nn) * 128 + 32 * ib + l31) * NIN + 1536 + h * 64 + 32 * et + 4 * hf; \
            gvn[0] = *(const v2u*)gp_; gvn[1] = *(const v2u*)(gp_ + 8); gvn[2] = *(const v2u*)(gp_ + 16); gvn[3] = *(const v2u*)(gp_ + 24); } \
        csa = *(const f32x4*)(rope + sp_ * 32 + 8 * qd); csb = *(const f32x4*)(rope + sp_ * 32 + 8 * qd + 4); \
        sna = *(const f32x4*)(rope + SQ * 32 + sp_ * 32 + 8 * qd); snb = *(const f32x4*)(rope + SQ * 32 + sp_ * 32 + 8 * qd + 4); } while (0)
    RET_LOAD(0);
    for (int n = 0; n < c1; ++n) {
        const bool own = n >= c0;
        float cs[8], sn[8];
#pragma unroll
        for (int u = 0; u < 4; ++u) { cs[u] = csa[u]; cs[4 + u] = csb[u]; sn[u] = sna[u]; sn[4 + u] = snb[u]; }
        v2u gv[4];
#pragma unroll
        for (int g = 0; g < 4; ++g) gv[g] = gvn[g];
        __syncthreads();
        {
            float o1[8], o2[8];
#pragma unroll
            for (int u = 0; u < 8; ++u) { const unsigned w1 = k1[u >> 1], w2 = k2[u >> 1]; const float x1 = (u & 1) ? bf_hi(w1) : bf_lo(w1), x2 = (u & 1) ? bf_hi(w2) : bf_lo(w2);
                o1[u] = (x1 * cs[u] - x2 * sn[u]) * wk; o2[u] = (x1 * sn[u] + x2 * cs[u]) * wk; }
            *(LAS bf16x8*)(lds + LR_KS + r * RQ + (8 * qd) * 2) = pack8(o1[0], o1[1], o1[2], o1[3], o1[4], o1[5], o1[6], o1[7]);
            *(LAS bf16x8*)(lds + LR_KS + r * RQ + (32 + 8 * qd) * 2) = pack8(o2[0], o2[1], o2[2], o2[3], o2[4], o2[5], o2[6], o2[7]);
            *(LAS v4u*)(lds + LR_VS + r * RQ + (8 * qd) * 2) = v1; *(LAS v4u*)(lds + LR_VS + r * RQ + (32 + 8 * qd) * 2) = v2;
            if (own) {
#pragma unroll
                for (int u = 0; u < 8; ++u) { const unsigned w1 = q1[u >> 1], w2 = q2[u >> 1]; const float x1 = (u & 1) ? bf_hi(w1) : bf_lo(w1), x2 = (u & 1) ? bf_hi(w2) : bf_lo(w2);
                    o1[u] = (x1 * cs[u] - x2 * sn[u]) * wq; o2[u] = (x1 * sn[u] + x2 * cs[u]) * wq; }
                *(LAS bf16x8*)(lds + LR_QS + r * RQ + (8 * qd) * 2) = pack8(o1[0], o1[1], o1[2], o1[3], o1[4], o1[5], o1[6], o1[7]);
                *(LAS bf16x8*)(lds + LR_QS + r * RQ + (32 + 8 * qd) * 2) = pack8(o2[0], o2[1], o2[2], o2[3], o2[4], o2[5], o2[6], o2[7]);
            }
        }
        if (n + 1 < c1) RET_LOAD(n + 1);
        __syncthreads();
        if (own) {
            const size_t orow = (size_t)b * SQ + n * 128 + 32 * ib + l31;
            bf16x8 qf[4];
#pragma unroll
            for (int ks = 0; ks < 4; ++ks) qf[ks] = lds_frag16(lds + LR_QS + (32 * ib + l31) * RQ + (16 * ks + 8 * hf) * 2);
            f32x16 o;
#pragma unroll
            for (int i = 0; i < 16; ++i) o[i] = 0.f;
#pragma unroll
            for (int ks = 0; ks < 4; ++ks) o = MFMA32(lds_frag16(lds + LR_ST + (32 * et + l31) * RQ + (16 * ks + 8 * hf) * 2), qf[ks], o);
            for (int jb = 0; jb <= ib; ++jb) {
                f32x16 s;
#pragma unroll
                for (int i = 0; i < 16; ++i) s[i] = 0.f;
#pragma unroll
                for (int ks = 0; ks < 4; ++ks) s = MFMA32(lds_frag16(lds + LR_KS + (32 * jb + l31) * RQ + (16 * ks + 8 * hf) * 2), qf[ks], s);
                const bool diag = (jb == ib);
                float p[16];
#pragma unroll
                for (int i = 0; i < 16; ++i) p[i] = (diag && crow(i, hf) > l31) ? 0.f : s[i] * 0.125f;
#pragma unroll
                for (int st = 0; st < 2; ++st) {
                    const bf16x8 pf = pack8(p[8 * st], p[8 * st + 1], p[8 * st + 2], p[8 * st + 3], p[8 * st + 4], p[8 * st + 5], p[8 * st + 6], p[8 * st + 7]);
                    o = MFMA32(cat8(lds_tr4(lds + LR_VS, 32 * jb + 16 * st + 4 * hf, 32 * et, lane), lds_tr4(lds + LR_VS, 32 * jb + 16 * st + 8 + 4 * hf, 32 * et, lane)), pf, o);
                }
            }
            float s1 = 0.f, s2 = 0.f;
#pragma unroll
            for (int i = 0; i < 16; ++i) { s1 += o[i]; s2 += o[i] * o[i]; }
            s1 += __shfl_xor(s1, 32); s2 += __shfl_xor(s2, 32);
            if (hf == 0) *(LAS f32x2*)(lds + LR_LN + (et * 128 + 32 * ib + l31) * 8) = (f32x2){s1, s2};
            __syncthreads();
            const f32x2 ot = *(const LAS f32x2*)(lds + LR_LN + ((et ^ 1) * 128 + 32 * ib + l31) * 8);
            const float mu = (s1 + ot.x) * (1.0f / 64.0f), var = fmaxf((s2 + ot.y) * (1.0f / 64.0f) - mu * mu, 0.f), rs = 1.0f / sqrtf(var + 1e-6f);
#pragma unroll
            for (int g = 0; g < 4; ++g) {
                float y[4];
#pragma unroll
                for (int u = 0; u < 4; ++u) { const unsigned w = gv[g][u >> 1]; const float gg = (u & 1) ? bf_hi(w) : bf_lo(w); const float sg = gg / (1.0f + __expf(-gg)); y[u] = sg * ((o[4 * g + u] - mu) * rs); }
                v2u w; w.x = pk2(y[0], y[1]); w.y = pk2(y[2], y[3]);
                *(v2u*)(MIXED + orow * D + h * 64 + 32 * et + 8 * g + 4 * hf) = w;
            }
        }
        if (wave < 4) {
            const int se = wave >> 1, sd = wave & 1;
            f32x16 tmp;
#pragma unroll
            for (int i = 0; i < 16; ++i) tmp[i] = 0.f;
#pragma unroll
            for (int ks = 0; ks < 8; ++ks)
                tmp = MFMA32(cat8(lds_tr4(lds + LR_VS, 16 * ks + 8 * hf, 32 * se, lane), lds_tr4(lds + LR_VS, 16 * ks + 8 * hf + 4, 32 * se, lane)),
                             cat8(lds_tr4(lds + LR_KS, 16 * ks + 8 * hf, 32 * sd, lane), lds_tr4(lds + LR_KS, 16 * ks + 8 * hf + 4, 32 * sd, lane)), tmp);
#pragma unroll
            for (int i = 0; i < 16; ++i) stacc[i] = cd * (stacc[i] + 0.125f * tmp[i]);
#pragma unroll
            for (int i = 0; i < 16; i += 2) { const unsigned w = pk2(stacc[i], stacc[i + 1]);
                *(LAS bf16*)(lds + LR_ST + (32 * se + crow(i, hf)) * RQ + (32 * sd + l31) * 2) = (bf16)(w & 0xffffu);
                *(LAS bf16*)(lds + LR_ST + (32 * se + crow(i + 1, hf)) * RQ + (32 * sd + l31) * 2) = (bf16)(w >> 16); }
        }
    }
    __syncthreads();
#undef RET_LOAD
}

constexpr int LS_KN = 0, LS_VS = LS_KN + 256 * RQ, LS_QN = LS_VS + 256 * RQ, LS_END = LS_QN + 256 * RQ;
static_assert(LS_END <= RING_BYTES, "swa LDS");
__device__ __forceinline__ void swa_unit(const bf16* __restrict__ PROJ, bf16* __restrict__ MIXED, const float* __restrict__ qnw, const float* __restrict__ knw, const float* __restrict__ sinks,
                                         LAS unsigned char* lds, int b, int kvh, int n, int tid, int lane, int wave) {
    const int l31 = lane & 31, hf = lane >> 5;
    const int row = tid >> 1, half = tid & 1;
    {
        const int kpos = (n - 1) * 128 + row; const bool valid = kpos >= 0;
        v4u kk[4], vv[4];
#pragma unroll
        for (int c = 0; c < 4; ++c) { kk[c] = (v4u){0u, 0u, 0u, 0u}; vv[c] = (v4u){0u, 0u, 0u, 0u}; }
        if (valid) { const bf16* pr = PROJ + ((size_t)b * SQ + kpos) * NIN + 32 * half;
#pragma unroll
            for (int c = 0; c < 4; ++c) { kk[c] = *(const v4u*)(pr + 2560 + kvh * 64 + 8 * c); vv[c] = *(const v4u*)(pr + 2688 + kvh * 64 + 8 * c); } }
        float kf[32]; float ss = 0.f;
#pragma unroll
        for (int c = 0; c < 4; ++c)
#pragma unroll
            for (int u = 0; u < 4; ++u) { kf[8 * c + 2 * u] = bf_lo(kk[c][u]); kf[8 * c + 2 * u + 1] = bf_hi(kk[c][u]); }
#pragma unroll
        for (int i = 0; i < 32; ++i) ss += kf[i] * kf[i];
        ss += __shfl_xor(ss, 1);
        const float rstd = 0.125f / sqrtf(ss * (1.0f / 64.0f) + 1e-6f);
#pragma unroll
        for (int c = 0; c < 4; ++c) {
            const f32x4 g0 = *(const f32x4*)(knw + 32 * half + 8 * c), g1 = *(const f32x4*)(knw + 32 * half + 8 * c + 4);
            *(LAS bf16x8*)(lds + LS_KN + row * RQ + (32 * half + 8 * c) * 2) = pack8(kf[8 * c] * rstd * g0[0], kf[8 * c + 1] * rstd * g0[1], kf[8 * c + 2] * rstd * g0[2], kf[8 * c + 3] * rstd * g0[3],
                                                                                  kf[8 * c + 4] * rstd * g1[0], kf[8 * c + 5] * rstd * g1[1], kf[8 * c + 6] * rstd * g1[2], kf[8 * c + 7] * rstd * g1[3]);
            *(LAS v4u*)(lds + LS_VS + row * RQ + (32 * half + 8 * c) * 2) = vv[c];
        }
    }
    for (int rnd = 0; rnd < 2; ++rnd) {
        {
            const int hs = row >> 7, qrow = row & 127, hq = kvh * 4 + rnd * 2 + hs;
            const bf16* pr = PROJ + ((size_t)b * SQ + n * 128 + qrow) * NIN + 2048 + hq * 64 + 32 * half;
            v4u qq[4];
#pragma unroll
            for (int c = 0; c < 4; ++c) qq[c] = *(const v4u*)(pr + 8 * c);
            float qf[32]; float ss = 0.f;
#pragma unroll
            for (int c = 0; c < 4; ++c)
#pragma unroll
                for (int u = 0; u < 4; ++u) { qf[8 * c + 2 * u] = bf_lo(qq[c][u]); qf[8 * c + 2 * u + 1] = bf_hi(qq[c][u]); }
#pragma unroll
            for (int i = 0; i < 32; ++i) ss += qf[i] * qf[i];
            ss += __shfl_xor(ss, 1);
            const float rstd = 1.0f / sqrtf(ss * (1.0f / 64.0f) + 1e-6f);
#pragma unroll
            for (int c = 0; c < 4; ++c) {
                const f32x4 g0 = *(const f32x4*)(qnw + 32 * half + 8 * c), g1 = *(const f32x4*)(qnw + 32 * half + 8 * c + 4);
                *(LAS bf16x8*)(lds + LS_QN + row * RQ + (32 * half + 8 * c) * 2) = pack8(qf[8 * c] * rstd * g0[0], qf[8 * c + 1] * rstd * g0[1], qf[8 * c + 2] * rstd * g0[2], qf[8 * c + 3] * rstd * g0[3],
                                                                                      qf[8 * c + 4] * rstd * g1[0], qf[8 * c + 5] * rstd * g1[1], qf[8 * c + 6] * rstd * g1[2], qf[8 * c + 7] * rstd * g1[3]);
            }
        }
        __syncthreads();
        {
            const int hs = wave >> 2, ib = wave & 3, hq = kvh * 4 + rnd * 2 + hs;
            bf16x8 qf[4];
#pragma unroll
            for (int ks = 0; ks < 4; ++ks) qf[ks] = lds_frag16(lds + LS_QN + (hs * 128 + 32 * ib + l31) * RQ + (16 * ks + 8 * hf) * 2);
            f32x16 s[5];
#pragma unroll
            for (int t = 0; t < 5; ++t) {
#pragma unroll
                for (int i = 0; i < 16; ++i) s[t][i] = 0.f;
#pragma unroll
                for (int ks = 0; ks < 4; ++ks) s[t] = MFMA32(lds_frag16(lds + LS_KN + (32 * (ib + t) + l31) * RQ + (16 * ks + 8 * hf) * 2), qf[ks], s[t]);
            }
            const float sink = sinks[hq];
            float m = sink;
#pragma unroll
            for (int t = 0; t < 5; ++t)
#pragma unroll
                for (int i = 0; i < 16; ++i) {
                    bool ok = true;
                    if (t == 0) ok = crow(i, hf) > l31;
                    if (t == 4) ok = crow(i, hf) <= l31;
                    if (n == 0 && ib + t < 4) ok = false;
                    s[t][i] = ok ? s[t][i] : -INFINITY;
                    m = fmaxf(m, s[t][i]);
                }
            m = fmaxf(m, __shfl_xor(m, 32));
            float l = 0.f;
#pragma unroll
            for (int t = 0; t < 5; ++t)
#pragma unroll
                for (int i = 0; i < 16; ++i) { s[t][i] = exp2f((s[t][i] - m) * 1.4426950408889634f); l += s[t][i]; }
            l += __shfl_xor(l, 32);
            l += exp2f((sink - m) * 1.4426950408889634f);
            f32x16 o[2];
#pragma unroll
            for (int e2 = 0; e2 < 2; ++e2)
#pragma unroll
                for (int i = 0; i < 16; ++i) o[e2][i] = 0.f;
#pragma unroll
            for (int t = 0; t < 5; ++t)
#pragma unroll
                for (int st = 0; st < 2; ++st) {
                    const bf16x8 pf = pack8(s[t][8 * st], s[t][8 * st + 1], s[t][8 * st + 2], s[t][8 * st + 3], s[t][8 * st + 4], s[t][8 * st + 5], s[t][8 * st + 6], s[t][8 * st + 7]);
#pragma unroll
                    for (int e2 = 0; e2 < 2; ++e2) o[e2] = MFMA32(cat8(lds_tr4(lds + LS_VS, 32 * (ib + t) + 16 * st + 4 * hf, 32 * e2, lane), lds_tr4(lds + LS_VS, 32 * (ib + t) + 16 * st + 8 + 4 * hf, 32 * e2, lane)), pf, o[e2]);
                }
            const float inv = 1.0f / l;
            const size_t orow = (size_t)b * SQ + n * 128 + 32 * ib + l31;
#pragma unroll
            for (int e2 = 0; e2 < 2; ++e2)
#pragma unroll
                for (int g = 0; g < 4; ++g) { v2u w; w.x = pk2(o[e2][4 * g] * inv, o[e2][4 * g + 1] * inv); w.y = pk2(o[e2][4 * g + 2] * inv, o[e2][4 * g + 3] * inv);
                    *(v2u*)(MIXED + orow * D + 512 + hq * 64 + 32 * e2 + 8 * g + 4 * hf) = w; }
        }
        __syncthreads();
    }
}

__device__ __forceinline__ void p2_mixing(const Args& a, LAS unsigned char* lds, int bx, int G, int tid, int lane, int wave, int parts = 3) {
    const bf16* PROJ = (const bf16*)(a.ws + WS_R2); bf16* MIXED = (bf16*)(a.ws + WS_R1); const float* rope = (const float*)(a.ws + WS_ROPE);
    if (parts & 1) for (int u = bx; u < 256; u += G) {
        const int b = u >> 5, h = (u >> 2) & 7, grp = u & 3;
        const int c0 = grp == 0 ? 0 : grp == 1 ? 11 : grp == 2 ? 20 : 27, c1 = grp == 0 ? 11 : grp == 1 ? 20 : grp == 2 ? 27 : 32;
        ret_unit(PROJ, MIXED, rope, lds, b, h, c0, c1, tid, lane, wave);
    }
    if (parts & 2) for (int su = bx; su < 512; su += G) swa_unit(PROJ, MIXED, a.in[4], a.in[5], a.in[6], lds, su >> 6, (su >> 5) & 1, su & 31, tid, lane, wave);
}


template <int N> __device__ __forceinline__ void bitonic_sort_desc(float (&v)[N]) {
#pragma unroll
    for (int k = 2; k <= N; k <<= 1)
#pragma unroll
        for (int j = k >> 1; j > 0; j >>= 1)
#pragma unroll
            for (int i = 0; i < N; ++i) { const int l = i ^ j; if (l > i) { const bool desc = ((i & k) == 0); const float a = v[i], b = v[l]; const float hi = fmaxf(a, b), lo = fminf(a, b); v[i] = desc ? hi : lo; v[l] = desc ? lo : hi; } }
}
__device__ __forceinline__ void bitonic_merge16_desc(float (&v)[16]) {
#pragma unroll
    for (int j = 8; j > 0; j >>= 1)
#pragma unroll
        for (int i = 0; i < 16; ++i) { const int l = i ^ j; if (l > i) { const float a = v[i], b = v[l]; v[i] = fmaxf(a, b); v[l] = fminf(a, b); } }
}
__device__ __forceinline__ void top16_of_64(float (&v)[64], float (&out)[16]) {
    float b[4][16];
#pragma unroll
    for (int q = 0; q < 4; ++q) {
#pragma unroll
        for (int i = 0; i < 16; ++i) b[q][i] = v[16 * q + i];
        bitonic_sort_desc<16>(b[q]);
    }
    float t0[16], t1[16];
#pragma unroll
    for (int i = 0; i < 16; ++i) { t0[i] = fmaxf(b[0][i], b[1][15 - i]); t1[i] = fmaxf(b[2][i], b[3][15 - i]); }
    bitonic_merge16_desc(t0); bitonic_merge16_desc(t1);
#pragma unroll
    for (int i = 0; i < 16; ++i) out[i] = fmaxf(t0[i], t1[15 - i]);
    bitonic_merge16_desc(out);
}
__device__ __forceinline__ float dot2u(unsigned a, unsigned b, float c) { return __builtin_amdgcn_fdot2_f32_bf16(__builtin_bit_cast(b16x2, a), __builtin_bit_cast(b16x2, b), c, false); }
__device__ __forceinline__ float gelu_erf(float a) { return 0.5f * a * (1.0f + erff(a * 0.70710678118654752f)); }

constexpr int KROW = 272;
constexpr int LP_KEYS = 0, LP_LUT = LP_KEYS + 256 * KROW, LP_RSTD = LP_LUT + NWAVES * 32 * 32, LP_END = LP_RSTD + 4 * 128;
static_assert(LP_END <= RING_BYTES, "peer LDS");

__device__ __forceinline__ void p5a_topk(const Args& a, LAS unsigned char* lds, int vcu, int G, int tid, int lane, int wave PT_DECL) {
    unsigned char* ws = a.ws;
    const bf16* Q = (const bf16*)(ws + WS_R2 + 64 * MB); const bf16* XB1 = (const bf16*)(ws + WS_R2); unsigned char* H8 = ws + WS_R1; float* SH = (float*)(ws + WS_SH); const float* gffn = a.in[8];
    unsigned* PK = (unsigned*)(ws + WS_PK);
    const int l31 = lane & 31, hf = lane >> 5;
    for (int i = tid; i < 256 * 16; i += NTHR) { const int rr = i >> 4, c = i & 15; *(LAS v4u*)(lds + LP_KEYS + rr * KROW + c * 16) = *(const v4u*)((const bf16*)(ws + WS_KEYS) + rr * 128 + c * 8); }
    float gw[16];
    { const f32x4 g0 = *(const f32x4*)(gffn + 16 * lane), g1 = *(const f32x4*)(gffn + 16 * lane + 4), g2 = *(const f32x4*)(gffn + 16 * lane + 8), g3 = *(const f32x4*)(gffn + 16 * lane + 12);
#pragma unroll
      for (int u = 0; u < 4; ++u) { gw[u] = g0[u]; gw[4 + u] = g1[u]; gw[8 + u] = g2[u]; gw[12 + u] = g3[u]; } }
    { int gi = 0;
      for (int grp = vcu; grp < T / 32 && gi < 4; grp += G, ++gi) {
        const int t0 = grp * 32;
        {
            float xs[4][16];
#pragma unroll
            for (int q = 0; q < 4; ++q) {
                const bf16* xr = XB1 + ((size_t)t0 + 4 * wave + q) * D + 16 * lane;
                const v4u x0 = *(const v4u*)xr, x1 = *(const v4u*)(xr + 8);
#pragma unroll
                for (int u = 0; u < 4; ++u) { xs[q][2 * u] = bf_lo(x0[u]); xs[q][2 * u + 1] = bf_hi(x0[u]); xs[q][8 + 2 * u] = bf_lo(x1[u]); xs[q][8 + 2 * u + 1] = bf_hi(x1[u]); }
            }
            float ssq[4];
#pragma unroll
            for (int q = 0; q < 4; ++q) { float sq = 0.f;
#pragma unroll
                for (int u = 0; u < 16; ++u) sq += xs[q][u] * xs[q][u];
                ssq[q] = sq; }
#pragma unroll
            for (int o = 1; o < 64; o <<= 1)
#pragma unroll
                for (int q = 0; q < 4; ++q) ssq[q] += __shfl_xor(ssq[q], o);
            float am[4];
#pragma unroll
            for (int q = 0; q < 4; ++q) {
                const float rstd = 1.0f / sqrtf(ssq[q] * (1.0f / D) + 1e-6f);
                if (lane == 0) *(LAS float*)(lds + LP_RSTD + gi * 128 + (4 * wave + q) * 4) = rstd;
                float m = 0.f;
#pragma unroll
                for (int u = 0; u < 16; ++u) { xs[q][u] = xs[q][u] * rstd * gw[u]; m = fmaxf(m, fabsf(xs[q][u])); }
                am[q] = m;
            }
#pragma unroll
            for (int o = 1; o < 64; o <<= 1)
#pragma unroll
                for (int q = 0; q < 4; ++q) am[q] = fmaxf(am[q], __shfl_xor(am[q], o));
#pragma unroll
            for (int q = 0; q < 4; ++q) {
                const size_t tok = (size_t)t0 + 4 * wave + q;
                const float inv = am[q] > 0.f ? 127.0f / am[q] : 0.f;
                v4u w;
#pragma unroll
                for (int c = 0; c < 4; ++c) { unsigned ww = 0u;
#pragma unroll
                    for (int u = 0; u < 4; ++u) { const int qi = __float2int_rn(xs[q][4 * c + u] * inv); ww |= ((unsigned)qi & 0xffu) << (8 * u); }
                    w[c] = ww; }
                *(v4u*)(H8 + tok * D + 16 * lane) = w;
                if (lane == 0) SH[tok] = am[q] * (1.0f / 127.0f);
            }
        }
      }
    }
    __syncthreads();
    int gi = 0;
#pragma unroll 1
    for (int grp = vcu; grp < T / 32 && gi < 4; grp += G, ++gi) {
        const int t0 = grp * 32;
        PT_BEGIN();
        PT_ADD(0);
        {
            const int h = wave;
            float lst[2][16];
#pragma unroll
            for (int p = 0; p < 2; ++p) {
                const bf16* qrow = Q + (size_t)(t0 + l31) * NQ + h * 256 + p * 128 + 8 * hf;
                f32x16 acc[4];
#pragma unroll
                for (int q = 0; q < 4; ++q)
#pragma unroll
                    for (int i = 0; i < 16; ++i) acc[q][i] = 0.f;
#pragma unroll
                for (int ks = 0; ks < 8; ++ks) {
                    const bf16x8 qf = *(const bf16x8*)(qrow + 16 * ks);
#pragma unroll
                    for (int q = 0; q < 4; ++q) acc[q] = MFMA32(lds_frag16(lds + LP_KEYS + (p * 128 + 32 * q + l31) * KROW + (16 * ks + 8 * hf) * 2), qf, acc[q]);
                }
                float v[64];
#pragma unroll
                for (int q = 0; q < 4; ++q)
#pragma unroll
                    for (int i = 0; i < 16; ++i) v[16 * q + i] = __uint_as_float((__float_as_uint(acc[q][i]) & 0xffffff80u) | (unsigned)(32 * q + crow(i, hf)));
                float mine[16];
                top16_of_64(v, mine);
                float t[16];
#pragma unroll
                for (int i = 0; i < 16; ++i) t[i] = __shfl_xor(mine[i], 32);
#pragma unroll
                for (int i = 0; i < 16; ++i) lst[p][i] = fmaxf(mine[i], t[15 - i]);
                bitonic_merge16_desc(lst[p]);
            }
            PT_ADD(1);
            LAS unsigned char* lut = lds + LP_LUT + wave * 1024 + l31 * 32;
            {
                v4u wa, wb;
#pragma unroll
                for (int c = 0; c < 4; ++c) {
                    wa[c] = (__float_as_uint(lst[0][4 * c]) & 0x7fu) | ((__float_as_uint(lst[0][4 * c + 1]) & 0x7fu) << 8) | ((__float_as_uint(lst[0][4 * c + 2]) & 0x7fu) << 16) | ((__float_as_uint(lst[0][4 * c + 3]) & 0x7fu) << 24);
                    wb[c] = (__float_as_uint(lst[1][4 * c]) & 0x7fu) | ((__float_as_uint(lst[1][4 * c + 1]) & 0x7fu) << 8) | ((__float_as_uint(lst[1][4 * c + 2]) & 0x7fu) << 16) | ((__float_as_uint(lst[1][4 * c + 3]) & 0x7fu) << 24);
                }
                if (hf == 0) { *(LAS v4u*)lut = wa; *(LAS v4u*)(lut + 16) = wb; }
            }
            float cv[64];
            {
                int c = 0;
#pragma unroll
                for (int i = 0; i < 16; ++i)
#pragma unroll
                    for (int j = 0; j < 16; ++j)
                        if ((i + 1) * (j + 1) <= 16) {
                            const float sa = __uint_as_float(__float_as_uint(lst[0][i]) & 0xffffff80u), sb = __uint_as_float(__float_as_uint(lst[1][j]) & 0xffffff80u);
                            cv[c] = __uint_as_float((__float_as_uint(sa + sb) & 0xffffff00u) | (unsigned)(i * 16 + j)); ++c;
                        }
#pragma unroll
                for (int k = 50; k < 64; ++k) cv[k] = -3.0e38f;
            }
            float best[16];
            top16_of_64(cv, best);
            const float rstd = *(const LAS float*)(lds + LP_RSTD + gi * 128 + l31 * 4);
            const float s0 = __uint_as_float(__float_as_uint(best[0]) & 0xffffff00u);
            float ev[16], esum = 0.f;
#pragma unroll
            for (int k = 0; k < 16; ++k) { const float sk = __uint_as_float(__float_as_uint(best[k]) & 0xffffff00u); ev[k] = __expf(rstd * (sk - s0)); esum += ev[k]; }
            const float einv = 1.0f / esum;
            LDS_WAIT();
            asm volatile("" ::: "memory");
            {
                const size_t ob = (size_t)(t0 + l31) * 128 + h * 16 + 8 * hf;
                unsigned e8[8];
                const unsigned hm = hf ? 0xffffffffu : 0u;
#pragma unroll
                for (int j = 0; j < 8; ++j) { const unsigned code = ((__float_as_uint(best[8 + j]) & hm) | (__float_as_uint(best[j]) & ~hm)) & 0xffu;
                    const float gk = __uint_as_float((__float_as_uint(ev[8 + j]) & hm) | (__float_as_uint(ev[j]) & ~hm)) * einv;
                    const unsigned ia = *(const LAS unsigned char*)(lut + (code >> 4)), ib = *(const LAS unsigned char*)(lut + 16 + (code & 15u));
                    e8[j] = (ia * 128u + ib) | (pk2(0.f, gk) & 0xffff0000u); }
                *(v4u*)(PK + ob) = (v4u){e8[0], e8[1], e8[2], e8[3]}; *(v4u*)(PK + ob + 4) = (v4u){e8[4], e8[5], e8[6], e8[7]};
            }
            PT_ADD(2);
        }
    }
    __syncthreads();
}

constexpr int LB_H = 0, LB_LIST = LB_H + NWAVES * 4096, LB_GATE = LB_LIST + NWAVES * 2304, LB_SH = LB_GATE + NWAVES * 2048, LB_END = LB_SH + NWAVES * 16;
static_assert(LB_END <= RING_BYTES, "p5b LDS");
struct B5Batch { v4u ur[4][4]; unsigned em; float scl, svl; };
__device__ __forceinline__ int row16_sum(int x) {
    x += __builtin_amdgcn_update_dpp(0, x, 0xB1, 0xf, 0xf, false);
    x += __builtin_amdgcn_update_dpp(0, x, 0x4E, 0xf, 0xf, false);
    x += __builtin_amdgcn_update_dpp(0, x, 0x141, 0xf, 0xf, false);
    x += __builtin_amdgcn_update_dpp(0, x, 0x140, 0xf, 0xf, false);
    return x;
}
__device__ __forceinline__ void b5_issue(B5Batch& b, const LAS unsigned* list, int bt, const unsigned char* U8, const float* SU, const float* SV, int lane, int jmine) {
    const int g = lane >> 4, c = lane & 15;
#pragma unroll
    for (int ps = 0; ps < 4; ++ps) {
        const unsigned ent = list[16 * bt + 4 * ps + g];
        const unsigned char* rp = U8 + (size_t)(ent & 0xffffu) * D + 16 * c;
#pragma unroll
        for (int i = 0; i < 4; ++i) b.ur[ps][i] = *(const v4u*)(rp + 256 * i);
    }
    b.em = list[16 * bt + 4 * (c & 3) + g];
    const unsigned ee = b.em & 0xffffu; b.scl = SU[ee]; b.svl = SV[ee];
}
__device__ __forceinline__ void b5_compute(const B5Batch& b, const LAS unsigned* list, int bt, LAS unsigned char* hreg, const LAS float* gts, const LAS float* shs, unsigned* PK, int tok0, int lane) {
    const int g = lane >> 4, c = lane & 15;
    int res = 0;
#pragma unroll
    for (int ps = 0; ps < 4; ++ps) {
        const unsigned ent = list[16 * bt + 4 * ps + g];
        LAS unsigned char* hp = hreg + ((ent >> 28) & 3u) * 1024 + 16 * c;
        int acc = 0;
#pragma unroll
        for (int i = 0; i < 4; ++i) { const v4u hh = *(const LAS v4u*)(hp + 256 * i);
#pragma unroll
            for (int u = 0; u < 4; ++u) { const unsigned wa = b.ur[ps][i][u], ha = hh[u]; acc = __builtin_amdgcn_sdot4((int)ha, (int)wa, acc, false); } }
        const int tot = row16_sum(acc);
        res = (c == ps) ? tot : res;
    }
    const unsigned eslot = b.em >> 28, ek = (b.em >> 16) & 0xffu;
    if (c < 4 && eslot < 4u) {
        const float dot = (float)res * b.scl * shs[eslot];
        ((unsigned short*)(PK + ((size_t)tok0 + eslot) * 128 + ek))[1] = (unsigned short)(pk2(0.f, gelu_erf(dot) * gts[eslot * 128 + ek] * b.svl) >> 16);
    }
}
struct B5Pre { v2u pk[4]; v4u h0[4]; float shv; };
__device__ __forceinline__ void b5_prefetch(B5Pre& p, const unsigned* PK, const unsigned char* H8, const float* SH, int tok0, int lane) {
#pragma unroll
    for (int s = 0; s < 4; ++s) { const size_t tok = (size_t)tok0 + s;
        p.pk[s] = *(const v2u*)(PK + tok * 128 + 2 * lane); p.h0[s] = *(const v4u*)(H8 + tok * D + 16 * lane); }
    p.shv = SH[tok0 + (lane & 3)];
}
__device__ __forceinline__ void p5b_dots(const Args& a, LAS unsigned char* lds, int bx, int G, int tid, int lane, int wave) {
    unsigned char* ws = a.ws;
    const unsigned char* H8 = ws + WS_R1; const unsigned char* U8 = ws + WS_UB; const float* SU = (const float*)(ws + WS_SU); const float* SV = (const float*)(ws + WS_SV); const float* SH = (const float*)(ws + WS_SH);
    unsigned* PK = (unsigned*)(ws + WS_PK);
    LAS unsigned char* hreg = lds + LB_H + wave * 4096; LAS unsigned* list = (LAS unsigned*)(lds + LB_LIST + wave * 2304); LAS float* gts = (LAS float*)(lds + LB_GATE + wave * 2048); LAS float* shs = (LAS float*)(lds + LB_SH + wave * 16);
    const int jmine = ((lane >> 5) & 1) * 8 + ((lane >> 4) & 1) * 4 + ((lane >> 3) & 1) * 2 + ((lane >> 2) & 1);
    const unsigned long long ltmask = (1ull << lane) - 1ull;
    for (int vb = bx; vb < 256; vb += G) {
        const unsigned vx = (unsigned)(vb & 7); const int wi = vb >> 3;
        const int tw0 = wi * 1024 + wave * 128;
        B5Pre P;
        b5_prefetch(P, PK, H8, SH, tw0, lane);
#pragma unroll 1
        for (int ch = 0; ch < 32; ++ch) {
            const int tok0 = tw0 + 4 * ch;
            int n = 0;
            if (lane < 4) shs[lane] = P.shv;
#pragma unroll
            for (int s = 0; s < 4; ++s) {
                *(LAS v4u*)(hreg + s * 1024 + lane * 16) = P.h0[s];
                *(LAS f32x2*)(gts + s * 128 + 2 * lane) = (f32x2){bf_hi(P.pk[s].x), bf_hi(P.pk[s].y)};
                const unsigned id0 = P.pk[s].x & 0xffffu, id1 = P.pk[s].y & 0xffffu;
                const bool in0 = (id0 >> 11) == vx, in1 = (id1 >> 11) == vx;
                const unsigned long long m0 = __ballot(in0), m1 = __ballot(in1);
                const int c0 = __popcll(m0), c1 = __popcll(m1);
                if (in0) list[n + __popcll(m0 & ltmask)] = ((unsigned)s << 28) | ((unsigned)(2 * lane) << 16) | id0;
                if (in1) list[n + c0 + __popcll(m1 & ltmask)] = ((unsigned)s << 28) | ((unsigned)(2 * lane + 1) << 16) | id1;
                n += c0 + c1;
            }
            const int nb = (n + 15) >> 4;
            if (lane < 16) list[n + lane] = (0xfu << 28) | (vx << 11);
            if (ch + 1 < 32) b5_prefetch(P, PK, H8, SH, tok0 + 4, lane);
            LDS_WAIT(); asm volatile("" ::: "memory");
            B5Batch A, B;
            if (nb > 0) b5_issue(A, list, 0, U8, SU, SV, lane, jmine);
#pragma unroll 1
            for (int bt = 0; bt < nb; bt += 2) {
                if (bt + 1 < nb) b5_issue(B, list, bt + 1, U8, SU, SV, lane, jmine);
                b5_compute(A, list, bt, hreg, gts, shs, PK, tok0, lane);
                if (bt + 1 < nb) {
                    if (bt + 2 < nb) b5_issue(A, list, bt + 2, U8, SU, SV, lane, jmine);
                    b5_compute(B, list, bt + 1, hreg, gts, shs, PK, tok0, lane);
                }
            }
        }
    }
}

constexpr int LC_BUF = 0, LC_END = NWAVES * 2 * 1024;
struct C5Tok { v4u vv[16]; unsigned xa; float sa; };
__device__ __forceinline__ float c5_stage(LAS unsigned char* buf, v2u pk, int lane) {
    const unsigned idw = (pk.x & 0xffffu) | (pk.y << 16); const f32x2 av = {bf_hi(pk.x), bf_hi(pk.y)};
    float am = fmaxf(fabsf(av[0]), fabsf(av[1]));
#pragma unroll
    for (int o = 1; o < 64; o <<= 1) am = fmaxf(am, __shfl_xor(am, o));
    const float inv = am > 0.f ? 127.0f / am : 0.f;
    const int q0 = __float2int_rn(av[0] * inv), q1 = __float2int_rn(av[1] * inv);
    *(LAS unsigned*)(buf + 4 * lane) = idw;
    const int k0 = 2 * lane, k1 = 2 * lane + 1;
    *(LAS unsigned char*)(buf + 256 + (k0 & 7) * 16 + (k0 >> 3)) = (unsigned char)q0;
    *(LAS unsigned char*)(buf + 256 + (k1 & 7) * 16 + (k1 >> 3)) = (unsigned char)q1;
    return am * (1.0f / 127.0f);
}
__device__ __forceinline__ void c5_issue(C5Tok& t, LAS unsigned char* buf, const unsigned char* vbase, const bf16* xr, int g) {
#pragma unroll
    for (int j = 0; j < 16; ++j) {
        const int k = 8 * j + g;
        const unsigned e = *(const LAS unsigned short*)(buf + 2 * k);
        t.vv[j] = *(const v4u*)(vbase + (size_t)e * 128);
    }
    t.xa = *(const unsigned*)xr;
}
__device__ __forceinline__ void c5_finish(const C5Tok& t, LAS unsigned char* buf, bf16* xb, float* rss, int lane, int g) {
    int y[16];
#pragma unroll
    for (int u = 0; u < 16; ++u) y[u] = 0;
#pragma unroll
    for (int q = 0; q < 4; ++q) {
        const int a4 = (int)*(const LAS unsigned*)(buf + 256 + g * 16 + 4 * q);
#pragma unroll
        for (int u = 0; u < 4; ++u) {
            const unsigned r0 = t.vv[4 * q][u], r1 = t.vv[4 * q + 1][u], r2 = t.vv[4 * q + 2][u], r3 = t.vv[4 * q + 3][u];
            const unsigned lo01 = __builtin_amdgcn_perm(r1, r0, 0x05010400u), hi01 = __builtin_amdgcn_perm(r1, r0, 0x07030602u);
            const unsigned lo23 = __builtin_amdgcn_perm(r3, r2, 0x05010400u), hi23 = __builtin_amdgcn_perm(r3, r2, 0x07030602u);
            const unsigned t0 = __builtin_amdgcn_perm(lo23, lo01, 0x05040100u), t1 = __builtin_amdgcn_perm(lo23, lo01, 0x07060302u);
            const unsigned t2 = __builtin_amdgcn_perm(hi23, hi01, 0x05040100u), t3 = __builtin_amdgcn_perm(hi23, hi01, 0x07060302u);
            y[4 * u] = __builtin_amdgcn_sdot4((int)t0, a4, y[4 * u], false); y[4 * u + 1] = __builtin_amdgcn_sdot4((int)t1, a4, y[4 * u + 1], false);
            y[4 * u + 2] = __builtin_amdgcn_sdot4((int)t2, a4, y[4 * u + 2], false); y[4 * u + 3] = __builtin_amdgcn_sdot4((int)t3, a4, y[4 * u + 3], false);
        }
    }
    int y8[8], y4[4], y2[2];
    { const bool hi = (lane & 32) != 0;
#pragma unroll
      for (int u = 0; u < 8; ++u) { const int keep = hi ? y[u + 8] : y[u], send = hi ? y[u] : y[u + 8]; y8[u] = keep + __shfl_xor(send, 32); } }
    { const bool hi = (lane & 16) != 0;
#pragma unroll
      for (int u = 0; u < 4; ++u) { const int keep = hi ? y8[u + 4] : y8[u], send = hi ? y8[u] : y8[u + 4]; y4[u] = keep + __shfl_xor(send, 16); } }
    { const bool hi = (lane & 8) != 0;
#pragma unroll
      for (int u = 0; u < 2; ++u) { const int keep = hi ? y4[u + 2] : y4[u], send = hi ? y4[u] : y4[u + 2]; y2[u] = keep + __shfl_xor(send, 8); } }
    const float o0 = bf_lo(t.xa) + (float)y2[0] * t.sa, o1 = bf_hi(t.xa) + (float)y2[1] * t.sa;
    const float ss = wave_sum(o0 * o0 + o1 * o1);
    *(unsigned*)xb = pk2(o0, o1);
    if (lane == 0) *rss = ss;
}
__device__ __forceinline__ void p5c_axpy(const Args& a, LAS unsigned char* lds, int bx, int G, int tid, int lane, int wave) {
    unsigned char* ws = a.ws;
    const unsigned char* V8 = ws + WS_VB; const unsigned* PK = (const unsigned*)(ws + WS_PK);
    const bf16* XB1 = (const bf16*)(ws + WS_R2); bf16* XB2 = (bf16*)(ws + WS_R1); float* RSS2 = (float*)(ws + WS_RSS2);
    const int g = lane >> 3, c = lane & 7;
    const int colo = 16 * c + 8 * ((g >> 2) & 1) + 4 * ((g >> 1) & 1) + 2 * (g & 1);
    LAS unsigned char* buf0 = lds + LC_BUF + wave * 2048; LAS unsigned char* buf1 = buf0 + 1024;
    for (int vb = bx; vb < 256; vb += G) {
        const int vx = vb & 7, wi = vb >> 3;
        const size_t tw0 = (size_t)wi * 1024 + wave * 128;
        const unsigned char* vbase = V8 + (size_t)vx * ((size_t)NEXP * 128) + 16 * c;
        const bf16* xcol = XB1 + vx * 128 + colo; bf16* xbcol = XB2 + vx * 128 + colo;
        C5Tok A, B;
        v2u pk = *(const v2u*)(PK + tw0 * 128 + 2 * lane);
        A.sa = c5_stage(buf0, pk, lane);
        pk = *(const v2u*)(PK + (tw0 + 1) * 128 + 2 * lane);
        LDS_WAIT(); asm volatile("" ::: "memory");
        c5_issue(A, buf0, vbase, xcol + tw0 * D, g);
#pragma unroll 1
        for (int i = 0; i < 128; i += 2) {
            const size_t tok = tw0 + i;
            B.sa = c5_stage(buf1, pk, lane);
            if (i + 2 < 128) pk = *(const v2u*)(PK + (tok + 2) * 128 + 2 * lane);
            LDS_WAIT(); asm volatile("" ::: "memory");
            c5_issue(B, buf1, vbase, xcol + (tok + 1) * D, g);
            c5_finish(A, buf0, xbcol + tok * D, RSS2 + tok * 8 + vx, lane, g);
            if (i + 2 < 128) {
                A.sa = c5_stage(buf0, pk, lane);
                if (i + 3 < 128) pk = *(const v2u*)(PK + (tok + 3) * 128 + 2 * lane);
                LDS_WAIT(); asm volatile("" ::: "memory");
                c5_issue(A, buf0, vbase, xcol + (tok + 2) * D, g);
            }
            c5_finish(B, buf1, xbcol + (tok + 1) * D, RSS2 + (tok + 1) * 8 + vx, lane, g);
        }
    }
}

__global__ void __launch_bounds__(NTHR, 2) mk_fwd(Args a) {
    extern __shared__ __attribute__((aligned(16))) unsigned char lds_raw[];
    LAS unsigned char* lds = (LAS unsigned char*)lds_raw;
    const int tid = threadIdx.x, lane = tid & 63, wave = __builtin_amdgcn_readfirstlane(tid >> 6);
    const int G = gridDim.x, bx = blockIdx.x, vcu = (G % 8 == 0) ? (bx % 8) * (G / 8) + bx / 8 : bx;
    volatile LAS unsigned* MISC = (volatile LAS unsigned*)(lds + MISC_OFF);
    if (tid < 64) MISC[tid] = 0u;
    __syncthreads();
    unsigned char* ws = a.ws;
    const int lo = a.ph_lo, hi = a.ph_hi;
    XcdBarrier bar; bar.bar = (unsigned*)(ws + WS_CTL) + CW_BAR + a.li * XCD_BAR_WORDS; bar.x = 0; bar.st = nullptr;
    if (hi - lo > 1) bar = xcd_barrier_post((unsigned*)(ws + WS_CTL) + CW_BAR + a.li * XCD_BAR_WORDS, MISC + 8);
#define IN(k) (lo <= (k) && (k) < hi)
#define BOTH(k) (IN(k) && IN((k) + 1))
    if (IN(0)) { p0_prologue(a, lds, vcu, G, tid, lane, wave); if (BOTH(0)) xcd_barrier(bar); }
    if (IN(1)) {
        { pg8::Gemm g{(const bf16*)(ws + WS_R1), (const bf16*)(ws + WS_WIN), T, NIN, D}; pg8::StaticOrder S; S.init(T, NIN, G, bx);
          EpiStoreBf16 E{(bf16*)(ws + WS_R2), NIN};
          pg8::gemm_phase<EpiStoreBf16, pg8::StaticOrder, true, true>(lds, g, S, E); }
        { pg8::Gemm g{(const bf16*)(ws + WS_PB), (const bf16*)(ws + WS_WP), T, D, PLE}; pg8::StaticOrder S; S.init(T, D, G, bx);
          EpiStoreBf16 E{(bf16*)(ws + WS_PP), D};
          pg8::gemm_phase<EpiStoreBf16, pg8::StaticOrder, true, true>(lds, g, S, E); }
        if (BOTH(1)) xcd_barrier(bar);
    }
    if (IN(2)) { p2_mixing(a, lds, bx, G, tid, lane, wave); if (BOTH(2)) xcd_barrier(bar); }
    if (IN(3)) {
        pg8::Gemm g{(const bf16*)(ws + WS_R1), (const bf16*)(ws + WS_WOUT), T, D, D}; pg8::StaticOrder S; S.init(T, D, G, bx);
        EpiResid E{a.in[0], (bf16*)(ws + WS_R2)};
        pg8::gemm_phase<EpiResid, pg8::StaticOrder, true, true>(lds, g, S, E);
        if (BOTH(3)) xcd_barrier(bar);
    }
    if (IN(4)) {
        pg8::Gemm g{(const bf16*)(ws + WS_R2), (const bf16*)(ws + WS_WQ), T, NQ, D}; pg8::StaticOrder S; S.init(T, NQ, G, bx);
        EpiStoreBf16 E{(bf16*)(ws + WS_R2 + 64 * MB), NQ};
        pg8::gemm_phase<EpiStoreBf16, pg8::StaticOrder, true, true>(lds, g, S, E);
        if (BOTH(4)) xcd_barrier(bar);
    }
    if (IN(5)) {
        p5a_topk(a, lds, vcu, G, tid, lane, wave PT_ARG); xcd_barrier(bar);
        p5b_dots(a, lds, bx, G, tid, lane, wave); xcd_barrier(bar);
        p5c_axpy(a, lds, bx, G, tid, lane, wave);
        if (BOTH(5)) xcd_barrier(bar);
    }
    if (IN(6)) {
        pg8::Gemm g{(const bf16*)(ws + WS_R1), (const bf16*)(ws + WS_WG), T, D, D}; pg8::StaticOrder S; S.init(T, D, G, bx);
        EpiGate E{a.out, (const bf16*)(ws + WS_R1), (const bf16*)(ws + WS_PP), (const float*)(ws + WS_RSS2)};
        pg8::gemm_phase<EpiGate, pg8::StaticOrder, true, true>(lds, g, S, E);
    }
#undef IN
#undef BOTH
}
}
extern "C" void kernel_launch(void* const* d_in, const int* in_sizes, int n_in, void* d_out, int out_size, void* d_ws, size_t ws_size, hipStream_t stream) {
    using namespace mk;
    static int grid = 0;
    if (grid == 0) {
        int dev = 0, cus = 0;
        if (n_in != 16 || out_size != T * D || ws_size < WS_END) { fprintf(stderr, "kernel_launch: unexpected problem shape / workspace (%d inputs, out %d, ws %zu)\n", n_in, out_size, ws_size); grid = -1; return; }
        if (hipGetDevice(&dev) != hipSuccess || hipDeviceGetAttribute(&cus, hipDeviceAttributeMultiprocessorCount, dev) != hipSuccess) { fprintf(stderr, "device query failed\n"); grid = -1; return; }
        if (hipFuncSetAttribute((const void*)mk_fwd, hipFuncAttributeMaxDynamicSharedMemorySize, LDS_BYTES) != hipSuccess) { fprintf(stderr, "hipFuncSetAttribute failed\n"); grid = -1; return; }
        int per_cu = 0;
        if (hipOccupancyMaxActiveBlocksPerMultiprocessor(&per_cu, (const void*)mk_fwd, NTHR, LDS_BYTES) != hipSuccess || per_cu < 1) { fprintf(stderr, "occupancy query: %d blocks per CU\n", per_cu); (void)hipGetLastError(); }
        if (cus < 256) { fprintf(stderr, "kernel_launch: this kernel is laid out for a 256-CU device (found %d CUs)\n", cus); grid = -1; return; }
        grid = 256;
    }
    if (grid < 0) return;
    unsigned char* ws = (unsigned char*)d_ws;
    (void)hipMemsetAsync(ws + WS_CTL, 0, CTL_BYTES, stream);
    Args a{};
    for (int i = 0; i < 16; ++i) a.in[i] = (const float*)d_in[i];
    a.out = (float*)d_out; a.ws = ws; a.ph_lo = 0; a.ph_hi = 7; a.li = 0; a.pad = 0;
    hipLaunchKernelGGL(mk_fwd, dim3(grid), dim3(NTHR), LDS_BYTES, stream, a);
}
```

```cpp
#include <hip/hip_runtime.h>
#include <cstdio>
#include <cstdint>
#define LAS __attribute__((address_space(3)))
#define GAS __attribute__((address_space(1)))
namespace pg8 {
#define PG8_LAS __attribute__((address_space(3)))
typedef unsigned short bf16_t;
typedef short bf16x8 __attribute__((ext_vector_type(8)));
typedef float f32x4 __attribute__((ext_vector_type(4)));
typedef unsigned u32x4 __attribute__((ext_vector_type(4)));
constexpr int BM = 256, BK = 64, HALF = 128, HTB = HALF * BK * 2  , STAGE_BYTES = 8 * HTB, NXCD = 8, WGM = 8;

__host__ __device__ __forceinline__ int lds_byte(int r, int c) { const int st = (r >> 4) * 2 + (c >> 5), rr = r & 15, cc = c & 31, ob = rr * 64 + cc * 2; return st * 1024 + (ob ^ (((ob >> 9) & 1) << 5)); }
__host__ __device__ __forceinline__ void stage_rc(int b, int& R, int& C) { const int st = b / 1024, sb = b % 1024, swz = sb ^ (((sb >> 9) & 1) << 5); R = (st >> 1) * 16 + swz / 64; C = (st & 1) * 32 + (swz % 64) / 2; }
__host__ __device__ __forceinline__ int perm32(int rho) { const int n = rho >> 4, i = rho & 15; return 8 * (i >> 2) + 4 * n + (i & 3); }

struct Unit { int pm, pn; };
struct Gemm { const bf16_t* A; const bf16_t* Bt; int M, N, K; };

struct StaticOrder {
    int nM, nN, nwg, G, c;
    __host__ __device__ void init(int M, int N, int G_, int c_) { nM = M / BM; nN = N / BM; nwg = nM * nN; G = G_; c = c_; }
    __host__ __device__ bool next(int i, Unit& u) const {
        const long L = (long)i * G + c; if (L >= nwg) return false;
        int wgid = (int)L; { const int q = nwg / NXCD, r = nwg % NXCD, xcd = wgid % NXCD, off = wgid / NXCD; wgid = (xcd < r ? xcd * (q + 1) : r * (q + 1) + (xcd - r) * q) + off; }
        const int nig = WGM * nN, gid = wgid / nig, fm = gid * WGM, gsz = (nM - fm) < WGM ? (nM - fm) : WGM;
        u.pm = fm + ((wgid % nig) % gsz); u.pn = (wgid % nig) / gsz; return true;
    }
    __device__ __forceinline__ void a_ready(const Unit&) const {}
    __device__ __forceinline__ void done(const Unit&) const {}
};
__device__ __forceinline__ unsigned cvt_pk_bf16(float lo, float hi) { unsigned r; asm volatile("v_cvt_pk_bf16_f32 %0, %1, %2" : "=v"(r) : "v"(lo), "v"(hi)); return r; }
template <class Epi, class Sched, bool ALIGN_EPI = false, bool SP2 = false>
__device__ __forceinline__ void gemm_phase(PG8_LAS unsigned char* lds, const Gemm g, const Sched& S, const Epi& E) {
    const int tid = threadIdx.x, wid = __builtin_amdgcn_readfirstlane(tid >> 6), lane = tid & 63, wr = wid >> 2, wc = wid & 3, fr = lane & 15, fq = lane >> 4;
    const int K = g.K, nt = K / BK;
    unsigned voffA[2], voffB[2];
#pragma unroll
    for (int i = 0; i < 2; ++i) { int R, C; stage_rc(tid * 16 + i * 8192, R, C); const int Rb = Epi::PERM ? ((R & ~31) + perm32(R & 31)) : R;
        voffA[i] = (unsigned)(R * K + C) * 2u; voffB[i] = (unsigned)(Rb * K + C) * 2u; }
    const size_t kstep = (size_t)(BK * 2);
    const size_t hstep = (size_t)HALF * K * 2;
    const size_t tstep = 2 * hstep;
    const unsigned ldsw = (unsigned)wid * 1024u;
    const int aoff = lds_byte(wr * 64 + fr, fq * 8), boff = lds_byte(wc * 32 + fr, fq * 8);
#define PG8_SA(b, h) (((b) * 2 + (h)) * HTB)
#define PG8_SB(b, h) ((4 + (b) * 2 + (h)) * HTB)
#define PG8_STAGE(bufoff, gbase, voff) do { _Pragma("unroll") for (int _i = 0; _i < 2; ++_i) \
        __builtin_amdgcn_global_load_lds((const unsigned*)((const char*)(gbase) + (voff)[_i]), (PG8_LAS unsigned*)(lds + (bufoff) + ldsw + _i * 8192), 16, 0, 0); } while (0)
#define PG8_LDA(dst, b, h) do { _Pragma("unroll") for (int m = 0; m < 4; ++m) _Pragma("unroll") for (int k = 0; k < 2; ++k) dst[m][k] = *(const PG8_LAS bf16x8*)(lds + PG8_SA(b, h) + aoff + m * 2048 + k * 1024); } while (0)
#define PG8_LDB(dst, b, h) do { _Pragma("unroll") for (int n = 0; n < 2; ++n) _Pragma("unroll") for (int k = 0; k < 2; ++k) dst[n][k] = *(const PG8_LAS bf16x8*)(lds + PG8_SB(b, h) + boff + n * 2048 + k * 1024); } while (0)
#define PG8_MMA(ai, bj, At, Bt) do { __builtin_amdgcn_s_setprio(1); _Pragma("unroll") for (int m = 0; m < 4; ++m) _Pragma("unroll") for (int n = 0; n < 2; ++n) _Pragma("unroll") for (int k = 0; k < 2; ++k) \
        acc[ai][bj][m][n] = __builtin_amdgcn_mfma_f32_16x16x32_bf16(Bt[n][k], At[m][k], acc[ai][bj][m][n], 0, 0, 0); __builtin_amdgcn_s_setprio(0); } while (0)
#define PG8_WAIT_V(n) asm volatile("s_waitcnt vmcnt(" #n ")" ::: "memory")
#define PG8_WAIT_L(n) asm volatile("s_waitcnt lgkmcnt(" #n ")" ::: "memory")
#define PG8_BAR __builtin_amdgcn_s_barrier()
#define PG8_SCHED __builtin_amdgcn_sched_barrier(0)
    Unit cur, nxt; int ui = 0;
    if (!S.next(0, cur)) return;
    f32x4 acc[2][2][4][2];
#pragma unroll
    for (int a = 0; a < 2; ++a)
#pragma unroll
        for (int b = 0; b < 2; ++b)
#pragma unroll
            for (int m = 0; m < 4; ++m)
#pragma unroll
                for (int n = 0; n < 2; ++n) acc[a][b][m][n] = (f32x4){0.f, 0.f, 0.f, 0.f};
    bf16x8 At[4][2], B0[2][2], B1[2][2];
    const char* cA = (const char*)g.A + (size_t)cur.pm * tstep; const char* cB = (const char*)g.Bt + (size_t)cur.pn * tstep;
    S.a_ready(cur);
    if constexpr (SP2) {
        PG8_STAGE(PG8_SB(0, 0), cB, voffB); PG8_STAGE(PG8_SB(0, 1), cB + hstep, voffB); PG8_STAGE(PG8_SA(0, 0), cA, voffA); PG8_STAGE(PG8_SA(0, 1), cA + hstep, voffA);
        if (wr == 1) PG8_BAR;
        PG8_WAIT_V(2); PG8_BAR;
        PG8_STAGE(PG8_SB(1, 0), cB + kstep, voffB); PG8_STAGE(PG8_SA(1, 0), cA + kstep, voffA); PG8_STAGE(PG8_SB(1, 1), cB + hstep + kstep, voffB);
        PG8_WAIT_V(6); PG8_BAR;
    } else {
        PG8_STAGE(PG8_SB(0, 0), cB, voffB); PG8_STAGE(PG8_SA(0, 0), cA, voffA); PG8_STAGE(PG8_SB(0, 1), cB + hstep, voffB); PG8_STAGE(PG8_SA(0, 1), cA + hstep, voffA);
        if (wr == 1) PG8_BAR;
        PG8_WAIT_V(4); PG8_BAR;
        PG8_STAGE(PG8_SB(1, 0), cB + kstep, voffB); PG8_STAGE(PG8_SA(1, 0), cA + kstep, voffA); PG8_STAGE(PG8_SB(1, 1), cB + hstep + kstep, voffB);
        PG8_WAIT_V(6); PG8_BAR;
    }
    for (;;) {
        const bool has_next = S.next(ui + 1, nxt);
        const char* nA = has_next ? (const char*)g.A + (size_t)nxt.pm * tstep : cA; const char* nB = has_next ? (const char*)g.Bt + (size_t)nxt.pn * tstep : cB;
        for (int t = 0; t < nt; t += 2) {
            const bool last = (t == nt - 2);
            const char* a1 = cA + (size_t)(t + 1) * kstep;
            const char* a2 = last ? nA : cA + (size_t)(t + 2) * kstep; const char* b2 = last ? nB : cB + (size_t)(t + 2) * kstep;
            const char* a3 = a2 + kstep; const char* b3 = b2 + kstep;
            if (last && has_next) S.a_ready(nxt);
            if constexpr (SP2) {
            PG8_LDB(B0, 0, 0); PG8_LDB(B1, 0, 1); PG8_SCHED; PG8_LDA(At, 0, 0); PG8_STAGE(PG8_SA(1, 1), a1 + hstep, voffA);
            PG8_WAIT_V(8); PG8_WAIT_L(0); PG8_BAR; PG8_MMA(0, 0, At, B0); PG8_MMA(0, 1, At, B1); PG8_BAR; PG8_SCHED;
            PG8_LDA(At, 0, 1); PG8_STAGE(PG8_SB(0, 0), b2, voffB); PG8_STAGE(PG8_SB(0, 1), b2 + hstep, voffB); PG8_STAGE(PG8_SA(0, 0), a2, voffA);
            PG8_WAIT_V(8); PG8_WAIT_L(0); PG8_BAR; PG8_MMA(1, 0, At, B0); PG8_MMA(1, 1, At, B1); PG8_BAR; PG8_SCHED;
            PG8_LDB(B0, 1, 0); PG8_LDB(B1, 1, 1); PG8_SCHED; PG8_LDA(At, 1, 0); PG8_STAGE(PG8_SA(0, 1), a2 + hstep, voffA);
            PG8_WAIT_V(8); PG8_WAIT_L(0); PG8_BAR; PG8_MMA(0, 0, At, B0); PG8_MMA(0, 1, At, B1); PG8_BAR; PG8_SCHED;
            PG8_LDA(At, 1, 1); PG8_STAGE(PG8_SB(1, 0), b3, voffB); PG8_STAGE(PG8_SB(1, 1), b3 + hstep, voffB); PG8_STAGE(PG8_SA(1, 0), a3, voffA);
            PG8_WAIT_V(8); PG8_WAIT_L(0); PG8_BAR; PG8_MMA(1, 0, At, B0); PG8_MMA(1, 1, At, B1); PG8_BAR; PG8_SCHED;
            } else {
            PG8_LDB(B0, 0, 0); PG8_SCHED; PG8_LDA(At, 0, 0); PG8_STAGE(PG8_SA(1, 1), a1 + hstep, voffA);
            PG8_WAIT_L(8); PG8_BAR; PG8_WAIT_L(0); PG8_MMA(0, 0, At, B0); PG8_BAR; PG8_SCHED;
            PG8_LDB(B1, 0, 1); PG8_STAGE(PG8_SB(0, 0), b2, voffB);
            PG8_BAR; PG8_WAIT_L(0); PG8_MMA(0, 1, At, B1); PG8_BAR;
            PG8_LDA(At, 0, 1); PG8_STAGE(PG8_SA(0, 0), a2, voffA);
            PG8_BAR; PG8_WAIT_L(0); PG8_MMA(1, 0, At, B0); PG8_BAR; PG8_SCHED;
            PG8_STAGE(PG8_SB(0, 1), b2 + hstep, voffB);
            PG8_WAIT_V(6); PG8_BAR; PG8_MMA(1, 1, At, B1); PG8_BAR;
            PG8_LDB(B0, 1, 0); PG8_SCHED; PG8_LDA(At, 1, 0); PG8_STAGE(PG8_SA(0, 1), a2 + hstep, voffA);
            PG8_WAIT_L(8); PG8_BAR; PG8_WAIT_L(0); PG8_MMA(0, 0, At, B0); PG8_BAR; PG8_SCHED;
            PG8_LDB(B1, 1, 1); PG8_STAGE(PG8_SB(1, 0), b3, voffB);
            PG8_BAR; PG8_WAIT_L(0); PG8_MMA(0, 1, At, B1); PG8_BAR;
            PG8_LDA(At, 1, 1); PG8_STAGE(PG8_SA(1, 0), a3, voffA);
            PG8_BAR; PG8_WAIT_L(0); PG8_MMA(1, 0, At, B0); PG8_BAR; PG8_SCHED;
            PG8_STAGE(PG8_SB(1, 1), b3 + hstep, voffB);
            PG8_WAIT_V(6); PG8_BAR; PG8_MMA(1, 1, At, B1); PG8_BAR;
            }
        }
        if constexpr (ALIGN_EPI) { if (wr == 0) PG8_BAR; }
        if constexpr (!Epi::AFTER_DRAIN) { E(acc, cur, wr, wc, fr, fq); S.done(cur); }
        if (!has_next) break;
#pragma unroll
        for (int a = 0; a < 2; ++a)
#pragma unroll
            for (int b = 0; b < 2; ++b)
#pragma unroll
                for (int m = 0; m < 4; ++m)
#pragma unroll
                    for (int n = 0; n < 2; ++n) acc[a][b][m][n] = (f32x4){0.f, 0.f, 0.f, 0.f};
        cur = nxt; cA = nA; cB = nB; ++ui;
        if constexpr (ALIGN_EPI) { if (wr == 1) PG8_BAR; }
    }
    PG8_WAIT_V(0);
    if constexpr (!ALIGN_EPI) { if (wr == 0) PG8_BAR; }
    PG8_BAR;
    if constexpr (Epi::AFTER_DRAIN) { E.fused(acc, cur, wr, wc, fr, fq, lds, wid, lane); S.done(cur); }
#undef PG8_SA
#undef PG8_SB
#undef PG8_STAGE
#undef PG8_LDA
#undef PG8_LDB
#undef PG8_MMA
#undef PG8_WAIT_V
#undef PG8_WAIT_L
#undef PG8_BAR
#undef PG8_SCHED
}
}
#define XB_TMO      128
#define XB_XCNT(j)  (256  + 64 * (j))
#define XB_XSUB(j)  (1280 + 64 * (j))
#define XB_XGEN(j)  (2304 + 64 * (j))
#define XB_TOP      3328
#define XB_TOPGEN   3392
#define XCD_BAR_WORDS 3456
#define XB_SPIN_CAP (1u << 18)

__device__ __forceinline__ unsigned xb_ld(unsigned* p)              { return __hip_atomic_load(p, __ATOMIC_RELAXED, __HIP_MEMORY_SCOPE_AGENT); }
__device__ __forceinline__ unsigned xb_add(unsigned* p, unsigned v) { return __hip_atomic_fetch_add(p, v, __ATOMIC_RELAXED, __HIP_MEMORY_SCOPE_AGENT); }
__device__ __forceinline__ unsigned xb_xcc_id() { return (unsigned)__builtin_amdgcn_s_getreg((3 << 11) | 20) & 0xFu; }
#define XB_SPIN(cond, bar) do { unsigned _sp = 0; while (cond) { __builtin_amdgcn_s_sleep(1); \
    if ((++_sp & 255u) == 0u) { if (xb_ld(&(bar)[XB_TMO])) break; if (_sp > XB_SPIN_CAP) { atomicAdd(&(bar)[XB_TMO], 1u); break; } } } } while (0)

struct XcdBarrier {
    unsigned* bar; unsigned x;
    volatile LAS unsigned* st;
};

__device__ __forceinline__ XcdBarrier xcd_barrier_post(unsigned* bar, volatile LAS unsigned* st) {
    XcdBarrier b; b.bar = bar; b.x = xb_xcc_id(); b.st = st;
    if (threadIdx.x == 0) (void)xb_add(&bar[XB_XCNT(b.x)], 1u);
    return b;
}
__device__ __forceinline__ void xcd_barrier_complete(unsigned* bar, unsigned x, unsigned& nloc, unsigned& nx) {
    const unsigned G = gridDim.x * gridDim.y * gridDim.z;
    unsigned sum, cnt, mine, sp = 0u;
    for (;;) {
        sum = 0u; cnt = 0u; mine = 0u;
#pragma unroll
        for (unsigned j = 0; j < 16; ++j) { const unsigned c = xb_ld(&bar[XB_XCNT(j)]); sum += c; cnt += (c > 0u) ? 1u : 0u; mine = (j == x) ? c : mine; }
        if (sum == G) break;
        __builtin_amdgcn_s_sleep(1);
        if ((++sp & 255u) == 0u) { if (xb_ld(&bar[XB_TMO])) break; if (sp > XB_SPIN_CAP) { atomicAdd(&bar[XB_TMO], 1u); break; } }
    }
    nloc = mine > 0u ? mine : 1u; nx = cnt > 0u ? cnt : 1u;
}

__device__ __forceinline__ void xcd_barrier(const XcdBarrier& b) {
    asm volatile("s_waitcnt vmcnt(0)" ::: "memory");
    __syncthreads();
    if (threadIdx.x == 0) {
        unsigned* bar = b.bar;
        __builtin_amdgcn_s_waitcnt(0);
        unsigned nloc = b.st[0], nx = b.st[1];
        if (nloc == 0u) { xcd_barrier_complete(bar, b.x, nloc, nx); b.st[0] = nloc; b.st[1] = nx; }
        const unsigned old = xb_add(&bar[XB_XSUB(b.x)], 1u);
        const unsigned gen = old / nloc;
        if (old + 1u == (gen + 1u) * nloc) {
            __builtin_amdgcn_fence(__ATOMIC_RELEASE, "agent");
            asm volatile("s_waitcnt vmcnt(0)" ::: "memory");
            const unsigned og = xb_add(&bar[XB_TOP], 1u);
            const unsigned tg = og / nx;
            if (og + 1u == (tg + 1u) * nx) xb_add(&bar[XB_TOPGEN], 1u);
            else XB_SPIN(xb_ld(&bar[XB_TOPGEN]) == tg, bar);
            __builtin_amdgcn_fence(__ATOMIC_ACQUIRE, "agent");
            xb_add(&bar[XB_XGEN(b.x)], 1u);
            asm volatile("s_waitcnt vmcnt(0)" ::: "memory");
        } else {
            XB_SPIN(xb_ld(&bar[XB_XGEN(b.x)]) == gen, bar);
            __builtin_amdgcn_fence(__ATOMIC_ACQUIRE, "agent");
            asm volatile("s_waitcnt vmcnt(0)" ::: "memory");
        }
    }
    __syncthreads();
}
namespace mk {
typedef unsigned short bf16;
typedef unsigned v4u __attribute__((ext_vector_type(4)));
typedef unsigned v2u __attribute__((ext_vector_type(2)));
typedef float f32x4 __attribute__((ext_vector_type(4)));
typedef float f32x16 __attribute__((ext_vector_type(16)));
typedef short bf16x8 __attribute__((ext_vector_type(8)));
typedef short bf16x4 __attribute__((ext_vector_type(4)));

constexpr int T = 32768, D = 1024, SQ = 4096, NIN = 2816, NQ = 2048, PLE = 256, NEXP = 16384;
constexpr int NWAVES = 8, NTHR = 512;
constexpr int RING_BYTES = 131072, LDS_BYTES = 163840, MISC_OFF = LDS_BYTES - 256;

constexpr size_t MB = 1024 * 1024;
constexpr size_t WS_CTL = 0, CTL_BYTES = 256 * 1024;
constexpr size_t WS_WIN = WS_CTL + CTL_BYTES;
constexpr size_t WS_WOUT = WS_WIN + (size_t)NIN * D * 2;
constexpr size_t WS_WQ = WS_WOUT + (size_t)D * D * 2;
constexpr size_t WS_WG = WS_WQ + (size_t)NQ * D * 2;
constexpr size_t WS_WP = WS_WG + (size_t)D * D * 2;
constexpr size_t WS_KEYS = WS_WP + (size_t)D * PLE * 2;
constexpr size_t WS_ROPE = WS_KEYS + 2 * 128 * 128 * 2;
constexpr size_t WS_SU = WS_ROPE + 2 * (size_t)SQ * 32 * 4;
constexpr size_t WS_SV = WS_SU + 65536;
constexpr size_t WS_SH = WS_SV + 65536;
constexpr size_t WS_UB = 16 * MB;
constexpr size_t WS_VB = 32 * MB;
constexpr size_t WS_PB = 48 * MB;
constexpr size_t WS_PK = 64 * MB;
constexpr size_t WS_R1 = 96 * MB;
constexpr size_t WS_R2 = 160 * MB;
constexpr size_t WS_PP = 352 * MB;
constexpr size_t WS_RSS2 = 80 * MB;
constexpr size_t WS_END = 416 * MB;
static_assert(WS_SH + (size_t)T * 4 <= WS_UB, "ws map");
constexpr int CW_BAR = 1024;

#define LDS_WAIT() asm volatile("s_waitcnt lgkmcnt(0)" ::: "memory")
#define VM_WAIT() asm volatile("s_waitcnt vmcnt(0)" ::: "memory")
typedef float f32x2 __attribute__((ext_vector_type(2)));
typedef __bf16 b16x2 __attribute__((ext_vector_type(2)));
__device__ __forceinline__ unsigned pk2(float lo, float hi) { const f32x2 v = {lo, hi}; return __builtin_bit_cast(unsigned, __builtin_convertvector(v, b16x2)); }
__device__ __forceinline__ float bf_lo(unsigned w) { return __uint_as_float(w << 16); }
__device__ __forceinline__ float bf_hi(unsigned w) { return __uint_as_float(w & 0xffff0000u); }
__device__ __forceinline__ float wave_sum(float v) {
#pragma unroll
    for (int o = 1; o < 64; o <<= 1) v += __shfl_xor(v, o);
    return v;
}

#ifndef PROBE_ON
#define PT_DECL
#define PT_ARG
#define PT_BEGIN()
#define PT_ADD(k)
#endif
struct Args { const float* in[16]; float* out; unsigned char* ws; int ph_lo, ph_hi, li, pad; };

struct EpiStoreBf16 {
    static constexpr bool PERM = true, AFTER_DRAIN = false;
    bf16* O; int ldc;
    __device__ __forceinline__ void operator()(const pg8::f32x4 (&acc)[2][2][4][2], const pg8::Unit& u, int wr, int wc, int fr, int fq) const {
        const int row0 = u.pm * 256 + wr * 64 + fr, col0 = u.pn * 256 + wc * 32 + 8 * fq;
#pragma unroll
        for (int ai = 0; ai < 2; ++ai)
#pragma unroll
            for (int m = 0; m < 4; ++m) { bf16* rowp = O + (size_t)(row0 + ai * 128 + m * 16) * ldc + col0;
#pragma unroll
                for (int bj = 0; bj < 2; ++bj) { const pg8::f32x4 v0 = acc[ai][bj][m][0], v1 = acc[ai][bj][m][1];
                    pg8::u32x4 w; w.x = pk2(v0[0], v0[1]); w.y = pk2(v0[2], v0[3]); w.z = pk2(v1[0], v1[1]); w.w = pk2(v1[2], v1[3]);
                    *(pg8::u32x4*)(rowp + bj * 128) = w; } }
    }
};


struct EpiResid {
    static constexpr bool PERM = true, AFTER_DRAIN = false;
    const float* X; bf16* XB;
    __device__ __forceinline__ void operator()(const pg8::f32x4 (&acc)[2][2][4][2], const pg8::Unit& u, int wr, int wc, int fr, int fq) const {
        const int row0 = u.pm * 256 + wr * 64 + fr, col0 = u.pn * 256 + wc * 32 + 8 * fq;
#pragma unroll
        for (int ai = 0; ai < 2; ++ai)
#pragma unroll
            for (int m = 0; m < 4; ++m) { const size_t off = (size_t)(row0 + ai * 128 + m * 16) * D + col0;
#pragma unroll
                for (int bj = 0; bj < 2; ++bj) { const size_t o2 = off + bj * 128;
                    const pg8::f32x4 v0 = acc[ai][bj][m][0] + *(const pg8::f32x4*)(X + o2), v1 = acc[ai][bj][m][1] + *(const pg8::f32x4*)(X + o2 + 4);
                    pg8::u32x4 w; w.x = pk2(v0[0], v0[1]); w.y = pk2(v0[2], v0[3]); w.z = pk2(v1[0], v1[1]); w.w = pk2(v1[2], v1[3]);
                    *(pg8::u32x4*)(XB + o2) = w; } }
    }
};
struct EpiGate {
    static constexpr bool PERM = true, AFTER_DRAIN = false;
    float* O; const bf16* XB; const bf16* PP; const float* rss;
    __device__ __forceinline__ void operator()(const pg8::f32x4 (&acc)[2][2][4][2], const pg8::Unit& u, int wr, int wc, int fr, int fq) const {
        const int row0 = u.pm * 256 + wr * 64 + fr, col0 = u.pn * 256 + wc * 32 + 8 * fq;
#pragma unroll
        for (int ai = 0; ai < 2; ++ai)
#pragma unroll
            for (int m = 0; m < 4; ++m) { const int row = row0 + ai * 128 + m * 16; const size_t off = (size_t)row * D + col0;
                const pg8::f32x4 q0 = *(const pg8::f32x4*)(rss + (size_t)row * 8), q1 = *(const pg8::f32x4*)(rss + (size_t)row * 8 + 4);
                const float rs = 1.0f / sqrtf((((q0[0] + q0[1]) + (q0[2] + q0[3])) + ((q1[0] + q1[1]) + (q1[2] + q1[3]))) * (1.0f / D) + 1e-6f);
#pragma unroll
                for (int bj = 0; bj < 2; ++bj) { const size_t o2 = off + bj * 128;
                    const pg8::u32x4 pw = *(const pg8::u32x4*)(PP + o2), xw = *(const pg8::u32x4*)(XB + o2);
                    const pg8::f32x4 a0 = acc[ai][bj][m][0] * rs, a1 = acc[ai][bj][m][1] * rs;
                    pg8::f32x4 x0, x1;
                    x0[0] = bf_lo(xw.x) + bf_lo(pw.x) / (1.0f + __expf(-a0[0])); x0[1] = bf_hi(xw.x) + bf_hi(pw.x) / (1.0f + __expf(-a0[1])); x0[2] = bf_lo(xw.y) + bf_lo(pw.y) / (1.0f + __expf(-a0[2])); x0[3] = bf_hi(xw.y) + bf_hi(pw.y) / (1.0f + __expf(-a0[3]));
                    x1[0] = bf_lo(xw.z) + bf_lo(pw.z) / (1.0f + __expf(-a1[0])); x1[1] = bf_hi(xw.z) + bf_hi(pw.z) / (1.0f + __expf(-a1[1])); x1[2] = bf_lo(xw.w) + bf_lo(pw.w) / (1.0f + __expf(-a1[2])); x1[3] = bf_hi(xw.w) + bf_hi(pw.w) / (1.0f + __expf(-a1[3]));
                    *(pg8::f32x4*)(O + o2) = x0; *(pg8::f32x4*)(O + o2 + 4) = x1; } }
    }
};

__device__ __forceinline__ void p0_transpose_item(const float* __restrict__ W, const float* __restrict__ gsc, int K, int N, bf16* __restrict__ WT, LAS float* scr, int item, int lane) {
    const int nblk = N / 32, kb = item / nblk, nb = item % nblk, k0 = 64 * kb, n0 = 32 * nb;
    float wv[32];
#pragma unroll
    for (int i = 0; i < 32; ++i) { const int kk = 2 * i + (lane >> 5); wv[i] = W[(size_t)(k0 + kk) * N + n0 + (lane & 31)]; }
    if (gsc) {
#pragma unroll
        for (int i = 0; i < 32; ++i) wv[i] *= gsc[k0 + 2 * i + (lane >> 5)];
    }
#pragma unroll
    for (int i = 0; i < 32; ++i) scr[(2 * i + (lane >> 5)) * 33 + (lane & 31)] = wv[i];
    LDS_WAIT(); asm volatile("" ::: "memory");
    const int c = lane & 7;
#pragma unroll
    for (int j = 0; j < 4; ++j) { const int n = (lane >> 3) + 8 * j; const LAS float* s = scr + (8 * c) * 33 + n;
        v4u o; o.x = pk2(s[0 * 33], s[1 * 33]); o.y = pk2(s[2 * 33], s[3 * 33]); o.z = pk2(s[4 * 33], s[5 * 33]); o.w = pk2(s[6 * 33], s[7 * 33]);
        *(v4u*)(WT + (size_t)(n0 + n) * K + k0 + 8 * c) = o; }
    LDS_WAIT(); asm volatile("" ::: "memory");
}
__device__ __forceinline__ void p0_convert(const float* __restrict__ src, bf16* __restrict__ dst, size_t n8, size_t gtid, size_t gthreads) {
    size_t i = gtid;
    for (; i + 3 * gthreads < n8; i += 4 * gthreads) {
        f32x4 a[4], b[4];
#pragma unroll
        for (int r = 0; r < 4; ++r) { a[r] = ((const f32x4*)src)[2 * (i + r * gthreads)]; b[r] = ((const f32x4*)src)[2 * (i + r * gthreads) + 1]; }
#pragma unroll
        for (int r = 0; r < 4; ++r) { v4u o; o.x = pk2(a[r][0], a[r][1]); o.y = pk2(a[r][2], a[r][3]); o.z = pk2(b[r][0], b[r][1]); o.w = pk2(b[r][2], b[r][3]); ((v4u*)dst)[i + r * gthreads] = o; }
    }
    for (; i < n8; i += gthreads) {
        const f32x4 a = ((const f32x4*)src)[2 * i], b = ((const f32x4*)src)[2 * i + 1];
        v4u o; o.x = pk2(a[0], a[1]); o.y = pk2(a[2], a[3]); o.z = pk2(b[0], b[1]); o.w = pk2(b[2], b[3]);
        ((v4u*)dst)[i] = o;
    }
}
__device__ __forceinline__ void rms_row_to_bf16(const float* __restrict__ xrow, const float* __restrict__ g, bf16* __restrict__ orow, int lane) {
    const f32x4* xr = (const f32x4*)xrow + lane; const f32x4* gr = (const f32x4*)g + lane;
    f32x4 v[4]; float s = 0.f;
#pragma unroll
    for (int j = 0; j < 4; ++j) { v[j] = xr[64 * j]; s += (v[j][0] * v[j][0] + v[j][1] * v[j][1]) + (v[j][2] * v[j][2] + v[j][3] * v[j][3]); }
    const float rstd = 1.0f / sqrtf(wave_sum(s) * (1.0f / D) + 1e-6f);
    v2u* o8 = (v2u*)orow + lane;
#pragma unroll
    for (int j = 0; j < 4; ++j) { const f32x4 gg = gr[64 * j]; v2u w; w.x = pk2(v[j][0] * rstd * gg[0], v[j][1] * rstd * gg[1]); w.y = pk2(v[j][2] * rstd * gg[2], v[j][3] * rstd * gg[3]); o8[64 * j] = w; }
}

__device__ __forceinline__ void p0_prologue(const Args& a, LAS unsigned char* lds, int vcu, int G, int tid, int lane, int wave) {
    unsigned char* ws = a.ws;
    LAS float* scr = (LAS float*)(lds + wave * 16384);
    const int gw = vcu * NWAVES + wave, NGW = G * NWAVES;
    constexpr int I_IN = (D / 64) * (NIN / 32), I_OUT = (D / 64) * (D / 32), I_Q = (D / 64) * (NQ / 32), I_G = I_OUT, I_P = (PLE / 64) * (D / 32);
    constexpr int NITEMS = I_IN + I_OUT + I_Q + I_G + I_P;
    for (int it = gw; it < NITEMS; it += NGW) {
        int r = it;
        if (r < I_IN) { p0_transpose_item(a.in[3], nullptr, D, NIN, (bf16*)(ws + WS_WIN), scr, r, lane); continue; } r -= I_IN;
        if (r < I_OUT) { p0_transpose_item(a.in[7], nullptr, D, D, (bf16*)(ws + WS_WOUT), scr, r, lane); continue; } r -= I_OUT;
        if (r < I_Q) { p0_transpose_item(a.in[9], a.in[8], D, NQ, (bf16*)(ws + WS_WQ), scr, r, lane); continue; } r -= I_Q;
        if (r < I_G) { p0_transpose_item(a.in[14], a.in[13], D, D, (bf16*)(ws + WS_WG), scr, r, lane); continue; } r -= I_G;
        p0_transpose_item(a.in[15], nullptr, PLE, D, (bf16*)(ws + WS_WP), scr, r, lane);
    }
    const size_t gtid = (size_t)vcu * NTHR + tid, gthreads = (size_t)G * NTHR;
    p0_convert(a.in[10], (bf16*)(ws + WS_KEYS), 2 * 128 * 128 / 8, gtid, gthreads);
    for (int r0 = gw; r0 < 2 * NEXP; r0 += 4 * NGW) {
        float xs[4][16];
#pragma unroll
        for (int rr = 0; rr < 4; ++rr) {
            const int r = r0 + rr * NGW; const int isv = r >= NEXP, e = isv ? r - NEXP : r;
            const float* src = (isv ? a.in[12] : a.in[11]) + (size_t)e * D + 16 * lane;
            const f32x4 x0 = *(const f32x4*)src, x1 = *(const f32x4*)(src + 4), x2 = *(const f32x4*)(src + 8), x3 = *(const f32x4*)(src + 12);
#pragma unroll
            for (int u = 0; u < 4; ++u) { xs[rr][u] = x0[u]; xs[rr][4 + u] = x1[u]; xs[rr][8 + u] = x2[u]; xs[rr][12 + u] = x3[u]; }
        }
#pragma unroll
        for (int rr = 0; rr < 4; ++rr) {
            const int r = r0 + rr * NGW; const int isv = r >= NEXP, e = isv ? r - NEXP : r;
            float am = 0.f;
#pragma unroll
            for (int u = 0; u < 16; ++u) am = fmaxf(am, fabsf(xs[rr][u]));
#pragma unroll
            for (int o = 1; o < 64; o <<= 1) am = fmaxf(am, __shfl_xor(am, o));
            const float inv = am > 0.f ? 127.0f / am : 0.f; const unsigned bias = 0u;
            v4u w;
#pragma unroll
            for (int c = 0; c < 4; ++c) { unsigned ww = 0u;
#pragma unroll
                for (int u = 0; u < 4; ++u) { const int q = __float2int_rn(xs[rr][4 * c + u] * inv); ww |= (((unsigned)q + bias) & 0xffu) << (8 * u); }
                w[c] = ww; }
            if (isv) *(v4u*)(ws + WS_VB + (size_t)(lane >> 3) * ((size_t)NEXP * 128) + (size_t)e * 128 + 16 * (lane & 7)) = w;
            else *(v4u*)(ws + WS_UB + (size_t)e * D + 16 * lane) = w;
            if (lane == 0) ((float*)(ws + (isv ? WS_SV : WS_SU)))[e] = am * (1.0f / 127.0f);
        }
    }
    p0_convert(a.in[1], (bf16*)(ws + WS_PB), (size_t)T * PLE / 8, gtid, gthreads);
    for (size_t i = gtid; i < (size_t)SQ * 32; i += gthreads) {
        const int pos = (int)(i >> 5), c = (int)(i & 31);
        const float freq = powf(10000.0f, -(float)c / 32.0f);
        const float ang = (float)pos * freq;
        float sn, cs; sincosf(ang, &sn, &cs);
        ((float*)(ws + WS_ROPE))[i] = cs; ((float*)(ws + WS_ROPE))[(size_t)SQ * 32 + i] = sn;
    }
    for (int m0 = gw; m0 < T; m0 += 4 * NGW) {
        f32x4 v[4][4]; float ssq[4];
#pragma unroll
        for (int rr = 0; rr < 4; ++rr) { const f32x4* xr = (const f32x4*)(a.in[0] + (size_t)(m0 + rr * NGW) * D) + lane;
#pragma unroll
            for (int j = 0; j < 4; ++j) v[rr][j] = xr[64 * j]; }
#pragma unroll
        for (int rr = 0; rr < 4; ++rr) { float sq = 0.f;
#pragma unroll
            for (int j = 0; j < 4; ++j) sq += (v[rr][j][0] * v[rr][j][0] + v[rr][j][1] * v[rr][j][1]) + (v[rr][j][2] * v[rr][j][2] + v[rr][j][3] * v[rr][j][3]);
            ssq[rr] = sq; }
#pragma unroll
        for (int o = 1; o < 64; o <<= 1)
#pragma unroll
            for (int rr = 0; rr < 4; ++rr) ssq[rr] += __shfl_xor(ssq[rr], o);
        const f32x4* gr = (const f32x4*)a.in[2] + lane;
#pragma unroll
        for (int rr = 0; rr < 4; ++rr) { const float rstd = 1.0f / sqrtf(ssq[rr] * (1.0f / D) + 1e-6f); v2u* o8 = (v2u*)((bf16*)(ws + WS_R1) + (size_t)(m0 + rr * NGW) * D) + lane;
#pragma unroll
            for (int j = 0; j < 4; ++j) { const f32x4 gg = gr[64 * j]; v2u w; w.x = pk2(v[rr][j][0] * rstd * gg[0], v[rr][j][1] * rstd * gg[1]); w.y = pk2(v[rr][j][2] * rstd * gg[2], v[rr][j][3] * rstd * gg[3]); o8[64 * j] = w; } }
    }
}


#define MFMA32(a, b, c) __builtin_amdgcn_mfma_f32_32x32x16_bf16((a), (b), (c), 0, 0, 0)
__device__ __forceinline__ int crow(int r, int hf) { return (r & 3) + 8 * (r >> 2) + 4 * hf; }
__device__ __forceinline__ bf16x8 pack8(float a0, float a1, float a2, float a3, float a4, float a5, float a6, float a7) {
    v4u w; w.x = pk2(a0, a1); w.y = pk2(a2, a3); w.z = pk2(a4, a5); w.w = pk2(a6, a7); return __builtin_bit_cast(bf16x8, w);
}
__device__ __forceinline__ bf16x8 lds_frag16(LAS unsigned char* p) { return *(const LAS bf16x8*)p; }
__device__ __forceinline__ bf16x8 lds_frag8x2(LAS unsigned char* p) {
    const bf16x4 lo = *(const LAS bf16x4*)p, hi = *(const LAS bf16x4*)(p + 16); return __builtin_shufflevector(lo, hi, 0, 1, 2, 3, 4, 5, 6, 7);
}
typedef short s16x4 __attribute__((ext_vector_type(4)));
__device__ __forceinline__ s16x4 lds_tr4(LAS unsigned char* tile, int r0, int c0, int lane) {
    const int i = lane & 15;
    return __builtin_amdgcn_ds_read_tr16_b64_v4i16((LAS s16x4*)(tile + (r0 + (i >> 2)) * 144 + (c0 + 16 * ((lane >> 4) & 1) + 4 * (i & 3)) * 2));
}
__device__ __forceinline__ bf16x8 cat8(s16x4 lo, s16x4 hi) { return __builtin_shufflevector(lo, hi, 0, 1, 2, 3, 4, 5, 6, 7); }
constexpr int RQ = 144;
constexpr int LR_QS = 0, LR_KS = LR_QS + 128 * RQ, LR_VS = LR_KS + 128 * RQ, LR_ST = LR_VS + 128 * RQ, LR_LN = LR_ST + 64 * RQ, LR_END = LR_LN + 2 * 128 * 8;
static_assert(LR_END <= RING_BYTES, "retention LDS");
__device__ __forceinline__ void ret_unit(const bf16* __restrict__ PROJ, bf16* __restrict__ MIXED, const float* __restrict__ rope, LAS unsigned char* lds,
                                         int b, int h, int c0, int c1, int tid, int lane, int wave) {
    const float gam = 1.0f - exp2f(-5.0f - (float)h), lg2 = log2f(gam), cd = exp2f(lg2 * 128.0f);
    const int l31 = lane & 31, hf = lane >> 5, ib = wave >> 1, et = wave & 1;
    const int r = tid >> 2, qd = tid & 3;
    const float wq = exp2f(lg2 * (float)(r + 1)), wk = exp2f(-lg2 * (float)(r + 1));
    f32x16 stacc;
#pragma unroll
    for (int i = 0; i < 16; ++i) stacc[i] = 0.f;
    for (int i = tid; i < 64 * RQ / 4; i += NTHR) ((LAS unsigned*)(lds + LR_ST))[i] = 0u;
    v4u k1, k2, v1, v2, q1 = {0u, 0u, 0u, 0u}, q2 = {0u, 0u, 0u, 0u}; f32x4 csa, csb, sna, snb; v2u gvn[4] = {{0u, 0u}, {0u, 0u}, {0u, 0u}, {0u, 0u}};
#define RET_LOAD(nn) do { const int sp_ = (nn) * 128 + r; const bf16* pr_ = PROJ + ((size_t)b * SQ + sp_) * NIN + h * 64 + 8 * qd; \
        k1 = *(const v4u*)(pr_ + 512); k2 = *(const v4u*)(pr_ + 512 + 32); v1 = *(const v4u*)(pr_ + 1024); v2 = *(const v4u*)(pr_ + 1024 + 32); \
        if ((nn) >= c0) { q1 = *(const v4u*)(pr_); q2 = *(const v4u*)(pr_ + 32); \
            const bf16* gp_ = PROJ + ((size_t)b * SQ + (nn) * 128 + 32 * ib + l31) * NIN + 1536 + h * 64 + 32 * et + 4 * hf; \
            gvn[0] = *(const v2u*)gp_; gvn[1] = *(const v2u*)(gp_ + 8); gvn[2] = *(const v2u*)(gp_ + 16); gvn[3] = *(const v2u*)(gp_ + 24); } \
        csa = *(const f32x4*)(rope + sp_ * 32 + 8 * qd); csb = *(const f32x4*)(rope + sp_ * 32 + 8 * qd + 4); \
        sna = *(const f32x4*)(rope + SQ * 32 + sp_ * 32 + 8 * qd); snb = *(const f32x4*)(rope + SQ * 32 + sp_ * 32 + 8 * qd + 4); } while (0)
    RET_LOAD(0);
    for (int n = 0; n < c1; ++n) {
        const bool own = n >= c0;
        float cs[8], sn[8];
#pragma unroll
        for (int u = 0; u < 4; ++u) { cs[u] = csa[u]; cs[4 + u] = csb[u]; sn[u] = sna[u]; sn[4 + u] = snb[u]; }
        v2u gv[4];
#pragma unroll
        for (int g = 0; g < 4; ++g) gv[g] = gvn[g];
        __syncthreads();
        {
            float o1[8], o2[8];
#pragma unroll
            for (int u = 0; u < 8; ++u) { const unsigned w1 = k1[u >> 1], w2 = k2[u >> 1]; const float x1 = (u & 1) ? bf_hi(w1) : bf_lo(w1), x2 = (u & 1) ? bf_hi(w2) : bf_lo(w2);
                o1[u] = (x1 * cs[u] - x2 * sn[u]) * wk; o2[u] = (x1 * sn[u] + x2 * cs[u]) * wk; }
            *(LAS bf16x8*)(lds + LR_KS + r * RQ + (8 * qd) * 2) = pack8(o1[0], o1[1], o1[2], o1[3], o1[4], o1[5], o1[6], o1[7]);
            *(LAS bf16x8*)(lds + LR_KS + r * RQ + (32 + 8 * qd) * 2) = pack8(o2[0], o2[1], o2[2], o2[3], o2[4], o2[5], o2[6], o2[7]);
            *(LAS v4u*)(lds + LR_VS + r * RQ + (8 * qd) * 2) = v1; *(LAS v4u*)(lds + LR_VS + r * RQ + (32 + 8 * qd) * 2) = v2;
            if (own) {
#pragma unroll
                for (int u = 0; u < 8; ++u) { const unsigned w1 = q1[u >> 1], w2 = q2[u >> 1]; const float x1 = (u & 1) ? bf_hi(w1) : bf_lo(w1), x2 = (u & 1) ? bf_hi(w2) : bf_lo(w2);
                    o1[u] = (x1 * cs[u] - x2 * sn[u]) * wq; o2[u] = (x1 * sn[u] + x2 * cs[u]) * wq; }
                *(LAS bf16x8*)(lds + LR_QS + r * RQ + (8 * qd) * 2) = pack8(o1[0], o1[1], o1[2], o1[3], o1[4], o1[5], o1[6], o1[7]);
                *(LAS bf16x8*)(lds + LR_QS + r * RQ + (32 + 8 * qd) * 2) = pack8(o2[0], o2[1], o2[2], o2[3], o2[4], o2[5], o2[6], o2[7]);
            }
        }
        if (n + 1 < c1) RET_LOAD(n + 1);
        __syncthreads();
        if (own) {
            const size_t orow = (size_t)b * SQ + n * 128 + 32 * ib + l31;
            bf16x8 qf[4];
#pragma unroll
            for (int ks = 0; ks < 4; ++ks) qf[ks] = lds_frag16(lds + LR_QS + (32 * ib + l31) * RQ + (16 * ks + 8 * hf) * 2);
            f32x16 o;
#pragma unroll
            for (int i = 0; i < 16; ++i) o[i] = 0.f;
#pragma unroll
            for (int ks = 0; ks < 4; ++ks) o = MFMA32(lds_frag16(lds + LR_ST + (32 * et + l31) * RQ + (16 * ks + 8 * hf) * 2), qf[ks], o);
            for (int jb = 0; jb <= ib; ++jb) {
                f32x16 s;
#pragma unroll
                for (int i = 0; i < 16; ++i) s[i] = 0.f;
#pragma unroll
                for (int ks = 0; ks < 4; ++ks) s = MFMA32(lds_frag16(lds + LR_KS + (32 * jb + l31) * RQ + (16 * ks + 8 * hf) * 2), qf[ks], s);
                const bool diag = (jb == ib);
                float p[16];
#pragma unroll
                for (int i = 0; i < 16; ++i) p[i] = (diag && crow(i, hf) > l31) ? 0.f : s[i] * 0.125f;
#pragma unroll
                for (int st = 0; st < 2; ++st) {
                    const bf16x8 pf = pack8(p[8 * st], p[8 * st + 1], p[8 * st + 2], p[8 * st + 3], p[8 * st + 4], p[8 * st + 5], p[8 * st + 6], p[8 * st + 7]);
                    o = MFMA32(cat8(lds_tr4(lds + LR_VS, 32 * jb + 16 * st + 4 * hf, 32 * et, lane), lds_tr4(lds + LR_VS, 32 * jb + 16 * st + 8 + 4 * hf, 32 * et, lane)), pf, o);
                }
            }
            float s1 = 0.f, s2 = 0.f;
#pragma unroll
            for (int i = 0; i < 16; ++i) { s1 += o[i]; s2 += o[i] * o[i]; }
            s1 += __shfl_xor(s1, 32); s2 += __shfl_xor(s2, 32);
            if (hf == 0) *(LAS f32x2*)(lds + LR_LN + (et * 128 + 32 * ib + l31) * 8) = (f32x2){s1, s2};
            __syncthreads();
            const f32x2 ot = *(const LAS f32x2*)(lds + LR_LN + ((et ^ 1) * 128 + 32 * ib + l31) * 8);
            const float mu = (s1 + ot.x) * (1.0f / 64.0f), var = fmaxf((s2 + ot.y) * (1.0f / 64.0f) - mu * mu, 0.f), rs = 1.0f / sqrtf(var + 1e-6f);
#pragma unroll
            for (int g = 0; g < 4; ++g) {
                float y[4];
#pragma unroll
                for (int u = 0; u < 4; ++u) { const unsigned w = gv[g][u >> 1]; const float gg = (u & 1) ? bf_hi(w) : bf_lo(w); const float sg = gg / (1.0f + __expf(-gg)); y[u] = sg * ((o[4 * g + u] - mu) * rs); }
                v2u w; w.x = pk2(y[0], y[1]); w.y = pk2(y[2], y[3]);
                *(v2u*)(MIXED + orow * D + h * 64 + 32 * et + 8 * g + 4 * hf) = w;
            }
        }
        if (wave < 4) {
            const int se = wave >> 1, sd = wave & 1;
            f32x16 tmp;
#pragma unroll
            for (int i = 0; i < 16; ++i) tmp[i] = 0.f;
#pragma unroll
            for (int ks = 0; ks < 8; ++ks)
                tmp = MFMA32(cat8(lds_tr4(lds + LR_VS, 16 * ks + 8 * hf, 32 * se, lane), lds_tr4(lds + LR_VS, 16 * ks + 8 * hf + 4, 32 * se, lane)),
                             cat8(lds_tr4(lds + LR_KS, 16 * ks + 8 * hf, 32 * sd, lane), lds_tr4(lds + LR_KS, 16 * ks + 8 * hf + 4, 32 * sd, lane)), tmp);
#pragma unroll
            for (int i = 0; i < 16; ++i) stacc[i] = cd * (stacc[i] + 0.125f * tmp[i]);
#pragma unroll
            for (int i = 0; i < 16; i += 2) { const unsigned w = pk2(stacc[i], stacc[i + 1]);
                *(LAS bf16*)(lds + LR_ST + (32 * se + crow(i, hf)) * RQ + (32 * sd + l31) * 2) = (bf16)(w & 0xffffu);
                *(LAS bf16*)(lds + LR_ST + (32 * se + crow(i + 1, hf)) * RQ + (32 * sd + l31) * 2) = (bf16)(w >> 16); }
        }
    }
    __syncthreads();
#undef RET_LOAD
}

constexpr int LS_KN = 0, LS_VS = LS_KN + 256 * RQ, LS_QN = LS_VS + 256 * RQ, LS_END = LS_QN + 256 * RQ;
static_assert(LS_END <= RING_BYTES, "swa LDS");
__device__ __forceinline__ void swa_unit(const bf16* __restrict__ PROJ, bf16* __restrict__ MIXED, const float* __restrict__ qnw, const float* __restrict__ knw, const float* __restrict__ sinks,
                                         LAS unsigned char* lds, int b, int kvh, int n, int tid, int lane, int wave) {
    const int l31 = lane & 31, hf = lane >> 5;
    const int row = tid >> 1, half = tid & 1;
    {
        const int kpos = (n - 1) * 128 + row; const bool valid = kpos >= 0;
        v4u kk[4], vv[4];
#pragma unroll
        for (int c = 0; c < 4; ++c) { kk[c] = (v4u){0u, 0u, 0u, 0u}; vv[c] = (v4u){0u, 0u, 0u, 0u}; }
        if (valid) { const bf16* pr = PROJ + ((size_t)b * SQ + kpos) * NIN + 32 * half;
#pragma unroll
            for (int c = 0; c < 4; ++c) { kk[c] = *(const v4u*)(pr + 2560 + kvh * 64 + 8 * c); vv[c] = *(const v4u*)(pr + 2688 + kvh * 64 + 8 * c); } }
        float kf[32]; float ss = 0.f;
#pragma unroll
        for (int c = 0; c < 4; ++c)
#pragma unroll
            for (int u = 0; u < 4; ++u) { kf[8 * c + 2 * u] = bf_lo(kk[c][u]); kf[8 * c + 2 * u + 1] = bf_hi(kk[c][u]); }
#pragma unroll
        for (int i = 0; i < 32; ++i) ss += kf[i] * kf[i];
        ss += __shfl_xor(ss, 1);
        const float rstd = 0.125f / sqrtf(ss * (1.0f / 64.0f) + 1e-6f);
#pragma unroll
        for (int c = 0; c < 4; ++c) {
            const f32x4 g0 = *(const f32x4*)(knw + 32 * half + 8 * c), g1 = *(const f32x4*)(knw + 32 * half + 8 * c + 4);
            *(LAS bf16x8*)(lds + LS_KN + row * RQ + (32 * half + 8 * c) * 2) = pack8(kf[8 * c] * rstd * g0[0], kf[8 * c + 1] * rstd * g0[1], kf[8 * c + 2] * rstd * g0[2], kf[8 * c + 3] * rstd * g0[3],
                                                                                  kf[8 * c + 4] * rstd * g1[0], kf[8 * c + 5] * rstd * g1[1], kf[8 * c + 6] * rstd * g1[2], kf[8 * c + 7] * rstd * g1[3]);
            *(LAS v4u*)(lds + LS_VS + row * RQ + (32 * half + 8 * c) * 2) = vv[c];
        }
    }
    for (int rnd = 0; rnd < 2; ++rnd) {
        {
            const int hs = row >> 7, qrow = row & 127, hq = kvh * 4 + rnd * 2 + hs;
            const bf16* pr = PROJ + ((size_t)b * SQ + n * 128 + qrow) * NIN + 2048 + hq * 64 + 32 * half;
            v4u qq[4];
#pragma unroll
            for (int c = 0; c < 4; ++c) qq[c] = *(const v4u*)(pr + 8 * c);
            float qf[32]; float ss = 0.f;
#pragma unroll
            for (int c = 0; c < 4; ++c)
#pragma unroll
                for (int u = 0; u < 4; ++u) { qf[8 * c + 2 * u] = bf_lo(qq[c][u]); qf[8 * c + 2 * u + 1] = bf_hi(qq[c][u]); }
#pragma unroll
            for (int i = 0; i < 32; ++i) ss += qf[i] * qf[i];
            ss += __shfl_xor(ss, 1);
            const float rstd = 1.0f / sqrtf(ss * (1.0f / 64.0f) + 1e-6f);
#pragma unroll
            for (int c = 0; c < 4; ++c) {
                const f32x4 g0 = *(const f32x4*)(qnw + 32 * half + 8 * c), g1 = *(const f32x4*)(qnw + 32 * half + 8 * c + 4);
                *(LAS bf16x8*)(lds + LS_QN + row * RQ + (32 * half + 8 * c) * 2) = pack8(qf[8 * c] * rstd * g0[0], qf[8 * c + 1] * rstd * g0[1], qf[8 * c + 2] * rstd * g0[2], qf[8 * c + 3] * rstd * g0[3],
                                                                                      qf[8 * c + 4] * rstd * g1[0], qf[8 * c + 5] * rstd * g1[1], qf[8 * c + 6] * rstd * g1[2], qf[8 * c + 7] * rstd * g1[3]);
            }
        }
        __syncthreads();
        {
            const int hs = wave >> 2, ib = wave & 3, hq = kvh * 4 + rnd * 2 + hs;
            bf16x8 qf[4];
#pragma unroll
            for (int ks = 0; ks < 4; ++ks) qf[ks] = lds_frag16(lds + LS_QN + (hs * 128 + 32 * ib + l31) * RQ + (16 * ks + 8 * hf) * 2);
            f32x16 s[5];
#pragma unroll
            for (int t = 0; t < 5; ++t) {
#pragma unroll
                for (int i = 0; i < 16; ++i) s[t][i] = 0.f;
#pragma unroll
                for (int ks = 0; ks < 4; ++ks) s[t] = MFMA32(lds_frag16(lds + LS_KN + (32 * (ib + t) + l31) * RQ + (16 * ks + 8 * hf) * 2), qf[ks], s[t]);
            }
            const float sink = sinks[hq];
            float m = sink;
#pragma unroll
            for (int t = 0; t < 5; ++t)
#pragma unroll
                for (int i = 0; i < 16; ++i) {
                    bool ok = true;
                    if (t == 0) ok = crow(i, hf) > l31;
                    if (t == 4) ok = crow(i, hf) <= l31;
                    if (n == 0 && ib + t < 4) ok = false;
                    s[t][i] = ok ? s[t][i] : -INFINITY;
                    m = fmaxf(m, s[t][i]);
                }
            m = fmaxf(m, __shfl_xor(m, 32));
            float l = 0.f;
#pragma unroll
            for (int t = 0; t < 5; ++t)
#pragma unroll
                for (int i = 0; i < 16; ++i) { s[t][i] = exp2f((s[t][i] - m) * 1.4426950408889634f); l += s[t][i]; }
            l += __shfl_xor(l, 32);
            l += exp2f((sink - m) * 1.4426950408889634f);
            f32x16 o[2];
#pragma unroll
            for (int e2 = 0; e2 < 2; ++e2)
#pragma unroll
                for (int i = 0; i < 16; ++i) o[e2][i] = 0.f;
#pragma unroll
            for (int t = 0; t < 5; ++t)
#pragma unroll
                for (int st = 0; st < 2; ++st) {
                    const bf16x8 pf = pack8(s[t][8 * st], s[t][8 * st + 1], s[t][8 * st + 2], s[t][8 * st + 3], s[t][8 * st + 4], s[t][8 * st + 5], s[t][8 * st + 6], s[t][8 * st + 7]);
#pragma unroll
                    for (int e2 = 0; e2 < 2; ++e2) o[e2] = MFMA32(cat8(lds_tr4(lds + LS_VS, 32 * (ib + t) + 16 * st + 4 * hf, 32 * e2, lane), lds_tr4(lds + LS_VS, 32 * (ib + t) + 16 * st + 8 + 4 * hf, 32 * e2, lane)), pf, o[e2]);
                }
            const float inv = 1.0f / l;
            const size_t orow = (size_t)b * SQ + n * 128 + 32 * ib + l31;
#pragma unroll
            for (int e2 = 0; e2 < 2; ++e2)
#pragma unroll
                for (int g = 0; g < 4; ++g) { v2u w; w.x = pk2(o[e2][4 * g] * inv, o[e2][4 * g + 1] * inv); w.y = pk2(o[e2][4 * g + 2] * inv, o[e2][4 * g + 3] * inv);
                    *(v2u*)(MIXED + orow * D + 512 + hq * 64 + 32 * e2 + 8 * g + 4 * hf) = w; }
        }
        __syncthreads();
    }
}

__device__ __forceinline__ void p2_mixing(const Args& a, LAS unsigned char* lds, int bx, int G, int tid, int lane, int wave, int parts = 3) {
    const bf16* PROJ = (const bf16*)(a.ws + WS_R2); bf16* MIXED = (bf16*)(a.ws + WS_R1); const float* rope = (const float*)(a.ws + WS_ROPE);
    if (parts & 1) for (int u = bx; u < 256; u += G) {
        const int b = u >> 5, h = (u >> 2) & 7, grp = u & 3;
        const int c0 = grp == 0 ? 0 : grp == 1 ? 11 : grp == 2 ? 20 : 27, c1 = grp == 0 ? 11 : grp == 1 ? 20 : grp == 2 ? 27 : 32;
        ret_unit(PROJ, MIXED, rope, lds, b, h, c0, c1, tid, lane, wave);
    }
    if (parts & 2) for (int su = bx; su < 512; su += G) swa_unit(PROJ, MIXED, a.in[4], a.in[5], a.in[6], lds, su >> 6, (su >> 5) & 1, su & 31, tid, lane, wave);
}


template <int N> __device__ __forceinline__ void bitonic_sort_desc(float (&v)[N]) {
#pragma unroll
    for (int k = 2; k <= N; k <<= 1)
#pragma unroll
        for (int j = k >> 1; j > 0; j >>= 1)
#pragma unroll
            for (int i = 0; i < N; ++i) { const int l = i ^ j; if (l > i) { const bool desc = ((i & k) == 0); const float a = v[i], b = v[l]; const float hi = fmaxf(a, b), lo = fminf(a, b); v[i] = desc ? hi : lo; v[l] = desc ? lo : hi; } }
}
__device__ __forceinline__ void sort16_desc(float (&v)[16]) {
    constexpr int A[63] = {0,2,0,1,1,4,6,4,5,5,0,2,2,1,3,3,1,3,5,8,10,8,9,9,12,14,12,13,13,8,10,10,9,11,11,9,11,13,0,4,4,2,6,6,2,6,10,1,5,5,3,7,7,3,7,11,1,3,5,7,9,11,13};
    constexpr int B[63] = {1,3,2,3,2,5,7,6,7,6,4,6,4,5,7,5,2,4,6,9,11,10,11,10,13,15,14,15,14,12,14,12,13,15,13,10,12,14,8,12,8,10,14,10,4,8,12,9,13,9,11,15,11,5,9,13,2,4,6,8,10,12,14};
#pragma unroll
    for (int i = 0; i < 63; ++i) { const float a = v[A[i]], b = v[B[i]]; v[A[i]] = fmaxf(a, b); v[B[i]] = fminf(a, b); }
}
__device__ __forceinline__ void bitonic_merge16_desc(float (&v)[16]) {
#pragma unroll
    for (int j = 8; j > 0; j >>= 1)
#pragma unroll
        for (int i = 0; i < 16; ++i) { const int l = i ^ j; if (l > i) { const float a = v[i], b = v[l]; v[i] = fmaxf(a, b); v[l] = fminf(a, b); } }
}
__device__ __forceinline__ void top16_of_64(float (&v)[64], float (&out)[16]) {
    float b[4][16];
#pragma unroll
    for (int q = 0; q < 4; ++q) {
#pragma unroll
        for (int i = 0; i < 16; ++i) b[q][i] = v[16 * q + i];
        sort16_desc(b[q]);
    }
    float t0[16], t1[16];
#pragma unroll
    for (int i = 0; i < 16; ++i) { t0[i] = fmaxf(b[0][i], b[1][15 - i]); t1[i] = fmaxf(b[2][i], b[3][15 - i]); }
    bitonic_merge16_desc(t0); bitonic_merge16_desc(t1);
#pragma unroll
    for (int i = 0; i < 16; ++i) out[i] = fmaxf(t0[i], t1[15 - i]);
    bitonic_merge16_desc(out);
}
__device__ __forceinline__ float dot2u(unsigned a, unsigned b, float c) { return __builtin_amdgcn_fdot2_f32_bf16(__builtin_bit_cast(b16x2, a), __builtin_bit_cast(b16x2, b), c, false); }
__device__ __forceinline__ float gelu_erf(float v) {
    const float av = fabsf(v), t = __builtin_amdgcn_rcpf(av * 0.2316418882f + 1.0f);
    float q = t * 0.5307027145f + (-0.7265760135f); q = q * t + 0.7107068705f; q = q * t + (-0.142248368f); q = q * t + 0.127414796f; q = q * t;
    const float e = __builtin_amdgcn_exp2f((v * v) * (-0.72134752044f));
    const float m = v * (q * e);
    return v < 0.f ? m : v - m;
}

constexpr int KROW = 272;
constexpr int LP_KEYS = 0, LP_LUT = LP_KEYS + 256 * KROW, LP_RSTD = LP_LUT + NWAVES * 32 * 32, LP_END = LP_RSTD + 4 * 128;
static_assert(LP_END <= RING_BYTES, "peer LDS");

__device__ __forceinline__ void p5a_topk(const Args& a, LAS unsigned char* lds, int vcu, int G, int tid, int lane, int wave PT_DECL) {
    unsigned char* ws = a.ws;
    const bf16* Q = (const bf16*)(ws + WS_R2 + 64 * MB); const bf16* XB1 = (const bf16*)(ws + WS_R2); unsigned char* H8 = ws + WS_R1; float* SH = (float*)(ws + WS_SH); const float* gffn = a.in[8];
    unsigned* PK = (unsigned*)(ws + WS_PK);
    const int l31 = lane & 31, hf = lane >> 5;
    for (int i = tid; i < 256 * 16; i += NTHR) { const int rr = i >> 4, c = i & 15; *(LAS v4u*)(lds + LP_KEYS + rr * KROW + c * 16) = *(const v4u*)((const bf16*)(ws + WS_KEYS) + rr * 128 + c * 8); }
    float gw[16];
    { const f32x4 g0 = *(const f32x4*)(gffn + 16 * lane), g1 = *(const f32x4*)(gffn + 16 * lane + 4), g2 = *(const f32x4*)(gffn + 16 * lane + 8), g3 = *(const f32x4*)(gffn + 16 * lane + 12);
#pragma unroll
      for (int u = 0; u < 4; ++u) { gw[u] = g0[u]; gw[4 + u] = g1[u]; gw[8 + u] = g2[u]; gw[12 + u] = g3[u]; } }
    { int gi = 0;
      for (int grp = vcu; grp < T / 32 && gi < 4; grp += G, ++gi) {
        const int t0 = grp * 32;
        {
            float xs[4][16];
#pragma unroll
            for (int q = 0; q < 4; ++q) {
                const bf16* xr = XB1 + ((size_t)t0 + 4 * wave + q) * D + 16 * lane;
                const v4u x0 = *(const v4u*)xr, x1 = *(const v4u*)(xr + 8);
#pragma unroll
                for (int u = 0; u < 4; ++u) { xs[q][2 * u] = bf_lo(x0[u]); xs[q][2 * u + 1] = bf_hi(x0[u]); xs[q][8 + 2 * u] = bf_lo(x1[u]); xs[q][8 + 2 * u + 1] = bf_hi(x1[u]); }
            }
            float ssq[4];
#pragma unroll
            for (int q = 0; q < 4; ++q) { float sq = 0.f;
#pragma unroll
                for (int u = 0; u < 16; ++u) sq += xs[q][u] * xs[q][u];
                ssq[q] = sq; }
#pragma unroll
            for (int o = 1; o < 64; o <<= 1)
#pragma unroll
                for (int q = 0; q < 4; ++q) ssq[q] += __shfl_xor(ssq[q], o);
            float am[4];
#pragma unroll
            for (int q = 0; q < 4; ++q) {
                const float rstd = 1.0f / sqrtf(ssq[q] * (1.0f / D) + 1e-6f);
                if (lane == 0) *(LAS float*)(lds + LP_RSTD + gi * 128 + (4 * wave + q) * 4) = rstd;
                float m = 0.f;
#pragma unroll
                for (int u = 0; u < 16; ++u) { xs[q][u] = xs[q][u] * rstd * gw[u]; m = fmaxf(m, fabsf(xs[q][u])); }
                am[q] = m;
            }
#pragma unroll
            for (int o = 1; o < 64; o <<= 1)
#pragma unroll
                for (int q = 0; q < 4; ++q) am[q] = fmaxf(am[q], __shfl_xor(am[q], o));
#pragma unroll
            for (int q = 0; q < 4; ++q) {
                const size_t tok = (size_t)t0 + 4 * wave + q;
                const float inv = am[q] > 0.f ? 127.0f / am[q] : 0.f;
                v4u w;
#pragma unroll
                for (int c = 0; c < 4; ++c) { unsigned ww = 0u;
#pragma unroll
                    for (int u = 0; u < 4; ++u) { const int qi = __float2int_rn(xs[q][4 * c + u] * inv); ww |= ((unsigned)qi & 0xffu) << (8 * u); }
                    w[c] = ww; }
                *(v4u*)(H8 + tok * D + 16 * lane) = w;
                if (lane == 0) SH[tok] = am[q] * (1.0f / 127.0f);
            }
        }
      }
    }
    __syncthreads();
    int gi = 0;
#pragma unroll 1
    for (int grp = vcu; grp < T / 32 && gi < 4; grp += G, ++gi) {
        const int t0 = grp * 32;
        PT_BEGIN();
        PT_ADD(0);
        {
            const int h = wave;
            float lst[2][16];
#pragma unroll
            for (int p = 0; p < 2; ++p) {
                const bf16* qrow = Q + (size_t)(t0 + l31) * NQ + h * 256 + p * 128 + 8 * hf;
                f32x16 acc[4];
#pragma unroll
                for (int q = 0; q < 4; ++q)
#pragma unroll
                    for (int i = 0; i < 16; ++i) acc[q][i] = 0.f;
#pragma unroll
                for (int ks = 0; ks < 8; ++ks) {
                    const bf16x8 qf = *(const bf16x8*)(qrow + 16 * ks);
#pragma unroll
                    for (int q = 0; q < 4; ++q) acc[q] = MFMA32(lds_frag16(lds + LP_KEYS + (p * 128 + 32 * q + l31) * KROW + (16 * ks + 8 * hf) * 2), qf, acc[q]);
                }
                float v[64];
#pragma unroll
                for (int q = 0; q < 4; ++q)
#pragma unroll
                    for (int i = 0; i < 16; ++i) v[16 * q + i] = __uint_as_float((__float_as_uint(acc[q][i]) & 0xffffff80u) | (unsigned)(32 * q + crow(i, hf)));
                float mine[16];
                top16_of_64(v, mine);
                float t[16];
#pragma unroll
                for (int i = 0; i < 16; ++i) t[i] = __shfl_xor(mine[i], 32);
#pragma unroll
                for (int i = 0; i < 16; ++i) lst[p][i] = fmaxf(mine[i], t[15 - i]);
                bitonic_merge16_desc(lst[p]);
            }
            PT_ADD(1);
            LAS unsigned char* lut = lds + LP_LUT + wave * 1024 + l31 * 32;
            {
                v4u wa, wb;
#pragma unroll
                for (int c = 0; c < 4; ++c) {
                    wa[c] = (__float_as_uint(lst[0][4 * c]) & 0x7fu) | ((__float_as_uint(lst[0][4 * c + 1]) & 0x7fu) << 8) | ((__float_as_uint(lst[0][4 * c + 2]) & 0x7fu) << 16) | ((__float_as_uint(lst[0][4 * c + 3]) & 0x7fu) << 24);
                    wb[c] = (__float_as_uint(lst[1][4 * c]) & 0x7fu) | ((__float_as_uint(lst[1][4 * c + 1]) & 0x7fu) << 8) | ((__float_as_uint(lst[1][4 * c + 2]) & 0x7fu) << 16) | ((__float_as_uint(lst[1][4 * c + 3]) & 0x7fu) << 24);
                }
                if (hf == 0) { *(LAS v4u*)lut = wa; *(LAS v4u*)(lut + 16) = wb; }
            }
            float cv[64];
            {
                int c = 0;
#pragma unroll
                for (int i = 0; i < 16; ++i)
#pragma unroll
                    for (int j = 0; j < 16; ++j)
                        if ((i + 1) * (j + 1) <= 16) {
                            const float sa = __uint_as_float(__float_as_uint(lst[0][i]) & 0xffffff80u), sb = __uint_as_float(__float_as_uint(lst[1][j]) & 0xffffff80u);
                            cv[c] = __uint_as_float((__float_as_uint(sa + sb) & 0xffffff00u) | (unsigned)(i * 16 + j)); ++c;
                        }
#pragma unroll
                for (int k = 50; k < 64; ++k) cv[k] = -3.0e38f;
            }
            float best[16];
            top16_of_64(cv, best);
            const float rstd = *(const LAS float*)(lds + LP_RSTD + gi * 128 + l31 * 4);
            const float s0 = __uint_as_float(__float_as_uint(best[0]) & 0xffffff00u);
            float ev[16], esum = 0.f;
#pragma unroll
            for (int k = 0; k < 16; ++k) { const float sk = __uint_as_float(__float_as_uint(best[k]) & 0xffffff00u); ev[k] = __expf(rstd * (sk - s0)); esum += ev[k]; }
            const float einv = 1.0f / esum;
            LDS_WAIT();
            asm volatile("" ::: "memory");
            {
                const size_t ob = (size_t)(t0 + l31) * 128 + h * 16 + 8 * hf;
                unsigned e8[8];
                const unsigned hm = hf ? 0xffffffffu : 0u;
#pragma unroll
                for (int j = 0; j < 8; ++j) { const unsigned code = ((__float_as_uint(best[8 + j]) & hm) | (__float_as_uint(best[j]) & ~hm)) & 0xffu;
                    const float gk = __uint_as_float((__float_as_uint(ev[8 + j]) & hm) | (__float_as_uint(ev[j]) & ~hm)) * einv;
                    const unsigned ia = *(const LAS unsigned char*)(lut + (code >> 4)), ib = *(const LAS unsigned char*)(lut + 16 + (code & 15u));
                    e8[j] = (ia * 128u + ib) | (pk2(0.f, gk) & 0xffff0000u); }
                *(v4u*)(PK + ob) = (v4u){e8[0], e8[1], e8[2], e8[3]}; *(v4u*)(PK + ob + 4) = (v4u){e8[4], e8[5], e8[6], e8[7]};
            }
            PT_ADD(2);
        }
    }
    __syncthreads();
}

constexpr int LB_H = 0, LB_LIST = LB_H + NWAVES * 4096, LB_GATE = LB_LIST + NWAVES * 2304, LB_SH = LB_GATE + NWAVES * 2048, LB_END = LB_SH + NWAVES * 16;
static_assert(LB_END <= RING_BYTES, "p5b LDS");
struct B5Batch { v4u ur[4][4]; unsigned em; float scl, svl; };
__device__ __forceinline__ float wave_sum_dpp(float x) {
    x += __builtin_bit_cast(float, __builtin_amdgcn_update_dpp(0, __builtin_bit_cast(int, x), 0xB1, 0xf, 0xf, false));
    x += __builtin_bit_cast(float, __builtin_amdgcn_update_dpp(0, __builtin_bit_cast(int, x), 0x4E, 0xf, 0xf, false));
    x += __builtin_bit_cast(float, __builtin_amdgcn_update_dpp(0, __builtin_bit_cast(int, x), 0x141, 0xf, 0xf, false));
    x += __builtin_bit_cast(float, __builtin_amdgcn_update_dpp(0, __builtin_bit_cast(int, x), 0x140, 0xf, 0xf, false));
    x += __builtin_bit_cast(float, __builtin_amdgcn_update_dpp(0, __builtin_bit_cast(int, x), 0x142, 0xa, 0xf, false));
    x += __builtin_bit_cast(float, __builtin_amdgcn_update_dpp(0, __builtin_bit_cast(int, x), 0x143, 0xc, 0xf, false));
    return __builtin_bit_cast(float, __builtin_amdgcn_readlane(__builtin_bit_cast(int, x), 63));
}
__device__ __forceinline__ float wave_max_dpp(float x) {
    x = fmaxf(x, __builtin_bit_cast(float, __builtin_amdgcn_update_dpp(0, __builtin_bit_cast(int, x), 0xB1, 0xf, 0xf, false)));
    x = fmaxf(x, __builtin_bit_cast(float, __builtin_amdgcn_update_dpp(0, __builtin_bit_cast(int, x), 0x4E, 0xf, 0xf, false)));
    x = fmaxf(x, __builtin_bit_cast(float, __builtin_amdgcn_update_dpp(0, __builtin_bit_cast(int, x), 0x141, 0xf, 0xf, false)));
    x = fmaxf(x, __builtin_bit_cast(float, __builtin_amdgcn_update_dpp(0, __builtin_bit_cast(int, x), 0x140, 0xf, 0xf, false)));
    x = fmaxf(x, __builtin_bit_cast(float, __builtin_amdgcn_update_dpp(0, __builtin_bit_cast(int, x), 0x142, 0xa, 0xf, false)));
    x = fmaxf(x, __builtin_bit_cast(float, __builtin_amdgcn_update_dpp(0, __builtin_bit_cast(int, x), 0x143, 0xc, 0xf, false)));
    return __builtin_bit_cast(float, __builtin_amdgcn_readlane(__builtin_bit_cast(int, x), 63));
}
__device__ __forceinline__ int row16_sum(int x) {
    x += __builtin_amdgcn_update_dpp(0, x, 0xB1, 0xf, 0xf, false);
    x += __builtin_amdgcn_update_dpp(0, x, 0x4E, 0xf, 0xf, false);
    x += __builtin_amdgcn_update_dpp(0, x, 0x141, 0xf, 0xf, false);
    x += __builtin_amdgcn_update_dpp(0, x, 0x140, 0xf, 0xf, false);
    return x;
}
__device__ __forceinline__ void b5_issue(B5Batch& b, const LAS unsigned* list, int bt, const unsigned char* U8, const float* SU, const float* SV, int lane, int jmine) {
    const int g = lane >> 4, c = lane & 15;
#pragma unroll
    for (int ps = 0; ps < 4; ++ps) {
        const unsigned ent = list[16 * bt + 4 * ps + g];
        const unsigned char* rp = U8 + ((ent & 0xffffu) * 1024u + 16u * (unsigned)c);
#pragma unroll
        for (int i = 0; i < 4; ++i) b.ur[ps][i] = *(const v4u*)(rp + 256 * i);
    }
    b.em = list[16 * bt + 4 * (c & 3) + g];
    const unsigned ee = b.em & 0xffffu; b.scl = SU[ee]; b.svl = SV[ee];
}
__device__ __forceinline__ void b5_compute(const B5Batch& b, const LAS unsigned* list, int bt, LAS unsigned char* hreg, const LAS float* gts, const LAS float* shs, unsigned* PK, int tok0, int lane) {
    const int g = lane >> 4, c = lane & 15;
    int res = 0;
#pragma unroll
    for (int ps = 0; ps < 4; ++ps) {
        const unsigned ent = list[16 * bt + 4 * ps + g];
        LAS unsigned char* hp = hreg + ((ent >> 28) & 3u) * 1024 + 16 * c;
        int acc = 0;
#pragma unroll
        for (int i = 0; i < 4; ++i) { const v4u hh = *(const LAS v4u*)(hp + 256 * i);
#pragma unroll
            for (int u = 0; u < 4; ++u) { const unsigned wa = b.ur[ps][i][u], ha = hh[u]; acc = __builtin_amdgcn_sdot4((int)ha, (int)wa, acc, false); } }
        const int tot = row16_sum(acc);
        res = (c == ps) ? tot : res;
    }
    const unsigned eslot = b.em >> 28, ek = (b.em >> 16) & 0xffu;
    if (c < 4 && eslot < 4u) {
        const float dot = (float)res * b.scl * shs[eslot];
        ((unsigned short*)(PK + ((size_t)tok0 + eslot) * 128 + ek))[1] = (unsigned short)(pk2(0.f, gelu_erf(dot) * gts[eslot * 128 + ek] * b.svl) >> 16);
    }
}
struct B5Pre { v2u pk[4]; v4u h0[4]; float shv; };
__device__ __forceinline__ void b5_prefetch(B5Pre& p, const unsigned* PK, const unsigned char* H8, const float* SH, int tok0, int lane) {
#pragma unroll
    for (int s = 0; s < 4; ++s) { const size_t tok = (size_t)tok0 + s;
        p.pk[s] = *(const v2u*)(PK + tok * 128 + 2 * lane); p.h0[s] = *(const v4u*)(H8 + tok * D + 16 * lane); }
    p.shv = SH[tok0 + (lane & 3)];
}
__device__ __forceinline__ void p5b_dots(const Args& a, LAS unsigned char* lds, int bx, int G, int tid, int lane, int wave) {
    unsigned char* ws = a.ws;
    const unsigned char* H8 = ws + WS_R1; const unsigned char* U8 = ws + WS_UB; const float* SU = (const float*)(ws + WS_SU); const float* SV = (const float*)(ws + WS_SV); const float* SH = (const float*)(ws + WS_SH);
    unsigned* PK = (unsigned*)(ws + WS_PK);
    LAS unsigned char* hreg = lds + LB_H + wave * 4096; LAS unsigned* list = (LAS unsigned*)(lds + LB_LIST + wave * 2304); LAS float* gts = (LAS float*)(lds + LB_GATE + wave * 2048); LAS float* shs = (LAS float*)(lds + LB_SH + wave * 16);
    const int jmine = ((lane >> 5) & 1) * 8 + ((lane >> 4) & 1) * 4 + ((lane >> 3) & 1) * 2 + ((lane >> 2) & 1);
    const unsigned long long ltmask = (1ull << lane) - 1ull;
    for (int vb = bx; vb < 256; vb += G) {
        const unsigned vx = (unsigned)(vb & 7); const int wi = vb >> 3;
        const int tw0 = wi * 1024 + wave * 128;
        B5Pre P;
        b5_prefetch(P, PK, H8, SH, tw0, lane);
#pragma unroll 1
        for (int ch = 0; ch < 32; ++ch) {
            const int tok0 = tw0 + 4 * ch;
            int n = 0;
            if (lane < 4) shs[lane] = P.shv;
#pragma unroll
            for (int s = 0; s < 4; ++s) {
                *(LAS v4u*)(hreg + s * 1024 + lane * 16) = P.h0[s];
                *(LAS f32x2*)(gts + s * 128 + 2 * lane) = (f32x2){bf_hi(P.pk[s].x), bf_hi(P.pk[s].y)};
                const unsigned id0 = P.pk[s].x & 0xffffu, id1 = P.pk[s].y & 0xffffu;
                const bool in0 = (id0 >> 11) == vx, in1 = (id1 >> 11) == vx;
                const unsigned long long m0 = __ballot(in0), m1 = __ballot(in1);
                const int c0 = __popcll(m0), c1 = __popcll(m1);
                if (in0) list[n + __popcll(m0 & ltmask)] = ((unsigned)s << 28) | ((unsigned)(2 * lane) << 16) | id0;
                if (in1) list[n + c0 + __popcll(m1 & ltmask)] = ((unsigned)s << 28) | ((unsigned)(2 * lane + 1) << 16) | id1;
                n += c0 + c1;
            }
            const int nb = (n + 15) >> 4;
            if (lane < 16) list[n + lane] = (0xfu << 28) | (vx << 11);
            if (ch + 1 < 32) b5_prefetch(P, PK, H8, SH, tok0 + 4, lane);
            LDS_WAIT(); asm volatile("" ::: "memory");
            B5Batch A, B;
            if (nb > 0) b5_issue(A, list, 0, U8, SU, SV, lane, jmine);
#pragma unroll 1
            for (int bt = 0; bt < nb; bt += 2) {
                if (bt + 1 < nb) b5_issue(B, list, bt + 1, U8, SU, SV, lane, jmine);
                b5_compute(A, list, bt, hreg, gts, shs, PK, tok0, lane);
                if (bt + 1 < nb) {
                    if (bt + 2 < nb) b5_issue(A, list, bt + 2, U8, SU, SV, lane, jmine);
                    b5_compute(B, list, bt + 1, hreg, gts, shs, PK, tok0, lane);
                }
            }
        }
    }
}

constexpr int LC_BUF = 0, LC_END = NWAVES * 2 * 1024;
struct C5Tok { v4u vv[16]; unsigned xa; float sa; };
__device__ __forceinline__ float c5_stage(LAS unsigned char* buf, v2u pk, int lane) {
    const unsigned idw = (pk.x & 0xffffu) | (pk.y << 16); const f32x2 av = {bf_hi(pk.x), bf_hi(pk.y)};
    const float am = wave_max_dpp(fmaxf(fabsf(av[0]), fabsf(av[1])));
    const float inv = am > 0.f ? 127.0f / am : 0.f;
    const int q0 = __float2int_rn(av[0] * inv), q1 = __float2int_rn(av[1] * inv);
    const int k0 = 2 * lane, k1 = 2 * lane + 1;
    *(LAS unsigned short*)(buf + ((k0 & 7) * 16 + (k0 >> 3)) * 2) = (unsigned short)(idw & 0xffffu);
    *(LAS unsigned short*)(buf + ((k1 & 7) * 16 + (k1 >> 3)) * 2) = (unsigned short)(idw >> 16);
    *(LAS unsigned char*)(buf + 256 + (k0 & 7) * 16 + (k0 >> 3)) = (unsigned char)q0;
    *(LAS unsigned char*)(buf + 256 + (k1 & 7) * 16 + (k1 >> 3)) = (unsigned char)q1;
    return am * (1.0f / 127.0f);
}
__device__ __forceinline__ void c5_issue(C5Tok& t, LAS unsigned char* buf, const unsigned char* vbase, unsigned coff, const bf16* xr, int g) {
    const v4u i0 = *(const LAS v4u*)(buf + g * 32), i1 = *(const LAS v4u*)(buf + g * 32 + 16);
#pragma unroll
    for (int j = 0; j < 16; ++j) {
        const unsigned w = (j < 8) ? i0[j >> 1] : i1[(j - 8) >> 1];
        const unsigned e = (j & 1) ? (w >> 16) : (w & 0xffffu);
        t.vv[j] = *(const v4u*)(vbase + (e * 128u + coff));
    }
    t.xa = *(const unsigned*)xr;
}
__device__ __forceinline__ void c5_finish(const C5Tok& t, LAS unsigned char* buf, bf16* xb, float* rss, int lane, int g) {
    int y[16];
#pragma unroll
    for (int u = 0; u < 16; ++u) y[u] = 0;
#pragma unroll
    for (int q = 0; q < 4; ++q) {
        const int a4 = (int)*(const LAS unsigned*)(buf + 256 + g * 16 + 4 * q);
#pragma unroll
        for (int u = 0; u < 4; ++u) {
            const unsigned r0 = t.vv[4 * q][u], r1 = t.vv[4 * q + 1][u], r2 = t.vv[4 * q + 2][u], r3 = t.vv[4 * q + 3][u];
            const unsigned lo01 = __builtin_amdgcn_perm(r1, r0, 0x05010400u), hi01 = __builtin_amdgcn_perm(r1, r0, 0x07030602u);
            const unsigned lo23 = __builtin_amdgcn_perm(r3, r2, 0x05010400u), hi23 = __builtin_amdgcn_perm(r3, r2, 0x07030602u);
            const unsigned t0 = __builtin_amdgcn_perm(lo23, lo01, 0x05040100u), t1 = __builtin_amdgcn_perm(lo23, lo01, 0x07060302u);
            const unsigned t2 = __builtin_amdgcn_perm(hi23, hi01, 0x05040100u), t3 = __builtin_amdgcn_perm(hi23, hi01, 0x07060302u);
            y[4 * u] = __builtin_amdgcn_sdot4((int)t0, a4, y[4 * u], false); y[4 * u + 1] = __builtin_amdgcn_sdot4((int)t1, a4, y[4 * u + 1], false);
            y[4 * u + 2] = __builtin_amdgcn_sdot4((int)t2, a4, y[4 * u + 2], false); y[4 * u + 3] = __builtin_amdgcn_sdot4((int)t3, a4, y[4 * u + 3], false);
        }
    }
    int y8[8], y4[4], y2[2];
    { const bool hi = (lane & 32) != 0;
#pragma unroll
      for (int u = 0; u < 8; ++u) { const int keep = hi ? y[u + 8] : y[u], send = hi ? y[u] : y[u + 8]; y8[u] = keep + __shfl_xor(send, 32); } }
    { const bool hi = (lane & 16) != 0;
#pragma unroll
      for (int u = 0; u < 4; ++u) { const int keep = hi ? y8[u + 4] : y8[u], send = hi ? y8[u] : y8[u + 4]; y4[u] = keep + __shfl_xor(send, 16); } }
    { const bool hi = (lane & 8) != 0;
#pragma unroll
      for (int u = 0; u < 2; ++u) { const int keep = hi ? y4[u + 2] : y4[u], send = hi ? y4[u] : y4[u + 2]; y2[u] = keep + __shfl_xor(send, 8); } }
    const float o0 = bf_lo(t.xa) + (float)y2[0] * t.sa, o1 = bf_hi(t.xa) + (float)y2[1] * t.sa;
    const float ss = wave_sum_dpp(o0 * o0 + o1 * o1);
    *(unsigned*)xb = pk2(o0, o1);
    if (lane == 0) *rss = ss;
}
__device__ __forceinline__ void p5c_axpy(const Args& a, LAS unsigned char* lds, int bx, int G, int tid, int lane, int wave) {
    unsigned char* ws = a.ws;
    const unsigned char* V8 = ws + WS_VB; const unsigned* PK = (const unsigned*)(ws + WS_PK);
    const bf16* XB1 = (const bf16*)(ws + WS_R2); bf16* XB2 = (bf16*)(ws + WS_R1); float* RSS2 = (float*)(ws + WS_RSS2);
    const int g = lane >> 3, c = lane & 7;
    const int colo = 16 * c + 8 * ((g >> 2) & 1) + 4 * ((g >> 1) & 1) + 2 * (g & 1);
    LAS unsigned char* buf0 = lds + LC_BUF + wave * 2048; LAS unsigned char* buf1 = buf0 + 1024;
    for (int vb = bx; vb < 256; vb += G) {
        const int vx = vb & 7, wi = vb >> 3;
        const size_t tw0 = (size_t)wi * 1024 + wave * 128;
        const unsigned char* vbase = V8 + (size_t)vx * ((size_t)NEXP * 128); const unsigned coff = 16u * (unsigned)c;
        const bf16* xcol = XB1 + vx * 128 + colo; bf16* xbcol = XB2 + vx * 128 + colo;
        C5Tok A, B;
        v2u pk = *(const v2u*)(PK + tw0 * 128 + 2 * lane);
        A.sa = c5_stage(buf0, pk, lane);
        pk = *(const v2u*)(PK + (tw0 + 1) * 128 + 2 * lane);
        LDS_WAIT(); asm volatile("" ::: "memory");
        c5_issue(A, buf0, vbase, coff, xcol + tw0 * D, g);
#pragma unroll 1
        for (int i = 0; i < 128; i += 2) {
            const size_t tok = tw0 + i;
            B.sa = c5_stage(buf1, pk, lane);
            if (i + 2 < 128) pk = *(const v2u*)(PK + (tok + 2) * 128 + 2 * lane);
            LDS_WAIT(); asm volatile("" ::: "memory");
            c5_issue(B, buf1, vbase, coff, xcol + (tok + 1) * D, g);
            c5_finish(A, buf0, xbcol + tok * D, RSS2 + tok * 8 + vx, lane, g);
            if (i + 2 < 128) {
                A.sa = c5_stage(buf0, pk, lane);
                if (i + 3 < 128) pk = *(const v2u*)(PK + (tok + 3) * 128 + 2 * lane);
                LDS_WAIT(); asm volatile("" ::: "memory");
                c5_issue(A, buf0, vbase, coff, xcol + (tok + 2) * D, g);
            }
            c5_finish(B, buf1, xbcol + (tok + 1) * D, RSS2 + (tok + 1) * 8 + vx, lane, g);
        }
    }
}

__global__ void __launch_bounds__(NTHR, 2) mk_fwd(Args a) {
    extern __shared__ __attribute__((aligned(16))) unsigned char lds_raw[];
    LAS unsigned char* lds = (LAS unsigned char*)lds_raw;
    const int tid = threadIdx.x, lane = tid & 63, wave = __builtin_amdgcn_readfirstlane(tid >> 6);
    const int G = gridDim.x, bx = blockIdx.x, vcu = (G % 8 == 0) ? (bx % 8) * (G / 8) + bx / 8 : bx;
    volatile LAS unsigned* MISC = (volatile LAS unsigned*)(lds + MISC_OFF);
    if (tid < 64) MISC[tid] = 0u;
    __syncthreads();
    unsigned char* ws = a.ws;
    const int lo = a.ph_lo, hi = a.ph_hi;
    XcdBarrier bar; bar.bar = (unsigned*)(ws + WS_CTL) + CW_BAR + a.li * XCD_BAR_WORDS; bar.x = 0; bar.st = nullptr;
    if (hi - lo > 1) bar = xcd_barrier_post((unsigned*)(ws + WS_CTL) + CW_BAR + a.li * XCD_BAR_WORDS, MISC + 8);
#define IN(k) (lo <= (k) && (k) < hi)
#define BOTH(k) (IN(k) && IN((k) + 1))
    if (IN(0)) { p0_prologue(a, lds, vcu, G, tid, lane, wave); if (BOTH(0)) xcd_barrier(bar); }
    if (IN(1)) {
        { pg8::Gemm g{(const bf16*)(ws + WS_R1), (const bf16*)(ws + WS_WIN), T, NIN, D}; pg8::StaticOrder S; S.init(T, NIN, G, bx);
          EpiStoreBf16 E{(bf16*)(ws + WS_R2), NIN};
          pg8::gemm_phase<EpiStoreBf16, pg8::StaticOrder, true, true>(lds, g, S, E); }
        { pg8::Gemm g{(const bf16*)(ws + WS_PB), (const bf16*)(ws + WS_WP), T / 2, D, PLE}; pg8::StaticOrder S; S.init(T / 2, D, G, bx);
          EpiStoreBf16 E{(bf16*)(ws + WS_PP), D};
          pg8::gemm_phase<EpiStoreBf16, pg8::StaticOrder, true, true>(lds, g, S, E); }
        { pg8::Gemm g{(const bf16*)(ws + WS_PB) + (size_t)(T / 2) * PLE, (const bf16*)(ws + WS_WP), T / 2, D, PLE}; pg8::StaticOrder S;
          if (G == 256) S.init(T / 2, D, 128, bx >= 128 ? bx - 128 : (1 << 28)); else S.init(T / 2, D, G, bx);
          EpiStoreBf16 E{(bf16*)(ws + WS_PP) + (size_t)(T / 2) * D, D};
          pg8::gemm_phase<EpiStoreBf16, pg8::StaticOrder, true, true>(lds, g, S, E); }
        if (BOTH(1)) xcd_barrier(bar);
    }
    if (IN(2)) { p2_mixing(a, lds, bx, G, tid, lane, wave); if (BOTH(2)) xcd_barrier(bar); }
    if (IN(3)) {
        pg8::Gemm g{(const bf16*)(ws + WS_R1), (const bf16*)(ws + WS_WOUT), T, D, D}; pg8::StaticOrder S; S.init(T, D, G, bx);
        EpiResid E{a.in[0], (bf16*)(ws + WS_R2)};
        pg8::gemm_phase<EpiResid, pg8::StaticOrder, true, true>(lds, g, S, E);
        if (BOTH(3)) xcd_barrier(bar);
    }
    if (IN(4)) {
        pg8::Gemm g{(const bf16*)(ws + WS_R2), (const bf16*)(ws + WS_WQ), T, NQ, D}; pg8::StaticOrder S; S.init(T, NQ, G, bx);
        EpiStoreBf16 E{(bf16*)(ws + WS_R2 + 64 * MB), NQ};
        pg8::gemm_phase<EpiStoreBf16, pg8::StaticOrder, true, true>(lds, g, S, E);
        if (BOTH(4)) xcd_barrier(bar);
    }
    if (IN(5)) {
        p5a_topk(a, lds, vcu, G, tid, lane, wave PT_ARG); xcd_barrier(bar);
        p5b_dots(a, lds, bx, G, tid, lane, wave); xcd_barrier(bar);
        p5c_axpy(a, lds, bx, G, tid, lane, wave);
        if (BOTH(5)) xcd_barrier(bar);
    }
    if (IN(6)) {
        pg8::Gemm g{(const bf16*)(ws + WS_R1), (const bf16*)(ws + WS_WG), T, D, D}; pg8::StaticOrder S; S.init(T, D, G, bx);
        EpiGate E{a.out, (const bf16*)(ws + WS_R1), (const bf16*)(ws + WS_PP), (const float*)(ws + WS_RSS2)};
        pg8::gemm_phase<EpiGate, pg8::StaticOrder, true, true>(lds, g, S, E);
    }
#undef IN
#undef BOTH
}
}
extern "C" void kernel_launch(void* const* d_in, const int* in_sizes, int n_in, void* d_out, int out_size, void* d_ws, size_t ws_size, hipStream_t stream) {
    using namespace mk;
    static int grid = 0;
    if (grid == 0) {
        int dev = 0, cus = 0;
        if (n_in != 16 || out_size != T * D || ws_size < WS_END) { fprintf(stderr, "kernel_launch: unexpected problem shape / workspace (%d inputs, out %d, ws %zu)\n", n_in, out_size, ws_size); grid = -1; return; }
        if (hipGetDevice(&dev) != hipSuccess || hipDeviceGetAttribute(&cus, hipDeviceAttributeMultiprocessorCount, dev) != hipSuccess) { fprintf(stderr, "device query failed\n"); grid = -1; return; }
        if (hipFuncSetAttribute((const void*)mk_fwd, hipFuncAttributeMaxDynamicSharedMemorySize, LDS_BYTES) != hipSuccess) { fprintf(stderr, "hipFuncSetAttribute failed\n"); grid = -1; return; }
        int per_cu = 0;
        if (hipOccupancyMaxActiveBlocksPerMultiprocessor(&per_cu, (const void*)mk_fwd, NTHR, LDS_BYTES) != hipSuccess || per_cu < 1) { fprintf(stderr, "occupancy query: %d blocks per CU\n", per_cu); (void)hipGetLastError(); }
        if (cus < 256) { fprintf(stderr, "kernel_launch: this kernel is laid out for a 256-CU device (found %d CUs)\n", cus); grid = -1; return; }
        grid = 256;
    }
    if (grid < 0) return;
    unsigned char* ws = (unsigned char*)d_ws;
    (void)hipMemsetAsync(ws + WS_CTL, 0, CTL_BYTES, stream);
    Args a{};
    for (int i = 0; i < 16; ++i) a.in[i] = (const float*)d_in[i];
    a.out = (float*)d_out; a.ws = ws; a.ph_lo = 0; a.ph_hi = 7; a.li = 0; a.pad = 0;
    hipLaunchKernelGGL(mk_fwd, dim3(grid), dim3(NTHR), LDS_BYTES, stream, a);
}
```

```cpp
#include <hip/hip_runtime.h>
#include <cstdio>
#include <cstdint>
#define LAS __attribute__((address_space(3)))
#define GAS __attribute__((address_space(1)))
namespace pg8 {
#define PG8_LAS __attribute__((address_space(3)))
typedef unsigned short bf16_t;
typedef short bf16x8 __attribute__((ext_vector_type(8)));
typedef float f32x4 __attribute__((ext_vector_type(4)));
typedef unsigned u32x4 __attribute__((ext_vector_type(4)));
constexpr int BM = 256, BK = 64, HALF = 128, HTB = HALF * BK * 2  , STAGE_BYTES = 8 * HTB, NXCD = 8, WGM = 8;

__host__ __device__ __forceinline__ int lds_byte(int r, int c) { const int st = (r >> 4) * 2 + (c >> 5), rr = r & 15, cc = c & 31, ob = rr * 64 + cc * 2; return st * 1024 + (ob ^ (((ob >> 9) & 1) << 5)); }
__host__ __device__ __forceinline__ void stage_rc(int b, int& R, int& C) { const int st = b / 1024, sb = b % 1024, swz = sb ^ (((sb >> 9) & 1) << 5); R = (st >> 1) * 16 + swz / 64; C = (st & 1) * 32 + (swz % 64) / 2; }
__host__ __device__ __forceinline__ int perm32(int rho) { const int n = rho >> 4, i = rho & 15; return 8 * (i >> 2) + 4 * n + (i & 3); }

struct Unit { int pm, pn; };
struct Gemm { const bf16_t* A; const bf16_t* Bt; int M, N, K; };

struct StaticOrder {
    int nM, nN, nwg, G, c;
    __host__ __device__ void init(int M, int N, int G_, int c_) { nM = M / BM; nN = N / BM; nwg = nM * nN; G = G_; c = c_; }
    __host__ __device__ bool next(int i, Unit& u) const {
        const long L = (long)i * G + c; if (L >= nwg) return false;
        int wgid = (int)L; { const int q = nwg / NXCD, r = nwg % NXCD, xcd = wgid % NXCD, off = wgid / NXCD; wgid = (xcd < r ? xcd * (q + 1) : r * (q + 1) + (xcd - r) * q) + off; }
        const int nig = WGM * nN, gid = wgid / nig, fm = gid * WGM, gsz = (nM - fm) < WGM ? (nM - fm) : WGM;
        u.pm = fm + ((wgid % nig) % gsz); u.pn = (wgid % nig) / gsz; return true;
    }
    __device__ __forceinline__ void a_ready(const Unit&) const {}
    __device__ __forceinline__ void done(const Unit&) const {}
};
__device__ __forceinline__ unsigned cvt_pk_bf16(float lo, float hi) { unsigned r; asm volatile("v_cvt_pk_bf16_f32 %0, %1, %2" : "=v"(r) : "v"(lo), "v"(hi)); return r; }
template <class Epi, class Sched, bool ALIGN_EPI = false, bool SP2 = false>
__device__ __forceinline__ void gemm_phase(PG8_LAS unsigned char* lds, const Gemm g, const Sched& S, const Epi& E) {
    const int tid = threadIdx.x, wid = __builtin_amdgcn_readfirstlane(tid >> 6), lane = tid & 63, wr = wid >> 2, wc = wid & 3, fr = lane & 15, fq = lane >> 4;
    const int K = g.K, nt = K / BK;
    unsigned voffA[2], voffB[2];
#pragma unroll
    for (int i = 0; i < 2; ++i) { int R, C; stage_rc(tid * 16 + i * 8192, R, C); const int Rb = Epi::PERM ? ((R & ~31) + perm32(R & 31)) : R;
        voffA[i] = (unsigned)(R * K + C) * 2u; voffB[i] = (unsigned)(Rb * K + C) * 2u; }
    const size_t kstep = (size_t)(BK * 2);
    const size_t hstep = (size_t)HALF * K * 2;
    const size_t tstep = 2 * hstep;
    const unsigned ldsw = (unsigned)wid * 1024u;
    const int aoff = lds_byte(wr * 64 + fr, fq * 8), boff = lds_byte(wc * 32 + fr, fq * 8);
#define PG8_SA(b, h) (((b) * 2 + (h)) * HTB)
#define PG8_SB(b, h) ((4 + (b) * 2 + (h)) * HTB)
#define PG8_STAGE(bufoff, gbase, voff) do { _Pragma("unroll") for (int _i = 0; _i < 2; ++_i) \
        __builtin_amdgcn_global_load_lds((const unsigned*)((const char*)(gbase) + (voff)[_i]), (PG8_LAS unsigned*)(lds + (bufoff) + ldsw + _i * 8192), 16, 0, 0); } while (0)
#define PG8_LDA(dst, b, h) do { _Pragma("unroll") for (int m = 0; m < 4; ++m) _Pragma("unroll") for (int k = 0; k < 2; ++k) dst[m][k] = *(const PG8_LAS bf16x8*)(lds + PG8_SA(b, h) + aoff + m * 2048 + k * 1024); } while (0)
#define PG8_LDB(dst, b, h) do { _Pragma("unroll") for (int n = 0; n < 2; ++n) _Pragma("unroll") for (int k = 0; k < 2; ++k) dst[n][k] = *(const PG8_LAS bf16x8*)(lds + PG8_SB(b, h) + boff + n * 2048 + k * 1024); } while (0)
#define PG8_MMA(ai, bj, At, Bt) do { __builtin_amdgcn_s_setprio(1); _Pragma("unroll") for (int m = 0; m < 4; ++m) _Pragma("unroll") for (int n = 0; n < 2; ++n) _Pragma("unroll") for (int k = 0; k < 2; ++k) \
        acc[ai][bj][m][n] = __builtin_amdgcn_mfma_f32_16x16x32_bf16(Bt[n][k], At[m][k], acc[ai][bj][m][n], 0, 0, 0); __builtin_amdgcn_s_setprio(0); } while (0)
#define PG8_WAIT_V(n) asm volatile("s_waitcnt vmcnt(" #n ")" ::: "memory")
#define PG8_WAIT_L(n) asm volatile("s_waitcnt lgkmcnt(" #n ")" ::: "memory")
#define PG8_BAR __builtin_amdgcn_s_barrier()
#define PG8_SCHED __builtin_amdgcn_sched_barrier(0)
    Unit cur, nxt; int ui = 0;
    if (!S.next(0, cur)) return;
    f32x4 acc[2][2][4][2];
#pragma unroll
    for (int a = 0; a < 2; ++a)
#pragma unroll
        for (int b = 0; b < 2; ++b)
#pragma unroll
            for (int m = 0; m < 4; ++m)
#pragma unroll
                for (int n = 0; n < 2; ++n) acc[a][b][m][n] = (f32x4){0.f, 0.f, 0.f, 0.f};
    bf16x8 At[4][2], B0[2][2], B1[2][2];
    const char* cA = (const char*)g.A + (size_t)cur.pm * tstep; const char* cB = (const char*)g.Bt + (size_t)cur.pn * tstep;
    S.a_ready(cur);
    if constexpr (SP2) {
        PG8_STAGE(PG8_SB(0, 0), cB, voffB); PG8_STAGE(PG8_SB(0, 1), cB + hstep, voffB); PG8_STAGE(PG8_SA(0, 0), cA, voffA); PG8_STAGE(PG8_SA(0, 1), cA + hstep, voffA);
        if (wr == 1) PG8_BAR;
        PG8_WAIT_V(2); PG8_BAR;
        PG8_STAGE(PG8_SB(1, 0), cB + kstep, voffB); PG8_STAGE(PG8_SA(1, 0), cA + kstep, voffA); PG8_STAGE(PG8_SB(1, 1), cB + hstep + kstep, voffB);
        PG8_WAIT_V(6); PG8_BAR;
    } else {
        PG8_STAGE(PG8_SB(0, 0), cB, voffB); PG8_STAGE(PG8_SA(0, 0), cA, voffA); PG8_STAGE(PG8_SB(0, 1), cB + hstep, voffB); PG8_STAGE(PG8_SA(0, 1), cA + hstep, voffA);
        if (wr == 1) PG8_BAR;
        PG8_WAIT_V(4); PG8_BAR;
        PG8_STAGE(PG8_SB(1, 0), cB + kstep, voffB); PG8_STAGE(PG8_SA(1, 0), cA + kstep, voffA); PG8_STAGE(PG8_SB(1, 1), cB + hstep + kstep, voffB);
        PG8_WAIT_V(6); PG8_BAR;
    }
    for (;;) {
        const bool has_next = S.next(ui + 1, nxt);
        const char* nA = has_next ? (const char*)g.A + (size_t)nxt.pm * tstep : cA; const char* nB = has_next ? (const char*)g.Bt + (size_t)nxt.pn * tstep : cB;
        for (int t = 0; t < nt; t += 2) {
            const bool last = (t == nt - 2);
            const char* a1 = cA + (size_t)(t + 1) * kstep;
            const char* a2 = last ? nA : cA + (size_t)(t + 2) * kstep; const char* b2 = last ? nB : cB + (size_t)(t + 2) * kstep;
            const char* a3 = a2 + kstep; const char* b3 = b2 + kstep;
            if (last && has_next) S.a_ready(nxt);
            if constexpr (SP2) {
            PG8_LDB(B0, 0, 0); PG8_LDB(B1, 0, 1); PG8_SCHED; PG8_LDA(At, 0, 0); PG8_STAGE(PG8_SA(1, 1), a1 + hstep, voffA);
            PG8_WAIT_V(8); PG8_WAIT_L(0); PG8_BAR; PG8_MMA(0, 0, At, B0); PG8_MMA(0, 1, At, B1); PG8_BAR; PG8_SCHED;
            PG8_LDA(At, 0, 1); PG8_STAGE(PG8_SB(0, 0), b2, voffB); PG8_STAGE(PG8_SB(0, 1), b2 + hstep, voffB); PG8_STAGE(PG8_SA(0, 0), a2, voffA);
            PG8_WAIT_V(8); PG8_WAIT_L(0); PG8_BAR; PG8_MMA(1, 0, At, B0); PG8_MMA(1, 1, At, B1); PG8_BAR; PG8_SCHED;
            PG8_LDB(B0, 1, 0); PG8_LDB(B1, 1, 1); PG8_SCHED; PG8_LDA(At, 1, 0); PG8_STAGE(PG8_SA(0, 1), a2 + hstep, voffA);
            PG8_WAIT_V(8); PG8_WAIT_L(0); PG8_BAR; PG8_MMA(0, 0, At, B0); PG8_MMA(0, 1, At, B1); PG8_BAR; PG8_SCHED;
            PG8_LDA(At, 1, 1); PG8_STAGE(PG8_SB(1, 0), b3, voffB); PG8_STAGE(PG8_SB(1, 1), b3 + hstep, voffB); PG8_STAGE(PG8_SA(1, 0), a3, voffA);
            PG8_WAIT_V(8); PG8_WAIT_L(0); PG8_BAR; PG8_MMA(1, 0, At, B0); PG8_MMA(1, 1, At, B1); PG8_BAR; PG8_SCHED;
            } else {
            PG8_LDB(B0, 0, 0); PG8_SCHED; PG8_LDA(At, 0, 0); PG8_STAGE(PG8_SA(1, 1), a1 + hstep, voffA);
            PG8_WAIT_L(8); PG8_BAR; PG8_WAIT_L(0); PG8_MMA(0, 0, At, B0); PG8_BAR; PG8_SCHED;
            PG8_LDB(B1, 0, 1); PG8_STAGE(PG8_SB(0, 0), b2, voffB);
            PG8_BAR; PG8_WAIT_L(0); PG8_MMA(0, 1, At, B1); PG8_BAR;
            PG8_LDA(At, 0, 1); PG8_STAGE(PG8_SA(0, 0), a2, voffA);
            PG8_BAR; PG8_WAIT_L(0); PG8_MMA(1, 0, At, B0); PG8_BAR; PG8_SCHED;
            PG8_STAGE(PG8_SB(0, 1), b2 + hstep, voffB);
            PG8_WAIT_V(6); PG8_BAR; PG8_MMA(1, 1, At, B1); PG8_BAR;
            PG8_LDB(B0, 1, 0); PG8_SCHED; PG8_LDA(At, 1, 0); PG8_STAGE(PG8_SA(0, 1), a2 + hstep, voffA);
            PG8_WAIT_L(8); PG8_BAR; PG8_WAIT_L(0); PG8_MMA(0, 0, At, B0); PG8_BAR; PG8_SCHED;
            PG8_LDB(B1, 1, 1); PG8_STAGE(PG8_SB(1, 0), b3, voffB);
            PG8_BAR; PG8_WAIT_L(0); PG8_MMA(0, 1, At, B1); PG8_BAR;
            PG8_LDA(At, 1, 1); PG8_STAGE(PG8_SA(1, 0), a3, voffA);
            PG8_BAR; PG8_WAIT_L(0); PG8_MMA(1, 0, At, B0); PG8_BAR; PG8_SCHED;
            PG8_STAGE(PG8_SB(1, 1), b3 + hstep, voffB);
            PG8_WAIT_V(6); PG8_BAR; PG8_MMA(1, 1, At, B1); PG8_BAR;
            }
        }
        if constexpr (ALIGN_EPI) { if (wr == 0) PG8_BAR; }
        if constexpr (!Epi::AFTER_DRAIN) { E(acc, cur, wr, wc, fr, fq); S.done(cur); }
        if (!has_next) break;
#pragma unroll
        for (int a = 0; a < 2; ++a)
#pragma unroll
            for (int b = 0; b < 2; ++b)
#pragma unroll
                for (int m = 0; m < 4; ++m)
#pragma unroll
                    for (int n = 0; n < 2; ++n) acc[a][b][m][n] = (f32x4){0.f, 0.f, 0.f, 0.f};
        cur = nxt; cA = nA; cB = nB; ++ui;
        if constexpr (ALIGN_EPI) { if (wr == 1) PG8_BAR; }
    }
    PG8_WAIT_V(0);
    if constexpr (!ALIGN_EPI) { if (wr == 0) PG8_BAR; }
    PG8_BAR;
    if constexpr (Epi::AFTER_DRAIN) { E.fused(acc, cur, wr, wc, fr, fq, lds, wid, lane); S.done(cur); }
#undef PG8_SA
#undef PG8_SB
#undef PG8_STAGE
#undef PG8_LDA
#undef PG8_LDB
#undef PG8_MMA
#undef PG8_WAIT_V
#undef PG8_WAIT_L
#undef PG8_BAR
#undef PG8_SCHED
}
}
#define XB_TMO      128
#define XB_XCNT(j)  (256  + 64 * (j))
#define XB_XSUB(j)  (1280 + 64 * (j))
#define XB_XGEN(j)  (2304 + 64 * (j))
#define XB_TOP      3328
#define XB_TOPGEN   3392
#define XCD_BAR_WORDS 3456
#define XB_SPIN_CAP (1u << 18)

__device__ __forceinline__ unsigned xb_ld(unsigned* p)              { return __hip_atomic_load(p, __ATOMIC_RELAXED, __HIP_MEMORY_SCOPE_AGENT); }
__device__ __forceinline__ unsigned xb_add(unsigned* p, unsigned v) { return __hip_atomic_fetch_add(p, v, __ATOMIC_RELAXED, __HIP_MEMORY_SCOPE_AGENT); }
__device__ __forceinline__ unsigned xb_xcc_id() { return (unsigned)__builtin_amdgcn_s_getreg((3 << 11) | 20) & 0xFu; }
#define XB_SPIN(cond, bar) do { unsigned _sp = 0; while (cond) { __builtin_amdgcn_s_sleep(1); \
    if ((++_sp & 255u) == 0u) { if (xb_ld(&(bar)[XB_TMO])) break; if (_sp > XB_SPIN_CAP) { atomicAdd(&(bar)[XB_TMO], 1u); break; } } } } while (0)

struct XcdBarrier {
    unsigned* bar; unsigned x;
    volatile LAS unsigned* st;
};

__device__ __forceinline__ XcdBarrier xcd_barrier_post(unsigned* bar, volatile LAS unsigned* st) {
    XcdBarrier b; b.bar = bar; b.x = xb_xcc_id(); b.st = st;
    if (threadIdx.x == 0) (void)xb_add(&bar[XB_XCNT(b.x)], 1u);
    return b;
}
__device__ __forceinline__ void xcd_barrier_complete(unsigned* bar, unsigned x, unsigned& nloc, unsigned& nx) {
    const unsigned G = gridDim.x * gridDim.y * gridDim.z;
    unsigned sum, cnt, mine, sp = 0u;
    for (;;) {
        sum = 0u; cnt = 0u; mine = 0u;
#pragma unroll
        for (unsigned j = 0; j < 16; ++j) { const unsigned c = xb_ld(&bar[XB_XCNT(j)]); sum += c; cnt += (c > 0u) ? 1u : 0u; mine = (j == x) ? c : mine; }
        if (sum == G) break;
        __builtin_amdgcn_s_sleep(1);
        if ((++sp & 255u) == 0u) { if (xb_ld(&bar[XB_TMO])) break; if (sp > XB_SPIN_CAP) { atomicAdd(&bar[XB_TMO], 1u); break; } }
    }
    nloc = mine > 0u ? mine : 1u; nx = cnt > 0u ? cnt : 1u;
}

__device__ __forceinline__ void xcd_barrier(const XcdBarrier& b) {
    asm volatile("s_waitcnt vmcnt(0)" ::: "memory");
    __syncthreads();
    if (threadIdx.x == 0) {
        unsigned* bar = b.bar;
        __builtin_amdgcn_s_waitcnt(0);
        unsigned nloc = b.st[0], nx = b.st[1];
        if (nloc == 0u) { xcd_barrier_complete(bar, b.x, nloc, nx); b.st[0] = nloc; b.st[1] = nx; }
        const unsigned old = xb_add(&bar[XB_XSUB(b.x)], 1u);
        const unsigned gen = old / nloc;
        if (old + 1u == (gen + 1u) * nloc) {
            __builtin_amdgcn_fence(__ATOMIC_RELEASE, "agent");
            asm volatile("s_waitcnt vmcnt(0)" ::: "memory");
            const unsigned og = xb_add(&bar[XB_TOP], 1u);
            const unsigned tg = og / nx;
            if (og + 1u == (tg + 1u) * nx) xb_add(&bar[XB_TOPGEN], 1u);
            else XB_SPIN(xb_ld(&bar[XB_TOPGEN]) == tg, bar);
            __builtin_amdgcn_fence(__ATOMIC_ACQUIRE, "agent");
            xb_add(&bar[XB_XGEN(b.x)], 1u);
            asm volatile("s_waitcnt vmcnt(0)" ::: "memory");
        } else {
            XB_SPIN(xb_ld(&bar[XB_XGEN(b.x)]) == gen, bar);
            __builtin_amdgcn_fence(__ATOMIC_ACQUIRE, "agent");
            asm volatile("s_waitcnt vmcnt(0)" ::: "memory");
        }
    }
    __syncthreads();
}
namespace mk {
typedef unsigned short bf16;
typedef unsigned v4u __attribute__((ext_vector_type(4)));
typedef unsigned v2u __attribute__((ext_vector_type(2)));
typedef float f32x4 __attribute__((ext_vector_type(4)));
typedef float f32x16 __attribute__((ext_vector_type(16)));
typedef short bf16x8 __attribute__((ext_vector_type(8)));
typedef short bf16x4 __attribute__((ext_vector_type(4)));

constexpr int T = 32768, D = 1024, SQ = 4096, NIN = 2816, NQ = 2048, PLE = 256, NEXP = 16384;
constexpr int NWAVES = 8, NTHR = 512;
constexpr int RING_BYTES = 131072, LDS_BYTES = 163840, MISC_OFF = LDS_BYTES - 256;

constexpr size_t MB = 1024 * 1024;
constexpr size_t WS_CTL = 0, CTL_BYTES = 256 * 1024;
constexpr size_t WS_WIN = WS_CTL + CTL_BYTES;
constexpr size_t WS_WOUT = WS_WIN + (size_t)NIN * D * 2;
constexpr size_t WS_WQ = WS_WOUT + (size_t)D * D * 2;
constexpr size_t WS_WG = WS_WQ + (size_t)NQ * D * 2;
constexpr size_t WS_WP = WS_WG + (size_t)D * D * 2;
constexpr size_t WS_KEYS = WS_WP + (size_t)D * PLE * 2;
constexpr size_t WS_ROPE = WS_KEYS + 2 * 128 * 128 * 2;
constexpr size_t WS_SU = WS_ROPE + 2 * (size_t)SQ * 32 * 4;
constexpr size_t WS_SV = WS_SU + 65536;
constexpr size_t WS_SH = WS_SV + 65536;
constexpr size_t WS_SHS = WS_SH + (size_t)T * 4;
constexpr size_t WS_UB = 16 * MB;
constexpr size_t WS_VB = 32 * MB;
constexpr size_t WS_PB = 48 * MB;
constexpr size_t WS_PK = 64 * MB;
constexpr size_t WS_R1 = 96 * MB;
constexpr size_t WS_R2 = 160 * MB;
constexpr size_t WS_PP = 352 * MB;
constexpr size_t WS_RSS2 = 80 * MB;
constexpr size_t WS_RSTD0 = 82 * MB;
constexpr size_t WS_XB0 = 416 * MB;
constexpr size_t WS_END = 480 * MB;
static_assert(WS_SHS + (size_t)T * 4 <= WS_UB, "ws map");
constexpr int CW_BAR = 1024;

#define LDS_WAIT() asm volatile("s_waitcnt lgkmcnt(0)" ::: "memory")
#define VM_WAIT() asm volatile("s_waitcnt vmcnt(0)" ::: "memory")
typedef float f32x2 __attribute__((ext_vector_type(2)));
typedef int v2i __attribute__((ext_vector_type(2)));
typedef __bf16 b16x2 __attribute__((ext_vector_type(2)));
__device__ __forceinline__ unsigned pk2(float lo, float hi) { const f32x2 v = {lo, hi}; return __builtin_bit_cast(unsigned, __builtin_convertvector(v, b16x2)); }
__device__ __forceinline__ float bf_lo(unsigned w) { return __uint_as_float(w << 16); }
__device__ __forceinline__ float bf_hi(unsigned w) { return __uint_as_float(w & 0xffff0000u); }
__device__ __forceinline__ float wave_sum(float v) {
#pragma unroll
    for (int o = 1; o < 64; o <<= 1) v += __shfl_xor(v, o);
    return v;
}

#ifndef PROBE_ON
#define PT_DECL
#define PT_ARG
#define PT_BEGIN()
#define PT_ADD(k)
#endif
struct Args { const float* in[16]; float* out; unsigned char* ws; int ph_lo, ph_hi, li, pad; };

struct EpiStoreBf16 {
    static constexpr bool PERM = true, AFTER_DRAIN = false;
    bf16* O; int ldc; const float* rowscale;
    __device__ __forceinline__ void operator()(const pg8::f32x4 (&acc)[2][2][4][2], const pg8::Unit& u, int wr, int wc, int fr, int fq) const {
        const int row0 = u.pm * 256 + wr * 64 + fr, col0 = u.pn * 256 + wc * 32 + 8 * fq;
#pragma unroll
        for (int ai = 0; ai < 2; ++ai)
#pragma unroll
            for (int m = 0; m < 4; ++m) { bf16* rowp = O + (size_t)(row0 + ai * 128 + m * 16) * ldc + col0; const float rsc = rowscale ? rowscale[row0 + ai * 128 + m * 16] : 1.0f;
#pragma unroll
                for (int bj = 0; bj < 2; ++bj) { const pg8::f32x4 v0 = acc[ai][bj][m][0] * rsc, v1 = acc[ai][bj][m][1] * rsc;
                    pg8::u32x4 w; w.x = pk2(v0[0], v0[1]); w.y = pk2(v0[2], v0[3]); w.z = pk2(v1[0], v1[1]); w.w = pk2(v1[2], v1[3]);
                    *(pg8::u32x4*)(rowp + bj * 128) = w; } }
    }
};


struct EpiResid {
    static constexpr bool PERM = true, AFTER_DRAIN = false;
    const bf16* X; bf16* XB;
    __device__ __forceinline__ void operator()(const pg8::f32x4 (&acc)[2][2][4][2], const pg8::Unit& u, int wr, int wc, int fr, int fq) const {
        const int row0 = u.pm * 256 + wr * 64 + fr, col0 = u.pn * 256 + wc * 32 + 8 * fq;
#pragma unroll
        for (int ai = 0; ai < 2; ++ai)
#pragma unroll
            for (int m = 0; m < 4; ++m) { const size_t off = (size_t)(row0 + ai * 128 + m * 16) * D + col0;
#pragma unroll
                for (int bj = 0; bj < 2; ++bj) { const size_t o2 = off + bj * 128;
                    const pg8::u32x4 xw = *(const pg8::u32x4*)(X + o2);
                    const pg8::f32x4 v0 = acc[ai][bj][m][0] + (pg8::f32x4){bf_lo(xw.x), bf_hi(xw.x), bf_lo(xw.y), bf_hi(xw.y)}, v1 = acc[ai][bj][m][1] + (pg8::f32x4){bf_lo(xw.z), bf_hi(xw.z), bf_lo(xw.w), bf_hi(xw.w)};
                    pg8::u32x4 w; w.x = pk2(v0[0], v0[1]); w.y = pk2(v0[2], v0[3]); w.z = pk2(v1[0], v1[1]); w.w = pk2(v1[2], v1[3]);
                    *(pg8::u32x4*)(XB + o2) = w; } }
    }
};
struct EpiGate {
    static constexpr bool PERM = true, AFTER_DRAIN = false;
    float* O; const bf16* XB; const bf16* PP; const float* rss;
    __device__ __forceinline__ void operator()(const pg8::f32x4 (&acc)[2][2][4][2], const pg8::Unit& u, int wr, int wc, int fr, int fq) const {
        const int row0 = u.pm * 256 + wr * 64 + fr, col0 = u.pn * 256 + wc * 32 + 8 * fq;
#pragma unroll
        for (int ai = 0; ai < 2; ++ai)
#pragma unroll
            for (int m = 0; m < 4; ++m) { const int row = row0 + ai * 128 + m * 16; const size_t off = (size_t)row * D + col0;
                const pg8::f32x4 q0 = *(const pg8::f32x4*)(rss + (size_t)row * 8), q1 = *(const pg8::f32x4*)(rss + (size_t)row * 8 + 4);
                const float rs = 1.0f / sqrtf((((q0[0] + q0[1]) + (q0[2] + q0[3])) + ((q1[0] + q1[1]) + (q1[2] + q1[3]))) * (1.0f / D) + 1e-6f);
#pragma unroll
                for (int bj = 0; bj < 2; ++bj) { const size_t o2 = off + bj * 128;
                    const pg8::u32x4 pw = *(const pg8::u32x4*)(PP + o2), xw = *(const pg8::u32x4*)(XB + o2);
                    const pg8::f32x4 a0 = acc[ai][bj][m][0] * rs, a1 = acc[ai][bj][m][1] * rs;
                    pg8::f32x4 x0, x1;
                    x0[0] = bf_lo(xw.x) + bf_lo(pw.x) * __builtin_amdgcn_rcpf(1.0f + __expf(-a0[0])); x0[1] = bf_hi(xw.x) + bf_hi(pw.x) * __builtin_amdgcn_rcpf(1.0f + __expf(-a0[1])); x0[2] = bf_lo(xw.y) + bf_lo(pw.y) * __builtin_amdgcn_rcpf(1.0f + __expf(-a0[2])); x0[3] = bf_hi(xw.y) + bf_hi(pw.y) * __builtin_amdgcn_rcpf(1.0f + __expf(-a0[3]));
                    x1[0] = bf_lo(xw.z) + bf_lo(pw.z) * __builtin_amdgcn_rcpf(1.0f + __expf(-a1[0])); x1[1] = bf_hi(xw.z) + bf_hi(pw.z) * __builtin_amdgcn_rcpf(1.0f + __expf(-a1[1])); x1[2] = bf_lo(xw.w) + bf_lo(pw.w) * __builtin_amdgcn_rcpf(1.0f + __expf(-a1[2])); x1[3] = bf_hi(xw.w) + bf_hi(pw.w) * __builtin_amdgcn_rcpf(1.0f + __expf(-a1[3]));
                    *(pg8::f32x4*)(O + o2) = x0; *(pg8::f32x4*)(O + o2 + 4) = x1; } }
    }
};

__device__ __forceinline__ void p0_transpose_item(const float* __restrict__ W, const float* __restrict__ gsc, int K, int N, bf16* __restrict__ WT, LAS float* scr, int item, int lane) {
    const int nblk = N / 32, kb = item / nblk, nb = item % nblk, k0 = 64 * kb, n0 = 32 * nb;
    float wv[32];
#pragma unroll
    for (int i = 0; i < 32; ++i) { const int kk = 2 * i + (lane >> 5); wv[i] = __builtin_nontemporal_load(W + (size_t)(k0 + kk) * N + n0 + (lane & 31)); }
    if (gsc) {
#pragma unroll
        for (int i = 0; i < 32; ++i) wv[i] *= gsc[k0 + 2 * i + (lane >> 5)];
    }
#pragma unroll
    for (int i = 0; i < 32; ++i) scr[(2 * i + (lane >> 5)) * 33 + (lane & 31)] = wv[i];
    LDS_WAIT(); asm volatile("" ::: "memory");
    const int c = lane & 7;
#pragma unroll
    for (int j = 0; j < 4; ++j) { const int n = (lane >> 3) + 8 * j; const LAS float* s = scr + (8 * c) * 33 + n;
        v4u o; o.x = pk2(s[0 * 33], s[1 * 33]); o.y = pk2(s[2 * 33], s[3 * 33]); o.z = pk2(s[4 * 33], s[5 * 33]); o.w = pk2(s[6 * 33], s[7 * 33]);
        *(v4u*)(WT + (size_t)(n0 + n) * K + k0 + 8 * c) = o; }
    LDS_WAIT(); asm volatile("" ::: "memory");
}
__device__ __forceinline__ void p0_convert(const float* __restrict__ src, bf16* __restrict__ dst, size_t n8, size_t gtid, size_t gthreads) {
    size_t i = gtid;
    for (; i + 3 * gthreads < n8; i += 4 * gthreads) {
        f32x4 a[4], b[4];
#pragma unroll
        for (int r = 0; r < 4; ++r) { a[r] = __builtin_nontemporal_load((const f32x4*)src + 2 * (i + r * gthreads)); b[r] = __builtin_nontemporal_load((const f32x4*)src + 2 * (i + r * gthreads) + 1); }
#pragma unroll
        for (int r = 0; r < 4; ++r) { v4u o; o.x = pk2(a[r][0], a[r][1]); o.y = pk2(a[r][2], a[r][3]); o.z = pk2(b[r][0], b[r][1]); o.w = pk2(b[r][2], b[r][3]); __builtin_nontemporal_store(o, (v4u*)dst + i + r * gthreads); }
    }
    for (; i < n8; i += gthreads) {
        const f32x4 a = ((const f32x4*)src)[2 * i], b = ((const f32x4*)src)[2 * i + 1];
        v4u o; o.x = pk2(a[0], a[1]); o.y = pk2(a[2], a[3]); o.z = pk2(b[0], b[1]); o.w = pk2(b[2], b[3]);
        ((v4u*)dst)[i] = o;
    }
}
__device__ __forceinline__ void rms_row_to_bf16(const float* __restrict__ xrow, const float* __restrict__ g, bf16* __restrict__ orow, int lane) {
    const f32x4* xr = (const f32x4*)xrow + lane; const f32x4* gr = (const f32x4*)g + lane;
    f32x4 v[4]; float s = 0.f;
#pragma unroll
    for (int j = 0; j < 4; ++j) { v[j] = xr[64 * j]; s += (v[j][0] * v[j][0] + v[j][1] * v[j][1]) + (v[j][2] * v[j][2] + v[j][3] * v[j][3]); }
    const float rstd = 1.0f / sqrtf(wave_sum(s) * (1.0f / D) + 1e-6f);
    v2u* o8 = (v2u*)orow + lane;
#pragma unroll
    for (int j = 0; j < 4; ++j) { const f32x4 gg = gr[64 * j]; v2u w; w.x = pk2(v[j][0] * rstd * gg[0], v[j][1] * rstd * gg[1]); w.y = pk2(v[j][2] * rstd * gg[2], v[j][3] * rstd * gg[3]); o8[64 * j] = w; }
}

__device__ __forceinline__ void quant_rows(const Args& a, int r0, int rstride, int cnt, int lane) {
    unsigned char* ws = a.ws;
    f32x4 xs[4][4];
#pragma unroll
    for (int rr = 0; rr < 4; ++rr) {
        const int r = r0 + rr * rstride; const bool ok = rr < cnt && r < 2 * NEXP; const int rc = ok ? r : 0; const int isv = rc >= NEXP, e = isv ? rc - NEXP : rc;
        const f32x4* src = (const f32x4*)((isv ? a.in[12] : a.in[11]) + (size_t)e * D) + lane;
#pragma unroll
        for (int j = 0; j < 4; ++j) xs[rr][j] = __builtin_nontemporal_load(src + 64 * j);
    }
#pragma unroll
    for (int rr = 0; rr < 4; ++rr) {
        const int r = r0 + rr * rstride; const bool ok = rr < cnt && r < 2 * NEXP; const int rc = ok ? r : 0; const int isv = rc >= NEXP, e = isv ? rc - NEXP : rc;
        float am = 0.f, sq = 0.f;
#pragma unroll
        for (int j = 0; j < 4; ++j)
#pragma unroll
            for (int u = 0; u < 4; ++u) { am = fmaxf(am, fabsf(xs[rr][j][u])); sq += xs[rr][j][u] * xs[rr][j][u]; }
#pragma unroll
        for (int o = 1; o < 64; o <<= 1) { am = fmaxf(am, __shfl_xor(am, o)); sq += __shfl_xor(sq, o); }
        if (ok && isv) {
            const float step = fminf(0.355f * sqrtf(sq * (1.0f / D)), am * (1.0f / 7.0f));
            const float inv = step > 0.f ? 1.0f / step : 0.f;
#pragma unroll
            for (int j = 0; j < 4; ++j) { unsigned ww = 0u;
#pragma unroll
                for (int u = 0; u < 4; ++u) { int t = __float2int_rn(xs[rr][j][u] * inv); t = t < -7 ? -7 : t > 7 ? 7 : t; ww |= ((unsigned)t & 0xfu) << (4 * u); }
                __builtin_nontemporal_store((unsigned short)ww, (unsigned short*)(ws + WS_VB + (size_t)j * ((size_t)NEXP * 128) + (size_t)e * 128 + 2 * lane)); }
            if (lane == 0) ((float*)(ws + WS_SV))[e] = step;
        } else if (ok) {
            const float step = fminf(0.3352f * sqrtf(sq * (1.0f / D)), am * (1.0f / 7.5f));
            const float inv = step > 0.f ? 1.0f / step : 0.f;
#pragma unroll
            for (int j = 0; j < 4; ++j) { unsigned ww = 0u;
#pragma unroll
                for (int u = 0; u < 4; ++u) { int t = (int)floorf(xs[rr][j][u] * inv); t = t < -8 ? -8 : t > 7 ? 7 : t; ww |= ((unsigned)t & 0xfu) << (4 * u); }
                __builtin_nontemporal_store((unsigned short)ww, (unsigned short*)(ws + WS_UB + (size_t)e * 512 + 2 * lane + 128 * j)); }
            if (lane == 0) ((float*)(ws + WS_SU))[e] = step;
        }
    }
}
__device__ __forceinline__ void xcd_barrier_work(const XcdBarrier& b, const Args& a, LAS unsigned char* lds, int k, int vcu, int G, int wave, int lane) {
    asm volatile("s_waitcnt vmcnt(0)" ::: "memory");
    __syncthreads();
    if (wave == 0) {
      if (threadIdx.x == 0) {
        unsigned* bar = b.bar;
        __builtin_amdgcn_s_waitcnt(0);
        unsigned nloc = b.st[0], nx = b.st[1];
        if (nloc == 0u) { xcd_barrier_complete(bar, b.x, nloc, nx); b.st[0] = nloc; b.st[1] = nx; }
        const unsigned old = xb_add(&bar[XB_XSUB(b.x)], 1u);
        const unsigned gen = old / nloc;
        if (old + 1u == (gen + 1u) * nloc) {
            __builtin_amdgcn_fence(__ATOMIC_RELEASE, "agent");
            asm volatile("s_waitcnt vmcnt(0)" ::: "memory");
            const unsigned og = xb_add(&bar[XB_TOP], 1u);
            const unsigned tg = og / nx;
            if (og + 1u == (tg + 1u) * nx) xb_add(&bar[XB_TOPGEN], 1u);
            else XB_SPIN(xb_ld(&bar[XB_TOPGEN]) == tg, bar);
            __builtin_amdgcn_fence(__ATOMIC_ACQUIRE, "agent");
            xb_add(&bar[XB_XGEN(b.x)], 1u);
            asm volatile("s_waitcnt vmcnt(0)" ::: "memory");
        } else {
            XB_SPIN(xb_ld(&bar[XB_XGEN(b.x)]) == gen, bar);
            __builtin_amdgcn_fence(__ATOMIC_ACQUIRE, "agent");
            asm volatile("s_waitcnt vmcnt(0)" ::: "memory");
        }
      }
    } else {
        const int NW = G * (NWAVES - 1), gww = vcu * (NWAVES - 1) + (wave - 1);
        if (k == 1) {
            constexpr int I_OUT = (D / 64) * (D / 32), I_Q = (D / 64) * (NQ / 32), I_G = I_OUT;
            LAS float* scr = (LAS float*)(lds + wave * 16384);
            for (int it = gww; it < I_OUT + I_Q + I_G; it += NW) {
                int r = it;
                if (r < I_OUT) { p0_transpose_item(a.in[7], nullptr, D, D, (bf16*)(a.ws + WS_WOUT), scr, r, lane); continue; } r -= I_OUT;
                if (r < I_Q) { p0_transpose_item(a.in[9], a.in[8], D, NQ, (bf16*)(a.ws + WS_WQ), scr, r, lane); continue; } r -= I_Q;
                p0_transpose_item(a.in[14], a.in[13], D, D, (bf16*)(a.ws + WS_WG), scr, r, lane);
            }
        }
        { const int cnt = (k < 3) ? 5 : (k == 3) ? 4 : 0, before = 5 * (k < 3 ? k : 3);
          if (cnt > 0) { quant_rows(a, before * NW + gww, NW, 4, lane); if (cnt > 4) quant_rows(a, (before + 4) * NW + gww, NW, 1, lane); } }
    }
    __syncthreads();
}

__device__ __forceinline__ void p0_prologue(const Args& a, LAS unsigned char* lds, int vcu, int G, int tid, int lane, int wave) {
    unsigned char* ws = a.ws;
    LAS float* scr = (LAS float*)(lds + wave * 16384);
    const int gw = vcu * NWAVES + wave, NGW = G * NWAVES;
    constexpr int I_IN = (D / 64) * (NIN / 32), I_P = (PLE / 64) * (D / 32);
    constexpr int NITEMS = I_IN + I_P;
    for (int it = gw; it < NITEMS; it += NGW) {
        int r = it;
        if (r < I_IN) { p0_transpose_item(a.in[3], a.in[2], D, NIN, (bf16*)(ws + WS_WIN), scr, r, lane); continue; } r -= I_IN;
        p0_transpose_item(a.in[15], nullptr, PLE, D, (bf16*)(ws + WS_WP), scr, r, lane);
    }
    const size_t gtid = (size_t)vcu * NTHR + tid, gthreads = (size_t)G * NTHR;
    p0_convert(a.in[10], (bf16*)(ws + WS_KEYS), 2 * 128 * 128 / 8, gtid, gthreads);
    p0_convert(a.in[1], (bf16*)(ws + WS_PB), (size_t)T * PLE / 8, gtid, gthreads);
    for (size_t i = gtid; i < (size_t)SQ * 32; i += gthreads) {
        const int pos = (int)(i >> 5), c = (int)(i & 31);
        const float freq = powf(10000.0f, -(float)c / 32.0f);
        const float ang = (float)pos * freq;
        float sn, cs; sincosf(ang, &sn, &cs);
        ((float*)(ws + WS_ROPE))[i] = cs; ((float*)(ws + WS_ROPE))[(size_t)SQ * 32 + i] = sn;
    }
    for (int m0 = gw; m0 < T; m0 += 4 * NGW) {
        f32x4 v[4][4]; float ssq[4];
#pragma unroll
        for (int rr = 0; rr < 4; ++rr) { const f32x4* xr = (const f32x4*)(a.in[0] + (size_t)(m0 + rr * NGW) * D) + lane;
#pragma unroll
            for (int j = 0; j < 4; ++j) v[rr][j] = __builtin_nontemporal_load(xr + 64 * j); }
#pragma unroll
        for (int rr = 0; rr < 4; ++rr) { float sq = 0.f;
#pragma unroll
            for (int j = 0; j < 4; ++j) sq += (v[rr][j][0] * v[rr][j][0] + v[rr][j][1] * v[rr][j][1]) + (v[rr][j][2] * v[rr][j][2] + v[rr][j][3] * v[rr][j][3]);
            ssq[rr] = sq; }
#pragma unroll
        for (int o = 1; o < 64; o <<= 1)
#pragma unroll
            for (int rr = 0; rr < 4; ++rr) ssq[rr] += __shfl_xor(ssq[rr], o);
#pragma unroll
        for (int rr = 0; rr < 4; ++rr) { const float rstd = 1.0f / sqrtf(ssq[rr] * (1.0f / D) + 1e-6f); v2u* o8 = (v2u*)((bf16*)(ws + WS_XB0) + (size_t)(m0 + rr * NGW) * D) + lane;
            if (lane == 0) ((float*)(ws + WS_RSTD0))[m0 + rr * NGW] = rstd;
#pragma unroll
            for (int j = 0; j < 4; ++j) { v2u w; w.x = pk2(v[rr][j][0], v[rr][j][1]); w.y = pk2(v[rr][j][2], v[rr][j][3]); o8[64 * j] = w; } }
    }
}


#define MFMA32(a, b, c) __builtin_amdgcn_mfma_f32_32x32x16_bf16((a), (b), (c), 0, 0, 0)
__device__ __forceinline__ int crow(int r, int hf) { return (r & 3) + 8 * (r >> 2) + 4 * hf; }
__device__ __forceinline__ bf16x8 pack8(float a0, float a1, float a2, float a3, float a4, float a5, float a6, float a7) {
    v4u w; w.x = pk2(a0, a1); w.y = pk2(a2, a3); w.z = pk2(a4, a5); w.w = pk2(a6, a7); return __builtin_bit_cast(bf16x8, w);
}
__device__ __forceinline__ bf16x8 lds_frag16(LAS unsigned char* p) { return *(const LAS bf16x8*)p; }
__device__ __forceinline__ bf16x8 lds_frag8x2(LAS unsigned char* p) {
    const bf16x4 lo = *(const LAS bf16x4*)p, hi = *(const LAS bf16x4*)(p + 16); return __builtin_shufflevector(lo, hi, 0, 1, 2, 3, 4, 5, 6, 7);
}
typedef short s16x4 __attribute__((ext_vector_type(4)));
__device__ __forceinline__ s16x4 lds_tr4(LAS unsigned char* tile, int r0, int c0, int lane) {
    const int i = lane & 15;
    return __builtin_amdgcn_ds_read_tr16_b64_v4i16((LAS s16x4*)(tile + (r0 + (i >> 2)) * 144 + (c0 + 16 * ((lane >> 4) & 1) + 4 * (i & 3)) * 2));
}
__device__ __forceinline__ bf16x8 cat8(s16x4 lo, s16x4 hi) { return __builtin_shufflevector(lo, hi, 0, 1, 2, 3, 4, 5, 6, 7); }
constexpr int RQ = 144;
constexpr int LR_QS = 0, LR_KS = LR_QS + 128 * RQ, LR_VS = LR_KS + 128 * RQ, LR_ST = LR_VS + 128 * RQ, LR_LN = LR_ST + 64 * RQ, LR_V1 = LR_LN + 2 * 128 * 8, LR_END = LR_V1 + 128 * RQ;
static_assert(LR_END <= RING_BYTES, "retention LDS");
__device__ __forceinline__ void ret_unit(const bf16* __restrict__ PROJ, bf16* __restrict__ MIXED, const float* __restrict__ rope, LAS unsigned char* lds,
                                         int b, int h, int c0, int c1, int tid, int lane, int wave) {
    const float gam = 1.0f - exp2f(-5.0f - (float)h), lg2 = log2f(gam), cd = exp2f(lg2 * 128.0f);
    const int l31 = lane & 31, hf = lane >> 5, ib = wave >> 1, et = wave & 1;
    const int r = tid >> 2, qd = tid & 3;
    const float wq = exp2f(lg2 * (float)(r + 1)), wk = exp2f(-lg2 * (float)(r + 1));
    f32x16 stacc;
#pragma unroll
    for (int i = 0; i < 16; ++i) stacc[i] = 0.f;
    for (int i = tid; i < 64 * RQ / 4; i += NTHR) ((LAS unsigned*)(lds + LR_ST))[i] = 0u;
    v4u k1, k2, v1, v2, q1 = {0u, 0u, 0u, 0u}, q2 = {0u, 0u, 0u, 0u}; f32x4 csa, csb, sna, snb; v2u gvn[4] = {{0u, 0u}, {0u, 0u}, {0u, 0u}, {0u, 0u}};
#define RET_LOAD(nn) do { const int sp_ = (nn) * 128 + r; const bf16* pr_ = PROJ + ((size_t)b * SQ + sp_) * NIN + h * 64 + 8 * qd; \
        k1 = *(const v4u*)(pr_ + 512); k2 = *(const v4u*)(pr_ + 512 + 32); v1 = *(const v4u*)(pr_ + 1024); v2 = *(const v4u*)(pr_ + 1024 + 32); \
        if ((nn) >= c0) { q1 = *(const v4u*)(pr_); q2 = *(const v4u*)(pr_ + 32); \
            const bf16* gp_ = PROJ + ((size_t)b * SQ + (nn) * 128 + 32 * ib + l31) * NIN + 1536 + h * 64 + 32 * et + 4 * hf; \
            gvn[0] = *(const v2u*)gp_; gvn[1] = *(const v2u*)(gp_ + 8); gvn[2] = *(const v2u*)(gp_ + 16); gvn[3] = *(const v2u*)(gp_ + 24); } \
        csa = *(const f32x4*)(rope + sp_ * 32 + 8 * qd); csb = *(const f32x4*)(rope + sp_ * 32 + 8 * qd + 4); \
        sna = *(const f32x4*)(rope + SQ * 32 + sp_ * 32 + 8 * qd); snb = *(const f32x4*)(rope + SQ * 32 + sp_ * 32 + 8 * qd + 4); } while (0)
    int nstart = 0;
    if (c0 >= 2) {
        v4u kr[4][4];
        float rc[8], rs[8], dc[8], dsn[8];
        { const f32x4 c0v = *(const f32x4*)(rope + r * 32 + 8 * qd), c1v = *(const f32x4*)(rope + r * 32 + 8 * qd + 4), s0v = *(const f32x4*)(rope + SQ * 32 + r * 32 + 8 * qd), s1v = *(const f32x4*)(rope + SQ * 32 + r * 32 + 8 * qd + 4);
          const f32x4 d0v = *(const f32x4*)(rope + 128 * 32 + 8 * qd), d1v = *(const f32x4*)(rope + 128 * 32 + 8 * qd + 4), e0v = *(const f32x4*)(rope + SQ * 32 + 128 * 32 + 8 * qd), e1v = *(const f32x4*)(rope + SQ * 32 + 128 * 32 + 8 * qd + 4);
#pragma unroll
          for (int u = 0; u < 4; ++u) { rc[u] = c0v[u]; rc[4 + u] = c1v[u]; rs[u] = s0v[u]; rs[4 + u] = s1v[u]; dc[u] = d0v[u]; dc[4 + u] = d1v[u]; dsn[u] = e0v[u]; dsn[4 + u] = e1v[u]; } }
#define PRE_LOAD(slot, nn) do { const bf16* pr_ = PROJ + ((size_t)b * SQ + (nn) * 128 + r) * NIN + h * 64 + 8 * qd; \
        kr[slot][0] = *(const v4u*)(pr_ + 512); kr[slot][1] = *(const v4u*)(pr_ + 512 + 32); kr[slot][2] = *(const v4u*)(pr_ + 1024); kr[slot][3] = *(const v4u*)(pr_ + 1024 + 32); } while (0)
#define PRE_STAGE(slot, KT_, VT_) do { float o1_[8], o2_[8]; \
        _Pragma("unroll") for (int u = 0; u < 8; ++u) { const unsigned w1_ = kr[slot][0][u >> 1], w2_ = kr[slot][1][u >> 1]; const float x1_ = (u & 1) ? bf_hi(w1_) : bf_lo(w1_), x2_ = (u & 1) ? bf_hi(w2_) : bf_lo(w2_); \
            o1_[u] = (x1_ * rc[u] - x2_ * rs[u]) * wk; o2_[u] = (x1_ * rs[u] + x2_ * rc[u]) * wk; \
            const float nc_ = rc[u] * dc[u] - rs[u] * dsn[u], ns_ = rs[u] * dc[u] + rc[u] * dsn[u]; rc[u] = nc_; rs[u] = ns_; } \
        *(LAS bf16x8*)(lds + (KT_) + r * RQ + (8 * qd) * 2) = pack8(o1_[0], o1_[1], o1_[2], o1_[3], o1_[4], o1_[5], o1_[6], o1_[7]); \
        *(LAS bf16x8*)(lds + (KT_) + r * RQ + (32 + 8 * qd) * 2) = pack8(o2_[0], o2_[1], o2_[2], o2_[3], o2_[4], o2_[5], o2_[6], o2_[7]); \
        *(LAS v4u*)(lds + (VT_) + r * RQ + (8 * qd) * 2) = kr[slot][2]; *(LAS v4u*)(lds + (VT_) + r * RQ + (32 + 8 * qd) * 2) = kr[slot][3]; } while (0)
        const int npair = c0 >> 1;
        PRE_LOAD(0, 0); PRE_LOAD(1, 1);
        if (npair > 1) { PRE_LOAD(2, 2); PRE_LOAD(3, 3); }
#define PRE_STEP(S0, S1, NS0, NS1, pp) do { \
            __syncthreads(); \
            PRE_STAGE(S0, LR_KS, LR_VS); PRE_STAGE(S1, LR_QS, LR_V1); \
            if ((pp) + 2 < npair) { PRE_LOAD(NS0, 2 * ((pp) + 2)); PRE_LOAD(NS1, 2 * ((pp) + 2) + 1); } \
            __syncthreads(); \
            if (wave < 4) { const int se = wave >> 1, sd = wave & 1; f32x16 t0, t1; \
                _Pragma("unroll") for (int i = 0; i < 16; ++i) { t0[i] = 0.f; t1[i] = 0.f; } \
                _Pragma("unroll") for (int ks = 0; ks < 8; ++ks) { \
                    t0 = MFMA32(cat8(lds_tr4(lds + LR_VS, 16 * ks + 8 * hf, 32 * se, lane), lds_tr4(lds + LR_VS, 16 * ks + 8 * hf + 4, 32 * se, lane)), \
                                cat8(lds_tr4(lds + LR_KS, 16 * ks + 8 * hf, 32 * sd, lane), lds_tr4(lds + LR_KS, 16 * ks + 8 * hf + 4, 32 * sd, lane)), t0); \
                    t1 = MFMA32(cat8(lds_tr4(lds + LR_V1, 16 * ks + 8 * hf, 32 * se, lane), lds_tr4(lds + LR_V1, 16 * ks + 8 * hf + 4, 32 * se, lane)), \
                                cat8(lds_tr4(lds + LR_QS, 16 * ks + 8 * hf, 32 * sd, lane), lds_tr4(lds + LR_QS, 16 * ks + 8 * hf + 4, 32 * sd, lane)), t1); } \
                _Pragma("unroll") for (int i = 0; i < 16; ++i) stacc[i] = cd * (cd * (stacc[i] + 0.125f * t0[i]) + 0.125f * t1[i]); } } while (0)
        int pp = 0;
#pragma unroll 1
        for (; pp + 1 < npair; pp += 2) { PRE_STEP(0, 1, 0, 1, pp); PRE_STEP(2, 3, 2, 3, pp + 1); }
        if (pp < npair) { PRE_STEP(0, 1, 0, 1, pp); ++pp; }
        nstart = 2 * npair;
        __syncthreads();
        if (wave < 4) {
            const int se = wave >> 1, sd = wave & 1;
#pragma unroll
            for (int i = 0; i < 16; i += 2) { const unsigned w = pk2(stacc[i], stacc[i + 1]);
                *(LAS bf16*)(lds + LR_ST + (32 * se + crow(i, hf)) * RQ + (32 * sd + l31) * 2) = (bf16)(w & 0xffffu);
                *(LAS bf16*)(lds + LR_ST + (32 * se + crow(i + 1, hf)) * RQ + (32 * sd + l31) * 2) = (bf16)(w >> 16); }
        }
#undef PRE_LOAD
#undef PRE_STAGE
#undef PRE_STEP
    }
    RET_LOAD(nstart);
    for (int n = nstart; n < c1; ++n) {
        const bool own = n >= c0;
        float cs[8], sn[8];
#pragma unroll
        for (int u = 0; u < 4; ++u) { cs[u] = csa[u]; cs[4 + u] = csb[u]; sn[u] = sna[u]; sn[4 + u] = snb[u]; }
        v2u gv[4];
#pragma unroll
        for (int g = 0; g < 4; ++g) gv[g] = gvn[g];
        __syncthreads();
        {
            float o1[8], o2[8];
#pragma unroll
            for (int u = 0; u < 8; ++u) { const unsigned w1 = k1[u >> 1], w2 = k2[u >> 1]; const float x1 = (u & 1) ? bf_hi(w1) : bf_lo(w1), x2 = (u & 1) ? bf_hi(w2) : bf_lo(w2);
                o1[u] = (x1 * cs[u] - x2 * sn[u]) * wk; o2[u] = (x1 * sn[u] + x2 * cs[u]) * wk; }
            *(LAS bf16x8*)(lds + LR_KS + r * RQ + (8 * qd) * 2) = pack8(o1[0], o1[1], o1[2], o1[3], o1[4], o1[5], o1[6], o1[7]);
            *(LAS bf16x8*)(lds + LR_KS + r * RQ + (32 + 8 * qd) * 2) = pack8(o2[0], o2[1], o2[2], o2[3], o2[4], o2[5], o2[6], o2[7]);
            *(LAS v4u*)(lds + LR_VS + r * RQ + (8 * qd) * 2) = v1; *(LAS v4u*)(lds + LR_VS + r * RQ + (32 + 8 * qd) * 2) = v2;
            if (own) {
#pragma unroll
                for (int u = 0; u < 8; ++u) { const unsigned w1 = q1[u >> 1], w2 = q2[u >> 1]; const float x1 = (u & 1) ? bf_hi(w1) : bf_lo(w1), x2 = (u & 1) ? bf_hi(w2) : bf_lo(w2);
                    o1[u] = (x1 * cs[u] - x2 * sn[u]) * wq; o2[u] = (x1 * sn[u] + x2 * cs[u]) * wq; }
                *(LAS bf16x8*)(lds + LR_QS + r * RQ + (8 * qd) * 2) = pack8(o1[0], o1[1], o1[2], o1[3], o1[4], o1[5], o1[6], o1[7]);
                *(LAS bf16x8*)(lds + LR_QS + r * RQ + (32 + 8 * qd) * 2) = pack8(o2[0], o2[1], o2[2], o2[3], o2[4], o2[5], o2[6], o2[7]);
            }
        }
        if (n + 1 < c1) RET_LOAD(n + 1);
        __syncthreads();
        if (own) {
            const size_t orow = (size_t)b * SQ + n * 128 + 32 * ib + l31;
            bf16x8 qf[4];
#pragma unroll
            for (int ks = 0; ks < 4; ++ks) qf[ks] = lds_frag16(lds + LR_QS + (32 * ib + l31) * RQ + (16 * ks + 8 * hf) * 2);
            f32x16 o;
#pragma unroll
            for (int i = 0; i < 16; ++i) o[i] = 0.f;
#pragma unroll
            for (int ks = 0; ks < 4; ++ks) o = MFMA32(lds_frag16(lds + LR_ST + (32 * et + l31) * RQ + (16 * ks + 8 * hf) * 2), qf[ks], o);
            for (int jb = 0; jb <= ib; ++jb) {
                f32x16 s;
#pragma unroll
                for (int i = 0; i < 16; ++i) s[i] = 0.f;
#pragma unroll
                for (int ks = 0; ks < 4; ++ks) s = MFMA32(lds_frag16(lds + LR_KS + (32 * jb + l31) * RQ + (16 * ks + 8 * hf) * 2), qf[ks], s);
                const bool diag = (jb == ib);
                float p[16];
#pragma unroll
                for (int i = 0; i < 16; ++i) p[i] = (diag && crow(i, hf) > l31) ? 0.f : s[i] * 0.125f;
#pragma unroll
                for (int st = 0; st < 2; ++st) {
                    const bf16x8 pf = pack8(p[8 * st], p[8 * st + 1], p[8 * st + 2], p[8 * st + 3], p[8 * st + 4], p[8 * st + 5], p[8 * st + 6], p[8 * st + 7]);
                    o = MFMA32(cat8(lds_tr4(lds + LR_VS, 32 * jb + 16 * st + 4 * hf, 32 * et, lane), lds_tr4(lds + LR_VS, 32 * jb + 16 * st + 8 + 4 * hf, 32 * et, lane)), pf, o);
                }
            }
            float s1 = 0.f, s2 = 0.f;
#pragma unroll
            for (int i = 0; i < 16; ++i) { s1 += o[i]; s2 += o[i] * o[i]; }
            s1 += __shfl_xor(s1, 32); s2 += __shfl_xor(s2, 32);
            if (hf == 0) *(LAS f32x2*)(lds + LR_LN + (et * 128 + 32 * ib + l31) * 8) = (f32x2){s1, s2};
            __syncthreads();
            const f32x2 ot = *(const LAS f32x2*)(lds + LR_LN + ((et ^ 1) * 128 + 32 * ib + l31) * 8);
            const float mu = (s1 + ot.x) * (1.0f / 64.0f), var = fmaxf((s2 + ot.y) * (1.0f / 64.0f) - mu * mu, 0.f), rs = 1.0f / sqrtf(var + 1e-6f);
#pragma unroll
            for (int g = 0; g < 4; ++g) {
                float y[4];
#pragma unroll
                for (int u = 0; u < 4; ++u) { const unsigned w = gv[g][u >> 1]; const float gg = (u & 1) ? bf_hi(w) : bf_lo(w); const float sg = gg * __builtin_amdgcn_rcpf(1.0f + __expf(-gg)); y[u] = sg * ((o[4 * g + u] - mu) * rs); }
                v2u w; w.x = pk2(y[0], y[1]); w.y = pk2(y[2], y[3]);
                *(v2u*)(MIXED + orow * D + h * 64 + 32 * et + 8 * g + 4 * hf) = w;
            }
        }
        if (wave < 4) {
            const int se = wave >> 1, sd = wave & 1;
            f32x16 tmp;
#pragma unroll
            for (int i = 0; i < 16; ++i) tmp[i] = 0.f;
#pragma unroll
            for (int ks = 0; ks < 8; ++ks)
                tmp = MFMA32(cat8(lds_tr4(lds + LR_VS, 16 * ks + 8 * hf, 32 * se, lane), lds_tr4(lds + LR_VS, 16 * ks + 8 * hf + 4, 32 * se, lane)),
                             cat8(lds_tr4(lds + LR_KS, 16 * ks + 8 * hf, 32 * sd, lane), lds_tr4(lds + LR_KS, 16 * ks + 8 * hf + 4, 32 * sd, lane)), tmp);
#pragma unroll
            for (int i = 0; i < 16; ++i) stacc[i] = cd * (stacc[i] + 0.125f * tmp[i]);
#pragma unroll
            for (int i = 0; i < 16; i += 2) { const unsigned w = pk2(stacc[i], stacc[i + 1]);
                *(LAS bf16*)(lds + LR_ST + (32 * se + crow(i, hf)) * RQ + (32 * sd + l31) * 2) = (bf16)(w & 0xffffu);
                *(LAS bf16*)(lds + LR_ST + (32 * se + crow(i + 1, hf)) * RQ + (32 * sd + l31) * 2) = (bf16)(w >> 16); }
        }
    }
    __syncthreads();
#undef RET_LOAD
}

constexpr int LS_KN = 0, LS_VS = LS_KN + 256 * RQ, LS_QN = LS_VS + 256 * RQ, LS_END = LS_QN + 256 * RQ;
static_assert(LS_END <= RING_BYTES, "swa LDS");
__device__ __forceinline__ void swa_unit(const bf16* __restrict__ PROJ, bf16* __restrict__ MIXED, const float* __restrict__ qnw, const float* __restrict__ knw, const float* __restrict__ sinks,
                                         LAS unsigned char* lds, int b, int kvh, int n, int tid, int lane, int wave) {
    const int l31 = lane & 31, hf = lane >> 5;
    const int row = tid >> 1, half = tid & 1;
    v4u qq[4];
    { const int hs = row >> 7, qrow = row & 127, hq = kvh * 4 + hs;
      const bf16* pr = PROJ + ((size_t)b * SQ + n * 128 + qrow) * NIN + 2048 + hq * 64 + 32 * half;
#pragma unroll
      for (int c = 0; c < 4; ++c) qq[c] = *(const v4u*)(pr + 8 * c); }
    {
        const int kpos = (n - 1) * 128 + row; const bool valid = kpos >= 0;
        v4u kk[4], vv[4];
#pragma unroll
        for (int c = 0; c < 4; ++c) { kk[c] = (v4u){0u, 0u, 0u, 0u}; vv[c] = (v4u){0u, 0u, 0u, 0u}; }
        if (valid) { const bf16* pr = PROJ + ((size_t)b * SQ + kpos) * NIN + 32 * half;
#pragma unroll
            for (int c = 0; c < 4; ++c) { kk[c] = *(const v4u*)(pr + 2560 + kvh * 64 + 8 * c); vv[c] = *(const v4u*)(pr + 2688 + kvh * 64 + 8 * c); } }
        float kf[32]; float ss = 0.f;
#pragma unroll
        for (int c = 0; c < 4; ++c)
#pragma unroll
            for (int u = 0; u < 4; ++u) { kf[8 * c + 2 * u] = bf_lo(kk[c][u]); kf[8 * c + 2 * u + 1] = bf_hi(kk[c][u]); }
#pragma unroll
        for (int i = 0; i < 32; ++i) ss += kf[i] * kf[i];
        ss += __shfl_xor(ss, 1);
        const float rstd = 0.125f / sqrtf(ss * (1.0f / 64.0f) + 1e-6f);
#pragma unroll
        for (int c = 0; c < 4; ++c) {
            const f32x4 g0 = *(const f32x4*)(knw + 32 * half + 8 * c), g1 = *(const f32x4*)(knw + 32 * half + 8 * c + 4);
            *(LAS bf16x8*)(lds + LS_KN + row * RQ + (32 * half + 8 * c) * 2) = pack8(kf[8 * c] * rstd * g0[0], kf[8 * c + 1] * rstd * g0[1], kf[8 * c + 2] * rstd * g0[2], kf[8 * c + 3] * rstd * g0[3],
                                                                                  kf[8 * c + 4] * rstd * g1[0], kf[8 * c + 5] * rstd * g1[1], kf[8 * c + 6] * rstd * g1[2], kf[8 * c + 7] * rstd * g1[3]);
            *(LAS v4u*)(lds + LS_VS + row * RQ + (32 * half + 8 * c) * 2) = vv[c];
        }
    }
    for (int rnd = 0; rnd < 2; ++rnd) {
        {
            float qf[32]; float ss = 0.f;
#pragma unroll
            for (int c = 0; c < 4; ++c)
#pragma unroll
                for (int u = 0; u < 4; ++u) { qf[8 * c + 2 * u] = bf_lo(qq[c][u]); qf[8 * c + 2 * u + 1] = bf_hi(qq[c][u]); }
#pragma unroll
            for (int i = 0; i < 32; ++i) ss += qf[i] * qf[i];
            ss += __shfl_xor(ss, 1);
            const float rstd = 1.0f / sqrtf(ss * (1.0f / 64.0f) + 1e-6f);
#pragma unroll
            for (int c = 0; c < 4; ++c) {
                const f32x4 g0 = *(const f32x4*)(qnw + 32 * half + 8 * c), g1 = *(const f32x4*)(qnw + 32 * half + 8 * c + 4);
                *(LAS bf16x8*)(lds + LS_QN + row * RQ + (32 * half + 8 * c) * 2) = pack8(qf[8 * c] * rstd * g0[0], qf[8 * c + 1] * rstd * g0[1], qf[8 * c + 2] * rstd * g0[2], qf[8 * c + 3] * rstd * g0[3],
                                                                                      qf[8 * c + 4] * rstd * g1[0], qf[8 * c + 5] * rstd * g1[1], qf[8 * c + 6] * rstd * g1[2], qf[8 * c + 7] * rstd * g1[3]);
            }
        }
        if (rnd == 0) {
            const int hs = row >> 7, qrow = row & 127, hq = kvh * 4 + 2 + hs;
            const bf16* pr = PROJ + ((size_t)b * SQ + n * 128 + qrow) * NIN + 2048 + hq * 64 + 32 * half;
#pragma unroll
            for (int c = 0; c < 4; ++c) qq[c] = *(const v4u*)(pr + 8 * c);
        }
        __syncthreads();
        {
            const int hs = wave >> 2, ib = wave & 3, hq = kvh * 4 + rnd * 2 + hs;
            bf16x8 qf[4];
#pragma unroll
            for (int ks = 0; ks < 4; ++ks) qf[ks] = lds_frag16(lds + LS_QN + (hs * 128 + 32 * ib + l31) * RQ + (16 * ks + 8 * hf) * 2);
            f32x16 s[5];
#pragma unroll
            for (int t = 0; t < 5; ++t) {
#pragma unroll
                for (int i = 0; i < 16; ++i) s[t][i] = 0.f;
#pragma unroll
                for (int ks = 0; ks < 4; ++ks) s[t] = MFMA32(lds_frag16(lds + LS_KN + (32 * (ib + t) + l31) * RQ + (16 * ks + 8 * hf) * 2), qf[ks], s[t]);
            }
            const float sink = sinks[hq];
            float m = sink;
#pragma unroll
            for (int t = 0; t < 5; ++t)
#pragma unroll
                for (int i = 0; i < 16; ++i) {
                    bool ok = true;
                    if (t == 0) ok = crow(i, hf) > l31;
                    if (t == 4) ok = crow(i, hf) <= l31;
                    if (n == 0 && ib + t < 4) ok = false;
                    s[t][i] = ok ? s[t][i] : -INFINITY;
                    m = fmaxf(m, s[t][i]);
                }
            m = fmaxf(m, __shfl_xor(m, 32));
            float l = 0.f;
#pragma unroll
            for (int t = 0; t < 5; ++t)
#pragma unroll
                for (int i = 0; i < 16; ++i) { s[t][i] = __builtin_amdgcn_exp2f((s[t][i] - m) * 1.4426950408889634f); l += s[t][i]; }
            l += __shfl_xor(l, 32);
            l += __builtin_amdgcn_exp2f((sink - m) * 1.4426950408889634f);
            f32x16 o[2];
#pragma unroll
            for (int e2 = 0; e2 < 2; ++e2)
#pragma unroll
                for (int i = 0; i < 16; ++i) o[e2][i] = 0.f;
#pragma unroll
            for (int t = 0; t < 5; ++t)
#pragma unroll
                for (int st = 0; st < 2; ++st) {
                    const bf16x8 pf = pack8(s[t][8 * st], s[t][8 * st + 1], s[t][8 * st + 2], s[t][8 * st + 3], s[t][8 * st + 4], s[t][8 * st + 5], s[t][8 * st + 6], s[t][8 * st + 7]);
#pragma unroll
                    for (int e2 = 0; e2 < 2; ++e2) o[e2] = MFMA32(cat8(lds_tr4(lds + LS_VS, 32 * (ib + t) + 16 * st + 4 * hf, 32 * e2, lane), lds_tr4(lds + LS_VS, 32 * (ib + t) + 16 * st + 8 + 4 * hf, 32 * e2, lane)), pf, o[e2]);
                }
            const float inv = 1.0f / l;
            const size_t orow = (size_t)b * SQ + n * 128 + 32 * ib + l31;
#pragma unroll
            for (int e2 = 0; e2 < 2; ++e2)
#pragma unroll
                for (int g = 0; g < 4; ++g) { v2u w; w.x = pk2(o[e2][4 * g] * inv, o[e2][4 * g + 1] * inv); w.y = pk2(o[e2][4 * g + 2] * inv, o[e2][4 * g + 3] * inv);
                    *(v2u*)(MIXED + orow * D + 512 + hq * 64 + 32 * e2 + 8 * g + 4 * hf) = w; }
        }
        __syncthreads();
    }
}

__device__ __forceinline__ void p2_mixing(const Args& a, LAS unsigned char* lds, int bx, int G, int tid, int lane, int wave, int parts = 3) {
    const bf16* PROJ = (const bf16*)(a.ws + WS_R2); bf16* MIXED = (bf16*)(a.ws + WS_R1); const float* rope = (const float*)(a.ws + WS_ROPE);
    if (parts & 1) for (int u = bx; u < 256; u += G) {
        const int b = (u >> 3) & 7, h = u & 7, grp = u >> 6;
        const int c0 = grp == 0 ? 0 : grp == 1 ? 11 : grp == 2 ? 20 : 27, c1 = grp == 0 ? 11 : grp == 1 ? 20 : grp == 2 ? 27 : 32;
        ret_unit(PROJ, MIXED, rope, lds, b, h, c0, c1, tid, lane, wave);
    }
    if (parts & 2) for (int su = bx; su < 512; su += G) swa_unit(PROJ, MIXED, a.in[4], a.in[5], a.in[6], lds, su >> 6, (su >> 5) & 1, su & 31, tid, lane, wave);
}


__device__ __forceinline__ float wave_sum_dpp(float x) {
    x += __builtin_bit_cast(float, __builtin_amdgcn_update_dpp(0, __builtin_bit_cast(int, x), 0xB1, 0xf, 0xf, false));
    x += __builtin_bit_cast(float, __builtin_amdgcn_update_dpp(0, __builtin_bit_cast(int, x), 0x4E, 0xf, 0xf, false));
    x += __builtin_bit_cast(float, __builtin_amdgcn_update_dpp(0, __builtin_bit_cast(int, x), 0x141, 0xf, 0xf, false));
    x += __builtin_bit_cast(float, __builtin_amdgcn_update_dpp(0, __builtin_bit_cast(int, x), 0x140, 0xf, 0xf, false));
    x += __builtin_bit_cast(float, __builtin_amdgcn_update_dpp(0, __builtin_bit_cast(int, x), 0x142, 0xa, 0xf, false));
    x += __builtin_bit_cast(float, __builtin_amdgcn_update_dpp(0, __builtin_bit_cast(int, x), 0x143, 0xc, 0xf, false));
    return __builtin_bit_cast(float, __builtin_amdgcn_readlane(__builtin_bit_cast(int, x), 63));
}
__device__ __forceinline__ float wave_max_dpp(float x) {
    x = fmaxf(x, __builtin_bit_cast(float, __builtin_amdgcn_update_dpp(0, __builtin_bit_cast(int, x), 0xB1, 0xf, 0xf, false)));
    x = fmaxf(x, __builtin_bit_cast(float, __builtin_amdgcn_update_dpp(0, __builtin_bit_cast(int, x), 0x4E, 0xf, 0xf, false)));
    x = fmaxf(x, __builtin_bit_cast(float, __builtin_amdgcn_update_dpp(0, __builtin_bit_cast(int, x), 0x141, 0xf, 0xf, false)));
    x = fmaxf(x, __builtin_bit_cast(float, __builtin_amdgcn_update_dpp(0, __builtin_bit_cast(int, x), 0x140, 0xf, 0xf, false)));
    x = fmaxf(x, __builtin_bit_cast(float, __builtin_amdgcn_update_dpp(0, __builtin_bit_cast(int, x), 0x142, 0xa, 0xf, false)));
    x = fmaxf(x, __builtin_bit_cast(float, __builtin_amdgcn_update_dpp(0, __builtin_bit_cast(int, x), 0x143, 0xc, 0xf, false)));
    return __builtin_bit_cast(float, __builtin_amdgcn_readlane(__builtin_bit_cast(int, x), 63));
}
__device__ __forceinline__ int row16_sum(int x) {
    x += __builtin_amdgcn_update_dpp(0, x, 0xB1, 0xf, 0xf, false);
    x += __builtin_amdgcn_update_dpp(0, x, 0x4E, 0xf, 0xf, false);
    x += __builtin_amdgcn_update_dpp(0, x, 0x141, 0xf, 0xf, false);
    x += __builtin_amdgcn_update_dpp(0, x, 0x140, 0xf, 0xf, false);
    return x;
}
template <int N> __device__ __forceinline__ void bitonic_sort_desc(float (&v)[N]) {
#pragma unroll
    for (int k = 2; k <= N; k <<= 1)
#pragma unroll
        for (int j = k >> 1; j > 0; j >>= 1)
#pragma unroll
            for (int i = 0; i < N; ++i) { const int l = i ^ j; if (l > i) { const bool desc = ((i & k) == 0); const float a = v[i], b = v[l]; const float hi = fmaxf(a, b), lo = fminf(a, b); v[i] = desc ? hi : lo; v[l] = desc ? lo : hi; } }
}
__device__ __forceinline__ void sort16_desc(float (&v)[16]) {
    constexpr int A[63] = {0,2,0,1,1,4,6,4,5,5,0,2,2,1,3,3,1,3,5,8,10,8,9,9,12,14,12,13,13,8,10,10,9,11,11,9,11,13,0,4,4,2,6,6,2,6,10,1,5,5,3,7,7,3,7,11,1,3,5,7,9,11,13};
    constexpr int B[63] = {1,3,2,3,2,5,7,6,7,6,4,6,4,5,7,5,2,4,6,9,11,10,11,10,13,15,14,15,14,12,14,12,13,15,13,10,12,14,8,12,8,10,14,10,4,8,12,9,13,9,11,15,11,5,9,13,2,4,6,8,10,12,14};
#pragma unroll
    for (int i = 0; i < 63; ++i) { const float a = v[A[i]], b = v[B[i]]; v[A[i]] = fmaxf(a, b); v[B[i]] = fminf(a, b); }
}
__device__ __forceinline__ void bitonic_merge16_desc(float (&v)[16]) {
#pragma unroll
    for (int j = 8; j > 0; j >>= 1)
#pragma unroll
        for (int i = 0; i < 16; ++i) { const int l = i ^ j; if (l > i) { const float a = v[i], b = v[l]; v[i] = fmaxf(a, b); v[l] = fminf(a, b); } }
}
__device__ __forceinline__ void top16_of_64(float (&v)[64], float (&out)[16]) {
    float b[4][16];
#pragma unroll
    for (int q = 0; q < 4; ++q) {
#pragma unroll
        for (int i = 0; i < 16; ++i) b[q][i] = v[16 * q + i];
        sort16_desc(b[q]);
    }
    float t0[16], t1[16];
#pragma unroll
    for (int i = 0; i < 16; ++i) { t0[i] = fmaxf(b[0][i], b[1][15 - i]); t1[i] = fmaxf(b[2][i], b[3][15 - i]); }
    bitonic_merge16_desc(t0); bitonic_merge16_desc(t1);
#pragma unroll
    for (int i = 0; i < 16; ++i) out[i] = fmaxf(t0[i], t1[15 - i]);
    bitonic_merge16_desc(out);
}
__device__ __forceinline__ float dot2u(unsigned a, unsigned b, float c) { return __builtin_amdgcn_fdot2_f32_bf16(__builtin_bit_cast(b16x2, a), __builtin_bit_cast(b16x2, b), c, false); }
__device__ __forceinline__ float gelu_erf(float v) {
    const float av = fabsf(v), t = __builtin_amdgcn_rcpf(av * 0.2316418882f + 1.0f);
    float q = t * 0.5307027145f + (-0.7265760135f); q = q * t + 0.7107068705f; q = q * t + (-0.142248368f); q = q * t + 0.127414796f; q = q * t;
    const float e = __builtin_amdgcn_exp2f((v * v) * (-0.72134752044f));
    const float m = v * (q * e);
    return v < 0.f ? m : v - m;
}

constexpr int KROW = 272;
constexpr int LP_KEYS = 0, LP_LUT = LP_KEYS + 256 * KROW, LP_RSTD = LP_LUT + NWAVES * 32 * 32, LP_END = LP_RSTD + 4 * 128;
static_assert(LP_END <= RING_BYTES, "peer LDS");

__device__ __forceinline__ void p5a_topk(const Args& a, LAS unsigned char* lds, int vcu, int G, int tid, int lane, int wave PT_DECL) {
    unsigned char* ws = a.ws;
    const bf16* Q = (const bf16*)(ws + WS_R2 + 64 * MB); const bf16* XB1 = (const bf16*)(ws + WS_R2); unsigned char* H8 = ws + WS_R1; float* SH = (float*)(ws + WS_SH); float* SHS = (float*)(ws + WS_SHS); const float* gffn = a.in[8];
    unsigned* PK = (unsigned*)(ws + WS_PK);
    const int l31 = lane & 31, hf = lane >> 5;
    for (int i = tid; i < 256 * 16; i += NTHR) { const int rr = i >> 4, c = i & 15; *(LAS v4u*)(lds + LP_KEYS + rr * KROW + c * 16) = *(const v4u*)((const bf16*)(ws + WS_KEYS) + rr * 128 + c * 8); }
    float gw[16];
    { const f32x4 g0 = *(const f32x4*)(gffn + 16 * lane), g1 = *(const f32x4*)(gffn + 16 * lane + 4), g2 = *(const f32x4*)(gffn + 16 * lane + 8), g3 = *(const f32x4*)(gffn + 16 * lane + 12);
#pragma unroll
      for (int u = 0; u < 4; ++u) { gw[u] = g0[u]; gw[4 + u] = g1[u]; gw[8 + u] = g2[u]; gw[12 + u] = g3[u]; } }
    { int gi = 0;
      for (int grp = vcu; grp < T / 32 && gi < 4; grp += G, ++gi) {
        const int t0 = grp * 32;
        {
            float xs[4][16];
#pragma unroll
            for (int q = 0; q < 4; ++q) {
                const bf16* xr = XB1 + ((size_t)t0 + 4 * wave + q) * D + 16 * lane;
                const v4u x0 = *(const v4u*)xr, x1 = *(const v4u*)(xr + 8);
#pragma unroll
                for (int u = 0; u < 4; ++u) { xs[q][2 * u] = bf_lo(x0[u]); xs[q][2 * u + 1] = bf_hi(x0[u]); xs[q][8 + 2 * u] = bf_lo(x1[u]); xs[q][8 + 2 * u + 1] = bf_hi(x1[u]); }
            }
            float ssq[4];
#pragma unroll
            for (int q = 0; q < 4; ++q) { float sq = 0.f;
#pragma unroll
                for (int u = 0; u < 16; ++u) sq += xs[q][u] * xs[q][u];
                ssq[q] = sq; }
#pragma unroll
            for (int o = 1; o < 64; o <<= 1)
#pragma unroll
                for (int q = 0; q < 4; ++q) ssq[q] += __shfl_xor(ssq[q], o);
            float am[4], hs2[4];
#pragma unroll
            for (int q = 0; q < 4; ++q) {
                const float rstd = 1.0f / sqrtf(ssq[q] * (1.0f / D) + 1e-6f);
                if (lane == 0) *(LAS float*)(lds + LP_RSTD + gi * 128 + (4 * wave + q) * 4) = rstd;
                float m = 0.f, s2 = 0.f;
#pragma unroll
                for (int u = 0; u < 16; ++u) { xs[q][u] = xs[q][u] * rstd * gw[u]; m = fmaxf(m, fabsf(xs[q][u])); s2 += xs[q][u] * xs[q][u]; }
                am[q] = m; hs2[q] = s2;
            }
#pragma unroll
            for (int o = 1; o < 64; o <<= 1)
#pragma unroll
                for (int q = 0; q < 4; ++q) am[q] = fmaxf(am[q], __shfl_xor(am[q], o));
#pragma unroll
            for (int q = 0; q < 4; ++q) {
                const size_t tok = (size_t)t0 + 4 * wave + q;
                const float step = fminf(0.355f * sqrtf(wave_sum_dpp(hs2[q]) * (1.0f / D)), am[q] * (1.0f / 7.0f));
                const float inv = step > 0.f ? 1.0f / step : 0.f;
                v2u wh = {0u, 0u}; int hsum = 0;
#pragma unroll
                for (int u = 0; u < 16; ++u) { int qi = __float2int_rn(xs[q][u] * inv); qi = qi < -7 ? -7 : qi > 7 ? 7 : qi; hsum += qi; const unsigned nb = (unsigned)qi & 15u;
                    if (u < 8) wh.x |= nb << (4 * u); else wh.y |= nb << (4 * (u - 8)); }
                *(v2u*)(H8 + tok * 512 + 8 * lane) = wh;
                const float hs = wave_sum_dpp((float)hsum);
                if (lane == 0) { SH[tok] = step; SHS[tok] = 0.5f * hs; }
            }
        }
      }
    }
    __syncthreads();
    int gi = 0;
    bf16x8 qfr[8];
    { const bf16* qrow = Q + (size_t)(vcu * 32 + (lane & 31)) * NQ + wave * 256 + 8 * (lane >> 5);
#pragma unroll
      for (int ks = 0; ks < 8; ++ks) qfr[ks] = *(const bf16x8*)(qrow + 16 * ks); }
#pragma unroll 1
    for (int grp = vcu; grp < T / 32 && gi < 4; grp += G, ++gi) {
        const int t0 = grp * 32;
        PT_BEGIN();
        PT_ADD(0);
        {
            const int h = wave;
            float lst[2][16];
#pragma unroll
            for (int p = 0; p < 2; ++p) {
                f32x16 acc[4];
#pragma unroll
                for (int q = 0; q < 4; ++q)
#pragma unroll
                    for (int i = 0; i < 16; ++i) acc[q][i] = 0.f;
#pragma unroll
                for (int ks = 0; ks < 8; ++ks) {
#pragma unroll
                    for (int q = 0; q < 4; ++q) acc[q] = MFMA32(lds_frag16(lds + LP_KEYS + (p * 128 + 32 * q + l31) * KROW + (16 * ks + 8 * hf) * 2), qfr[ks], acc[q]);
                }
                {
                    const bool more = (p == 0) || (gi + 1 < 4 && grp + G < T / 32);
                    const size_t tn = (p == 0) ? (size_t)(t0 + l31) : (size_t)(t0 + G * 32 + l31);
                    const bf16* qrow = Q + tn * NQ + h * 256 + (p == 0 ? 128 : 0) + 8 * hf;
                    if (more) {
#pragma unroll
                        for (int ks = 0; ks < 8; ++ks) qfr[ks] = *(const bf16x8*)(qrow + 16 * ks);
                    }
                    __builtin_amdgcn_sched_barrier(0);
                }
                float v[64];
#pragma unroll
                for (int q = 0; q < 4; ++q)
#pragma unroll
                    for (int i = 0; i < 16; ++i) v[16 * q + i] = __uint_as_float((__float_as_uint(acc[q][i]) & 0xffffff80u) | (unsigned)(32 * q + crow(i, hf)));
                float mine[16];
                top16_of_64(v, mine);
                float t[16];
#pragma unroll
                for (int i = 0; i < 16; ++i) t[i] = __shfl_xor(mine[i], 32);
#pragma unroll
                for (int i = 0; i < 16; ++i) lst[p][i] = fmaxf(mine[i], t[15 - i]);
                bitonic_merge16_desc(lst[p]);
            }
            PT_ADD(1);
            LAS unsigned char* lut = lds + LP_LUT + wave * 1024 + l31 * 32;
            {
                v4u wa, wb;
#pragma unroll
                for (int c = 0; c < 4; ++c) {
                    wa[c] = (__float_as_uint(lst[0][4 * c]) & 0x7fu) | ((__float_as_uint(lst[0][4 * c + 1]) & 0x7fu) << 8) | ((__float_as_uint(lst[0][4 * c + 2]) & 0x7fu) << 16) | ((__float_as_uint(lst[0][4 * c + 3]) & 0x7fu) << 24);
                    wb[c] = (__float_as_uint(lst[1][4 * c]) & 0x7fu) | ((__float_as_uint(lst[1][4 * c + 1]) & 0x7fu) << 8) | ((__float_as_uint(lst[1][4 * c + 2]) & 0x7fu) << 16) | ((__float_as_uint(lst[1][4 * c + 3]) & 0x7fu) << 24);
                }
                if (hf == 0) { *(LAS v4u*)lut = wa; *(LAS v4u*)(lut + 16) = wb; }
            }
            float cv[64];
            {
                int c = 0;
#pragma unroll
                for (int i = 0; i < 16; ++i)
#pragma unroll
                    for (int j = 0; j < 16; ++j)
                        if ((i + 1) * (j + 1) <= 16) {
                            const float sa = __uint_as_float(__float_as_uint(lst[0][i]) & 0xffffff80u), sb = __uint_as_float(__float_as_uint(lst[1][j]) & 0xffffff80u);
                            cv[c] = __uint_as_float((__float_as_uint(sa + sb) & 0xffffff00u) | (unsigned)(i * 16 + j)); ++c;
                        }
#pragma unroll
                for (int k = 50; k < 64; ++k) cv[k] = -3.0e38f;
            }
            float best[16];
            top16_of_64(cv, best);
            const float rstd = *(const LAS float*)(lds + LP_RSTD + gi * 128 + l31 * 4);
            const float s0 = __uint_as_float(__float_as_uint(best[0]) & 0xffffff00u);
            float ev[16], esum = 0.f;
#pragma unroll
            for (int k = 0; k < 16; ++k) { const float sk = __uint_as_float(__float_as_uint(best[k]) & 0xffffff00u); ev[k] = __expf(rstd * (sk - s0)); esum += ev[k]; }
            const float einv = 1.0f / esum;
            LDS_WAIT();
            asm volatile("" ::: "memory");
            {
                const size_t ob = (size_t)(t0 + l31) * 128 + h * 16 + 8 * hf;
                unsigned e8[8];
                const unsigned hm = hf ? 0xffffffffu : 0u;
#pragma unroll
                for (int j = 0; j < 8; ++j) { const unsigned code = ((__float_as_uint(best[8 + j]) & hm) | (__float_as_uint(best[j]) & ~hm)) & 0xffu;
                    const float gk = __uint_as_float((__float_as_uint(ev[8 + j]) & hm) | (__float_as_uint(ev[j]) & ~hm)) * einv;
                    const unsigned ia = *(const LAS unsigned char*)(lut + (code >> 4)), ib = *(const LAS unsigned char*)(lut + 16 + (code & 15u));
                    e8[j] = (ia * 128u + ib) | (pk2(0.f, gk) & 0xffff0000u); }
                *(v4u*)(PK + ob) = (v4u){e8[0], e8[1], e8[2], e8[3]}; *(v4u*)(PK + ob + 4) = (v4u){e8[4], e8[5], e8[6], e8[7]};
            }
            PT_ADD(2);
        }
    }
    __syncthreads();
}

constexpr int LB_H = 0, LB_LIST = LB_H + NWAVES * 4096, LB_GATE = LB_LIST + NWAVES * 4608, LB_SH = LB_GATE + NWAVES * 4096, LB_END = LB_SH + NWAVES * 64;
static_assert(LB_END <= MISC_OFF, "p5b LDS");
struct B5Batch { v4u ur[4][2]; };
struct B5Blk { unsigned em; float scl, svl; };
__device__ __forceinline__ void b5_issue(B5Batch& b, const LAS unsigned* list, int bt, const unsigned char* U8, int lane) {
    const int g = lane >> 4, c = lane & 15;
#pragma unroll
    for (int ps = 0; ps < 4; ++ps) {
        const unsigned ent = list[16 * bt + 4 * ps + g];
        const unsigned char* rp = U8 + ((ent & 0xffffu) * 512u + 16u * (unsigned)c);
#pragma unroll
        for (int i = 0; i < 2; ++i) b.ur[ps][i] = *(const v4u*)(rp + 256 * i);
    }
}
__device__ __forceinline__ void b5_blk_issue(B5Blk& k, const LAS unsigned* list, int blk, const float* SU, const float* SV, int lane) {
    const int g = lane >> 4, c = lane & 15;
    k.em = list[64 * blk + 16 * (c >> 2) + 4 * (c & 3) + g];
    const unsigned ee = k.em & 0xffffu; k.scl = SU[ee]; k.svl = SV[ee];
}
__device__ __forceinline__ void b5_compute(const B5Batch& b, const LAS unsigned* list, int bt, LAS unsigned char* hreg, int lane, int& res) {
    const int g = lane >> 4, c = lane & 15;
    int acc[4];
#pragma unroll
    for (int ps = 0; ps < 4; ++ps) {
        const unsigned ent = list[16 * bt + 4 * ps + g];
        LAS unsigned char* hp = hreg + ((ent >> 28) & 3u) * 512 + 16 * c;
        int ac = 0;
#pragma unroll
        for (int i = 0; i < 2; ++i) { const v4u hv = *(const LAS v4u*)(hp + 256 * i);
#pragma unroll
            for (int u = 0; u < 4; ++u) ac = __builtin_amdgcn_sdot8((int)hv[u], (int)b.ur[ps][i][u], ac, false); }
        acc[ps] = ac;
    }
    const bool o1 = (c & 1) != 0, o2 = (c & 2) != 0;
    const int k0 = o1 ? acc[1] : acc[0], s0 = o1 ? acc[0] : acc[1], k1 = o1 ? acc[3] : acc[2], s1 = o1 ? acc[2] : acc[3];
    const int b0 = k0 + __builtin_amdgcn_update_dpp(0, s0, 0xB1, 0xf, 0xf, false);
    const int b1 = k1 + __builtin_amdgcn_update_dpp(0, s1, 0xB1, 0xf, 0xf, false);
    const int k2 = o2 ? b1 : b0, s2 = o2 ? b0 : b1;
    int d = k2 + __builtin_amdgcn_update_dpp(0, s2, 0x4E, 0xf, 0xf, false);
    d += __builtin_amdgcn_update_dpp(0, d, 0x124, 0xf, 0xf, false);
    d += __builtin_amdgcn_update_dpp(0, d, 0x128, 0xf, 0xf, false);
    res = ((c >> 2) == (bt & 3)) ? d : res;
}
__device__ __forceinline__ void b5_epilogue(const B5Blk& k, int res, const LAS float* gts, const LAS float* shs, unsigned* PK, int tok0) {
    const unsigned eslot = k.em >> 28, ek = (k.em >> 16) & 0xffu;
    if (eslot < 4u) {
        const float dot = ((float)res + shs[4 + eslot]) * k.scl * shs[eslot];
        ((unsigned short*)(PK + ((size_t)tok0 + eslot) * 128 + ek))[1] = (unsigned short)(pk2(0.f, gelu_erf(dot) * gts[eslot * 128 + ek] * k.svl) >> 16);
    }
}
struct B5Pre { v2u pk[4]; v2u h0[4]; float shv; };
__device__ __forceinline__ void b5_prefetch(B5Pre& p, const unsigned* PK, const unsigned char* H8, const float* SH, int tok0, int lane) {
#pragma unroll
    for (int s = 0; s < 4; ++s) { const size_t tok = (size_t)tok0 + s;
        p.pk[s] = *(const v2u*)(PK + tok * 128 + 2 * lane); p.h0[s] = *(const v2u*)(H8 + tok * 512 + 8 * lane); }
    p.shv = (lane & 4) ? SH[T + tok0 + (lane & 3)] : SH[tok0 + (lane & 3)];
}
__device__ __forceinline__ int b5_build(const B5Pre& P, LAS unsigned char* hreg, LAS unsigned* list, LAS float* gts, LAS float* shs, unsigned vx, int lane, unsigned long long ltmask) {
    int n = 0;
    if (lane < 8) shs[lane] = P.shv;
#pragma unroll
    for (int s = 0; s < 4; ++s) {
        *(LAS v2u*)(hreg + s * 512 + lane * 8) = P.h0[s];
        *(LAS f32x2*)(gts + s * 128 + 2 * lane) = (f32x2){bf_hi(P.pk[s].x), bf_hi(P.pk[s].y)};
        const unsigned id0 = P.pk[s].x & 0xffffu, id1 = P.pk[s].y & 0xffffu;
        const bool in0 = (id0 >> 12) == vx, in1 = (id1 >> 12) == vx;
        const unsigned long long m0 = __ballot(in0), m1 = __ballot(in1);
        const int c0 = __popcll(m0), c1 = __popcll(m1);
        if (in0) list[n + __popcll(m0 & ltmask)] = ((unsigned)s << 28) | ((unsigned)(2 * lane) << 16) | id0;
        if (in1) list[n + c0 + __popcll(m1 & ltmask)] = ((unsigned)s << 28) | ((unsigned)(2 * lane + 1) << 16) | id1;
        n += c0 + c1;
    }
    list[n + lane] = (0xfu << 28) | (vx << 12);
    const int nb = (n + 15) >> 4;
    return nb < 2 ? 2 : nb;
}
__device__ __forceinline__ void p5b_dots(const Args& a, LAS unsigned char* lds, int bx, int G, int tid, int lane, int wave) {
    unsigned char* ws = a.ws;
    const unsigned char* H8 = ws + WS_R1; const unsigned char* U8 = ws + WS_UB; const float* SU = (const float*)(ws + WS_SU); const float* SV = (const float*)(ws + WS_SV); const float* SH = (const float*)(ws + WS_SH);
    unsigned* PK = (unsigned*)(ws + WS_PK);
    LAS unsigned char* hreg0 = lds + LB_H + wave * 4096; LAS unsigned* list0 = (LAS unsigned*)(lds + LB_LIST + wave * 4608); LAS float* gts0 = (LAS float*)(lds + LB_GATE + wave * 4096); LAS float* shs0 = (LAS float*)(lds + LB_SH + wave * 64);
    const unsigned long long ltmask = (1ull << lane) - 1ull;
    for (int vb = bx; vb < 256; vb += G) {
        const unsigned vx = (unsigned)(vb & 3); const int wi = vb >> 3;
        const int tw0 = ((vb >> 2) & 1) * (T / 2) + wi * 512 + wave * 64;
        B5Pre P;
        b5_prefetch(P, PK, H8, SH, tw0, lane);
        int nbn = b5_build(P, hreg0, list0, gts0, shs0, vx, lane, ltmask);
        b5_prefetch(P, PK, H8, SH, tw0 + 4, lane);
        LDS_WAIT(); asm volatile("" ::: "memory");
        B5Batch A, B; B5Blk K;
        b5_issue(A, list0, 0, U8, lane); b5_issue(B, list0, 1, U8, lane);
#pragma unroll 1
        for (int ch = 0; ch < 16; ++ch) {
            const int tok0 = tw0 + 4 * ch, par = ch & 1, nb = nbn;
            LAS unsigned char* hreg = hreg0 + par * 2048; LAS unsigned* list = list0 + par * 576; LAS float* gts = gts0 + par * 512; LAS float* shs = shs0 + par * 8;
            LAS unsigned* listn = list0 + (par ^ 1) * 576;
            const bool more = ch + 1 < 16;
            if (more) {
                nbn = b5_build(P, hreg0 + (par ^ 1) * 2048, listn, gts0 + (par ^ 1) * 512, shs0 + (par ^ 1) * 8, vx, lane, ltmask);
                if (ch + 2 < 16) b5_prefetch(P, PK, H8, SH, tok0 + 8, lane);
                LDS_WAIT(); asm volatile("" ::: "memory");
            }
            int res = 0;
#pragma unroll 1
            for (int bt = 0; bt < nb; bt += 2) {
                if ((bt & 3) == 0) b5_blk_issue(K, list, bt >> 2, SU, SV, lane);
                b5_compute(A, list, bt, hreg, lane, res);
                if (bt + 2 < nb) b5_issue(A, list, bt + 2, U8, lane); else if (more) b5_issue(A, listn, 0, U8, lane);
                if (bt + 1 < nb) {
                    b5_compute(B, list, bt + 1, hreg, lane, res);
                    if (bt + 3 < nb) b5_issue(B, list, bt + 3, U8, lane); else if (more) b5_issue(B, listn, 1, U8, lane);
                    if ((bt & 3) == 2) b5_epilogue(K, res, gts, shs, PK, tok0);
                }
            }
            if ((nb & 3) != 0) b5_epilogue(K, res, gts, shs, PK, tok0);
        }
    }
}

constexpr int LC_BUF = 0, LC_SB = 640, LC_TILE = NWAVES * 2 * LC_SB, LC_ROW = 144, LC_END = LC_TILE + NWAVES * 128 * LC_ROW;
static_assert(LC_END <= MISC_OFF, "p5c LDS");
struct C5Tok { v4u vv[16]; unsigned short xa[4]; float sa; };
__device__ __forceinline__ void c5_stage(C5Tok& t, LAS unsigned char* buf, v2u pk, int lane) {
    const f32x2 av = {bf_hi(pk.x), bf_hi(pk.y)};
    const float am = wave_max_dpp(fmaxf(fabsf(av[0]), fabsf(av[1])));
    const float inv = am > 0.f ? 119.0f / am : 0.f;
    const int q0 = __float2int_rn(av[0] * inv), q1 = __float2int_rn(av[1] * inv);
    const int k0 = 2 * lane, k1 = 2 * lane + 1;
    *(LAS unsigned*)(buf + ((k0 & 7) * 16 + (k0 >> 3)) * 4) = (pk.x & 0xffffu) << 7;
    *(LAS unsigned*)(buf + ((k1 & 7) * 16 + (k1 >> 3)) * 4) = (pk.y & 0xffffu) << 7;
    const unsigned b0 = (unsigned)(q0 + 8), b1 = (unsigned)(q1 + 8);
    *(LAS unsigned char*)(buf + 512 + (lane >> 3) * 16 + (lane & 7)) = (unsigned char)(((b0 >> 4) & 15u) | (((b1 >> 4) & 15u) << 4));
    *(LAS unsigned char*)(buf + 512 + (lane >> 3) * 16 + 8 + (lane & 7)) = (unsigned char)(((b0 & 15u) ^ 8u) | (((b1 & 15u) ^ 8u) << 4));
    t.sa = am * (1.0f / 119.0f);
}
__device__ __forceinline__ void c5_issue(C5Tok& t, LAS unsigned char* buf, const unsigned char* vbase, unsigned coff, const bf16* xr, int g) {
#pragma unroll
    for (int jj = 0; jj < 4; ++jj) {
        const v4u iv = *(const LAS v4u*)(buf + g * 64 + 16 * jj);
#pragma unroll
        for (int u = 0; u < 4; ++u) t.vv[4 * jj + u] = *(const v4u*)(vbase + (iv[u] | coff));
    }
#pragma unroll
    for (int m = 0; m < 4; ++m) t.xa[m] = *(const unsigned short*)(xr + 64 * m);
}
__device__ __forceinline__ void c5_finish(const C5Tok& t, LAS unsigned char* buf, LAS unsigned char* tile, bf16* xb, float* rss, int lane, int g, int c) {
    LAS unsigned char* wp = tile + g * LC_ROW + 16 * c;
#pragma unroll
    for (int j = 0; j < 16; ++j) *(LAS v4u*)(wp + j * 8 * LC_ROW) = t.vv[j];
    const LAS unsigned char* rp = tile + (lane & 15) * LC_ROW + 8 * (lane >> 4);
    int yh[4] = {0, 0, 0, 0}, yl[4] = {0, 0, 0, 0};
#pragma unroll
    for (int rb = 0; rb < 8; ++rb) {
        const v4u av = *(const LAS v4u*)(buf + 512 + 16 * rb);
#pragma unroll
        for (int m = 0; m < 4; ++m) {
            const v2i tv = __builtin_amdgcn_ds_read_tr4_b64_v2i32((LAS v2i*)(rp + rb * 16 * LC_ROW + 32 * m));
            yh[m] = __builtin_amdgcn_sdot8(tv.x, (int)av.x, yh[m], false); yl[m] = __builtin_amdgcn_sdot8(tv.x, (int)av.z, yl[m], false);
            yh[m] = __builtin_amdgcn_sdot8(tv.y, (int)av.y, yh[m], false); yl[m] = __builtin_amdgcn_sdot8(tv.y, (int)av.w, yl[m], false);
        }
    }
    float o[4], sq = 0.f;
#pragma unroll
    for (int m = 0; m < 4; ++m) { o[m] = bf_lo((unsigned)t.xa[m]) + (float)(16 * yh[m] + yl[m]) * t.sa; sq += o[m] * o[m]; }
    const float ss = wave_sum_dpp(sq);
    const unsigned w0 = pk2(o[0], o[1]), w1 = pk2(o[2], o[3]);
    *(unsigned short*)xb = (unsigned short)(w0 & 0xffffu); *(unsigned short*)(xb + 64) = (unsigned short)(w0 >> 16);
    *(unsigned short*)(xb + 128) = (unsigned short)(w1 & 0xffffu); *(unsigned short*)(xb + 192) = (unsigned short)(w1 >> 16);
    if (lane == 0) { rss[0] = ss; rss[4] = 0.f; }
}
__device__ __forceinline__ void p5c_axpy(const Args& a, LAS unsigned char* lds, int bx, int G, int tid, int lane, int wave) {
    unsigned char* ws = a.ws;
    const unsigned char* V8 = ws + WS_VB; const unsigned* PK = (const unsigned*)(ws + WS_PK);
    const bf16* XB1 = (const bf16*)(ws + WS_R2); bf16* XB2 = (bf16*)(ws + WS_R1); float* RSS2 = (float*)(ws + WS_RSS2);
    const int g = lane >> 3, c = lane & 7;
    LAS unsigned char* buf0 = lds + LC_BUF + wave * (2 * LC_SB); LAS unsigned char* buf1 = buf0 + LC_SB; LAS unsigned char* tile = lds + LC_TILE + wave * (128 * LC_ROW);
    for (int vb = bx; vb < 256; vb += G) {
        const int vx = vb & 7, cs = vx & 3, wi = vb >> 3;
        const size_t tw0 = (size_t)(vx >> 2) * (T / 2) + (size_t)wi * 512 + wave * 64;
        const unsigned char* vbase = V8 + (size_t)cs * ((size_t)NEXP * 128); const unsigned coff = 16u * (unsigned)c;
        const bf16* xcol = XB1 + cs * 256 + lane; bf16* xbcol = XB2 + cs * 256 + lane;
        C5Tok A, B;
        v2u pk = *(const v2u*)(PK + tw0 * 128 + 2 * lane);
        c5_stage(A, buf0, pk, lane);
        pk = *(const v2u*)(PK + (tw0 + 1) * 128 + 2 * lane);
        LDS_WAIT(); asm volatile("" ::: "memory");
        c5_issue(A, buf0, vbase, coff, xcol + tw0 * D, g);
#pragma unroll 1
        for (int i = 0; i < 64; i += 2) {
            const size_t tok = tw0 + i;
            c5_stage(B, buf1, pk, lane);
            if (i + 2 < 64) pk = *(const v2u*)(PK + (tok + 2) * 128 + 2 * lane);
            LDS_WAIT(); asm volatile("" ::: "memory");
            c5_issue(B, buf1, vbase, coff, xcol + (tok + 1) * D, g);
            c5_finish(A, buf0, tile, xbcol + tok * D, RSS2 + tok * 8 + cs, lane, g, c);
            if (i + 2 < 64) {
                c5_stage(A, buf0, pk, lane);
                if (i + 3 < 64) pk = *(const v2u*)(PK + (tok + 3) * 128 + 2 * lane);
                LDS_WAIT(); asm volatile("" ::: "memory");
                c5_issue(A, buf0, vbase, coff, xcol + (tok + 2) * D, g);
            }
            c5_finish(B, buf1, tile, xbcol + (tok + 1) * D, RSS2 + (tok + 1) * 8 + cs, lane, g, c);
        }
    }
}

__global__ void __launch_bounds__(NTHR, 2) mk_fwd(Args a) {
    extern __shared__ __attribute__((aligned(16))) unsigned char lds_raw[];
    LAS unsigned char* lds = (LAS unsigned char*)lds_raw;
    const int tid = threadIdx.x, lane = tid & 63, wave = __builtin_amdgcn_readfirstlane(tid >> 6);
    const int G = gridDim.x, bx = blockIdx.x, vcu = (G % 8 == 0) ? (bx % 8) * (G / 8) + bx / 8 : bx;
    volatile LAS unsigned* MISC = (volatile LAS unsigned*)(lds + MISC_OFF);
    if (tid < 64) MISC[tid] = 0u;
    __syncthreads();
    unsigned char* ws = a.ws;
    const int lo = a.ph_lo, hi = a.ph_hi;
    XcdBarrier bar; bar.bar = (unsigned*)(ws + WS_CTL) + CW_BAR + a.li * XCD_BAR_WORDS; bar.x = 0; bar.st = nullptr;
    if (hi - lo > 1) bar = xcd_barrier_post((unsigned*)(ws + WS_CTL) + CW_BAR + a.li * XCD_BAR_WORDS, MISC + 8);
#define IN(k) (lo <= (k) && (k) < hi)
#define BOTH(k) (IN(k) && IN((k) + 1))
    if (IN(0)) { p0_prologue(a, lds, vcu, G, tid, lane, wave); if (BOTH(0)) xcd_barrier_work(bar, a, lds, 0, vcu, G, wave, lane); }
    if (IN(1)) {
        { pg8::Gemm g{(const bf16*)(ws + WS_XB0), (const bf16*)(ws + WS_WIN), T, NIN, D}; pg8::StaticOrder S; S.init(T, NIN, G, bx);
          EpiStoreBf16 E{(bf16*)(ws + WS_R2), NIN, (const float*)(ws + WS_RSTD0)};
          pg8::gemm_phase<EpiStoreBf16, pg8::StaticOrder, true, true>(lds, g, S, E); }
        { pg8::Gemm g{(const bf16*)(ws + WS_PB), (const bf16*)(ws + WS_WP), T / 2, D, PLE}; pg8::StaticOrder S; S.init(T / 2, D, G, bx);
          EpiStoreBf16 E{(bf16*)(ws + WS_PP), D, nullptr};
          pg8::gemm_phase<EpiStoreBf16, pg8::StaticOrder, true, true>(lds, g, S, E); }
        { pg8::Gemm g{(const bf16*)(ws + WS_PB) + (size_t)(T / 2) * PLE, (const bf16*)(ws + WS_WP), T / 2, D, PLE}; pg8::StaticOrder S;
          if (G == 256) S.init(T / 2, D, 128, bx >= 128 ? bx - 128 : (1 << 28)); else S.init(T / 2, D, G, bx);
          EpiStoreBf16 E{(bf16*)(ws + WS_PP) + (size_t)(T / 2) * D, D, nullptr};
          pg8::gemm_phase<EpiStoreBf16, pg8::StaticOrder, true, true>(lds, g, S, E); }
        if (BOTH(1)) xcd_barrier_work(bar, a, lds, 1, vcu, G, wave, lane);
    }
    if (IN(2)) { p2_mixing(a, lds, bx, G, tid, lane, wave); if (BOTH(2)) xcd_barrier_work(bar, a, lds, 2, vcu, G, wave, lane); }
    if (IN(3)) {
        pg8::Gemm g{(const bf16*)(ws + WS_R1), (const bf16*)(ws + WS_WOUT), T, D, D}; pg8::StaticOrder S; S.init(T, D, G, bx);
        EpiResid E{(const bf16*)(ws + WS_XB0), (bf16*)(ws + WS_R2)};
        pg8::gemm_phase<EpiResid, pg8::StaticOrder, true, true>(lds, g, S, E);
        if (BOTH(3)) xcd_barrier_work(bar, a, lds, 3, vcu, G, wave, lane);
    }
    if (IN(4)) {
        pg8::Gemm g{(const bf16*)(ws + WS_R2), (const bf16*)(ws + WS_WQ), T, NQ, D}; pg8::StaticOrder S; S.init(T, NQ, G, bx);
        EpiStoreBf16 E{(bf16*)(ws + WS_R2 + 64 * MB), NQ, nullptr};
        pg8::gemm_phase<EpiStoreBf16, pg8::StaticOrder, true, true>(lds, g, S, E);
        if (BOTH(4)) xcd_barrier_work(bar, a, lds, 4, vcu, G, wave, lane);
    }
    if (IN(5)) {
        p5a_topk(a, lds, vcu, G, tid, lane, wave PT_ARG); xcd_barrier(bar);
        p5b_dots(a, lds, bx, G, tid, lane, wave); xcd_barrier(bar);
        p5c_axpy(a, lds, bx, G, tid, lane, wave);
        if (BOTH(5)) xcd_barrier(bar);
    }
    if (IN(6)) {
        pg8::Gemm g{(const bf16*)(ws + WS_R1), (const bf16*)(ws + WS_WG), T, D, D}; pg8::StaticOrder S; S.init(T, D, G, bx);
        EpiGate E{a.out, (const bf16*)(ws + WS_R1), (const bf16*)(ws + WS_PP), (const float*)(ws + WS_RSS2)};
        pg8::gemm_phase<EpiGate, pg8::StaticOrder, true, true>(lds, g, S, E);
    }
#undef IN
#undef BOTH
}
}
extern "C" void kernel_launch(void* const* d_in, const int* in_sizes, int n_in, void* d_out, int out_size, void* d_ws, size_t ws_size, hipStream_t stream) {
    using namespace mk;
    static int grid = 0;
    if (grid == 0) {
        int dev = 0, cus = 0;
        if (n_in != 16 || out_size != T * D || ws_size < WS_END) { fprintf(stderr, "kernel_launch: unexpected problem shape / workspace (%d inputs, out %d, ws %zu)\n", n_in, out_size, ws_size); grid = -1; return; }
        if (hipGetDevice(&dev) != hipSuccess || hipDeviceGetAttribute(&cus, hipDeviceAttributeMultiprocessorCount, dev) != hipSuccess) { fprintf(stderr, "device query failed\n"); grid = -1; return; }
        if (hipFuncSetAttribute((const void*)mk_fwd, hipFuncAttributeMaxDynamicSharedMemorySize, LDS_BYTES) != hipSuccess) { fprintf(stderr, "hipFuncSetAttribute failed\n"); grid = -1; return; }
        int per_cu = 0;
        if (hipOccupancyMaxActiveBlocksPerMultiprocessor(&per_cu, (const void*)mk_fwd, NTHR, LDS_BYTES) != hipSuccess || per_cu < 1) { fprintf(stderr, "occupancy query: %d blocks per CU\n", per_cu); (void)hipGetLastError(); }
        if (cus < 256) { fprintf(stderr, "kernel_launch: this kernel is laid out for a 256-CU device (found %d CUs)\n", cus); grid = -1; return; }
        grid = 256;
    }
    if (grid < 0) return;
    unsigned char* ws = (unsigned char*)d_ws;
    (void)hipMemsetAsync(ws + WS_CTL, 0, CTL_BYTES, stream);
    Args a{};
    for (int i = 0; i < 16; ++i) a.in[i] = (const float*)d_in[i];
    a.out = (float*)d_out; a.ws = ws; a.ph_lo = 0; a.ph_hi = 7; a.li = 0; a.pad = 0;
    hipLaunchKernelGGL(mk_fwd, dim3(grid), dim3(NTHR), LDS_BYTES, stream, a);
}
```

```cpp
#include <hip/hip_runtime.h>
#include <cstdio>
#include <cstdint>
#define LAS __attribute__((address_space(3)))
#define GAS __attribute__((address_space(1)))
namespace pg8 {
#define PG8_LAS __attribute__((address_space(3)))
typedef unsigned short bf16_t;
typedef short bf16x8 __attribute__((ext_vector_type(8)));
typedef float f32x4 __attribute__((ext_vector_type(4)));
typedef unsigned u32x4 __attribute__((ext_vector_type(4)));
constexpr int BM = 256, BK = 64, HALF = 128, HTB = HALF * BK * 2  , STAGE_BYTES = 8 * HTB, NXCD = 8, WGM = 8;

__host__ __device__ __forceinline__ int lds_byte(int r, int c) { const int st = (r >> 4) * 2 + (c >> 5), rr = r & 15, cc = c & 31, ob = rr * 64 + cc * 2; return st * 1024 + (ob ^ (((ob >> 9) & 1) << 5)); }
__host__ __device__ __forceinline__ void stage_rc(int b, int& R, int& C) { const int st = b / 1024, sb = b % 1024, swz = sb ^ (((sb >> 9) & 1) << 5); R = (st >> 1) * 16 + swz / 64; C = (st & 1) * 32 + (swz % 64) / 2; }
__host__ __device__ __forceinline__ int perm32(int rho) { const int n = rho >> 4, i = rho & 15; return 8 * (i >> 2) + 4 * n + (i & 3); }

struct Unit { int pm, pn; };
struct Gemm { const bf16_t* A; const bf16_t* Bt; int M, N, K; };

struct StaticOrder {
    int nM, nN, nwg, G, c;
    __host__ __device__ void init(int M, int N, int G_, int c_) { nM = M / BM; nN = N / BM; nwg = nM * nN; G = G_; c = c_; }
    __host__ __device__ bool next(int i, Unit& u) const {
        const long L = (long)i * G + c; if (L >= nwg) return false;
        int wgid = (int)L; { const int q = nwg / NXCD, r = nwg % NXCD, xcd = wgid % NXCD, off = wgid / NXCD; wgid = (xcd < r ? xcd * (q + 1) : r * (q + 1) + (xcd - r) * q) + off; }
        const int nig = WGM * nN, gid = wgid / nig, fm = gid * WGM, gsz = (nM - fm) < WGM ? (nM - fm) : WGM;
        u.pm = fm + ((wgid % nig) % gsz); u.pn = (wgid % nig) / gsz; return true;
    }
    __device__ __forceinline__ void a_ready(const Unit&) const {}
    __device__ __forceinline__ void done(const Unit&) const {}
};
__device__ __forceinline__ unsigned cvt_pk_bf16(float lo, float hi) { unsigned r; asm volatile("v_cvt_pk_bf16_f32 %0, %1, %2" : "=v"(r) : "v"(lo), "v"(hi)); return r; }
template <class Epi, class Sched, bool ALIGN_EPI = false, bool SP2 = false>
__device__ __forceinline__ void gemm_phase(PG8_LAS unsigned char* lds, const Gemm g, const Sched& S, const Epi& E) {
    const int tid = threadIdx.x, wid = __builtin_amdgcn_readfirstlane(tid >> 6), lane = tid & 63, wr = wid >> 2, wc = wid & 3, fr = lane & 15, fq = lane >> 4;
    const int K = g.K, nt = K / BK;
    unsigned voffA[2], voffB[2];
#pragma unroll
    for (int i = 0; i < 2; ++i) { int R, C; stage_rc(tid * 16 + i * 8192, R, C); const int Rb = Epi::PERM ? ((R & ~31) + perm32(R & 31)) : R;
        voffA[i] = (unsigned)(R * K + C) * 2u; voffB[i] = (unsigned)(Rb * K + C) * 2u; }
    const size_t kstep = (size_t)(BK * 2);
    const size_t hstep = (size_t)HALF * K * 2;
    const size_t tstep = 2 * hstep;
    const unsigned ldsw = (unsigned)wid * 1024u;
    const int aoff = lds_byte(wr * 64 + fr, fq * 8), boff = lds_byte(wc * 32 + fr, fq * 8);
#define PG8_SA(b, h) (((b) * 2 + (h)) * HTB)
#define PG8_SB(b, h) ((4 + (b) * 2 + (h)) * HTB)
#define PG8_STAGE(bufoff, gbase, voff) do { _Pragma("unroll") for (int _i = 0; _i < 2; ++_i) \
        __builtin_amdgcn_global_load_lds((const unsigned*)((const char*)(gbase) + (voff)[_i]), (PG8_LAS unsigned*)(lds + (bufoff) + ldsw + _i * 8192), 16, 0, 0); } while (0)
#define PG8_LDA(dst, b, h) do { _Pragma("unroll") for (int m = 0; m < 4; ++m) _Pragma("unroll") for (int k = 0; k < 2; ++k) dst[m][k] = *(const PG8_LAS bf16x8*)(lds + PG8_SA(b, h) + aoff + m * 2048 + k * 1024); } while (0)
#define PG8_LDB(dst, b, h) do { _Pragma("unroll") for (int n = 0; n < 2; ++n) _Pragma("unroll") for (int k = 0; k < 2; ++k) dst[n][k] = *(const PG8_LAS bf16x8*)(lds + PG8_SB(b, h) + boff + n * 2048 + k * 1024); } while (0)
#define PG8_MMA(ai, bj, At, Bt) do { __builtin_amdgcn_s_setprio(1); _Pragma("unroll") for (int m = 0; m < 4; ++m) _Pragma("unroll") for (int n = 0; n < 2; ++n) _Pragma("unroll") for (int k = 0; k < 2; ++k) \
        acc[ai][bj][m][n] = __builtin_amdgcn_mfma_f32_16x16x32_bf16(Bt[n][k], At[m][k], acc[ai][bj][m][n], 0, 0, 0); __builtin_amdgcn_s_setprio(0); } while (0)
#define PG8_WAIT_V(n) asm volatile("s_waitcnt vmcnt(" #n ")" ::: "memory")
#define PG8_WAIT_L(n) asm volatile("s_waitcnt lgkmcnt(" #n ")" ::: "memory")
#define PG8_BAR __builtin_amdgcn_s_barrier()
#define PG8_SCHED __builtin_amdgcn_sched_barrier(0)
    Unit cur, nxt; int ui = 0;
    if (!S.next(0, cur)) return;
    f32x4 acc[2][2][4][2];
#pragma unroll
    for (int a = 0; a < 2; ++a)
#pragma unroll
        for (int b = 0; b < 2; ++b)
#pragma unroll
            for (int m = 0; m < 4; ++m)
#pragma unroll
                for (int n = 0; n < 2; ++n) acc[a][b][m][n] = (f32x4){0.f, 0.f, 0.f, 0.f};
    bf16x8 At[4][2], B0[2][2], B1[2][2];
    const char* cA = (const char*)g.A + (size_t)cur.pm * tstep; const char* cB = (const char*)g.Bt + (size_t)cur.pn * tstep;
    S.a_ready(cur);
    if constexpr (SP2) {
        PG8_STAGE(PG8_SB(0, 0), cB, voffB); PG8_STAGE(PG8_SB(0, 1), cB + hstep, voffB); PG8_STAGE(PG8_SA(0, 0), cA, voffA); PG8_STAGE(PG8_SA(0, 1), cA + hstep, voffA);
        if (wr == 1) PG8_BAR;
        PG8_WAIT_V(2); PG8_BAR;
        PG8_STAGE(PG8_SB(1, 0), cB + kstep, voffB); PG8_STAGE(PG8_SA(1, 0), cA + kstep, voffA); PG8_STAGE(PG8_SB(1, 1), cB + hstep + kstep, voffB);
        PG8_WAIT_V(6); PG8_BAR;
    } else {
        PG8_STAGE(PG8_SB(0, 0), cB, voffB); PG8_STAGE(PG8_SA(0, 0), cA, voffA); PG8_STAGE(PG8_SB(0, 1), cB + hstep, voffB); PG8_STAGE(PG8_SA(0, 1), cA + hstep, voffA);
        if (wr == 1) PG8_BAR;
        PG8_WAIT_V(4); PG8_BAR;
        PG8_STAGE(PG8_SB(1, 0), cB + kstep, voffB); PG8_STAGE(PG8_SA(1, 0), cA + kstep, voffA); PG8_STAGE(PG8_SB(1, 1), cB + hstep + kstep, voffB);
        PG8_WAIT_V(6); PG8_BAR;
    }
    for (;;) {
        const bool has_next = S.next(ui + 1, nxt);
        const char* nA = has_next ? (const char*)g.A + (size_t)nxt.pm * tstep : cA; const char* nB = has_next ? (const char*)g.Bt + (size_t)nxt.pn * tstep : cB;
        for (int t = 0; t < nt; t += 2) {
            const bool last = (t == nt - 2);
            const char* a1 = cA + (size_t)(t + 1) * kstep;
            const char* a2 = last ? nA : cA + (size_t)(t + 2) * kstep; const char* b2 = last ? nB : cB + (size_t)(t + 2) * kstep;
            const char* a3 = a2 + kstep; const char* b3 = b2 + kstep;
            if (last && has_next) S.a_ready(nxt);
            if constexpr (SP2) {
            PG8_LDB(B0, 0, 0); PG8_LDB(B1, 0, 1); PG8_SCHED; PG8_LDA(At, 0, 0); PG8_STAGE(PG8_SA(1, 1), a1 + hstep, voffA);
            PG8_WAIT_V(8); PG8_WAIT_L(0); PG8_BAR; PG8_MMA(0, 0, At, B0); PG8_MMA(0, 1, At, B1); PG8_BAR; PG8_SCHED;
            PG8_LDA(At, 0, 1); PG8_STAGE(PG8_SB(0, 0), b2, voffB); PG8_STAGE(PG8_SB(0, 1), b2 + hstep, voffB); PG8_STAGE(PG8_SA(0, 0), a2, voffA);
            PG8_WAIT_V(8); PG8_WAIT_L(0); PG8_BAR; PG8_MMA(1, 0, At, B0); PG8_MMA(1, 1, At, B1); PG8_BAR; PG8_SCHED;
            PG8_LDB(B0, 1, 0); PG8_LDB(B1, 1, 1); PG8_SCHED; PG8_LDA(At, 1, 0); PG8_STAGE(PG8_SA(0, 1), a2 + hstep, voffA);
            PG8_WAIT_V(8); PG8_WAIT_L(0); PG8_BAR; PG8_MMA(0, 0, At, B0); PG8_MMA(0, 1, At, B1); PG8_BAR; PG8_SCHED;
            PG8_LDA(At, 1, 1); PG8_STAGE(PG8_SB(1, 0), b3, voffB); PG8_STAGE(PG8_SB(1, 1), b3 + hstep, voffB); PG8_STAGE(PG8_SA(1, 0), a3, voffA);
            PG8_WAIT_V(8); PG8_WAIT_L(0); PG8_BAR; PG8_MMA(1, 0, At, B0); PG8_MMA(1, 1, At, B1); PG8_BAR; PG8_SCHED;
            } else {
            PG8_LDB(B0, 0, 0); PG8_SCHED; PG8_LDA(At, 0, 0); PG8_STAGE(PG8_SA(1, 1), a1 + hstep, voffA);
            PG8_WAIT_L(8); PG8_BAR; PG8_WAIT_L(0); PG8_MMA(0, 0, At, B0); PG8_BAR; PG8_SCHED;
            PG8_LDB(B1, 0, 1); PG8_STAGE(PG8_SB(0, 0), b2, voffB);
            PG8_BAR; PG8_WAIT_L(0); PG8_MMA(0, 1, At, B1); PG8_BAR;
            PG8_LDA(At, 0, 1); PG8_STAGE(PG8_SA(0, 0), a2, voffA);
            PG8_BAR; PG8_WAIT_L(0); PG8_MMA(1, 0, At, B0); PG8_BAR; PG8_SCHED;
            PG8_STAGE(PG8_SB(0, 1), b2 + hstep, voffB);
            PG8_WAIT_V(6); PG8_BAR; PG8_MMA(1, 1, At, B1); PG8_BAR;
            PG8_LDB(B0, 1, 0); PG8_SCHED; PG8_LDA(At, 1, 0); PG8_STAGE(PG8_SA(0, 1), a2 + hstep, voffA);
            PG8_WAIT_L(8); PG8_BAR; PG8_WAIT_L(0); PG8_MMA(0, 0, At, B0); PG8_BAR; PG8_SCHED;
            PG8_LDB(B1, 1, 1); PG8_STAGE(PG8_SB(1, 0), b3, voffB);
            PG8_BAR; PG8_WAIT_L(0); PG8_MMA(0, 1, At, B1); PG8_BAR;
            PG8_LDA(At, 1, 1); PG8_STAGE(PG8_SA(1, 0), a3, voffA);
            PG8_BAR; PG8_WAIT_L(0); PG8_MMA(1, 0, At, B0); PG8_BAR; PG8_SCHED;
            PG8_STAGE(PG8_SB(1, 1), b3 + hstep, voffB);
            PG8_WAIT_V(6); PG8_BAR; PG8_MMA(1, 1, At, B1); PG8_BAR;
            }
        }
        if constexpr (ALIGN_EPI) { if (wr == 0) PG8_BAR; }
        if constexpr (!Epi::AFTER_DRAIN) { E(acc, cur, wr, wc, fr, fq); S.done(cur); }
        if (!has_next) break;
#pragma unroll
        for (int a = 0; a < 2; ++a)
#pragma unroll
            for (int b = 0; b < 2; ++b)
#pragma unroll
                for (int m = 0; m < 4; ++m)
#pragma unroll
                    for (int n = 0; n < 2; ++n) acc[a][b][m][n] = (f32x4){0.f, 0.f, 0.f, 0.f};
        cur = nxt; cA = nA; cB = nB; ++ui;
        if constexpr (ALIGN_EPI) { if (wr == 1) PG8_BAR; }
    }
    PG8_WAIT_V(0);
    if constexpr (!ALIGN_EPI) { if (wr == 0) PG8_BAR; }
    PG8_BAR;
    if constexpr (Epi::AFTER_DRAIN) { E.fused(acc, cur, wr, wc, fr, fq, lds, wid, lane); S.done(cur); }
#undef PG8_SA
#undef PG8_SB
#undef PG8_STAGE
#undef PG8_LDA
#undef PG8_LDB
#undef PG8_MMA
#undef PG8_WAIT_V
#undef PG8_WAIT_L
#undef PG8_BAR
#undef PG8_SCHED
}
}
#define XB_TMO      128
#define XB_XCNT(j)  (256  + 64 * (j))
#define XB_XSUB(j)  (1280 + 64 * (j))
#define XB_XGEN(j)  (2304 + 64 * (j))
#define XB_TOP      3328
#define XB_TOPGEN   3392
#define XCD_BAR_WORDS 3456
#define XB_SPIN_CAP (1u << 18)

__device__ __forceinline__ unsigned xb_ld(unsigned* p)              { return __hip_atomic_load(p, __ATOMIC_RELAXED, __HIP_MEMORY_SCOPE_AGENT); }
__device__ __forceinline__ unsigned xb_add(unsigned* p, unsigned v) { return __hip_atomic_fetch_add(p, v, __ATOMIC_RELAXED, __HIP_MEMORY_SCOPE_AGENT); }
__device__ __forceinline__ unsigned xb_xcc_id() { return (unsigned)__builtin_amdgcn_s_getreg((3 << 11) | 20) & 0xFu; }
#define XB_SPIN(cond, bar) do { unsigned _sp = 0; while (cond) { __builtin_amdgcn_s_sleep(1); \
    if ((++_sp & 255u) == 0u) { if (xb_ld(&(bar)[XB_TMO])) break; if (_sp > XB_SPIN_CAP) { atomicAdd(&(bar)[XB_TMO], 1u); break; } } } } while (0)

struct XcdBarrier {
    unsigned* bar; unsigned x;
    volatile LAS unsigned* st;
};

__device__ __forceinline__ XcdBarrier xcd_barrier_post(unsigned* bar, volatile LAS unsigned* st) {
    XcdBarrier b; b.bar = bar; b.x = xb_xcc_id(); b.st = st;
    if (threadIdx.x == 0) (void)xb_add(&bar[XB_XCNT(b.x)], 1u);
    return b;
}
__device__ __forceinline__ void xcd_barrier_complete(unsigned* bar, unsigned x, unsigned& nloc, unsigned& nx) {
    const unsigned G = gridDim.x * gridDim.y * gridDim.z;
    unsigned sum, cnt, mine, sp = 0u;
    for (;;) {
        sum = 0u; cnt = 0u; mine = 0u;
#pragma unroll
        for (unsigned j = 0; j < 16; ++j) { const unsigned c = xb_ld(&bar[XB_XCNT(j)]); sum += c; cnt += (c > 0u) ? 1u : 0u; mine = (j == x) ? c : mine; }
        if (sum == G) break;
        __builtin_amdgcn_s_sleep(1);
        if ((++sp & 255u) == 0u) { if (xb_ld(&bar[XB_TMO])) break; if (sp > XB_SPIN_CAP) { atomicAdd(&bar[XB_TMO], 1u); break; } }
    }
    nloc = mine > 0u ? mine : 1u; nx = cnt > 0u ? cnt : 1u;
}

__device__ __forceinline__ void xcd_barrier(const XcdBarrier& b) {
    asm volatile("s_waitcnt vmcnt(0)" ::: "memory");
    __syncthreads();
    if (threadIdx.x == 0) {
        unsigned* bar = b.bar;
        __builtin_amdgcn_s_waitcnt(0);
        unsigned nloc = b.st[0], nx = b.st[1];
        if (nloc == 0u) { xcd_barrier_complete(bar, b.x, nloc, nx); b.st[0] = nloc; b.st[1] = nx; }
        const unsigned old = xb_add(&bar[XB_XSUB(b.x)], 1u);
        const unsigned gen = old / nloc;
        if (old + 1u == (gen + 1u) * nloc) {
            __builtin_amdgcn_fence(__ATOMIC_RELEASE, "agent");
            asm volatile("s_waitcnt vmcnt(0)" ::: "memory");
            const unsigned og = xb_add(&bar[XB_TOP], 1u);
            const unsigned tg = og / nx;
            if (og + 1u == (tg + 1u) * nx) xb_add(&bar[XB_TOPGEN], 1u);
            else XB_SPIN(xb_ld(&bar[XB_TOPGEN]) == tg, bar);
            __builtin_amdgcn_fence(__ATOMIC_ACQUIRE, "agent");
            xb_add(&bar[XB_XGEN(b.x)], 1u);
            asm volatile("s_waitcnt vmcnt(0)" ::: "memory");
        } else {
            XB_SPIN(xb_ld(&bar[XB_XGEN(b.x)]) == gen, bar);
            __builtin_amdgcn_fence(__ATOMIC_ACQUIRE, "agent");
            asm volatile("s_waitcnt vmcnt(0)" ::: "memory");
        }
    }
    __syncthreads();
}
namespace mk {
typedef unsigned short bf16;
typedef unsigned v4u __attribute__((ext_vector_type(4)));
typedef unsigned v2u __attribute__((ext_vector_type(2)));
typedef float f32x4 __attribute__((ext_vector_type(4)));
typedef float f32x16 __attribute__((ext_vector_type(16)));
typedef short bf16x8 __attribute__((ext_vector_type(8)));
typedef short bf16x4 __attribute__((ext_vector_type(4)));

constexpr int T = 32768, D = 1024, SQ = 4096, NIN = 2816, NQ = 2048, PLE = 256, NEXP = 16384;
constexpr int NWAVES = 8, NTHR = 512;
constexpr int RING_BYTES = 131072, LDS_BYTES = 163840, MISC_OFF = LDS_BYTES - 256;

constexpr size_t MB = 1024 * 1024;
constexpr size_t WS_CTL = 0, CTL_BYTES = 256 * 1024;
constexpr size_t WS_WIN = WS_CTL + CTL_BYTES;
constexpr size_t WS_WOUT = WS_WIN + (size_t)NIN * D * 2;
constexpr size_t WS_WQ = WS_WOUT + (size_t)D * D * 2;
constexpr size_t WS_WG = WS_WQ + (size_t)NQ * D * 2;
constexpr size_t WS_WP = WS_WG + (size_t)D * D * 2;
constexpr size_t WS_KEYS = WS_WP + (size_t)D * PLE * 2;
constexpr size_t WS_ROPE = WS_KEYS + 2 * 128 * 128 * 2;
constexpr size_t WS_SU = WS_ROPE + 2 * (size_t)SQ * 32 * 4;
constexpr size_t WS_SV = WS_SU + 65536;
constexpr size_t WS_SH = WS_SV + 65536;
constexpr size_t WS_SHS = WS_SH + (size_t)T * 4;
constexpr size_t WS_UB = 16 * MB;
constexpr size_t WS_VB = 32 * MB;
constexpr size_t WS_PB = 48 * MB;
constexpr size_t WS_PK = 64 * MB;
constexpr size_t WS_R1 = 96 * MB;
constexpr size_t WS_R2 = 160 * MB;
constexpr size_t WS_PP = 352 * MB;
constexpr size_t WS_RSS2 = 80 * MB;
constexpr size_t WS_RSTD0 = 82 * MB;
constexpr size_t WS_XB0 = 416 * MB;
constexpr size_t WS_END = 480 * MB;
static_assert(WS_SHS + (size_t)T * 4 <= WS_UB, "ws map");
constexpr int CW_BAR = 1024;

#define LDS_WAIT() asm volatile("s_waitcnt lgkmcnt(0)" ::: "memory")
#define VM_WAIT() asm volatile("s_waitcnt vmcnt(0)" ::: "memory")
typedef float f32x2 __attribute__((ext_vector_type(2)));
typedef int v2i __attribute__((ext_vector_type(2)));
typedef __bf16 b16x2 __attribute__((ext_vector_type(2)));
__device__ __forceinline__ unsigned pk2(float lo, float hi) { const f32x2 v = {lo, hi}; return __builtin_bit_cast(unsigned, __builtin_convertvector(v, b16x2)); }
__device__ __forceinline__ float bf_lo(unsigned w) { return __uint_as_float(w << 16); }
__device__ __forceinline__ float bf_hi(unsigned w) { return __uint_as_float(w & 0xffff0000u); }
__device__ __forceinline__ float wave_sum(float v) {
#pragma unroll
    for (int o = 1; o < 64; o <<= 1) v += __shfl_xor(v, o);
    return v;
}

#ifndef PROBE_ON
#define PT_DECL
#define PT_ARG
#define PT_BEGIN()
#define PT_ADD(k)
#endif
struct Args { const float* in[16]; float* out; unsigned char* ws; int ph_lo, ph_hi, li, pad; };

struct EpiStoreBf16 {
    static constexpr bool PERM = true, AFTER_DRAIN = false;
    bf16* O; int ldc; const float* rowscale;
    __device__ __forceinline__ void operator()(const pg8::f32x4 (&acc)[2][2][4][2], const pg8::Unit& u, int wr, int wc, int fr, int fq) const {
        const int row0 = u.pm * 256 + wr * 64 + fr, col0 = u.pn * 256 + wc * 32 + 8 * fq;
#pragma unroll
        for (int ai = 0; ai < 2; ++ai)
#pragma unroll
            for (int m = 0; m < 4; ++m) { bf16* rowp = O + (size_t)(row0 + ai * 128 + m * 16) * ldc + col0; const float rsc = rowscale ? rowscale[row0 + ai * 128 + m * 16] : 1.0f;
#pragma unroll
                for (int bj = 0; bj < 2; ++bj) { const pg8::f32x4 v0 = acc[ai][bj][m][0] * rsc, v1 = acc[ai][bj][m][1] * rsc;
                    pg8::u32x4 w; w.x = pk2(v0[0], v0[1]); w.y = pk2(v0[2], v0[3]); w.z = pk2(v1[0], v1[1]); w.w = pk2(v1[2], v1[3]);
                    *(pg8::u32x4*)(rowp + bj * 128) = w; } }
    }
};


struct EpiResid {
    static constexpr bool PERM = true, AFTER_DRAIN = false;
    const bf16* X; bf16* XB;
    __device__ __forceinline__ void operator()(const pg8::f32x4 (&acc)[2][2][4][2], const pg8::Unit& u, int wr, int wc, int fr, int fq) const {
        const int row0 = u.pm * 256 + wr * 64 + fr, col0 = u.pn * 256 + wc * 32 + 8 * fq;
#pragma unroll
        for (int ai = 0; ai < 2; ++ai)
#pragma unroll
            for (int m = 0; m < 4; ++m) { const size_t off = (size_t)(row0 + ai * 128 + m * 16) * D + col0;
#pragma unroll
                for (int bj = 0; bj < 2; ++bj) { const size_t o2 = off + bj * 128;
                    const pg8::u32x4 xw = *(const pg8::u32x4*)(X + o2);
                    const pg8::f32x4 v0 = acc[ai][bj][m][0] + (pg8::f32x4){bf_lo(xw.x), bf_hi(xw.x), bf_lo(xw.y), bf_hi(xw.y)}, v1 = acc[ai][bj][m][1] + (pg8::f32x4){bf_lo(xw.z), bf_hi(xw.z), bf_lo(xw.w), bf_hi(xw.w)};
                    pg8::u32x4 w; w.x = pk2(v0[0], v0[1]); w.y = pk2(v0[2], v0[3]); w.z = pk2(v1[0], v1[1]); w.w = pk2(v1[2], v1[3]);
                    *(pg8::u32x4*)(XB + o2) = w; } }
    }
};
struct EpiGate {
    static constexpr bool PERM = true, AFTER_DRAIN = false;
    float* O; const bf16* XB; const bf16* PP; const float* rss;
    __device__ __forceinline__ void operator()(const pg8::f32x4 (&acc)[2][2][4][2], const pg8::Unit& u, int wr, int wc, int fr, int fq) const {
        const int row0 = u.pm * 256 + wr * 64 + fr, col0 = u.pn * 256 + wc * 32 + 8 * fq;
#pragma unroll
        for (int ai = 0; ai < 2; ++ai)
#pragma unroll
            for (int m = 0; m < 4; ++m) { const int row = row0 + ai * 128 + m * 16; const size_t off = (size_t)row * D + col0;
                const pg8::f32x4 q0 = *(const pg8::f32x4*)(rss + (size_t)row * 8), q1 = *(const pg8::f32x4*)(rss + (size_t)row * 8 + 4);
                const float rs = 1.0f / sqrtf((((q0[0] + q0[1]) + (q0[2] + q0[3])) + ((q1[0] + q1[1]) + (q1[2] + q1[3]))) * (1.0f / D) + 1e-6f);
#pragma unroll
                for (int bj = 0; bj < 2; ++bj) { const size_t o2 = off + bj * 128;
                    const pg8::u32x4 pw = *(const pg8::u32x4*)(PP + o2), xw = *(const pg8::u32x4*)(XB + o2);
                    const pg8::f32x4 a0 = acc[ai][bj][m][0] * rs, a1 = acc[ai][bj][m][1] * rs;
                    pg8::f32x4 x0, x1;
                    x0[0] = bf_lo(xw.x) + bf_lo(pw.x) * __builtin_amdgcn_rcpf(1.0f + __expf(-a0[0])); x0[1] = bf_hi(xw.x) + bf_hi(pw.x) * __builtin_amdgcn_rcpf(1.0f + __expf(-a0[1])); x0[2] = bf_lo(xw.y) + bf_lo(pw.y) * __builtin_amdgcn_rcpf(1.0f + __expf(-a0[2])); x0[3] = bf_hi(xw.y) + bf_hi(pw.y) * __builtin_amdgcn_rcpf(1.0f + __expf(-a0[3]));
                    x1[0] = bf_lo(xw.z) + bf_lo(pw.z) * __builtin_amdgcn_rcpf(1.0f + __expf(-a1[0])); x1[1] = bf_hi(xw.z) + bf_hi(pw.z) * __builtin_amdgcn_rcpf(1.0f + __expf(-a1[1])); x1[2] = bf_lo(xw.w) + bf_lo(pw.w) * __builtin_amdgcn_rcpf(1.0f + __expf(-a1[2])); x1[3] = bf_hi(xw.w) + bf_hi(pw.w) * __builtin_amdgcn_rcpf(1.0f + __expf(-a1[3]));
                    *(pg8::f32x4*)(O + o2) = x0; *(pg8::f32x4*)(O + o2 + 4) = x1; } }
    }
};

__device__ __forceinline__ void p0_transpose_item(const float* __restrict__ W, const float* __restrict__ gsc, int K, int N, bf16* __restrict__ WT, LAS float* scr, int item, int lane) {
    const int nblk = N / 32, kb = item / nblk, nb = item % nblk, k0 = 64 * kb, n0 = 32 * nb;
    float wv[32];
#pragma unroll
    for (int i = 0; i < 32; ++i) { const int kk = 2 * i + (lane >> 5); wv[i] = __builtin_nontemporal_load(W + (size_t)(k0 + kk) * N + n0 + (lane & 31)); }
    if (gsc) {
#pragma unroll
        for (int i = 0; i < 32; ++i) wv[i] *= gsc[k0 + 2 * i + (lane >> 5)];
    }
#pragma unroll
    for (int i = 0; i < 32; ++i) scr[(2 * i + (lane >> 5)) * 33 + (lane & 31)] = wv[i];
    LDS_WAIT(); asm volatile("" ::: "memory");
    const int c = lane & 7;
#pragma unroll
    for (int j = 0; j < 4; ++j) { const int n = (lane >> 3) + 8 * j; const LAS float* s = scr + (8 * c) * 33 + n;
        v4u o; o.x = pk2(s[0 * 33], s[1 * 33]); o.y = pk2(s[2 * 33], s[3 * 33]); o.z = pk2(s[4 * 33], s[5 * 33]); o.w = pk2(s[6 * 33], s[7 * 33]);
        *(v4u*)(WT + (size_t)(n0 + n) * K + k0 + 8 * c) = o; }
    LDS_WAIT(); asm volatile("" ::: "memory");
}
__device__ __forceinline__ void p0_convert(const float* __restrict__ src, bf16* __restrict__ dst, size_t n8, size_t gtid, size_t gthreads) {
    size_t i = gtid;
    for (; i + 3 * gthreads < n8; i += 4 * gthreads) {
        f32x4 a[4], b[4];
#pragma unroll
        for (int r = 0; r < 4; ++r) { a[r] = __builtin_nontemporal_load((const f32x4*)src + 2 * (i + r * gthreads)); b[r] = __builtin_nontemporal_load((const f32x4*)src + 2 * (i + r * gthreads) + 1); }
#pragma unroll
        for (int r = 0; r < 4; ++r) { v4u o; o.x = pk2(a[r][0], a[r][1]); o.y = pk2(a[r][2], a[r][3]); o.z = pk2(b[r][0], b[r][1]); o.w = pk2(b[r][2], b[r][3]); __builtin_nontemporal_store(o, (v4u*)dst + i + r * gthreads); }
    }
    for (; i < n8; i += gthreads) {
        const f32x4 a = ((const f32x4*)src)[2 * i], b = ((const f32x4*)src)[2 * i + 1];
        v4u o; o.x = pk2(a[0], a[1]); o.y = pk2(a[2], a[3]); o.z = pk2(b[0], b[1]); o.w = pk2(b[2], b[3]);
        ((v4u*)dst)[i] = o;
    }
}
__device__ __forceinline__ void rms_row_to_bf16(const float* __restrict__ xrow, const float* __restrict__ g, bf16* __restrict__ orow, int lane) {
    const f32x4* xr = (const f32x4*)xrow + lane; const f32x4* gr = (const f32x4*)g + lane;
    f32x4 v[4]; float s = 0.f;
#pragma unroll
    for (int j = 0; j < 4; ++j) { v[j] = xr[64 * j]; s += (v[j][0] * v[j][0] + v[j][1] * v[j][1]) + (v[j][2] * v[j][2] + v[j][3] * v[j][3]); }
    const float rstd = 1.0f / sqrtf(wave_sum(s) * (1.0f / D) + 1e-6f);
    v2u* o8 = (v2u*)orow + lane;
#pragma unroll
    for (int j = 0; j < 4; ++j) { const f32x4 gg = gr[64 * j]; v2u w; w.x = pk2(v[j][0] * rstd * gg[0], v[j][1] * rstd * gg[1]); w.y = pk2(v[j][2] * rstd * gg[2], v[j][3] * rstd * gg[3]); o8[64 * j] = w; }
}

__device__ __forceinline__ void quant_rows(const Args& a, int r0, int rstride, int cnt, int lane) {
    unsigned char* ws = a.ws;
    f32x4 xs[4][4];
#pragma unroll
    for (int rr = 0; rr < 4; ++rr) {
        const int r = r0 + rr * rstride; const bool ok = rr < cnt && r < 2 * NEXP; const int rc = ok ? r : 0; const int isv = rc >= NEXP, e = isv ? rc - NEXP : rc;
        const f32x4* src = (const f32x4*)((isv ? a.in[12] : a.in[11]) + (size_t)e * D) + lane;
#pragma unroll
        for (int j = 0; j < 4; ++j) xs[rr][j] = __builtin_nontemporal_load(src + 64 * j);
    }
#pragma unroll
    for (int rr = 0; rr < 4; ++rr) {
        const int r = r0 + rr * rstride; const bool ok = rr < cnt && r < 2 * NEXP; const int rc = ok ? r : 0; const int isv = rc >= NEXP, e = isv ? rc - NEXP : rc;
        float am = 0.f, sq = 0.f;
#pragma unroll
        for (int j = 0; j < 4; ++j)
#pragma unroll
            for (int u = 0; u < 4; ++u) { am = fmaxf(am, fabsf(xs[rr][j][u])); sq += xs[rr][j][u] * xs[rr][j][u]; }
#pragma unroll
        for (int o = 1; o < 64; o <<= 1) { am = fmaxf(am, __shfl_xor(am, o)); sq += __shfl_xor(sq, o); }
        if (ok && isv) {
            const float step = fminf(0.355f * sqrtf(sq * (1.0f / D)), am * (1.0f / 7.0f));
            const float inv = step > 0.f ? 1.0f / step : 0.f;
#pragma unroll
            for (int j = 0; j < 4; ++j) { unsigned ww = 0u;
#pragma unroll
                for (int u = 0; u < 4; ++u) { int t = __float2int_rn(xs[rr][j][u] * inv); t = t < -7 ? -7 : t > 7 ? 7 : t; ww |= ((unsigned)t & 0xfu) << (4 * u); }
                __builtin_nontemporal_store((unsigned short)ww, (unsigned short*)(ws + WS_VB + (size_t)j * ((size_t)NEXP * 128) + (size_t)e * 128 + 2 * lane)); }
            if (lane == 0) ((float*)(ws + WS_SV))[e] = step;
        } else if (ok) {
            const float step = fminf(0.3352f * sqrtf(sq * (1.0f / D)), am * (1.0f / 7.5f));
            const float inv = step > 0.f ? 1.0f / step : 0.f;
#pragma unroll
            for (int j = 0; j < 4; ++j) { unsigned ww = 0u;
#pragma unroll
                for (int u = 0; u < 4; ++u) { int t = (int)floorf(xs[rr][j][u] * inv); t = t < -8 ? -8 : t > 7 ? 7 : t; ww |= ((unsigned)t & 0xfu) << (4 * u); }
                __builtin_nontemporal_store((unsigned short)ww, (unsigned short*)(ws + WS_UB + (size_t)e * 512 + 2 * lane + 128 * j)); }
            if (lane == 0) ((float*)(ws + WS_SU))[e] = step;
        }
    }
}
__device__ __forceinline__ void xcd_barrier_work(const XcdBarrier& b, const Args& a, LAS unsigned char* lds, int k, int vcu, int G, int wave, int lane) {
    asm volatile("s_waitcnt vmcnt(0)" ::: "memory");
    __syncthreads();
    if (wave == 0) {
      if (threadIdx.x == 0) {
        unsigned* bar = b.bar;
        __builtin_amdgcn_s_waitcnt(0);
        unsigned nloc = b.st[0], nx = b.st[1];
        if (nloc == 0u) { xcd_barrier_complete(bar, b.x, nloc, nx); b.st[0] = nloc; b.st[1] = nx; }
        const unsigned old = xb_add(&bar[XB_XSUB(b.x)], 1u);
        const unsigned gen = old / nloc;
        if (old + 1u == (gen + 1u) * nloc) {
            __builtin_amdgcn_fence(__ATOMIC_RELEASE, "agent");
            asm volatile("s_waitcnt vmcnt(0)" ::: "memory");
            const unsigned og = xb_add(&bar[XB_TOP], 1u);
            const unsigned tg = og / nx;
            if (og + 1u == (tg + 1u) * nx) xb_add(&bar[XB_TOPGEN], 1u);
            else XB_SPIN(xb_ld(&bar[XB_TOPGEN]) == tg, bar);
            __builtin_amdgcn_fence(__ATOMIC_ACQUIRE, "agent");
            xb_add(&bar[XB_XGEN(b.x)], 1u);
            asm volatile("s_waitcnt vmcnt(0)" ::: "memory");
        } else {
            XB_SPIN(xb_ld(&bar[XB_XGEN(b.x)]) == gen, bar);
            __builtin_amdgcn_fence(__ATOMIC_ACQUIRE, "agent");
            asm volatile("s_waitcnt vmcnt(0)" ::: "memory");
        }
      }
    } else {
        const int NW = G * (NWAVES - 1), gww = vcu * (NWAVES - 1) + (wave - 1);
        if (k == 1) {
            constexpr int I_OUT = (D / 64) * (D / 32), I_Q = (D / 64) * (NQ / 32), I_G = I_OUT;
            LAS float* scr = (LAS float*)(lds + wave * 16384);
            for (int it = gww; it < I_OUT + I_Q + I_G; it += NW) {
                int r = it;
                if (r < I_OUT) { p0_transpose_item(a.in[7], nullptr, D, D, (bf16*)(a.ws + WS_WOUT), scr, r, lane); continue; } r -= I_OUT;
                if (r < I_Q) { p0_transpose_item(a.in[9], a.in[8], D, NQ, (bf16*)(a.ws + WS_WQ), scr, r, lane); continue; } r -= I_Q;
                p0_transpose_item(a.in[14], a.in[13], D, D, (bf16*)(a.ws + WS_WG), scr, r, lane);
            }
        }
        { const int cnt = (k < 3) ? 5 : (k == 3) ? 4 : 0, before = 5 * (k < 3 ? k : 3);
          if (cnt > 0) { quant_rows(a, before * NW + gww, NW, 4, lane); if (cnt > 4) quant_rows(a, (before + 4) * NW + gww, NW, 1, lane); } }
    }
    __syncthreads();
}

__device__ __forceinline__ void p0_prologue(const Args& a, LAS unsigned char* lds, int vcu, int G, int tid, int lane, int wave) {
    unsigned char* ws = a.ws;
    LAS float* scr = (LAS float*)(lds + wave * 16384);
    const int gw = vcu * NWAVES + wave, NGW = G * NWAVES;
    constexpr int I_IN = (D / 64) * (NIN / 32), I_P = (PLE / 64) * (D / 32);
    constexpr int NITEMS = I_IN + I_P;
    for (int it = gw; it < NITEMS; it += NGW) {
        int r = it;
        if (r < I_IN) { p0_transpose_item(a.in[3], a.in[2], D, NIN, (bf16*)(ws + WS_WIN), scr, r, lane); continue; } r -= I_IN;
        p0_transpose_item(a.in[15], nullptr, PLE, D, (bf16*)(ws + WS_WP), scr, r, lane);
    }
    const size_t gtid = (size_t)vcu * NTHR + tid, gthreads = (size_t)G * NTHR;
    p0_convert(a.in[10], (bf16*)(ws + WS_KEYS), 2 * 128 * 128 / 8, gtid, gthreads);
    p0_convert(a.in[1], (bf16*)(ws + WS_PB), (size_t)T * PLE / 8, gtid, gthreads);
    for (size_t i = gtid; i < (size_t)SQ * 32; i += gthreads) {
        const int pos = (int)(i >> 5), c = (int)(i & 31);
        const float freq = powf(10000.0f, -(float)c / 32.0f);
        const float ang = (float)pos * freq;
        float sn, cs; sincosf(ang, &sn, &cs);
        ((float*)(ws + WS_ROPE))[i] = cs; ((float*)(ws + WS_ROPE))[(size_t)SQ * 32 + i] = sn;
    }
    for (int m0 = gw; m0 < T; m0 += 4 * NGW) {
        f32x4 v[4][4]; float ssq[4];
#pragma unroll
        for (int rr = 0; rr < 4; ++rr) { const f32x4* xr = (const f32x4*)(a.in[0] + (size_t)(m0 + rr * NGW) * D) + lane;
#pragma unroll
            for (int j = 0; j < 4; ++j) v[rr][j] = __builtin_nontemporal_load(xr + 64 * j); }
#pragma unroll
        for (int rr = 0; rr < 4; ++rr) { float sq = 0.f;
#pragma unroll
            for (int j = 0; j < 4; ++j) sq += (v[rr][j][0] * v[rr][j][0] + v[rr][j][1] * v[rr][j][1]) + (v[rr][j][2] * v[rr][j][2] + v[rr][j][3] * v[rr][j][3]);
            ssq[rr] = sq; }
#pragma unroll
        for (int o = 1; o < 64; o <<= 1)
#pragma unroll
            for (int rr = 0; rr < 4; ++rr) ssq[rr] += __shfl_xor(ssq[rr], o);
#pragma unroll
        for (int rr = 0; rr < 4; ++rr) { const float rstd = 1.0f / sqrtf(ssq[rr] * (1.0f / D) + 1e-6f); v2u* o8 = (v2u*)((bf16*)(ws + WS_XB0) + (size_t)(m0 + rr * NGW) * D) + lane;
            if (lane == 0) ((float*)(ws + WS_RSTD0))[m0 + rr * NGW] = rstd;
#pragma unroll
            for (int j = 0; j < 4; ++j) { v2u w; w.x = pk2(v[rr][j][0], v[rr][j][1]); w.y = pk2(v[rr][j][2], v[rr][j][3]); o8[64 * j] = w; } }
    }
}


#define MFMA32(a, b, c) __builtin_amdgcn_mfma_f32_32x32x16_bf16((a), (b), (c), 0, 0, 0)
__device__ __forceinline__ int crow(int r, int hf) { return (r & 3) + 8 * (r >> 2) + 4 * hf; }
__device__ __forceinline__ bf16x8 pack8(float a0, float a1, float a2, float a3, float a4, float a5, float a6, float a7) {
    v4u w; w.x = pk2(a0, a1); w.y = pk2(a2, a3); w.z = pk2(a4, a5); w.w = pk2(a6, a7); return __builtin_bit_cast(bf16x8, w);
}
__device__ __forceinline__ bf16x8 lds_frag16(LAS unsigned char* p) { return *(const LAS bf16x8*)p; }
__device__ __forceinline__ bf16x8 lds_frag8x2(LAS unsigned char* p) {
    const bf16x4 lo = *(const LAS bf16x4*)p, hi = *(const LAS bf16x4*)(p + 16); return __builtin_shufflevector(lo, hi, 0, 1, 2, 3, 4, 5, 6, 7);
}
typedef short s16x4 __attribute__((ext_vector_type(4)));
__device__ __forceinline__ s16x4 lds_tr4(LAS unsigned char* tile, int r0, int c0, int lane) {
    const int i = lane & 15;
    return __builtin_amdgcn_ds_read_tr16_b64_v4i16((LAS s16x4*)(tile + (r0 + (i >> 2)) * 144 + (c0 + 16 * ((lane >> 4) & 1) + 4 * (i & 3)) * 2));
}
__device__ __forceinline__ bf16x8 cat8(s16x4 lo, s16x4 hi) { return __builtin_shufflevector(lo, hi, 0, 1, 2, 3, 4, 5, 6, 7); }
constexpr int RQ = 144;
constexpr int LR_QS = 0, LR_KS = LR_QS + 128 * RQ, LR_VS = LR_KS + 128 * RQ, LR_ST = LR_VS + 128 * RQ, LR_LN = LR_ST + 64 * RQ, LR_V1 = LR_LN + 2 * 128 * 8, LR_END = LR_V1 + 128 * RQ;
static_assert(LR_END <= RING_BYTES, "retention LDS");
__device__ __forceinline__ void ret_unit(const bf16* __restrict__ PROJ, bf16* __restrict__ MIXED, const float* __restrict__ rope, LAS unsigned char* lds,
                                         int b, int h, int c0, int c1, int tid, int lane, int wave) {
    const float gam = 1.0f - exp2f(-5.0f - (float)h), lg2 = log2f(gam), cd = exp2f(lg2 * 128.0f);
    const int l31 = lane & 31, hf = lane >> 5, ib = wave >> 1, et = wave & 1;
    const int r = tid >> 2, qd = tid & 3;
    const float wq = exp2f(lg2 * (float)(r + 1)), wk = exp2f(-lg2 * (float)(r + 1));
    f32x16 stacc;
#pragma unroll
    for (int i = 0; i < 16; ++i) stacc[i] = 0.f;
    for (int i = tid; i < 64 * RQ / 4; i += NTHR) ((LAS unsigned*)(lds + LR_ST))[i] = 0u;
    v4u k1, k2, v1, v2, q1 = {0u, 0u, 0u, 0u}, q2 = {0u, 0u, 0u, 0u}; f32x4 csa, csb, sna, snb; v2u gvn[4] = {{0u, 0u}, {0u, 0u}, {0u, 0u}, {0u, 0u}};
#define RET_LOAD(nn) do { const int sp_ = (nn) * 128 + r; const bf16* pr_ = PROJ + ((size_t)b * SQ + sp_) * NIN + h * 64 + 8 * qd; \
        k1 = *(const v4u*)(pr_ + 512); k2 = *(const v4u*)(pr_ + 512 + 32); v1 = *(const v4u*)(pr_ + 1024); v2 = *(const v4u*)(pr_ + 1024 + 32); \
        if ((nn) >= c0) { q1 = *(const v4u*)(pr_); q2 = *(const v4u*)(pr_ + 32); \
            const bf16* gp_ = PROJ + ((size_t)b * SQ + (nn) * 128 + 32 * ib + l31) * NIN + 1536 + h * 64 + 32 * et + 4 * hf; \
            gvn[0] = *(const v2u*)gp_; gvn[1] = *(const v2u*)(gp_ + 8); gvn[2] = *(const v2u*)(gp_ + 16); gvn[3] = *(const v2u*)(gp_ + 24); } \
        csa = *(const f32x4*)(rope + sp_ * 32 + 8 * qd); csb = *(const f32x4*)(rope + sp_ * 32 + 8 * qd + 4); \
        sna = *(const f32x4*)(rope + SQ * 32 + sp_ * 32 + 8 * qd); snb = *(const f32x4*)(rope + SQ * 32 + sp_ * 32 + 8 * qd + 4); } while (0)
    int nstart = 0;
    if (c0 >= 2) {
        v4u kr[4][4];
        float rc[8], rs[8], dc[8], dsn[8];
        { const f32x4 c0v = *(const f32x4*)(rope + r * 32 + 8 * qd), c1v = *(const f32x4*)(rope + r * 32 + 8 * qd + 4), s0v = *(const f32x4*)(rope + SQ * 32 + r * 32 + 8 * qd), s1v = *(const f32x4*)(rope + SQ * 32 + r * 32 + 8 * qd + 4);
          const f32x4 d0v = *(const f32x4*)(rope + 128 * 32 + 8 * qd), d1v = *(const f32x4*)(rope + 128 * 32 + 8 * qd + 4), e0v = *(const f32x4*)(rope + SQ * 32 + 128 * 32 + 8 * qd), e1v = *(const f32x4*)(rope + SQ * 32 + 128 * 32 + 8 * qd + 4);
#pragma unroll
          for (int u = 0; u < 4; ++u) { rc[u] = c0v[u]; rc[4 + u] = c1v[u]; rs[u] = s0v[u]; rs[4 + u] = s1v[u]; dc[u] = d0v[u]; dc[4 + u] = d1v[u]; dsn[u] = e0v[u]; dsn[4 + u] = e1v[u]; } }
#define PRE_LOAD(slot, nn) do { const bf16* pr_ = PROJ + ((size_t)b * SQ + (nn) * 128 + r) * NIN + h * 64 + 8 * qd; \
        kr[slot][0] = *(const v4u*)(pr_ + 512); kr[slot][1] = *(const v4u*)(pr_ + 512 + 32); kr[slot][2] = *(const v4u*)(pr_ + 1024); kr[slot][3] = *(const v4u*)(pr_ + 1024 + 32); } while (0)
#define PRE_STAGE(slot, KT_, VT_) do { float o1_[8], o2_[8]; \
        _Pragma("unroll") for (int u = 0; u < 8; ++u) { const unsigned w1_ = kr[slot][0][u >> 1], w2_ = kr[slot][1][u >> 1]; const float x1_ = (u & 1) ? bf_hi(w1_) : bf_lo(w1_), x2_ = (u & 1) ? bf_hi(w2_) : bf_lo(w2_); \
            o1_[u] = (x1_ * rc[u] - x2_ * rs[u]) * wk; o2_[u] = (x1_ * rs[u] + x2_ * rc[u]) * wk; \
            const float nc_ = rc[u] * dc[u] - rs[u] * dsn[u], ns_ = rs[u] * dc[u] + rc[u] * dsn[u]; rc[u] = nc_; rs[u] = ns_; } \
        *(LAS bf16x8*)(lds + (KT_) + r * RQ + (8 * qd) * 2) = pack8(o1_[0], o1_[1], o1_[2], o1_[3], o1_[4], o1_[5], o1_[6], o1_[7]); \
        *(LAS bf16x8*)(lds + (KT_) + r * RQ + (32 + 8 * qd) * 2) = pack8(o2_[0], o2_[1], o2_[2], o2_[3], o2_[4], o2_[5], o2_[6], o2_[7]); \
        *(LAS v4u*)(lds + (VT_) + r * RQ + (8 * qd) * 2) = kr[slot][2]; *(LAS v4u*)(lds + (VT_) + r * RQ + (32 + 8 * qd) * 2) = kr[slot][3]; } while (0)
        const int npair = c0 >> 1;
        PRE_LOAD(0, 0); PRE_LOAD(1, 1);
        if (npair > 1) { PRE_LOAD(2, 2); PRE_LOAD(3, 3); }
#define PRE_STEP(S0, S1, NS0, NS1, pp) do { \
            __syncthreads(); \
            PRE_STAGE(S0, LR_KS, LR_VS); PRE_STAGE(S1, LR_QS, LR_V1); \
            if ((pp) + 2 < npair) { PRE_LOAD(NS0, 2 * ((pp) + 2)); PRE_LOAD(NS1, 2 * ((pp) + 2) + 1); } \
            __syncthreads(); \
            if (wave < 4) { const int se = wave >> 1, sd = wave & 1; f32x16 t0, t1; \
                _Pragma("unroll") for (int i = 0; i < 16; ++i) { t0[i] = 0.f; t1[i] = 0.f; } \
                _Pragma("unroll") for (int ks = 0; ks < 8; ++ks) { \
                    t0 = MFMA32(cat8(lds_tr4(lds + LR_VS, 16 * ks + 8 * hf, 32 * se, lane), lds_tr4(lds + LR_VS, 16 * ks + 8 * hf + 4, 32 * se, lane)), \
                                cat8(lds_tr4(lds + LR_KS, 16 * ks + 8 * hf, 32 * sd, lane), lds_tr4(lds + LR_KS, 16 * ks + 8 * hf + 4, 32 * sd, lane)), t0); \
                    t1 = MFMA32(cat8(lds_tr4(lds + LR_V1, 16 * ks + 8 * hf, 32 * se, lane), lds_tr4(lds + LR_V1, 16 * ks + 8 * hf + 4, 32 * se, lane)), \
                                cat8(lds_tr4(lds + LR_QS, 16 * ks + 8 * hf, 32 * sd, lane), lds_tr4(lds + LR_QS, 16 * ks + 8 * hf + 4, 32 * sd, lane)), t1); } \
                _Pragma("unroll") for (int i = 0; i < 16; ++i) stacc[i] = cd * (cd * (stacc[i] + 0.125f * t0[i]) + 0.125f * t1[i]); } } while (0)
        int pp = 0;
#pragma unroll 1
        for (; pp + 1 < npair; pp += 2) { PRE_STEP(0, 1, 0, 1, pp); PRE_STEP(2, 3, 2, 3, pp + 1); }
        if (pp < npair) { PRE_STEP(0, 1, 0, 1, pp); ++pp; }
        nstart = 2 * npair;
        __syncthreads();
        if (wave < 4) {
            const int se = wave >> 1, sd = wave & 1;
#pragma unroll
            for (int i = 0; i < 16; i += 2) { const unsigned w = pk2(stacc[i], stacc[i + 1]);
                *(LAS bf16*)(lds + LR_ST + (32 * se + crow(i, hf)) * RQ + (32 * sd + l31) * 2) = (bf16)(w & 0xffffu);
                *(LAS bf16*)(lds + LR_ST + (32 * se + crow(i + 1, hf)) * RQ + (32 * sd + l31) * 2) = (bf16)(w >> 16); }
        }
#undef PRE_LOAD
#undef PRE_STAGE
#undef PRE_STEP
    }
    RET_LOAD(nstart);
    for (int n = nstart; n < c1; ++n) {
        const bool own = n >= c0;
        float cs[8], sn[8];
#pragma unroll
        for (int u = 0; u < 4; ++u) { cs[u] = csa[u]; cs[4 + u] = csb[u]; sn[u] = sna[u]; sn[4 + u] = snb[u]; }
        v2u gv[4];
#pragma unroll
        for (int g = 0; g < 4; ++g) gv[g] = gvn[g];
        __syncthreads();
        {
            float o1[8], o2[8];
#pragma unroll
            for (int u = 0; u < 8; ++u) { const unsigned w1 = k1[u >> 1], w2 = k2[u >> 1]; const float x1 = (u & 1) ? bf_hi(w1) : bf_lo(w1), x2 = (u & 1) ? bf_hi(w2) : bf_lo(w2);
                o1[u] = (x1 * cs[u] - x2 * sn[u]) * wk; o2[u] = (x1 * sn[u] + x2 * cs[u]) * wk; }
            *(LAS bf16x8*)(lds + LR_KS + r * RQ + (8 * qd) * 2) = pack8(o1[0], o1[1], o1[2], o1[3], o1[4], o1[5], o1[6], o1[7]);
            *(LAS bf16x8*)(lds + LR_KS + r * RQ + (32 + 8 * qd) * 2) = pack8(o2[0], o2[1], o2[2], o2[3], o2[4], o2[5], o2[6], o2[7]);
            *(LAS v4u*)(lds + LR_VS + r * RQ + (8 * qd) * 2) = v1; *(LAS v4u*)(lds + LR_VS + r * RQ + (32 + 8 * qd) * 2) = v2;
            if (own) {
#pragma unroll
                for (int u = 0; u < 8; ++u) { const unsigned w1 = q1[u >> 1], w2 = q2[u >> 1]; const float x1 = (u & 1) ? bf_hi(w1) : bf_lo(w1), x2 = (u & 1) ? bf_hi(w2) : bf_lo(w2);
                    o1[u] = (x1 * cs[u] - x2 * sn[u]) * wq; o2[u] = (x1 * sn[u] + x2 * cs[u]) * wq; }
                *(LAS bf16x8*)(lds + LR_QS + r * RQ + (8 * qd) * 2) = pack8(o1[0], o1[1], o1[2], o1[3], o1[4], o1[5], o1[6], o1[7]);
                *(LAS bf16x8*)(lds + LR_QS + r * RQ + (32 + 8 * qd) * 2) = pack8(o2[0], o2[1], o2[2], o2[3], o2[4], o2[5], o2[6], o2[7]);
            }
        }
        if (n + 1 < c1) RET_LOAD(n + 1);
        __syncthreads();
        if (own) {
            const size_t orow = (size_t)b * SQ + n * 128 + 32 * ib + l31;
            bf16x8 qf[4];
#pragma unroll
            for (int ks = 0; ks < 4; ++ks) qf[ks] = lds_frag16(lds + LR_QS + (32 * ib + l31) * RQ + (16 * ks + 8 * hf) * 2);
            f32x16 o;
#pragma unroll
            for (int i = 0; i < 16; ++i) o[i] = 0.f;
#pragma unroll
            for (int ks = 0; ks < 4; ++ks) o = MFMA32(lds_frag16(lds + LR_ST + (32 * et + l31) * RQ + (16 * ks + 8 * hf) * 2), qf[ks], o);
            for (int jb = 0; jb <= ib; ++jb) {
                f32x16 s;
#pragma unroll
                for (int i = 0; i < 16; ++i) s[i] = 0.f;
#pragma unroll
                for (int ks = 0; ks < 4; ++ks) s = MFMA32(lds_frag16(lds + LR_KS + (32 * jb + l31) * RQ + (16 * ks + 8 * hf) * 2), qf[ks], s);
                const bool diag = (jb == ib);
                float p[16];
#pragma unroll
                for (int i = 0; i < 16; ++i) p[i] = (diag && crow(i, hf) > l31) ? 0.f : s[i] * 0.125f;
#pragma unroll
                for (int st = 0; st < 2; ++st) {
                    const bf16x8 pf = pack8(p[8 * st], p[8 * st + 1], p[8 * st + 2], p[8 * st + 3], p[8 * st + 4], p[8 * st + 5], p[8 * st + 6], p[8 * st + 7]);
                    o = MFMA32(cat8(lds_tr4(lds + LR_VS, 32 * jb + 16 * st + 4 * hf, 32 * et, lane), lds_tr4(lds + LR_VS, 32 * jb + 16 * st + 8 + 4 * hf, 32 * et, lane)), pf, o);
                }
            }
            float s1 = 0.f, s2 = 0.f;
#pragma unroll
            for (int i = 0; i < 16; ++i) { s1 += o[i]; s2 += o[i] * o[i]; }
            s1 += __shfl_xor(s1, 32); s2 += __shfl_xor(s2, 32);
            if (hf == 0) *(LAS f32x2*)(lds + LR_LN + (et * 128 + 32 * ib + l31) * 8) = (f32x2){s1, s2};
            __syncthreads();
            const f32x2 ot = *(const LAS f32x2*)(lds + LR_LN + ((et ^ 1) * 128 + 32 * ib + l31) * 8);
            const float mu = (s1 + ot.x) * (1.0f / 64.0f), var = fmaxf((s2 + ot.y) * (1.0f / 64.0f) - mu * mu, 0.f), rs = 1.0f / sqrtf(var + 1e-6f);
#pragma unroll
            for (int g = 0; g < 4; ++g) {
                float y[4];
#pragma unroll
                for (int u = 0; u < 4; ++u) { const unsigned w = gv[g][u >> 1]; const float gg = (u & 1) ? bf_hi(w) : bf_lo(w); const float sg = gg * __builtin_amdgcn_rcpf(1.0f + __expf(-gg)); y[u] = sg * ((o[4 * g + u] - mu) * rs); }
                v2u w; w.x = pk2(y[0], y[1]); w.y = pk2(y[2], y[3]);
                *(v2u*)(MIXED + orow * D + h * 64 + 32 * et + 8 * g + 4 * hf) = w;
            }
        }
        if (wave < 4) {
            const int se = wave >> 1, sd = wave & 1;
            f32x16 tmp;
#pragma unroll
            for (int i = 0; i < 16; ++i) tmp[i] = 0.f;
#pragma unroll
            for (int ks = 0; ks < 8; ++ks)
                tmp = MFMA32(cat8(lds_tr4(lds + LR_VS, 16 * ks + 8 * hf, 32 * se, lane), lds_tr4(lds + LR_VS, 16 * ks + 8 * hf + 4, 32 * se, lane)),
                             cat8(lds_tr4(lds + LR_KS, 16 * ks + 8 * hf, 32 * sd, lane), lds_tr4(lds + LR_KS, 16 * ks + 8 * hf + 4, 32 * sd, lane)), tmp);
#pragma unroll
            for (int i = 0; i < 16; ++i) stacc[i] = cd * (stacc[i] + 0.125f * tmp[i]);
#pragma unroll
            for (int i = 0; i < 16; i += 2) { const unsigned w = pk2(stacc[i], stacc[i + 1]);
                *(LAS bf16*)(lds + LR_ST + (32 * se + crow(i, hf)) * RQ + (32 * sd + l31) * 2) = (bf16)(w & 0xffffu);
                *(LAS bf16*)(lds + LR_ST + (32 * se + crow(i + 1, hf)) * RQ + (32 * sd + l31) * 2) = (bf16)(w >> 16); }
        }
    }
    __syncthreads();
#undef RET_LOAD
}

constexpr int LS_KN = 0, LS_VS = LS_KN + 256 * RQ, LS_QN = LS_VS + 256 * RQ, LS_END = LS_QN + 256 * RQ;
static_assert(LS_END <= RING_BYTES, "swa LDS");
__device__ __forceinline__ void swa_unit(const bf16* __restrict__ PROJ, bf16* __restrict__ MIXED, const float* __restrict__ qnw, const float* __restrict__ knw, const float* __restrict__ sinks,
                                         LAS unsigned char* lds, int b, int kvh, int n, int tid, int lane, int wave) {
    const int l31 = lane & 31, hf = lane >> 5;
    const int row = tid >> 1, half = tid & 1;
    v4u qq[4];
    { const int hs = row >> 7, qrow = row & 127, hq = kvh * 4 + hs;
      const bf16* pr = PROJ + ((size_t)b * SQ + n * 128 + qrow) * NIN + 2048 + hq * 64 + 32 * half;
#pragma unroll
      for (int c = 0; c < 4; ++c) qq[c] = *(const v4u*)(pr + 8 * c); }
    {
        const int kpos = (n - 1) * 128 + row; const bool valid = kpos >= 0;
        v4u kk[4], vv[4];
#pragma unroll
        for (int c = 0; c < 4; ++c) { kk[c] = (v4u){0u, 0u, 0u, 0u}; vv[c] = (v4u){0u, 0u, 0u, 0u}; }
        if (valid) { const bf16* pr = PROJ + ((size_t)b * SQ + kpos) * NIN + 32 * half;
#pragma unroll
            for (int c = 0; c < 4; ++c) { kk[c] = *(const v4u*)(pr + 2560 + kvh * 64 + 8 * c); vv[c] = *(const v4u*)(pr + 2688 + kvh * 64 + 8 * c); } }
        float kf[32]; float ss = 0.f;
#pragma unroll
        for (int c = 0; c < 4; ++c)
#pragma unroll
            for (int u = 0; u < 4; ++u) { kf[8 * c + 2 * u] = bf_lo(kk[c][u]); kf[8 * c + 2 * u + 1] = bf_hi(kk[c][u]); }
#pragma unroll
        for (int i = 0; i < 32; ++i) ss += kf[i] * kf[i];
        ss += __shfl_xor(ss, 1);
        const float rstd = 0.125f / sqrtf(ss * (1.0f / 64.0f) + 1e-6f);
#pragma unroll
        for (int c = 0; c < 4; ++c) {
            const f32x4 g0 = *(const f32x4*)(knw + 32 * half + 8 * c), g1 = *(const f32x4*)(knw + 32 * half + 8 * c + 4);
            *(LAS bf16x8*)(lds + LS_KN + row * RQ + (32 * half + 8 * c) * 2) = pack8(kf[8 * c] * rstd * g0[0], kf[8 * c + 1] * rstd * g0[1], kf[8 * c + 2] * rstd * g0[2], kf[8 * c + 3] * rstd * g0[3],
                                                                                  kf[8 * c + 4] * rstd * g1[0], kf[8 * c + 5] * rstd * g1[1], kf[8 * c + 6] * rstd * g1[2], kf[8 * c + 7] * rstd * g1[3]);
            *(LAS v4u*)(lds + LS_VS + row * RQ + (32 * half + 8 * c) * 2) = vv[c];
        }
    }
    for (int rnd = 0; rnd < 2; ++rnd) {
        {
            float qf[32]; float ss = 0.f;
#pragma unroll
            for (int c = 0; c < 4; ++c)
#pragma unroll
                for (int u = 0; u < 4; ++u) { qf[8 * c + 2 * u] = bf_lo(qq[c][u]); qf[8 * c + 2 * u + 1] = bf_hi(qq[c][u]); }
#pragma unroll
            for (int i = 0; i < 32; ++i) ss += qf[i] * qf[i];
            ss += __shfl_xor(ss, 1);
            const float rstd = 1.0f / sqrtf(ss * (1.0f / 64.0f) + 1e-6f);
#pragma unroll
            for (int c = 0; c < 4; ++c) {
                const f32x4 g0 = *(const f32x4*)(qnw + 32 * half + 8 * c), g1 = *(const f32x4*)(qnw + 32 * half + 8 * c + 4);
                *(LAS bf16x8*)(lds + LS_QN + row * RQ + (32 * half + 8 * c) * 2) = pack8(qf[8 * c] * rstd * g0[0], qf[8 * c + 1] * rstd * g0[1], qf[8 * c + 2] * rstd * g0[2], qf[8 * c + 3] * rstd * g0[3],
                                                                                      qf[8 * c + 4] * rstd * g1[0], qf[8 * c + 5] * rstd * g1[1], qf[8 * c + 6] * rstd * g1[2], qf[8 * c + 7] * rstd * g1[3]);
            }
        }
        if (rnd == 0) {
            const int hs = row >> 7, qrow = row & 127, hq = kvh * 4 + 2 + hs;
            const bf16* pr = PROJ + ((size_t)b * SQ + n * 128 + qrow) * NIN + 2048 + hq * 64 + 32 * half;
#pragma unroll
            for (int c = 0; c < 4; ++c) qq[c] = *(const v4u*)(pr + 8 * c);
        }
        __syncthreads();
        {
            const int hs = wave >> 2, ib = wave & 3, hq = kvh * 4 + rnd * 2 + hs;
            bf16x8 qf[4];
#pragma unroll
            for (int ks = 0; ks < 4; ++ks) qf[ks] = lds_frag16(lds + LS_QN + (hs * 128 + 32 * ib + l31) * RQ + (16 * ks + 8 * hf) * 2);
            f32x16 s[5];
#pragma unroll
            for (int t = 0; t < 5; ++t) {
#pragma unroll
                for (int i = 0; i < 16; ++i) s[t][i] = 0.f;
#pragma unroll
                for (int ks = 0; ks < 4; ++ks) s[t] = MFMA32(lds_frag16(lds + LS_KN + (32 * (ib + t) + l31) * RQ + (16 * ks + 8 * hf) * 2), qf[ks], s[t]);
            }
            const float sink = sinks[hq];
            float m = sink;
#pragma unroll
            for (int t = 0; t < 5; ++t)
#pragma unroll
                for (int i = 0; i < 16; ++i) {
                    bool ok = true;
                    if (t == 0) ok = crow(i, hf) > l31;
                    if (t == 4) ok = crow(i, hf) <= l31;
                    if (n == 0 && ib + t < 4) ok = false;
                    s[t][i] = ok ? s[t][i] : -INFINITY;
                    m = fmaxf(m, s[t][i]);
                }
            m = fmaxf(m, __shfl_xor(m, 32));
            float l = 0.f;
#pragma unroll
            for (int t = 0; t < 5; ++t)
#pragma unroll
                for (int i = 0; i < 16; ++i) { s[t][i] = __builtin_amdgcn_exp2f((s[t][i] - m) * 1.4426950408889634f); l += s[t][i]; }
            l += __shfl_xor(l, 32);
            l += __builtin_amdgcn_exp2f((sink - m) * 1.4426950408889634f);
            f32x16 o[2];
#pragma unroll
            for (int e2 = 0; e2 < 2; ++e2)
#pragma unroll
                for (int i = 0; i < 16; ++i) o[e2][i] = 0.f;
#pragma unroll
            for (int t = 0; t < 5; ++t)
#pragma unroll
                for (int st = 0; st < 2; ++st) {
                    const bf16x8 pf = pack8(s[t][8 * st], s[t][8 * st + 1], s[t][8 * st + 2], s[t][8 * st + 3], s[t][8 * st + 4], s[t][8 * st + 5], s[t][8 * st + 6], s[t][8 * st + 7]);
#pragma unroll
                    for (int e2 = 0; e2 < 2; ++e2) o[e2] = MFMA32(cat8(lds_tr4(lds + LS_VS, 32 * (ib + t) + 16 * st + 4 * hf, 32 * e2, lane), lds_tr4(lds + LS_VS, 32 * (ib + t) + 16 * st + 8 + 4 * hf, 32 * e2, lane)), pf, o[e2]);
                }
            const float inv = 1.0f / l;
            const size_t orow = (size_t)b * SQ + n * 128 + 32 * ib + l31;
#pragma unroll
            for (int e2 = 0; e2 < 2; ++e2)
#pragma unroll
                for (int g = 0; g < 4; ++g) { v2u w; w.x = pk2(o[e2][4 * g] * inv, o[e2][4 * g + 1] * inv); w.y = pk2(o[e2][4 * g + 2] * inv, o[e2][4 * g + 3] * inv);
                    *(v2u*)(MIXED + orow * D + 512 + hq * 64 + 32 * e2 + 8 * g + 4 * hf) = w; }
        }
        __syncthreads();
    }
}

__device__ __forceinline__ void p2_mixing(const Args& a, LAS unsigned char* lds, int bx, int G, int tid, int lane, int wave, int parts = 3) {
    const bf16* PROJ = (const bf16*)(a.ws + WS_R2); bf16* MIXED = (bf16*)(a.ws + WS_R1); const float* rope = (const float*)(a.ws + WS_ROPE);
    if (parts & 1) for (int u = bx; u < 256; u += G) {
        const int b = (u >> 3) & 7, h = u & 7, grp = u >> 6;
        const int c0 = grp == 0 ? 0 : grp == 1 ? 11 : grp == 2 ? 20 : 27, c1 = grp == 0 ? 11 : grp == 1 ? 20 : grp == 2 ? 27 : 32;
        ret_unit(PROJ, MIXED, rope, lds, b, h, c0, c1, tid, lane, wave);
    }
    if (parts & 2) for (int su = bx; su < 512; su += G) swa_unit(PROJ, MIXED, a.in[4], a.in[5], a.in[6], lds, su >> 6, (su >> 5) & 1, su & 31, tid, lane, wave);
}


__device__ __forceinline__ float wave_sum_dpp(float x) {
    x += __builtin_bit_cast(float, __builtin_amdgcn_update_dpp(0, __builtin_bit_cast(int, x), 0xB1, 0xf, 0xf, false));
    x += __builtin_bit_cast(float, __builtin_amdgcn_update_dpp(0, __builtin_bit_cast(int, x), 0x4E, 0xf, 0xf, false));
    x += __builtin_bit_cast(float, __builtin_amdgcn_update_dpp(0, __builtin_bit_cast(int, x), 0x141, 0xf, 0xf, false));
    x += __builtin_bit_cast(float, __builtin_amdgcn_update_dpp(0, __builtin_bit_cast(int, x), 0x140, 0xf, 0xf, false));
    x += __builtin_bit_cast(float, __builtin_amdgcn_update_dpp(0, __builtin_bit_cast(int, x), 0x142, 0xa, 0xf, false));
    x += __builtin_bit_cast(float, __builtin_amdgcn_update_dpp(0, __builtin_bit_cast(int, x), 0x143, 0xc, 0xf, false));
    return __builtin_bit_cast(float, __builtin_amdgcn_readlane(__builtin_bit_cast(int, x), 63));
}
__device__ __forceinline__ float wave_max_dpp(float x) {
    x = fmaxf(x, __builtin_bit_cast(float, __builtin_amdgcn_update_dpp(0, __builtin_bit_cast(int, x), 0xB1, 0xf, 0xf, false)));
    x = fmaxf(x, __builtin_bit_cast(float, __builtin_amdgcn_update_dpp(0, __builtin_bit_cast(int, x), 0x4E, 0xf, 0xf, false)));
    x = fmaxf(x, __builtin_bit_cast(float, __builtin_amdgcn_update_dpp(0, __builtin_bit_cast(int, x), 0x141, 0xf, 0xf, false)));
    x = fmaxf(x, __builtin_bit_cast(float, __builtin_amdgcn_update_dpp(0, __builtin_bit_cast(int, x), 0x140, 0xf, 0xf, false)));
    x = fmaxf(x, __builtin_bit_cast(float, __builtin_amdgcn_update_dpp(0, __builtin_bit_cast(int, x), 0x142, 0xa, 0xf, false)));
    x = fmaxf(x, __builtin_bit_cast(float, __builtin_amdgcn_update_dpp(0, __builtin_bit_cast(int, x), 0x143, 0xc, 0xf, false)));
    return __builtin_bit_cast(float, __builtin_amdgcn_readlane(__builtin_bit_cast(int, x), 63));
}
__device__ __forceinline__ int row16_sum(int x) {
    x += __builtin_amdgcn_update_dpp(0, x, 0xB1, 0xf, 0xf, false);
    x += __builtin_amdgcn_update_dpp(0, x, 0x4E, 0xf, 0xf, false);
    x += __builtin_amdgcn_update_dpp(0, x, 0x141, 0xf, 0xf, false);
    x += __builtin_amdgcn_update_dpp(0, x, 0x140, 0xf, 0xf, false);
    return x;
}
template <int N> __device__ __forceinline__ void bitonic_sort_desc(float (&v)[N]) {
#pragma unroll
    for (int k = 2; k <= N; k <<= 1)
#pragma unroll
        for (int j = k >> 1; j > 0; j >>= 1)
#pragma unroll
            for (int i = 0; i < N; ++i) { const int l = i ^ j; if (l > i) { const bool desc = ((i & k) == 0); const float a = v[i], b = v[l]; const float hi = fmaxf(a, b), lo = fminf(a, b); v[i] = desc ? hi : lo; v[l] = desc ? lo : hi; } }
}
__device__ __forceinline__ void sort16_desc(float (&v)[16]) {
    constexpr int A[63] = {0,2,0,1,1,4,6,4,5,5,0,2,2,1,3,3,1,3,5,8,10,8,9,9,12,14,12,13,13,8,10,10,9,11,11,9,11,13,0,4,4,2,6,6,2,6,10,1,5,5,3,7,7,3,7,11,1,3,5,7,9,11,13};
    constexpr int B[63] = {1,3,2,3,2,5,7,6,7,6,4,6,4,5,7,5,2,4,6,9,11,10,11,10,13,15,14,15,14,12,14,12,13,15,13,10,12,14,8,12,8,10,14,10,4,8,12,9,13,9,11,15,11,5,9,13,2,4,6,8,10,12,14};
#pragma unroll
    for (int i = 0; i < 63; ++i) { const float a = v[A[i]], b = v[B[i]]; v[A[i]] = fmaxf(a, b); v[B[i]] = fminf(a, b); }
}
__device__ __forceinline__ void bitonic_merge16_desc(float (&v)[16]) {
#pragma unroll
    for (int j = 8; j > 0; j >>= 1)
#pragma unroll
        for (int i = 0; i < 16; ++i) { const int l = i ^ j; if (l > i) { const float a = v[i], b = v[l]; v[i] = fmaxf(a, b); v[l] = fminf(a, b); } }
}
__device__ __forceinline__ void top16_of_64(float (&v)[64], float (&out)[16]) {
    float b[4][16];
#pragma unroll
    for (int q = 0; q < 4; ++q) {
#pragma unroll
        for (int i = 0; i < 16; ++i) b[q][i] = v[16 * q + i];
        sort16_desc(b[q]);
    }
    float t0[16], t1[16];
#pragma unroll
    for (int i = 0; i < 16; ++i) { t0[i] = fmaxf(b[0][i], b[1][15 - i]); t1[i] = fmaxf(b[2][i], b[3][15 - i]); }
    bitonic_merge16_desc(t0); bitonic_merge16_desc(t1);
#pragma unroll
    for (int i = 0; i < 16; ++i) out[i] = fmaxf(t0[i], t1[15 - i]);
    bitonic_merge16_desc(out);
}
__device__ __forceinline__ float dot2u(unsigned a, unsigned b, float c) { return __builtin_amdgcn_fdot2_f32_bf16(__builtin_bit_cast(b16x2, a), __builtin_bit_cast(b16x2, b), c, false); }
__device__ __forceinline__ float gelu_erf(float v) {
    const float av = fabsf(v), t = __builtin_amdgcn_rcpf(av * 0.2316418882f + 1.0f);
    float q = t * 0.5307027145f + (-0.7265760135f); q = q * t + 0.7107068705f; q = q * t + (-0.142248368f); q = q * t + 0.127414796f; q = q * t;
    const float e = __builtin_amdgcn_exp2f((v * v) * (-0.72134752044f));
    const float m = v * (q * e);
    return v < 0.f ? m : v - m;
}

constexpr int KROW = 272;
constexpr int LP_KEYS = 0, LP_LUT = LP_KEYS + 256 * KROW, LP_RSTD = LP_LUT + NWAVES * 32 * 32, LP_END = LP_RSTD + 4 * 128;
static_assert(LP_END <= RING_BYTES, "peer LDS");

__device__ __forceinline__ void p5a_topk(const Args& a, LAS unsigned char* lds, int vcu, int G, int tid, int lane, int wave PT_DECL) {
    unsigned char* ws = a.ws;
    const bf16* Q = (const bf16*)(ws + WS_R2 + 64 * MB); const bf16* XB1 = (const bf16*)(ws + WS_R2); unsigned char* H8 = ws + WS_R1; float* SH = (float*)(ws + WS_SH); float* SHS = (float*)(ws + WS_SHS); const float* gffn = a.in[8];
    unsigned* PK = (unsigned*)(ws + WS_PK);
    const int l31 = lane & 31, hf = lane >> 5;
    for (int i = tid; i < 256 * 16; i += NTHR) { const int rr = i >> 4, c = i & 15; *(LAS v4u*)(lds + LP_KEYS + rr * KROW + c * 16) = *(const v4u*)((const bf16*)(ws + WS_KEYS) + rr * 128 + c * 8); }
    float gw[16];
    { const f32x4 g0 = *(const f32x4*)(gffn + 16 * lane), g1 = *(const f32x4*)(gffn + 16 * lane + 4), g2 = *(const f32x4*)(gffn + 16 * lane + 8), g3 = *(const f32x4*)(gffn + 16 * lane + 12);
#pragma unroll
      for (int u = 0; u < 4; ++u) { gw[u] = g0[u]; gw[4 + u] = g1[u]; gw[8 + u] = g2[u]; gw[12 + u] = g3[u]; } }
    { int gi = 0;
      for (int grp = vcu; grp < T / 32 && gi < 4; grp += G, ++gi) {
        const int t0 = grp * 32;
        {
            float xs[4][16];
#pragma unroll
            for (int q = 0; q < 4; ++q) {
                const bf16* xr = XB1 + ((size_t)t0 + 4 * wave + q) * D + 16 * lane;
                const v4u x0 = *(const v4u*)xr, x1 = *(const v4u*)(xr + 8);
#pragma unroll
                for (int u = 0; u < 4; ++u) { xs[q][2 * u] = bf_lo(x0[u]); xs[q][2 * u + 1] = bf_hi(x0[u]); xs[q][8 + 2 * u] = bf_lo(x1[u]); xs[q][8 + 2 * u + 1] = bf_hi(x1[u]); }
            }
            float ssq[4];
#pragma unroll
            for (int q = 0; q < 4; ++q) { float sq = 0.f;
#pragma unroll
                for (int u = 0; u < 16; ++u) sq += xs[q][u] * xs[q][u];
                ssq[q] = sq; }
#pragma unroll
            for (int o = 1; o < 64; o <<= 1)
#pragma unroll
                for (int q = 0; q < 4; ++q) ssq[q] += __shfl_xor(ssq[q], o);
            float am[4], hs2[4];
#pragma unroll
            for (int q = 0; q < 4; ++q) {
                const float rstd = 1.0f / sqrtf(ssq[q] * (1.0f / D) + 1e-6f);
                if (lane == 0) *(LAS float*)(lds + LP_RSTD + gi * 128 + (4 * wave + q) * 4) = rstd;
                float m = 0.f, s2 = 0.f;
#pragma unroll
                for (int u = 0; u < 16; ++u) { xs[q][u] = xs[q][u] * rstd * gw[u]; m = fmaxf(m, fabsf(xs[q][u])); s2 += xs[q][u] * xs[q][u]; }
                am[q] = m; hs2[q] = s2;
            }
#pragma unroll
            for (int o = 1; o < 64; o <<= 1)
#pragma unroll
                for (int q = 0; q < 4; ++q) am[q] = fmaxf(am[q], __shfl_xor(am[q], o));
#pragma unroll
            for (int q = 0; q < 4; ++q) {
                const size_t tok = (size_t)t0 + 4 * wave + q;
                const float step = fminf(0.355f * sqrtf(wave_sum_dpp(hs2[q]) * (1.0f / D)), am[q] * (1.0f / 7.0f));
                const float inv = step > 0.f ? 1.0f / step : 0.f;
                v2u wh = {0u, 0u}; int hsum = 0;
#pragma unroll
                for (int u = 0; u < 16; ++u) { int qi = __float2int_rn(xs[q][u] * inv); qi = qi < -7 ? -7 : qi > 7 ? 7 : qi; hsum += qi; const unsigned nb = (unsigned)qi & 15u;
                    if (u < 8) wh.x |= nb << (4 * u); else wh.y |= nb << (4 * (u - 8)); }
                *(v2u*)(H8 + tok * 512 + 8 * lane) = wh;
                const float hs = wave_sum_dpp((float)hsum);
                if (lane == 0) { SH[tok] = step; SHS[tok] = 0.5f * hs; }
            }
        }
      }
    }
    __syncthreads();
    int gi = 0;
    bf16x8 qfr[8];
    { const bf16* qrow = Q + (size_t)(vcu * 32 + (lane & 31)) * NQ + wave * 256 + 8 * (lane >> 5);
#pragma unroll
      for (int ks = 0; ks < 8; ++ks) qfr[ks] = *(const bf16x8*)(qrow + 16 * ks); }
#pragma unroll 1
    for (int grp = vcu; grp < T / 32 && gi < 4; grp += G, ++gi) {
        const int t0 = grp * 32;
        PT_BEGIN();
        PT_ADD(0);
        {
            const int h = wave;
            float lst[2][16];
#pragma unroll
            for (int p = 0; p < 2; ++p) {
                f32x16 acc[4];
#pragma unroll
                for (int q = 0; q < 4; ++q)
#pragma unroll
                    for (int i = 0; i < 16; ++i) acc[q][i] = 0.f;
#pragma unroll
                for (int ks = 0; ks < 8; ++ks) {
#pragma unroll
                    for (int q = 0; q < 4; ++q) acc[q] = MFMA32(lds_frag16(lds + LP_KEYS + (p * 128 + 32 * q + l31) * KROW + (16 * ks + 8 * hf) * 2), qfr[ks], acc[q]);
                }
                {
                    const bool more = (p == 0) || (gi + 1 < 4 && grp + G < T / 32);
                    const size_t tn = (p == 0) ? (size_t)(t0 + l31) : (size_t)(t0 + G * 32 + l31);
                    const bf16* qrow = Q + tn * NQ + h * 256 + (p == 0 ? 128 : 0) + 8 * hf;
                    if (more) {
#pragma unroll
                        for (int ks = 0; ks < 8; ++ks) qfr[ks] = *(const bf16x8*)(qrow + 16 * ks);
                    }
                    __builtin_amdgcn_sched_barrier(0);
                }
                float v[64];
#pragma unroll
                for (int q = 0; q < 4; ++q)
#pragma unroll
                    for (int i = 0; i < 16; ++i) v[16 * q + i] = __uint_as_float((__float_as_uint(acc[q][i]) & 0xffffff80u) | (unsigned)(32 * q + crow(i, hf)));
                float mine[16];
                top16_of_64(v, mine);
                float t[16];
#pragma unroll
                for (int i = 0; i < 16; ++i) t[i] = __shfl_xor(mine[i], 32);
#pragma unroll
                for (int i = 0; i < 16; ++i) lst[p][i] = fmaxf(mine[i], t[15 - i]);
                bitonic_merge16_desc(lst[p]);
            }
            PT_ADD(1);
            LAS unsigned char* lut = lds + LP_LUT + wave * 1024 + l31 * 32;
            {
                v4u wa, wb;
#pragma unroll
                for (int c = 0; c < 4; ++c) {
                    wa[c] = (__float_as_uint(lst[0][4 * c]) & 0x7fu) | ((__float_as_uint(lst[0][4 * c + 1]) & 0x7fu) << 8) | ((__float_as_uint(lst[0][4 * c + 2]) & 0x7fu) << 16) | ((__float_as_uint(lst[0][4 * c + 3]) & 0x7fu) << 24);
                    wb[c] = (__float_as_uint(lst[1][4 * c]) & 0x7fu) | ((__float_as_uint(lst[1][4 * c + 1]) & 0x7fu) << 8) | ((__float_as_uint(lst[1][4 * c + 2]) & 0x7fu) << 16) | ((__float_as_uint(lst[1][4 * c + 3]) & 0x7fu) << 24);
                }
                if (hf == 0) { *(LAS v4u*)lut = wa; *(LAS v4u*)(lut + 16) = wb; }
            }
            float best[16];
            {
            constexpr int CIA[25] = {0,0,0,0,0,0,0,0,0,0,0,0,0,0,0,0,2,2,2,2,2,3,3,3,3};
            constexpr int CJA[25] = {0,1,2,3,4,5,6,7,8,9,10,11,12,13,14,15,0,1,2,3,4,0,1,2,3};
            constexpr int CIB[25] = {1,1,1,1,1,1,1,1,4,4,4,5,5,6,6,7,7,8,9,10,11,12,13,14,15};
            constexpr int CJB[25] = {0,1,2,3,4,5,6,7,0,1,2,0,1,0,1,0,1,0,0,0,0,0,0,0,0};
                const unsigned hm = hf ? 0xffffffffu : 0u;
                float l0[16], l1[16];
#pragma unroll
                for (int i = 0; i < 16; ++i) { l0[i] = __uint_as_float(__float_as_uint(lst[0][i]) & 0xffffff80u); l1[i] = __uint_as_float(__float_as_uint(lst[1][i]) & 0xffffff80u); }
                float b0[16], b1[16];
#pragma unroll
                for (int c = 0; c < 32; ++c) {
                    float val = -3.0e38f;
                    if (c < 25) {
                        const unsigned ca = (__float_as_uint(l0[CIA[c]] + l1[CJA[c]]) & 0xffffff00u) | (unsigned)(CIA[c] * 16 + CJA[c]);
                        const unsigned cb = (__float_as_uint(l0[CIB[c]] + l1[CJB[c]]) & 0xffffff00u) | (unsigned)(CIB[c] * 16 + CJB[c]);
                        val = __uint_as_float((cb & hm) | (ca & ~hm));
                    }
                    if (c < 16) b0[c] = val; else b1[c - 16] = val;
                }
                sort16_desc(b0); sort16_desc(b1);
                float m2[16];
#pragma unroll
                for (int i = 0; i < 16; ++i) m2[i] = fmaxf(b0[i], b1[15 - i]);
                bitonic_merge16_desc(m2);
                float t2[16];
#pragma unroll
                for (int i = 0; i < 16; ++i) t2[i] = __shfl_xor(m2[i], 32);
#pragma unroll
                for (int i = 0; i < 16; ++i) best[i] = fmaxf(m2[i], t2[15 - i]);
                bitonic_merge16_desc(best);
            }
            const float rstd = *(const LAS float*)(lds + LP_RSTD + gi * 128 + l31 * 4);
            const float s0 = __uint_as_float(__float_as_uint(best[0]) & 0xffffff00u);
            float ev[16], esum = 0.f;
#pragma unroll
            for (int k = 0; k < 16; ++k) { const float sk = __uint_as_float(__float_as_uint(best[k]) & 0xffffff00u); ev[k] = __expf(rstd * (sk - s0)); esum += ev[k]; }
            const float einv = 1.0f / esum;
            LDS_WAIT();
            asm volatile("" ::: "memory");
            {
                const size_t ob = (size_t)(t0 + l31) * 128 + h * 16 + 8 * hf;
                unsigned e8[8];
                const unsigned hm = hf ? 0xffffffffu : 0u;
#pragma unroll
                for (int j = 0; j < 8; ++j) { const unsigned code = ((__float_as_uint(best[8 + j]) & hm) | (__float_as_uint(best[j]) & ~hm)) & 0xffu;
                    const float gk = __uint_as_float((__float_as_uint(ev[8 + j]) & hm) | (__float_as_uint(ev[j]) & ~hm)) * einv;
                    const unsigned ia = *(const LAS unsigned char*)(lut + (code >> 4)), ib = *(const LAS unsigned char*)(lut + 16 + (code & 15u));
                    e8[j] = (ia * 128u + ib) | (pk2(0.f, gk) & 0xffff0000u); }
                *(v4u*)(PK + ob) = (v4u){e8[0], e8[1], e8[2], e8[3]}; *(v4u*)(PK + ob + 4) = (v4u){e8[4], e8[5], e8[6], e8[7]};
            }
            PT_ADD(2);
        }
    }
    __syncthreads();
}

constexpr int LB_H = 0, LB_LIST = LB_H + NWAVES * 4096, LB_GATE = LB_LIST + NWAVES * 2304, LB_SH = LB_GATE + NWAVES * 2048, LB_END = LB_SH + NWAVES * 32;
static_assert(LB_END <= RING_BYTES, "p5b LDS");
struct B5Batch { v4u ur[4][2]; };
struct B5Blk { unsigned em; float scl, svl; };
__device__ __forceinline__ void b5_issue(B5Batch& b, const LAS unsigned* list, int bt, const unsigned char* U8, int lane) {
    const int g = lane >> 4, c = lane & 15;
#pragma unroll
    for (int ps = 0; ps < 4; ++ps) {
        const unsigned ent = list[16 * bt + 4 * ps + g];
        const unsigned char* rp = U8 + ((ent & 0xffffu) * 512u + 16u * (unsigned)c);
#pragma unroll
        for (int i = 0; i < 2; ++i) b.ur[ps][i] = *(const v4u*)(rp + 256 * i);
    }
}
__device__ __forceinline__ void b5_blk_issue(B5Blk& k, const LAS unsigned* list, int blk, const float* SU, const float* SV, int lane) {
    const int g = lane >> 4, c = lane & 15;
    k.em = list[64 * blk + 16 * (c >> 2) + 4 * (c & 3) + g];
    const unsigned ee = k.em & 0xffffu; k.scl = SU[ee]; k.svl = SV[ee];
}
__device__ __forceinline__ void b5_compute(const B5Batch& b, const LAS unsigned* list, int bt, LAS unsigned char* hreg, int lane, int& res) {
    const int g = lane >> 4, c = lane & 15;
    int acc[4];
#pragma unroll
    for (int ps = 0; ps < 4; ++ps) {
        const unsigned ent = list[16 * bt + 4 * ps + g];
        LAS unsigned char* hp = hreg + ((ent >> 28) & 3u) * 512 + 16 * c;
        int ac = 0;
#pragma unroll
        for (int i = 0; i < 2; ++i) { const v4u hv = *(const LAS v4u*)(hp + 256 * i);
#pragma unroll
            for (int u = 0; u < 4; ++u) ac = __builtin_amdgcn_sdot8((int)hv[u], (int)b.ur[ps][i][u], ac, false); }
        acc[ps] = ac;
    }
    const bool o1 = (c & 1) != 0, o2 = (c & 2) != 0;
    const int k0 = o1 ? acc[1] : acc[0], s0 = o1 ? acc[0] : acc[1], k1 = o1 ? acc[3] : acc[2], s1 = o1 ? acc[2] : acc[3];
    const int b0 = k0 + __builtin_amdgcn_update_dpp(0, s0, 0xB1, 0xf, 0xf, false);
    const int b1 = k1 + __builtin_amdgcn_update_dpp(0, s1, 0xB1, 0xf, 0xf, false);
    const int k2 = o2 ? b1 : b0, s2 = o2 ? b0 : b1;
    int d = k2 + __builtin_amdgcn_update_dpp(0, s2, 0x4E, 0xf, 0xf, false);
    d += __builtin_amdgcn_update_dpp(0, d, 0x124, 0xf, 0xf, false);
    d += __builtin_amdgcn_update_dpp(0, d, 0x128, 0xf, 0xf, false);
    res = ((c >> 2) == (bt & 3)) ? d : res;
}
__device__ __forceinline__ void b5_epilogue(const B5Blk& k, int res, const LAS float* gts, const LAS float* shs, unsigned* PK, int tok0) {
    const unsigned eslot = k.em >> 28, ek = (k.em >> 16) & 0xffu;
    if (eslot < 4u) {
        const float dot = ((float)res + shs[4 + eslot]) * k.scl * shs[eslot];
        ((unsigned short*)(PK + ((size_t)tok0 + eslot) * 128 + ek))[1] = (unsigned short)(pk2(0.f, gelu_erf(dot) * gts[eslot * 128 + ek] * k.svl) >> 16);
    }
}
struct B5Pre { v2u pk[4]; v2u h0[4]; float shv; };
__device__ __forceinline__ void b5_prefetch(B5Pre& p, const unsigned* PK, const unsigned char* H8, const float* SH, int tok0, int lane) {
#pragma unroll
    for (int s = 0; s < 4; ++s) { const size_t tok = (size_t)tok0 + s;
        p.pk[s] = *(const v2u*)(PK + tok * 128 + 2 * lane); p.h0[s] = *(const v2u*)(H8 + tok * 512 + 8 * lane); }
    p.shv = (lane & 4) ? SH[T + tok0 + (lane & 3)] : SH[tok0 + (lane & 3)];
}
__device__ __forceinline__ void p5b_dots(const Args& a, LAS unsigned char* lds, int bx, int G, int tid, int lane, int wave) {
    unsigned char* ws = a.ws;
    const unsigned char* H8 = ws + WS_R1; const unsigned char* U8 = ws + WS_UB; const float* SU = (const float*)(ws + WS_SU); const float* SV = (const float*)(ws + WS_SV); const float* SH = (const float*)(ws + WS_SH);
    unsigned* PK = (unsigned*)(ws + WS_PK);
    LAS unsigned char* hreg = lds + LB_H + wave * 4096; LAS unsigned* list = (LAS unsigned*)(lds + LB_LIST + wave * 2304); LAS float* gts = (LAS float*)(lds + LB_GATE + wave * 2048); LAS float* shs = (LAS float*)(lds + LB_SH + wave * 32);
    const int jmine = ((lane >> 5) & 1) * 8 + ((lane >> 4) & 1) * 4 + ((lane >> 3) & 1) * 2 + ((lane >> 2) & 1);
    const unsigned long long ltmask = (1ull << lane) - 1ull;
    for (int vb = bx; vb < 256; vb += G) {
        const unsigned vx = (unsigned)(vb & 3); const int wi = vb >> 3;
        const int tw0 = ((vb >> 2) & 1) * (T / 2) + wi * 512 + wave * 64;
        B5Pre P;
        b5_prefetch(P, PK, H8, SH, tw0, lane);
#pragma unroll 1
        for (int ch = 0; ch < 16; ++ch) {
            const int tok0 = tw0 + 4 * ch;
            int n = 0;
            if (lane < 8) shs[lane] = P.shv;
#pragma unroll
            for (int s = 0; s < 4; ++s) {
                *(LAS v2u*)(hreg + s * 512 + lane * 8) = P.h0[s];
                *(LAS f32x2*)(gts + s * 128 + 2 * lane) = (f32x2){bf_hi(P.pk[s].x), bf_hi(P.pk[s].y)};
                const unsigned id0 = P.pk[s].x & 0xffffu, id1 = P.pk[s].y & 0xffffu;
                const bool in0 = (id0 >> 12) == vx, in1 = (id1 >> 12) == vx;
                const unsigned long long m0 = __ballot(in0), m1 = __ballot(in1);
                const int c0 = __popcll(m0), c1 = __popcll(m1);
                if (in0) list[n + __popcll(m0 & ltmask)] = ((unsigned)s << 28) | ((unsigned)(2 * lane) << 16) | id0;
                if (in1) list[n + c0 + __popcll(m1 & ltmask)] = ((unsigned)s << 28) | ((unsigned)(2 * lane + 1) << 16) | id1;
                n += c0 + c1;
            }
            const int nb = (n + 15) >> 4;
            list[n + lane] = (0xfu << 28) | (vx << 12);
            if (ch + 1 < 16) b5_prefetch(P, PK, H8, SH, tok0 + 4, lane);
            LDS_WAIT(); asm volatile("" ::: "memory");
            B5Batch A, B; B5Blk K; int res = 0;
            if (nb > 0) b5_issue(A, list, 0, U8, lane);
#pragma unroll 1
            for (int bt = 0; bt < nb; bt += 2) {
                if (bt + 1 < nb) b5_issue(B, list, bt + 1, U8, lane);
                if ((bt & 3) == 0) b5_blk_issue(K, list, bt >> 2, SU, SV, lane);
                b5_compute(A, list, bt, hreg, lane, res);
                if (bt + 1 < nb) {
                    if (bt + 2 < nb) b5_issue(A, list, bt + 2, U8, lane);
                    b5_compute(B, list, bt + 1, hreg, lane, res);
                    if ((bt & 3) == 2) b5_epilogue(K, res, gts, shs, PK, tok0);
                }
            }
            if ((nb & 3) != 0) b5_epilogue(K, res, gts, shs, PK, tok0);
        }
    }
}

constexpr int LC_BUF = 0, LC_SB = 640, LC_TILE = NWAVES * 2 * LC_SB, LC_ROW = 144, LC_END = LC_TILE + NWAVES * 128 * LC_ROW;
static_assert(LC_END <= MISC_OFF, "p5c LDS");
struct C5Tok { v4u vv[16]; unsigned short xa[4]; float sa; };
__device__ __forceinline__ void c5_stage(C5Tok& t, LAS unsigned char* buf, v2u pk, int lane) {
    const f32x2 av = {bf_hi(pk.x), bf_hi(pk.y)};
    const float am = wave_max_dpp(fmaxf(fabsf(av[0]), fabsf(av[1])));
    const float inv = am > 0.f ? 119.0f / am : 0.f;
    const int q0 = __float2int_rn(av[0] * inv), q1 = __float2int_rn(av[1] * inv);
    const int k0 = 2 * lane, k1 = 2 * lane + 1;
    *(LAS unsigned*)(buf + ((k0 & 7) * 16 + (k0 >> 3)) * 4) = (pk.x & 0xffffu) << 7;
    *(LAS unsigned*)(buf + ((k1 & 7) * 16 + (k1 >> 3)) * 4) = (pk.y & 0xffffu) << 7;
    const unsigned b0 = (unsigned)(q0 + 8), b1 = (unsigned)(q1 + 8);
    *(LAS unsigned char*)(buf + 512 + (lane >> 3) * 16 + (lane & 7)) = (unsigned char)(((b0 >> 4) & 15u) | (((b1 >> 4) & 15u) << 4));
    *(LAS unsigned char*)(buf + 512 + (lane >> 3) * 16 + 8 + (lane & 7)) = (unsigned char)(((b0 & 15u) ^ 8u) | (((b1 & 15u) ^ 8u) << 4));
    t.sa = am * (1.0f / 119.0f);
}
__device__ __forceinline__ void c5_issue(C5Tok& t, LAS unsigned char* buf, const unsigned char* vbase, unsigned coff, const bf16* xr, int g) {
#pragma unroll
    for (int jj = 0; jj < 4; ++jj) {
        const v4u iv = *(const LAS v4u*)(buf + g * 64 + 16 * jj);
#pragma unroll
        for (int u = 0; u < 4; ++u) t.vv[4 * jj + u] = *(const v4u*)(vbase + (iv[u] | coff));
    }
#pragma unroll
    for (int m = 0; m < 4; ++m) t.xa[m] = *(const unsigned short*)(xr + 64 * m);
}
__device__ __forceinline__ void c5_finish(const C5Tok& t, LAS unsigned char* buf, LAS unsigned char* tile, bf16* xb, float* rss, int lane, int g, int c) {
    LAS unsigned char* wp = tile + g * LC_ROW + 16 * c;
#pragma unroll
    for (int j = 0; j < 16; ++j) *(LAS v4u*)(wp + j * 8 * LC_ROW) = t.vv[j];
    const LAS unsigned char* rp = tile + (lane & 15) * LC_ROW + 8 * (lane >> 4);
    int yh[4] = {0, 0, 0, 0}, yl[4] = {0, 0, 0, 0};
#pragma unroll
    for (int rb = 0; rb < 8; ++rb) {
        const v4u av = *(const LAS v4u*)(buf + 512 + 16 * rb);
#pragma unroll
        for (int m = 0; m < 4; ++m) {
            const v2i tv = __builtin_amdgcn_ds_read_tr4_b64_v2i32((LAS v2i*)(rp + rb * 16 * LC_ROW + 32 * m));
            yh[m] = __builtin_amdgcn_sdot8(tv.x, (int)av.x, yh[m], false); yl[m] = __builtin_amdgcn_sdot8(tv.x, (int)av.z, yl[m], false);
            yh[m] = __builtin_amdgcn_sdot8(tv.y, (int)av.y, yh[m], false); yl[m] = __builtin_amdgcn_sdot8(tv.y, (int)av.w, yl[m], false);
        }
    }
    float o[4], sq = 0.f;
#pragma unroll
    for (int m = 0; m < 4; ++m) { o[m] = bf_lo((unsigned)t.xa[m]) + (float)(16 * yh[m] + yl[m]) * t.sa; sq += o[m] * o[m]; }
    const float ss = wave_sum_dpp(sq);
    const unsigned w0 = pk2(o[0], o[1]), w1 = pk2(o[2], o[3]);
    *(unsigned short*)xb = (unsigned short)(w0 & 0xffffu); *(unsigned short*)(xb + 64) = (unsigned short)(w0 >> 16);
    *(unsigned short*)(xb + 128) = (unsigned short)(w1 & 0xffffu); *(unsigned short*)(xb + 192) = (unsigned short)(w1 >> 16);
    if (lane == 0) { rss[0] = ss; rss[4] = 0.f; }
}
__device__ __forceinline__ void p5c_axpy(const Args& a, LAS unsigned char* lds, int bx, int G, int tid, int lane, int wave) {
    unsigned char* ws = a.ws;
    const unsigned char* V8 = ws + WS_VB; const unsigned* PK = (const unsigned*)(ws + WS_PK);
    const bf16* XB1 = (const bf16*)(ws + WS_R2); bf16* XB2 = (bf16*)(ws + WS_R1); float* RSS2 = (float*)(ws + WS_RSS2);
    const int g = lane >> 3, c = lane & 7;
    LAS unsigned char* buf0 = lds + LC_BUF + wave * (2 * LC_SB); LAS unsigned char* buf1 = buf0 + LC_SB; LAS unsigned char* tile = lds + LC_TILE + wave * (128 * LC_ROW);
    for (int vb = bx; vb < 256; vb += G) {
        const int vx = vb & 7, cs = vx & 3, wi = vb >> 3;
        const size_t tw0 = (size_t)(vx >> 2) * (T / 2) + (size_t)wi * 512 + wave * 64;
        const unsigned char* vbase = V8 + (size_t)cs * ((size_t)NEXP * 128); const unsigned coff = 16u * (unsigned)c;
        const bf16* xcol = XB1 + cs * 256 + lane; bf16* xbcol = XB2 + cs * 256 + lane;
        C5Tok A, B;
        v2u pk = *(const v2u*)(PK + tw0 * 128 + 2 * lane);
        c5_stage(A, buf0, pk, lane);
        pk = *(const v2u*)(PK + (tw0 + 1) * 128 + 2 * lane);
        LDS_WAIT(); asm volatile("" ::: "memory");
        c5_issue(A, buf0, vbase, coff, xcol + tw0 * D, g);
#pragma unroll 1
        for (int i = 0; i < 64; i += 2) {
            const size_t tok = tw0 + i;
            c5_stage(B, buf1, pk, lane);
            if (i + 2 < 64) pk = *(const v2u*)(PK + (tok + 2) * 128 + 2 * lane);
            LDS_WAIT(); asm volatile("" ::: "memory");
            c5_issue(B, buf1, vbase, coff, xcol + (tok + 1) * D, g);
            c5_finish(A, buf0, tile, xbcol + tok * D, RSS2 + tok * 8 + cs, lane, g, c);
            if (i + 2 < 64) {
                c5_stage(A, buf0, pk, lane);
                if (i + 3 < 64) pk = *(const v2u*)(PK + (tok + 3) * 128 + 2 * lane);
                LDS_WAIT(); asm volatile("" ::: "memory");
                c5_issue(A, buf0, vbase, coff, xcol + (tok + 2) * D, g);
            }
            c5_finish(B, buf1, tile, xbcol + (tok + 1) * D, RSS2 + (tok + 1) * 8 + cs, lane, g, c);
        }
    }
}

__global__ void __launch_bounds__(NTHR, 2) mk_fwd(Args a) {
    extern __shared__ __attribute__((aligned(16))) unsigned char lds_raw[];
    LAS unsigned char* lds = (LAS unsigned char*)lds_raw;
    const int tid = threadIdx.x, lane = tid & 63, wave = __builtin_amdgcn_readfirstlane(tid >> 6);
    const int G = gridDim.x, bx = blockIdx.x, vcu = (G % 8 == 0) ? (bx % 8) * (G / 8) + bx / 8 : bx;
    volatile LAS unsigned* MISC = (volatile LAS unsigned*)(lds + MISC_OFF);
    if (tid < 64) MISC[tid] = 0u;
    __syncthreads();
    unsigned char* ws = a.ws;
    const int lo = a.ph_lo, hi = a.ph_hi;
    XcdBarrier bar; bar.bar = (unsigned*)(ws + WS_CTL) + CW_BAR + a.li * XCD_BAR_WORDS; bar.x = 0; bar.st = nullptr;
    if (hi - lo > 1) bar = xcd_barrier_post((unsigned*)(ws + WS_CTL) + CW_BAR + a.li * XCD_BAR_WORDS, MISC + 8);
#define IN(k) (lo <= (k) && (k) < hi)
#define BOTH(k) (IN(k) && IN((k) + 1))
    if (IN(0)) { p0_prologue(a, lds, vcu, G, tid, lane, wave); if (BOTH(0)) xcd_barrier_work(bar, a, lds, 0, vcu, G, wave, lane); }
    if (IN(1)) {
        { pg8::Gemm g{(const bf16*)(ws + WS_XB0), (const bf16*)(ws + WS_WIN), T, NIN, D}; pg8::StaticOrder S; S.init(T, NIN, G, bx);
          EpiStoreBf16 E{(bf16*)(ws + WS_R2), NIN, (const float*)(ws + WS_RSTD0)};
          pg8::gemm_phase<EpiStoreBf16, pg8::StaticOrder, true, true>(lds, g, S, E); }
        { pg8::Gemm g{(const bf16*)(ws + WS_PB), (const bf16*)(ws + WS_WP), T / 2, D, PLE}; pg8::StaticOrder S; S.init(T / 2, D, G, bx);
          EpiStoreBf16 E{(bf16*)(ws + WS_PP), D, nullptr};
          pg8::gemm_phase<EpiStoreBf16, pg8::StaticOrder, true, true>(lds, g, S, E); }
        { pg8::Gemm g{(const bf16*)(ws + WS_PB) + (size_t)(T / 2) * PLE, (const bf16*)(ws + WS_WP), T / 2, D, PLE}; pg8::StaticOrder S;
          if (G == 256) S.init(T / 2, D, 128, bx >= 128 ? bx - 128 : (1 << 28)); else S.init(T / 2, D, G, bx);
          EpiStoreBf16 E{(bf16*)(ws + WS_PP) + (size_t)(T / 2) * D, D, nullptr};
          pg8::gemm_phase<EpiStoreBf16, pg8::StaticOrder, true, true>(lds, g, S, E); }
        if (BOTH(1)) xcd_barrier_work(bar, a, lds, 1, vcu, G, wave, lane);
    }
    if (IN(2)) { p2_mixing(a, lds, bx, G, tid, lane, wave); if (BOTH(2)) xcd_barrier_work(bar, a, lds, 2, vcu, G, wave, lane); }
    if (IN(3)) {
        pg8::Gemm g{(const bf16*)(ws + WS_R1), (const bf16*)(ws + WS_WOUT), T, D, D}; pg8::StaticOrder S; S.init(T, D, G, bx);
        EpiResid E{(const bf16*)(ws + WS_XB0), (bf16*)(ws + WS_R2)};
        pg8::gemm_phase<EpiResid, pg8::StaticOrder, true, true>(lds, g, S, E);
        if (BOTH(3)) xcd_barrier_work(bar, a, lds, 3, vcu, G, wave, lane);
    }
    if (IN(4)) {
        pg8::Gemm g{(const bf16*)(ws + WS_R2), (const bf16*)(ws + WS_WQ), T, NQ, D}; pg8::StaticOrder S; S.init(T, NQ, G, bx);
        EpiStoreBf16 E{(bf16*)(ws + WS_R2 + 64 * MB), NQ, nullptr};
        pg8::gemm_phase<EpiStoreBf16, pg8::StaticOrder, true, true>(lds, g, S, E);
        if (BOTH(4)) xcd_barrier_work(bar, a, lds, 4, vcu, G, wave, lane);
    }
    if (IN(5)) {
        p5a_topk(a, lds, vcu, G, tid, lane, wave PT_ARG); xcd_barrier(bar);
        p5b_dots(a, lds, bx, G, tid, lane, wave); xcd_barrier(bar);
        p5c_axpy(a, lds, bx, G, tid, lane, wave);
        if (BOTH(5)) xcd_barrier(bar);
    }
    if (IN(6)) {
        pg8::Gemm g{(const bf16*)(ws + WS_R1), (const bf16*)(ws + WS_WG), T, D, D}; pg8::StaticOrder S; S.init(T, D, G, bx);
        EpiGate E{a.out, (const bf16*)(ws + WS_R1), (const bf16*)(ws + WS_PP), (const float*)(ws + WS_RSS2)};
        pg8::gemm_phase<EpiGate, pg8::StaticOrder, true, true>(lds, g, S, E);
    }
#undef IN
#undef BOTH
}
}
extern "C" void kernel_launch(void* const* d_in, const int* in_sizes, int n_in, void* d_out, int out_size, void* d_ws, size_t ws_size, hipStream_t stream) {
    using namespace mk;
    static int grid = 0;
    if (grid == 0) {
        int dev = 0, cus = 0;
        if (n_in != 16 || out_size != T * D || ws_size < WS_END) { fprintf(stderr, "kernel_launch: unexpected problem shape / workspace (%d inputs, out %d, ws %zu)\n", n_in, out_size, ws_size); grid = -1; return; }
        if (hipGetDevice(&dev) != hipSuccess || hipDeviceGetAttribute(&cus, hipDeviceAttributeMultiprocessorCount, dev) != hipSuccess) { fprintf(stderr, "device query failed\n"); grid = -1; return; }
        if (hipFuncSetAttribute((const void*)mk_fwd, hipFuncAttributeMaxDynamicSharedMemorySize, LDS_BYTES) != hipSuccess) { fprintf(stderr, "hipFuncSetAttribute failed\n"); grid = -1; return; }
        int per_cu = 0;
        if (hipOccupancyMaxActiveBlocksPerMultiprocessor(&per_cu, (const void*)mk_fwd, NTHR, LDS_BYTES) != hipSuccess || per_cu < 1) { fprintf(stderr, "occupancy query: %d blocks per CU\n", per_cu); (void)hipGetLastError(); }
        if (cus < 256) { fprintf(stderr, "kernel_launch: this kernel is laid out for a 256-CU device (found %d CUs)\n", cus); grid = -1; return; }
        grid = 256;
    }
    if (grid < 0) return;
    unsigned char* ws = (unsigned char*)d_ws;
    (void)hipMemsetAsync(ws + WS_CTL, 0, CTL_BYTES, stream);
    Args a{};
    for (int i = 0; i < 16; ++i) a.in[i] = (const float*)d_in[i];
    a.out = (float*)d_out; a.ws = ws; a.ph_lo = 0; a.ph_hi = 7; a.li = 0; a.pad = 0;
    hipLaunchKernelGGL(mk_fwd, dim3(grid), dim3(NTHR), LDS_BYTES, stream, a);
}
```

```cpp
#include <hip/hip_runtime.h>
#include <cstdio>
#include <cstdint>
#define LAS __attribute__((address_space(3)))
#define GAS __attribute__((address_space(1)))
namespace pg8 {
#define PG8_LAS __attribute__((address_space(3)))
typedef unsigned short bf16_t;
typedef short bf16x8 __attribute__((ext_vector_type(8)));
typedef float f32x4 __attribute__((ext_vector_type(4)));
typedef unsigned u32x4 __attribute__((ext_vector_type(4)));
constexpr int BM = 256, BK = 64, HALF = 128, HTB = HALF * BK * 2  , STAGE_BYTES = 8 * HTB, NXCD = 8, WGM = 8;

__host__ __device__ __forceinline__ int lds_byte(int r, int c) { const int st = (r >> 4) * 2 + (c >> 5), rr = r & 15, cc = c & 31, ob = rr * 64 + cc * 2; return st * 1024 + (ob ^ (((ob >> 9) & 1) << 5)); }
__host__ __device__ __forceinline__ void stage_rc(int b, int& R, int& C) { const int st = b / 1024, sb = b % 1024, swz = sb ^ (((sb >> 9) & 1) << 5); R = (st >> 1) * 16 + swz / 64; C = (st & 1) * 32 + (swz % 64) / 2; }
__host__ __device__ __forceinline__ int perm32(int rho) { const int n = rho >> 4, i = rho & 15; return 8 * (i >> 2) + 4 * n + (i & 3); }

struct Unit { int pm, pn; };
struct Gemm { const bf16_t* A; const bf16_t* Bt; int M, N, K; };

struct StaticOrder {
    int nM, nN, nwg, G, c;
    __host__ __device__ void init(int M, int N, int G_, int c_) { nM = M / BM; nN = N / BM; nwg = nM * nN; G = G_; c = c_; }
    __host__ __device__ bool next(int i, Unit& u) const {
        const long L = (long)i * G + c; if (L >= nwg) return false;
        int wgid = (int)L; { const int q = nwg / NXCD, r = nwg % NXCD, xcd = wgid % NXCD, off = wgid / NXCD; wgid = (xcd < r ? xcd * (q + 1) : r * (q + 1) + (xcd - r) * q) + off; }
        const int nig = WGM * nN, gid = wgid / nig, fm = gid * WGM, gsz = (nM - fm) < WGM ? (nM - fm) : WGM;
        u.pm = fm + ((wgid % nig) % gsz); u.pn = (wgid % nig) / gsz; return true;
    }
    __device__ __forceinline__ void a_ready(const Unit&) const {}
    __device__ __forceinline__ void done(const Unit&) const {}
};
__device__ __forceinline__ unsigned cvt_pk_bf16(float lo, float hi) { unsigned r; asm volatile("v_cvt_pk_bf16_f32 %0, %1, %2" : "=v"(r) : "v"(lo), "v"(hi)); return r; }
template <class Epi, class Sched, bool ALIGN_EPI = false, bool SP2 = false>
__device__ __forceinline__ void gemm_phase(PG8_LAS unsigned char* lds, const Gemm g, const Sched& S, const Epi& E) {
    const int tid = threadIdx.x, wid = __builtin_amdgcn_readfirstlane(tid >> 6), lane = tid & 63, wr = wid >> 2, wc = wid & 3, fr = lane & 15, fq = lane >> 4;
    const int K = g.K, nt = K / BK;
    unsigned voffA[2], voffB[2];
#pragma unroll
    for (int i = 0; i < 2; ++i) { int R, C; stage_rc(tid * 16 + i * 8192, R, C); const int Rb = Epi::PERM ? ((R & ~31) + perm32(R & 31)) : R;
        voffA[i] = (unsigned)(R * K + C) * 2u; voffB[i] = (unsigned)(Rb * K + C) * 2u; }
    const size_t kstep = (size_t)(BK * 2);
    const size_t hstep = (size_t)HALF * K * 2;
    const size_t tstep = 2 * hstep;
    const unsigned ldsw = (unsigned)wid * 1024u;
    const int aoff = lds_byte(wr * 64 + fr, fq * 8), boff = lds_byte(wc * 32 + fr, fq * 8);
#define PG8_SA(b, h) (((b) * 2 + (h)) * HTB)
#define PG8_SB(b, h) ((4 + (b) * 2 + (h)) * HTB)
#define PG8_STAGE(bufoff, gbase, voff) do { _Pragma("unroll") for (int _i = 0; _i < 2; ++_i) \
        __builtin_amdgcn_global_load_lds((const unsigned*)((const char*)(gbase) + (voff)[_i]), (PG8_LAS unsigned*)(lds + (bufoff) + ldsw + _i * 8192), 16, 0, 0); } while (0)
#define PG8_LDA(dst, b, h) do { _Pragma("unroll") for (int m = 0; m < 4; ++m) _Pragma("unroll") for (int k = 0; k < 2; ++k) dst[m][k] = *(const PG8_LAS bf16x8*)(lds + PG8_SA(b, h) + aoff + m * 2048 + k * 1024); } while (0)
#define PG8_LDB(dst, b, h) do { _Pragma("unroll") for (int n = 0; n < 2; ++n) _Pragma("unroll") for (int k = 0; k < 2; ++k) dst[n][k] = *(const PG8_LAS bf16x8*)(lds + PG8_SB(b, h) + boff + n * 2048 + k * 1024); } while (0)
#define PG8_MMA(ai, bj, At, Bt) do { __builtin_amdgcn_s_setprio(1); _Pragma("unroll") for (int m = 0; m < 4; ++m) _Pragma("unroll") for (int n = 0; n < 2; ++n) _Pragma("unroll") for (int k = 0; k < 2; ++k) \
        acc[ai][bj][m][n] = __builtin_amdgcn_mfma_f32_16x16x32_bf16(Bt[n][k], At[m][k], acc[ai][bj][m][n], 0, 0, 0); __builtin_amdgcn_s_setprio(0); } while (0)
#define PG8_WAIT_V(n) asm volatile("s_waitcnt vmcnt(" #n ")" ::: "memory")
#define PG8_WAIT_L(n) asm volatile("s_waitcnt lgkmcnt(" #n ")" ::: "memory")
#define PG8_BAR __builtin_amdgcn_s_barrier()
#define PG8_SCHED __builtin_amdgcn_sched_barrier(0)
    Unit cur, nxt; int ui = 0;
    if (!S.next(0, cur)) return;
    f32x4 acc[2][2][4][2];
#pragma unroll
    for (int a = 0; a < 2; ++a)
#pragma unroll
        for (int b = 0; b < 2; ++b)
#pragma unroll
            for (int m = 0; m < 4; ++m)
#pragma unroll
                for (int n = 0; n < 2; ++n) acc[a][b][m][n] = (f32x4){0.f, 0.f, 0.f, 0.f};
    bf16x8 At[4][2], B0[2][2], B1[2][2];
    const char* cA = (const char*)g.A + (size_t)cur.pm * tstep; const char* cB = (const char*)g.Bt + (size_t)cur.pn * tstep;
    S.a_ready(cur);
    if constexpr (SP2) {
        PG8_STAGE(PG8_SB(0, 0), cB, voffB); PG8_STAGE(PG8_SB(0, 1), cB + hstep, voffB); PG8_STAGE(PG8_SA(0, 0), cA, voffA); PG8_STAGE(PG8_SA(0, 1), cA + hstep, voffA);
        if (wr == 1) PG8_BAR;
        PG8_WAIT_V(2); PG8_BAR;
        PG8_STAGE(PG8_SB(1, 0), cB + kstep, voffB); PG8_STAGE(PG8_SA(1, 0), cA + kstep, voffA); PG8_STAGE(PG8_SB(1, 1), cB + hstep + kstep, voffB);
        PG8_WAIT_V(6); PG8_BAR;
    } else {
        PG8_STAGE(PG8_SB(0, 0), cB, voffB); PG8_STAGE(PG8_SA(0, 0), cA, voffA); PG8_STAGE(PG8_SB(0, 1), cB + hstep, voffB); PG8_STAGE(PG8_SA(0, 1), cA + hstep, voffA);
        if (wr == 1) PG8_BAR;
        PG8_WAIT_V(4); PG8_BAR;
        PG8_STAGE(PG8_SB(1, 0), cB + kstep, voffB); PG8_STAGE(PG8_SA(1, 0), cA + kstep, voffA); PG8_STAGE(PG8_SB(1, 1), cB + hstep + kstep, voffB);
        PG8_WAIT_V(6); PG8_BAR;
    }
    for (;;) {
        const bool has_next = S.next(ui + 1, nxt);
        const char* nA = has_next ? (const char*)g.A + (size_t)nxt.pm * tstep : cA; const char* nB = has_next ? (const char*)g.Bt + (size_t)nxt.pn * tstep : cB;
        for (int t = 0; t < nt; t += 2) {
            const bool last = (t == nt - 2);
            const char* a1 = cA + (size_t)(t + 1) * kstep;
            const char* a2 = last ? nA : cA + (size_t)(t + 2) * kstep; const char* b2 = last ? nB : cB + (size_t)(t + 2) * kstep;
            const char* a3 = a2 + kstep; const char* b3 = b2 + kstep;
            if (last && has_next) S.a_ready(nxt);
            if constexpr (SP2) {
            PG8_LDB(B0, 0, 0); PG8_LDB(B1, 0, 1); PG8_SCHED; PG8_LDA(At, 0, 0); PG8_STAGE(PG8_SA(1, 1), a1 + hstep, voffA);
            PG8_WAIT_V(8); PG8_WAIT_L(0); PG8_BAR; PG8_MMA(0, 0, At, B0); PG8_MMA(0, 1, At, B1); PG8_BAR; PG8_SCHED;
            PG8_LDA(At, 0, 1); PG8_STAGE(PG8_SB(0, 0), b2, voffB); PG8_STAGE(PG8_SB(0, 1), b2 + hstep, voffB); PG8_STAGE(PG8_SA(0, 0), a2, voffA);
            PG8_WAIT_V(8); PG8_WAIT_L(0); PG8_BAR; PG8_MMA(1, 0, At, B0); PG8_MMA(1, 1, At, B1); PG8_BAR; PG8_SCHED;
            PG8_LDB(B0, 1, 0); PG8_LDB(B1, 1, 1); PG8_SCHED; PG8_LDA(At, 1, 0); PG8_STAGE(PG8_SA(0, 1), a2 + hstep, voffA);
            PG8_WAIT_V(8); PG8_WAIT_L(0); PG8_BAR; PG8_MMA(0, 0, At, B0); PG8_MMA(0, 1, At, B1); PG8_BAR; PG8_SCHED;
            PG8_LDA(At, 1, 1); PG8_STAGE(PG8_SB(1, 0), b3, voffB); PG8_STAGE(PG8_SB(1, 1), b3 + hstep, voffB); PG8_STAGE(PG8_SA(1, 0), a3, voffA);
            PG8_WAIT_V(8); PG8_WAIT_L(0); PG8_BAR; PG8_MMA(1, 0, At, B0); PG8_MMA(1, 1, At, B1); PG8_BAR; PG8_SCHED;
            } else {
            PG8_LDB(B0, 0, 0); PG8_SCHED; PG8_LDA(At, 0, 0); PG8_STAGE(PG8_SA(1, 1), a1 + hstep, voffA);
            PG8_WAIT_L(8); PG8_BAR; PG8_WAIT_L(0); PG8_MMA(0, 0, At, B0); PG8_BAR; PG8_SCHED;
            PG8_LDB(B1, 0, 1); PG8_STAGE(PG8_SB(0, 0), b2, voffB);
            PG8_BAR; PG8_WAIT_L(0); PG8_MMA(0, 1, At, B1); PG8_BAR;
            PG8_LDA(At, 0, 1); PG8_STAGE(PG8_SA(0, 0), a2, voffA);
            PG8_BAR; PG8_WAIT_L(0); PG8_MMA(1, 0, At, B0); PG8_BAR; PG8_SCHED;
            PG8_STAGE(PG8_SB(0, 1), b2 + hstep, voffB);
            PG8_WAIT_V(6); PG8_BAR; PG8_MMA(1, 1, At, B1); PG8_BAR;
            PG8_LDB(B0, 1, 0); PG8_SCHED; PG8_LDA(At, 1, 0); PG8_STAGE(PG8_SA(0, 1), a2 + hstep, voffA);
            PG8_WAIT_L(8); PG8_BAR; PG8_WAIT_L(0); PG8_MMA(0, 0, At, B0); PG8_BAR; PG8_SCHED;
            PG8_LDB(B1, 1, 1); PG8_STAGE(PG8_SB(1, 0), b3, voffB);
            PG8_BAR; PG8_WAIT_L(0); PG8_MMA(0, 1, At, B1); PG8_BAR;
            PG8_LDA(At, 1, 1); PG8_STAGE(PG8_SA(1, 0), a3, voffA);
            PG8_BAR; PG8_WAIT_L(0); PG8_MMA(1, 0, At, B0); PG8_BAR; PG8_SCHED;
            PG8_STAGE(PG8_SB(1, 1), b3 + hstep, voffB);
            PG8_WAIT_V(6); PG8_BAR; PG8_MMA(1, 1, At, B1); PG8_BAR;
            }
        }
        if constexpr (ALIGN_EPI) { if (wr == 0) PG8_BAR; }
        if constexpr (!Epi::AFTER_DRAIN) { E(acc, cur, wr, wc, fr, fq); S.done(cur); }
        if (!has_next) break;
#pragma unroll
        for (int a = 0; a < 2; ++a)
#pragma unroll
            for (int b = 0; b < 2; ++b)
#pragma unroll
                for (int m = 0; m < 4; ++m)
#pragma unroll
                    for (int n = 0; n < 2; ++n) acc[a][b][m][n] = (f32x4){0.f, 0.f, 0.f, 0.f};
        cur = nxt; cA = nA; cB = nB; ++ui;
        if constexpr (ALIGN_EPI) { if (wr == 1) PG8_BAR; }
    }
    PG8_WAIT_V(0);
    if constexpr (!ALIGN_EPI) { if (wr == 0) PG8_BAR; }
    PG8_BAR;
    if constexpr (Epi::AFTER_DRAIN) { E.fused(acc, cur, wr, wc, fr, fq, lds, wid, lane); S.done(cur); }
#undef PG8_SA
#undef PG8_SB
#undef PG8_STAGE
#undef PG8_LDA
#undef PG8_LDB
#undef PG8_MMA
#undef PG8_WAIT_V
#undef PG8_WAIT_L
#undef PG8_BAR
#undef PG8_SCHED
}
}
#define XB_TMO      128
#define XB_XCNT(j)  (256  + 64 * (j))
#define XB_XSUB(j)  (1280 + 64 * (j))
#define XB_XGEN(j)  (2304 + 64 * (j))
#define XB_TOP      3328
#define XB_TOPGEN   3392
#define XCD_BAR_WORDS 3456
#define XB_SPIN_CAP (1u << 18)

__device__ __forceinline__ unsigned xb_ld(unsigned* p)              { return __hip_atomic_load(p, __ATOMIC_RELAXED, __HIP_MEMORY_SCOPE_AGENT); }
__device__ __forceinline__ unsigned xb_add(unsigned* p, unsigned v) { return __hip_atomic_fetch_add(p, v, __ATOMIC_RELAXED, __HIP_MEMORY_SCOPE_AGENT); }
__device__ __forceinline__ unsigned xb_xcc_id() { return (unsigned)__builtin_amdgcn_s_getreg((3 << 11) | 20) & 0xFu; }
#define XB_SPIN(cond, bar) do { unsigned _sp = 0; while (cond) { __builtin_amdgcn_s_sleep(1); \
    if ((++_sp & 255u) == 0u) { if (xb_ld(&(bar)[XB_TMO])) break; if (_sp > XB_SPIN_CAP) { atomicAdd(&(bar)[XB_TMO], 1u); break; } } } } while (0)

struct XcdBarrier {
    unsigned* bar; unsigned x;
    volatile LAS unsigned* st;
};

__device__ __forceinline__ XcdBarrier xcd_barrier_post(unsigned* bar, volatile LAS unsigned* st) {
    XcdBarrier b; b.bar = bar; b.x = xb_xcc_id(); b.st = st;
    if (threadIdx.x == 0) (void)xb_add(&bar[XB_XCNT(b.x)], 1u);
    return b;
}
__device__ __forceinline__ void xcd_barrier_complete(unsigned* bar, unsigned x, unsigned& nloc, unsigned& nx) {
    const unsigned G = gridDim.x * gridDim.y * gridDim.z;
    unsigned sum, cnt, mine, sp = 0u;
    for (;;) {
        sum = 0u; cnt = 0u; mine = 0u;
#pragma unroll
        for (unsigned j = 0; j < 16; ++j) { const unsigned c = xb_ld(&bar[XB_XCNT(j)]); sum += c; cnt += (c > 0u) ? 1u : 0u; mine = (j == x) ? c : mine; }
        if (sum == G) break;
        __builtin_amdgcn_s_sleep(1);
        if ((++sp & 255u) == 0u) { if (xb_ld(&bar[XB_TMO])) break; if (sp > XB_SPIN_CAP) { atomicAdd(&bar[XB_TMO], 1u); break; } }
    }
    nloc = mine > 0u ? mine : 1u; nx = cnt > 0u ? cnt : 1u;
}

__device__ __forceinline__ void xcd_barrier(const XcdBarrier& b) {
    asm volatile("s_waitcnt vmcnt(0)" ::: "memory");
    __syncthreads();
    if (threadIdx.x == 0) {
        unsigned* bar = b.bar;
        __builtin_amdgcn_s_waitcnt(0);
        unsigned nloc = b.st[0], nx = b.st[1];
        if (nloc == 0u) { xcd_barrier_complete(bar, b.x, nloc, nx); b.st[0] = nloc; b.st[1] = nx; }
        const unsigned old = xb_add(&bar[XB_XSUB(b.x)], 1u);
        const unsigned gen = old / nloc;
        if (old + 1u == (gen + 1u) * nloc) {
            __builtin_amdgcn_fence(__ATOMIC_RELEASE, "agent");
            asm volatile("s_waitcnt vmcnt(0)" ::: "memory");
            const unsigned og = xb_add(&bar[XB_TOP], 1u);
            const unsigned tg = og / nx;
            if (og + 1u == (tg + 1u) * nx) xb_add(&bar[XB_TOPGEN], 1u);
            else XB_SPIN(xb_ld(&bar[XB_TOPGEN]) == tg, bar);
            __builtin_amdgcn_fence(__ATOMIC_ACQUIRE, "agent");
            xb_add(&bar[XB_XGEN(b.x)], 1u);
            asm volatile("s_waitcnt vmcnt(0)" ::: "memory");
        } else {
            XB_SPIN(xb_ld(&bar[XB_XGEN(b.x)]) == gen, bar);
            __builtin_amdgcn_fence(__ATOMIC_ACQUIRE, "agent");
            asm volatile("s_waitcnt vmcnt(0)" ::: "memory");
        }
    }
    __syncthreads();
}
namespace mk {
typedef unsigned short bf16;
typedef unsigned v4u __attribute__((ext_vector_type(4)));
typedef unsigned v2u __attribute__((ext_vector_type(2)));
typedef float f32x4 __attribute__((ext_vector_type(4)));
typedef float f32x16 __attribute__((ext_vector_type(16)));
typedef short bf16x8 __attribute__((ext_vector_type(8)));
typedef short bf16x4 __attribute__((ext_vector_type(4)));

constexpr int T = 32768, D = 1024, SQ = 4096, NIN = 2816, NQ = 2048, PLE = 256, NEXP = 16384;
constexpr int NWAVES = 8, NTHR = 512;
constexpr int RING_BYTES = 131072, LDS_BYTES = 163840, MISC_OFF = LDS_BYTES - 256;

constexpr size_t MB = 1024 * 1024;
constexpr size_t WS_CTL = 0, CTL_BYTES = 256 * 1024;
constexpr size_t WS_WIN = WS_CTL + CTL_BYTES;
constexpr size_t WS_WOUT = WS_WIN + (size_t)NIN * D * 2;
constexpr size_t WS_WQ = WS_WOUT + (size_t)D * D * 2;
constexpr size_t WS_WG = WS_WQ + (size_t)NQ * D * 2;
constexpr size_t WS_WP = WS_WG + (size_t)D * D * 2;
constexpr size_t WS_KEYS = WS_WP + (size_t)D * PLE * 2;
constexpr size_t WS_ROPE = WS_KEYS + 2 * 128 * 128 * 2;
constexpr size_t WS_SU = WS_ROPE + 2 * (size_t)SQ * 32 * 4;
constexpr size_t WS_SV = WS_SU + 65536;
constexpr size_t WS_SH = WS_SV + 65536;
constexpr size_t WS_SHS = WS_SH + (size_t)T * 4;
constexpr size_t WS_UB = 16 * MB;
constexpr size_t WS_VB = 32 * MB;
constexpr size_t WS_PB = 48 * MB;
constexpr size_t WS_PK = 64 * MB;
constexpr size_t WS_R1 = 96 * MB;
constexpr size_t WS_R2 = 160 * MB;
constexpr size_t WS_PP = 352 * MB;
constexpr size_t WS_RSS2 = 80 * MB;
constexpr size_t WS_RSTD0 = 82 * MB;
constexpr size_t WS_XB0 = 416 * MB;
constexpr size_t WS_END = 480 * MB;
static_assert(WS_SHS + (size_t)T * 4 <= WS_UB, "ws map");
constexpr int CW_BAR = 1024;

#define LDS_WAIT() asm volatile("s_waitcnt lgkmcnt(0)" ::: "memory")
#define VM_WAIT() asm volatile("s_waitcnt vmcnt(0)" ::: "memory")
typedef float f32x2 __attribute__((ext_vector_type(2)));
typedef int v2i __attribute__((ext_vector_type(2)));
typedef __bf16 b16x2 __attribute__((ext_vector_type(2)));
__device__ __forceinline__ unsigned pk2(float lo, float hi) { const f32x2 v = {lo, hi}; return __builtin_bit_cast(unsigned, __builtin_convertvector(v, b16x2)); }
__device__ __forceinline__ float bf_lo(unsigned w) { return __uint_as_float(w << 16); }
__device__ __forceinline__ float bf_hi(unsigned w) { return __uint_as_float(w & 0xffff0000u); }
__device__ __forceinline__ float wave_sum(float v) {
#pragma unroll
    for (int o = 1; o < 64; o <<= 1) v += __shfl_xor(v, o);
    return v;
}

#ifndef PROBE_ON
#define PT_DECL
#define PT_ARG
#define PT_BEGIN()
#define PT_ADD(k)
#endif
struct Args { const float* in[16]; float* out; unsigned char* ws; int ph_lo, ph_hi, li, pad; };

struct EpiStoreBf16 {
    static constexpr bool PERM = true, AFTER_DRAIN = false;
    bf16* O; int ldc; const float* rowscale;
    __device__ __forceinline__ void operator()(const pg8::f32x4 (&acc)[2][2][4][2], const pg8::Unit& u, int wr, int wc, int fr, int fq) const {
        const int row0 = u.pm * 256 + wr * 64 + fr, col0 = u.pn * 256 + wc * 32 + 8 * fq;
#pragma unroll
        for (int ai = 0; ai < 2; ++ai)
#pragma unroll
            for (int m = 0; m < 4; ++m) { bf16* rowp = O + (size_t)(row0 + ai * 128 + m * 16) * ldc + col0; const float rsc = rowscale ? rowscale[row0 + ai * 128 + m * 16] : 1.0f;
#pragma unroll
                for (int bj = 0; bj < 2; ++bj) { const pg8::f32x4 v0 = acc[ai][bj][m][0] * rsc, v1 = acc[ai][bj][m][1] * rsc;
                    pg8::u32x4 w; w.x = pk2(v0[0], v0[1]); w.y = pk2(v0[2], v0[3]); w.z = pk2(v1[0], v1[1]); w.w = pk2(v1[2], v1[3]);
                    *(pg8::u32x4*)(rowp + bj * 128) = w; } }
    }
};


struct EpiResid {
    static constexpr bool PERM = true, AFTER_DRAIN = false;
    const bf16* X; bf16* XB;
    __device__ __forceinline__ void operator()(const pg8::f32x4 (&acc)[2][2][4][2], const pg8::Unit& u, int wr, int wc, int fr, int fq) const {
        const int row0 = u.pm * 256 + wr * 64 + fr, col0 = u.pn * 256 + wc * 32 + 8 * fq;
#pragma unroll
        for (int ai = 0; ai < 2; ++ai)
#pragma unroll
            for (int m = 0; m < 4; ++m) { const size_t off = (size_t)(row0 + ai * 128 + m * 16) * D + col0;
#pragma unroll
                for (int bj = 0; bj < 2; ++bj) { const size_t o2 = off + bj * 128;
                    const pg8::u32x4 xw = *(const pg8::u32x4*)(X + o2);
                    const pg8::f32x4 v0 = acc[ai][bj][m][0] + (pg8::f32x4){bf_lo(xw.x), bf_hi(xw.x), bf_lo(xw.y), bf_hi(xw.y)}, v1 = acc[ai][bj][m][1] + (pg8::f32x4){bf_lo(xw.z), bf_hi(xw.z), bf_lo(xw.w), bf_hi(xw.w)};
                    pg8::u32x4 w; w.x = pk2(v0[0], v0[1]); w.y = pk2(v0[2], v0[3]); w.z = pk2(v1[0], v1[1]); w.w = pk2(v1[2], v1[3]);
                    *(pg8::u32x4*)(XB + o2) = w; } }
    }
};
struct EpiGate {
    static constexpr bool PERM = true, AFTER_DRAIN = false;
    float* O; const bf16* XB; const bf16* PP; const float* rss;
    __device__ __forceinline__ void operator()(const pg8::f32x4 (&acc)[2][2][4][2], const pg8::Unit& u, int wr, int wc, int fr, int fq) const {
        const int row0 = u.pm * 256 + wr * 64 + fr, col0 = u.pn * 256 + wc * 32 + 8 * fq;
#pragma unroll
        for (int ai = 0; ai < 2; ++ai)
#pragma unroll
            for (int m = 0; m < 4; ++m) { const int row = row0 + ai * 128 + m * 16; const size_t off = (size_t)row * D + col0;
                const pg8::f32x4 q0 = *(const pg8::f32x4*)(rss + (size_t)row * 8);
                const float rs = 1.0f / sqrtf(((q0[0] + q0[1]) + (q0[2] + q0[3])) * (1.0f / D) + 1e-6f);
#pragma unroll
                for (int bj = 0; bj < 2; ++bj) { const size_t o2 = off + bj * 128;
                    const pg8::u32x4 pw = *(const pg8::u32x4*)(PP + o2), xw = *(const pg8::u32x4*)(XB + o2);
                    const pg8::f32x4 a0 = acc[ai][bj][m][0] * rs, a1 = acc[ai][bj][m][1] * rs;
                    pg8::f32x4 x0, x1;
                    x0[0] = bf_lo(xw.x) + bf_lo(pw.x) * __builtin_amdgcn_rcpf(1.0f + __expf(-a0[0])); x0[1] = bf_hi(xw.x) + bf_hi(pw.x) * __builtin_amdgcn_rcpf(1.0f + __expf(-a0[1])); x0[2] = bf_lo(xw.y) + bf_lo(pw.y) * __builtin_amdgcn_rcpf(1.0f + __expf(-a0[2])); x0[3] = bf_hi(xw.y) + bf_hi(pw.y) * __builtin_amdgcn_rcpf(1.0f + __expf(-a0[3]));
                    x1[0] = bf_lo(xw.z) + bf_lo(pw.z) * __builtin_amdgcn_rcpf(1.0f + __expf(-a1[0])); x1[1] = bf_hi(xw.z) + bf_hi(pw.z) * __builtin_amdgcn_rcpf(1.0f + __expf(-a1[1])); x1[2] = bf_lo(xw.w) + bf_lo(pw.w) * __builtin_amdgcn_rcpf(1.0f + __expf(-a1[2])); x1[3] = bf_hi(xw.w) + bf_hi(pw.w) * __builtin_amdgcn_rcpf(1.0f + __expf(-a1[3]));
                    *(pg8::f32x4*)(O + o2) = x0; *(pg8::f32x4*)(O + o2 + 4) = x1; } }
    }
};

__device__ __forceinline__ void p0_transpose_item(const float* __restrict__ W, const float* __restrict__ gsc, int K, int N, bf16* __restrict__ WT, LAS float* scr, int item, int lane) {
    const int nblk = N / 32, kb = item / nblk, nb = item % nblk, k0 = 64 * kb, n0 = 32 * nb;
    float wv[32];
#pragma unroll
    for (int i = 0; i < 32; ++i) { const int kk = 2 * i + (lane >> 5); wv[i] = __builtin_nontemporal_load(W + (size_t)(k0 + kk) * N + n0 + (lane & 31)); }
    if (gsc) {
#pragma unroll
        for (int i = 0; i < 32; ++i) wv[i] *= gsc[k0 + 2 * i + (lane >> 5)];
    }
#pragma unroll
    for (int i = 0; i < 32; ++i) scr[(2 * i + (lane >> 5)) * 33 + (lane & 31)] = wv[i];
    LDS_WAIT(); asm volatile("" ::: "memory");
    const int c = lane & 7;
#pragma unroll
    for (int j = 0; j < 4; ++j) { const int n = (lane >> 3) + 8 * j; const LAS float* s = scr + (8 * c) * 33 + n;
        v4u o; o.x = pk2(s[0 * 33], s[1 * 33]); o.y = pk2(s[2 * 33], s[3 * 33]); o.z = pk2(s[4 * 33], s[5 * 33]); o.w = pk2(s[6 * 33], s[7 * 33]);
        *(v4u*)(WT + (size_t)(n0 + n) * K + k0 + 8 * c) = o; }
    LDS_WAIT(); asm volatile("" ::: "memory");
}
__device__ __forceinline__ void p0_convert(const float* __restrict__ src, bf16* __restrict__ dst, size_t n8, size_t gtid, size_t gthreads) {
    size_t i = gtid;
    for (; i + 3 * gthreads < n8; i += 4 * gthreads) {
        f32x4 a[4], b[4];
#pragma unroll
        for (int r = 0; r < 4; ++r) { a[r] = __builtin_nontemporal_load((const f32x4*)src + 2 * (i + r * gthreads)); b[r] = __builtin_nontemporal_load((const f32x4*)src + 2 * (i + r * gthreads) + 1); }
#pragma unroll
        for (int r = 0; r < 4; ++r) { v4u o; o.x = pk2(a[r][0], a[r][1]); o.y = pk2(a[r][2], a[r][3]); o.z = pk2(b[r][0], b[r][1]); o.w = pk2(b[r][2], b[r][3]); __builtin_nontemporal_store(o, (v4u*)dst + i + r * gthreads); }
    }
    for (; i < n8; i += gthreads) {
        const f32x4 a = ((const f32x4*)src)[2 * i], b = ((const f32x4*)src)[2 * i + 1];
        v4u o; o.x = pk2(a[0], a[1]); o.y = pk2(a[2], a[3]); o.z = pk2(b[0], b[1]); o.w = pk2(b[2], b[3]);
        ((v4u*)dst)[i] = o;
    }
}
__device__ __forceinline__ void rms_row_to_bf16(const float* __restrict__ xrow, const float* __restrict__ g, bf16* __restrict__ orow, int lane) {
    const f32x4* xr = (const f32x4*)xrow + lane; const f32x4* gr = (const f32x4*)g + lane;
    f32x4 v[4]; float s = 0.f;
#pragma unroll
    for (int j = 0; j < 4; ++j) { v[j] = xr[64 * j]; s += (v[j][0] * v[j][0] + v[j][1] * v[j][1]) + (v[j][2] * v[j][2] + v[j][3] * v[j][3]); }
    const float rstd = 1.0f / sqrtf(wave_sum(s) * (1.0f / D) + 1e-6f);
    v2u* o8 = (v2u*)orow + lane;
#pragma unroll
    for (int j = 0; j < 4; ++j) { const f32x4 gg = gr[64 * j]; v2u w; w.x = pk2(v[j][0] * rstd * gg[0], v[j][1] * rstd * gg[1]); w.y = pk2(v[j][2] * rstd * gg[2], v[j][3] * rstd * gg[3]); o8[64 * j] = w; }
}

__device__ __forceinline__ void quant_rows(const Args& a, int r0, int rstride, int cnt, int lane) {
    unsigned char* ws = a.ws;
    f32x4 xs[4][4];
#pragma unroll
    for (int rr = 0; rr < 4; ++rr) {
        const int r = r0 + rr * rstride; const bool ok = rr < cnt && r < 2 * NEXP; const int rc = ok ? r : 0; const int isv = rc >= NEXP, e = isv ? rc - NEXP : rc;
        const f32x4* src = (const f32x4*)((isv ? a.in[12] : a.in[11]) + (size_t)e * D) + lane;
#pragma unroll
        for (int j = 0; j < 4; ++j) xs[rr][j] = __builtin_nontemporal_load(src + 64 * j);
    }
#pragma unroll
    for (int rr = 0; rr < 4; ++rr) {
        const int r = r0 + rr * rstride; const bool ok = rr < cnt && r < 2 * NEXP; const int rc = ok ? r : 0; const int isv = rc >= NEXP, e = isv ? rc - NEXP : rc;
        float am = 0.f, sq = 0.f;
#pragma unroll
        for (int j = 0; j < 4; ++j)
#pragma unroll
            for (int u = 0; u < 4; ++u) { am = fmaxf(am, fabsf(xs[rr][j][u])); sq += xs[rr][j][u] * xs[rr][j][u]; }
#pragma unroll
        for (int o = 1; o < 64; o <<= 1) { am = fmaxf(am, __shfl_xor(am, o)); sq += __shfl_xor(sq, o); }
        if (ok && isv) {
            const float step = fminf(0.355f * sqrtf(sq * (1.0f / D)), am * (1.0f / 7.0f));
            const float inv = step > 0.f ? 1.0f / step : 0.f;
#pragma unroll
            for (int j = 0; j < 4; ++j) { unsigned ww = 0u;
#pragma unroll
                for (int u = 0; u < 4; ++u) { int t = __float2int_rn(xs[rr][j][u] * inv); t = t < -7 ? -7 : t > 7 ? 7 : t; ww |= ((unsigned)t & 0xfu) << (4 * u); }
                const unsigned other = (unsigned)__builtin_amdgcn_update_dpp(0, (int)ww, 0xB1, 0xf, 0xf, false);
                const unsigned lo = (lane & 1) ? other : ww, hi = (lane & 1) ? ww : other; const int u0 = 2 * (lane & 1);
                unsigned char* vrow = ws + WS_VB + (size_t)j * ((size_t)NEXP * 128) + (size_t)e * 128 + (lane >> 1);
                vrow[32 * u0] = (unsigned char)(((lo >> (4 * u0)) & 15u) | (((hi >> (4 * u0)) & 15u) << 4));
                vrow[32 * (u0 + 1)] = (unsigned char)(((lo >> (4 * u0 + 4)) & 15u) | (((hi >> (4 * u0 + 4)) & 15u) << 4)); }
            if (lane == 0) ((float*)(ws + WS_SU))[2 * e + 1] = step;
        } else if (ok) {
            const float step = fminf(0.3352f * sqrtf(sq * (1.0f / D)), am * (1.0f / 7.5f));
            const float inv = step > 0.f ? 1.0f / step : 0.f;
#pragma unroll
            for (int j = 0; j < 4; ++j) { unsigned ww = 0u;
#pragma unroll
                for (int u = 0; u < 4; ++u) { int t = (int)floorf(xs[rr][j][u] * inv); t = t < -8 ? -8 : t > 7 ? 7 : t; ww |= ((unsigned)t & 0xfu) << (4 * u); }
                __builtin_nontemporal_store((unsigned short)ww, (unsigned short*)(ws + WS_UB + (size_t)e * 512 + 2 * lane + 128 * j)); }
            if (lane == 0) ((float*)(ws + WS_SU))[2 * e] = step;
        }
    }
}
#define XB_LSUB(j) (XCD_BAR_WORDS + 64 * (j))
#define XB_LGEN(j) (XCD_BAR_WORDS + 1024 + 64 * (j))
#define XB_CENSUS  (XCD_BAR_WORDS + 2048)
__device__ __forceinline__ void xcd_barrier_work(const XcdBarrier& b, const Args& a, LAS unsigned char* lds, int k, int vcu, int G, int wave, int lane, bool local = false) {
    asm volatile("s_waitcnt vmcnt(0)" ::: "memory");
    __syncthreads();
    if (wave == 0) {
      if (threadIdx.x == 0) {
        unsigned* bar = b.bar;
        __builtin_amdgcn_s_waitcnt(0);
        unsigned nloc = b.st[0], nx = b.st[1];
        if (nloc == 0u) { xcd_barrier_complete(bar, b.x, nloc, nx); b.st[0] = nloc; b.st[1] = nx; }
        if (local) {
            const unsigned old = xb_add(&bar[XB_LSUB(b.x)], 1u);
            const unsigned gen = old / nloc;
            if (old + 1u == (gen + 1u) * nloc) xb_add(&bar[XB_LGEN(b.x)], 1u);
            else XB_SPIN(xb_ld(&bar[XB_LGEN(b.x)]) == gen, bar);
            __builtin_amdgcn_fence(__ATOMIC_ACQUIRE, "agent");
            asm volatile("s_waitcnt vmcnt(0)" ::: "memory");
        } else {
        const unsigned old = xb_add(&bar[XB_XSUB(b.x)], 1u);
        const unsigned gen = old / nloc;
        if (old + 1u == (gen + 1u) * nloc) {
            __builtin_amdgcn_fence(__ATOMIC_RELEASE, "agent");
            asm volatile("s_waitcnt vmcnt(0)" ::: "memory");
            const unsigned og = xb_add(&bar[XB_TOP], 1u);
            const unsigned tg = og / nx;
            if (og + 1u == (tg + 1u) * nx) xb_add(&bar[XB_TOPGEN], 1u);
            else XB_SPIN(xb_ld(&bar[XB_TOPGEN]) == tg, bar);
            __builtin_amdgcn_fence(__ATOMIC_ACQUIRE, "agent");
            xb_add(&bar[XB_XGEN(b.x)], 1u);
            asm volatile("s_waitcnt vmcnt(0)" ::: "memory");
        } else {
            XB_SPIN(xb_ld(&bar[XB_XGEN(b.x)]) == gen, bar);
            __builtin_amdgcn_fence(__ATOMIC_ACQUIRE, "agent");
            asm volatile("s_waitcnt vmcnt(0)" ::: "memory");
        }
        }
      }
    } else {
        const int NW = G * (NWAVES - 1), gww = vcu * (NWAVES - 1) + (wave - 1);
        if (k == 1) {
            constexpr int I_OUT = (D / 64) * (D / 32), I_Q = (D / 64) * (NQ / 32), I_G = I_OUT;
            LAS float* scr = (LAS float*)(lds + wave * 16384);
            for (int it = gww; it < I_OUT + I_Q + I_G; it += NW) {
                int r = it;
                if (r < I_OUT) { p0_transpose_item(a.in[7], nullptr, D, D, (bf16*)(a.ws + WS_WOUT), scr, r, lane); continue; } r -= I_OUT;
                if (r < I_Q) { p0_transpose_item(a.in[9], a.in[8], D, NQ, (bf16*)(a.ws + WS_WQ), scr, r, lane); continue; } r -= I_Q;
                p0_transpose_item(a.in[14], a.in[13], D, D, (bf16*)(a.ws + WS_WG), scr, r, lane);
            }
        }
        { const int cnt = (k < 3) ? 5 : (k == 3) ? 4 : 0, before = 5 * (k < 3 ? k : 3);
          if (cnt > 0) { quant_rows(a, before * NW + gww, NW, 4, lane); if (cnt > 4) quant_rows(a, (before + 4) * NW + gww, NW, 1, lane); } }
    }
    __syncthreads();
}

__device__ __forceinline__ void p0_prologue(const Args& a, LAS unsigned char* lds, int vcu, int G, int tid, int lane, int wave) {
    unsigned char* ws = a.ws;
    LAS float* scr = (LAS float*)(lds + wave * 16384);
    const int gw = vcu * NWAVES + wave, NGW = G * NWAVES;
    constexpr int I_IN = (D / 64) * (NIN / 32), I_P = (PLE / 64) * (D / 32);
    constexpr int NITEMS = I_IN + I_P;
    for (int it = gw; it < NITEMS; it += NGW) {
        int r = it;
        if (r < I_IN) { p0_transpose_item(a.in[3], a.in[2], D, NIN, (bf16*)(ws + WS_WIN), scr, r, lane); continue; } r -= I_IN;
        p0_transpose_item(a.in[15], nullptr, PLE, D, (bf16*)(ws + WS_WP), scr, r, lane);
    }
    const size_t gtid = (size_t)vcu * NTHR + tid, gthreads = (size_t)G * NTHR;
    p0_convert(a.in[10], (bf16*)(ws + WS_KEYS), 2 * 128 * 128 / 8, gtid, gthreads);
    p0_convert(a.in[1], (bf16*)(ws + WS_PB), (size_t)T * PLE / 8, gtid, gthreads);
    for (size_t i = gtid; i < (size_t)SQ * 32; i += gthreads) {
        const int pos = (int)(i >> 5), c = (int)(i & 31);
        const float freq = powf(10000.0f, -(float)c / 32.0f);
        const float ang = (float)pos * freq;
        float sn, cs; sincosf(ang, &sn, &cs);
        ((float*)(ws + WS_ROPE))[i] = cs; ((float*)(ws + WS_ROPE))[(size_t)SQ * 32 + i] = sn;
    }
    for (int m0 = gw; m0 < T; m0 += 4 * NGW) {
        f32x4 v[4][4]; float ssq[4];
#pragma unroll
        for (int rr = 0; rr < 4; ++rr) { const f32x4* xr = (const f32x4*)(a.in[0] + (size_t)(m0 + rr * NGW) * D) + lane;
#pragma unroll
            for (int j = 0; j < 4; ++j) v[rr][j] = __builtin_nontemporal_load(xr + 64 * j); }
#pragma unroll
        for (int rr = 0; rr < 4; ++rr) { float sq = 0.f;
#pragma unroll
            for (int j = 0; j < 4; ++j) sq += (v[rr][j][0] * v[rr][j][0] + v[rr][j][1] * v[rr][j][1]) + (v[rr][j][2] * v[rr][j][2] + v[rr][j][3] * v[rr][j][3]);
            ssq[rr] = sq; }
#pragma unroll
        for (int o = 1; o < 64; o <<= 1)
#pragma unroll
            for (int rr = 0; rr < 4; ++rr) ssq[rr] += __shfl_xor(ssq[rr], o);
#pragma unroll
        for (int rr = 0; rr < 4; ++rr) { const float rstd = 1.0f / sqrtf(ssq[rr] * (1.0f / D) + 1e-6f); v2u* o8 = (v2u*)((bf16*)(ws + WS_XB0) + (size_t)(m0 + rr * NGW) * D) + lane;
            if (lane == 0) ((float*)(ws + WS_RSTD0))[m0 + rr * NGW] = rstd;
#pragma unroll
            for (int j = 0; j < 4; ++j) { v2u w; w.x = pk2(v[rr][j][0], v[rr][j][1]); w.y = pk2(v[rr][j][2], v[rr][j][3]); o8[64 * j] = w; } }
    }
}


#define MFMA32(a, b, c) __builtin_amdgcn_mfma_f32_32x32x16_bf16((a), (b), (c), 0, 0, 0)
__device__ __forceinline__ int crow(int r, int hf) { return (r & 3) + 8 * (r >> 2) + 4 * hf; }
__device__ __forceinline__ bf16x8 pack8(float a0, float a1, float a2, float a3, float a4, float a5, float a6, float a7) {
    v4u w; w.x = pk2(a0, a1); w.y = pk2(a2, a3); w.z = pk2(a4, a5); w.w = pk2(a6, a7); return __builtin_bit_cast(bf16x8, w);
}
__device__ __forceinline__ bf16x8 lds_frag16(LAS unsigned char* p) { return *(const LAS bf16x8*)p; }
__device__ __forceinline__ bf16x8 lds_frag8x2(LAS unsigned char* p) {
    const bf16x4 lo = *(const LAS bf16x4*)p, hi = *(const LAS bf16x4*)(p + 16); return __builtin_shufflevector(lo, hi, 0, 1, 2, 3, 4, 5, 6, 7);
}
typedef short s16x4 __attribute__((ext_vector_type(4)));
__device__ __forceinline__ s16x4 lds_tr4(LAS unsigned char* tile, int r0, int c0, int lane) {
    const int i = lane & 15;
    return __builtin_amdgcn_ds_read_tr16_b64_v4i16((LAS s16x4*)(tile + (r0 + (i >> 2)) * 144 + (c0 + 16 * ((lane >> 4) & 1) + 4 * (i & 3)) * 2));
}
__device__ __forceinline__ bf16x8 cat8(s16x4 lo, s16x4 hi) { return __builtin_shufflevector(lo, hi, 0, 1, 2, 3, 4, 5, 6, 7); }
constexpr int RQ = 144;
constexpr int LR_QS = 0, LR_KS = LR_QS + 128 * RQ, LR_VS = LR_KS + 128 * RQ, LR_ST = LR_VS + 128 * RQ, LR_LN = LR_ST + 64 * RQ, LR_V1 = LR_LN + 2 * 128 * 8, LR_ST2 = LR_V1 + 128 * RQ, LR_FLAG = LR_ST2 + 64 * RQ, LR_END = LR_FLAG + 64;
static_assert(LR_END <= RING_BYTES, "retention LDS");
__device__ __forceinline__ v4u widen_pair(v2u wk, v2u wk1) {
    const auto rx = __builtin_amdgcn_permlane32_swap(wk.x, wk1.x, false, false), ry = __builtin_amdgcn_permlane32_swap(wk.y, wk1.y, false, false);
    return (v4u){rx[0], ry[0], rx[1], ry[1]};
}
__device__ __forceinline__ void ret_unit(const bf16* __restrict__ PROJ, bf16* __restrict__ MIXED, const float* __restrict__ rope, LAS unsigned char* lds,
                                         int b, int h, int c0, int c1, int tid, int lane, int wave) {
    const float gam = 1.0f - exp2f(-5.0f - (float)h), lg2 = log2f(gam), cd = exp2f(lg2 * 128.0f);
    const int l31 = lane & 31, hf = lane >> 5, ib = wave >> 1, et = wave & 1;
    const int r = tid >> 2, qd = tid & 3;
    const float wq = exp2f(lg2 * (float)(r + 1)), wk = exp2f(-lg2 * (float)(r + 1));
    f32x16 stacc;
#pragma unroll
    for (int i = 0; i < 16; ++i) stacc[i] = 0.f;
    for (int i = tid; i < 64 * RQ / 4; i += NTHR) ((LAS unsigned*)(lds + LR_ST))[i] = 0u;
    if (tid < 16) ((LAS unsigned*)(lds + LR_FLAG))[tid] = 0u;
    int stp = 0; unsigned ownc = 0u;
    v4u k1, k2, v1, v2, q1 = {0u, 0u, 0u, 0u}, q2 = {0u, 0u, 0u, 0u}; f32x4 csa, csb, sna, snb; v2u gvn[4] = {{0u, 0u}, {0u, 0u}, {0u, 0u}, {0u, 0u}};
#define RET_LOAD(nn) do { const int sp_ = (nn) * 128 + r; const bf16* pr_ = PROJ + ((size_t)b * SQ + sp_) * NIN + h * 64 + 8 * qd; \
        k1 = *(const v4u*)(pr_ + 512); k2 = *(const v4u*)(pr_ + 512 + 32); v1 = *(const v4u*)(pr_ + 1024); v2 = *(const v4u*)(pr_ + 1024 + 32); \
        if ((nn) >= c0) { q1 = *(const v4u*)(pr_); q2 = *(const v4u*)(pr_ + 32); \
            const bf16* gp_ = PROJ + ((size_t)b * SQ + (nn) * 128 + 32 * ib + l31) * NIN + 1536 + h * 64 + 32 * et + 4 * hf; \
            gvn[0] = *(const v2u*)gp_; gvn[1] = *(const v2u*)(gp_ + 8); gvn[2] = *(const v2u*)(gp_ + 16); gvn[3] = *(const v2u*)(gp_ + 24); } \
        csa = *(const f32x4*)(rope + sp_ * 32 + 8 * qd); csb = *(const f32x4*)(rope + sp_ * 32 + 8 * qd + 4); \
        sna = *(const f32x4*)(rope + SQ * 32 + sp_ * 32 + 8 * qd); snb = *(const f32x4*)(rope + SQ * 32 + sp_ * 32 + 8 * qd + 4); } while (0)
    int nstart = 0;
    if (c0 >= 2) {
        v4u kr[4][4];
        float rc[8], rs[8], dc[8], dsn[8];
        { const f32x4 c0v = *(const f32x4*)(rope + r * 32 + 8 * qd), c1v = *(const f32x4*)(rope + r * 32 + 8 * qd + 4), s0v = *(const f32x4*)(rope + SQ * 32 + r * 32 + 8 * qd), s1v = *(const f32x4*)(rope + SQ * 32 + r * 32 + 8 * qd + 4);
          const f32x4 d0v = *(const f32x4*)(rope + 128 * 32 + 8 * qd), d1v = *(const f32x4*)(rope + 128 * 32 + 8 * qd + 4), e0v = *(const f32x4*)(rope + SQ * 32 + 128 * 32 + 8 * qd), e1v = *(const f32x4*)(rope + SQ * 32 + 128 * 32 + 8 * qd + 4);
#pragma unroll
          for (int u = 0; u < 4; ++u) { rc[u] = c0v[u] * wk; rc[4 + u] = c1v[u] * wk; rs[u] = s0v[u] * wk; rs[4 + u] = s1v[u] * wk; dc[u] = d0v[u]; dc[4 + u] = d1v[u]; dsn[u] = e0v[u]; dsn[4 + u] = e1v[u]; } }
#define PRE_LOAD(slot, nn) do { const bf16* pr_ = PROJ + ((size_t)b * SQ + (nn) * 128 + r) * NIN + h * 64 + 8 * qd; \
        kr[slot][0] = *(const v4u*)(pr_ + 512); kr[slot][1] = *(const v4u*)(pr_ + 512 + 32); kr[slot][2] = *(const v4u*)(pr_ + 1024); kr[slot][3] = *(const v4u*)(pr_ + 1024 + 32); } while (0)
#define PRE_STAGE(slot, KT_, VT_) do { float o1_[8], o2_[8]; \
        _Pragma("unroll") for (int u = 0; u < 8; ++u) { const unsigned w1_ = kr[slot][0][u >> 1], w2_ = kr[slot][1][u >> 1]; const float x1_ = (u & 1) ? bf_hi(w1_) : bf_lo(w1_), x2_ = (u & 1) ? bf_hi(w2_) : bf_lo(w2_); \
            o1_[u] = x1_ * rc[u] - x2_ * rs[u]; o2_[u] = x1_ * rs[u] + x2_ * rc[u]; \
            const float nc_ = rc[u] * dc[u] - rs[u] * dsn[u], ns_ = rs[u] * dc[u] + rc[u] * dsn[u]; rc[u] = nc_; rs[u] = ns_; } \
        *(LAS bf16x8*)(lds + (KT_) + r * RQ + (8 * qd) * 2) = pack8(o1_[0], o1_[1], o1_[2], o1_[3], o1_[4], o1_[5], o1_[6], o1_[7]); \
        *(LAS bf16x8*)(lds + (KT_) + r * RQ + (32 + 8 * qd) * 2) = pack8(o2_[0], o2_[1], o2_[2], o2_[3], o2_[4], o2_[5], o2_[6], o2_[7]); \
        *(LAS v4u*)(lds + (VT_) + r * RQ + (8 * qd) * 2) = kr[slot][2]; *(LAS v4u*)(lds + (VT_) + r * RQ + (32 + 8 * qd) * 2) = kr[slot][3]; } while (0)
        const int npair = c0 >> 1;
        PRE_LOAD(0, 0); PRE_LOAD(1, 1);
        if (npair > 1) { PRE_LOAD(2, 2); PRE_LOAD(3, 3); }
#define PRE_STEP(S0, S1, NS0, NS1, pp) do { \
            __syncthreads(); \
            PRE_STAGE(S0, LR_KS, LR_VS); PRE_STAGE(S1, LR_QS, LR_V1); \
            if ((pp) + 2 < npair) { PRE_LOAD(NS0, 2 * ((pp) + 2)); PRE_LOAD(NS1, 2 * ((pp) + 2) + 1); } \
            __syncthreads(); \
            if (wave < 4) { const int se = wave >> 1, sd = wave & 1; f32x16 t0, t1; \
                _Pragma("unroll") for (int i = 0; i < 16; ++i) { t0[i] = 0.f; t1[i] = 0.f; } \
                _Pragma("unroll") for (int ks = 0; ks < 8; ++ks) { \
                    t0 = MFMA32(cat8(lds_tr4(lds + LR_VS, 16 * ks + 8 * hf, 32 * se, lane), lds_tr4(lds + LR_VS, 16 * ks + 8 * hf + 4, 32 * se, lane)), \
                                cat8(lds_tr4(lds + LR_KS, 16 * ks + 8 * hf, 32 * sd, lane), lds_tr4(lds + LR_KS, 16 * ks + 8 * hf + 4, 32 * sd, lane)), t0); \
                    t1 = MFMA32(cat8(lds_tr4(lds + LR_V1, 16 * ks + 8 * hf, 32 * se, lane), lds_tr4(lds + LR_V1, 16 * ks + 8 * hf + 4, 32 * se, lane)), \
                                cat8(lds_tr4(lds + LR_QS, 16 * ks + 8 * hf, 32 * sd, lane), lds_tr4(lds + LR_QS, 16 * ks + 8 * hf + 4, 32 * sd, lane)), t1); } \
                _Pragma("unroll") for (int i = 0; i < 16; ++i) stacc[i] = cd * (cd * (stacc[i] + 0.125f * t0[i]) + 0.125f * t1[i]); } } while (0)
        int pp = 0;
#pragma unroll 1
        for (; pp + 1 < npair; pp += 2) { PRE_STEP(0, 1, 0, 1, pp); PRE_STEP(2, 3, 2, 3, pp + 1); }
        if (pp < npair) { PRE_STEP(0, 1, 0, 1, pp); ++pp; }
        nstart = 2 * npair;
        __syncthreads();
        if (wave < 4) {
            const int se = wave >> 1, sd = wave & 1;
#pragma unroll
            for (int i = 0; i < 16; i += 2) { const unsigned w = pk2(stacc[i], stacc[i + 1]);
                *(LAS bf16*)(lds + LR_ST + (32 * se + crow(i, hf)) * RQ + (32 * sd + l31) * 2) = (bf16)(w & 0xffffu);
                *(LAS bf16*)(lds + LR_ST + (32 * se + crow(i + 1, hf)) * RQ + (32 * sd + l31) * 2) = (bf16)(w >> 16); }
        }
#undef PRE_LOAD
#undef PRE_STAGE
#undef PRE_STEP
    }
    RET_LOAD(nstart);
    for (int n = nstart; n < c1; ++n) {
        const bool own = n >= c0;
        float cs[8], sn[8];
#pragma unroll
        for (int u = 0; u < 4; ++u) { cs[u] = csa[u]; cs[4 + u] = csb[u]; sn[u] = sna[u]; sn[4 + u] = snb[u]; }
        v2u gv[4];
#pragma unroll
        for (int g = 0; g < 4; ++g) gv[g] = gvn[g];
        __syncthreads();
        {
            float o1[8], o2[8];
#pragma unroll
            for (int u = 0; u < 8; ++u) { const unsigned w1 = k1[u >> 1], w2 = k2[u >> 1]; const float x1 = (u & 1) ? bf_hi(w1) : bf_lo(w1), x2 = (u & 1) ? bf_hi(w2) : bf_lo(w2);
                o1[u] = (x1 * cs[u] - x2 * sn[u]) * wk; o2[u] = (x1 * sn[u] + x2 * cs[u]) * wk; }
            *(LAS bf16x8*)(lds + LR_KS + r * RQ + (8 * qd) * 2) = pack8(o1[0], o1[1], o1[2], o1[3], o1[4], o1[5], o1[6], o1[7]);
            *(LAS bf16x8*)(lds + LR_KS + r * RQ + (32 + 8 * qd) * 2) = pack8(o2[0], o2[1], o2[2], o2[3], o2[4], o2[5], o2[6], o2[7]);
            *(LAS v4u*)(lds + LR_VS + r * RQ + (8 * qd) * 2) = v1; *(LAS v4u*)(lds + LR_VS + r * RQ + (32 + 8 * qd) * 2) = v2;
            if (own) {
#pragma unroll
                for (int u = 0; u < 8; ++u) { const unsigned w1 = q1[u >> 1], w2 = q2[u >> 1]; const float x1 = (u & 1) ? bf_hi(w1) : bf_lo(w1), x2 = (u & 1) ? bf_hi(w2) : bf_lo(w2);
                    o1[u] = (x1 * cs[u] - x2 * sn[u]) * wq; o2[u] = (x1 * sn[u] + x2 * cs[u]) * wq; }
                *(LAS bf16x8*)(lds + LR_QS + r * RQ + (8 * qd) * 2) = pack8(o1[0], o1[1], o1[2], o1[3], o1[4], o1[5], o1[6], o1[7]);
                *(LAS bf16x8*)(lds + LR_QS + r * RQ + (32 + 8 * qd) * 2) = pack8(o2[0], o2[1], o2[2], o2[3], o2[4], o2[5], o2[6], o2[7]);
            }
        }
        if (n + 1 < c1) RET_LOAD(n + 1);
        __syncthreads();
        if (own) {
            const size_t orow = (size_t)b * SQ + n * 128 + 32 * ib + l31;
            bf16x8 qf[4];
#pragma unroll
            for (int ks = 0; ks < 4; ++ks) qf[ks] = lds_frag16(lds + LR_QS + (32 * ib + l31) * RQ + (16 * ks + 8 * hf) * 2);
            f32x16 o;
#pragma unroll
            for (int i = 0; i < 16; ++i) o[i] = 0.f;
#pragma unroll
            for (int ks = 0; ks < 4; ++ks) o = MFMA32(lds_frag16(lds + (stp ? LR_ST2 : LR_ST) + (32 * et + l31) * RQ + (16 * ks + 8 * hf) * 2), qf[ks], o);
#pragma unroll
            for (int jp = 0; jp < 2; ++jp) {
                if (2 * jp <= ib) {
                    f32x16 sb[2];
#pragma unroll
                    for (int j2 = 0; j2 < 2; ++j2)
#pragma unroll
                        for (int i = 0; i < 16; ++i) sb[j2][i] = 0.f;
#pragma unroll
                    for (int ks = 0; ks < 4; ++ks)
#pragma unroll
                        for (int j2 = 0; j2 < 2; ++j2) sb[j2] = MFMA32(lds_frag16(lds + LR_KS + (32 * (2 * jp + j2) + l31) * RQ + (16 * ks + 8 * hf) * 2), qf[ks], sb[j2]);
#pragma unroll
                    for (int j2 = 0; j2 < 2; ++j2) {
                        const int jb = 2 * jp + j2;
                        if (jb <= ib) {
                            const bool diag = (jb == ib);
                            float p[16];
#pragma unroll
                            for (int i = 0; i < 16; ++i) p[i] = (diag && crow(i, hf) > l31) ? 0.f : sb[j2][i] * 0.125f;
#pragma unroll
                            for (int st = 0; st < 2; ++st) {
                                const bf16x8 pf = pack8(p[8 * st], p[8 * st + 1], p[8 * st + 2], p[8 * st + 3], p[8 * st + 4], p[8 * st + 5], p[8 * st + 6], p[8 * st + 7]);
                                o = MFMA32(cat8(lds_tr4(lds + LR_VS, 32 * jb + 16 * st + 4 * hf, 32 * et, lane), lds_tr4(lds + LR_VS, 32 * jb + 16 * st + 8 + 4 * hf, 32 * et, lane)), pf, o);
                            }
                        }
                    }
                }
            }
            float s1 = 0.f, s2 = 0.f;
#pragma unroll
            for (int i = 0; i < 16; ++i) { s1 += o[i]; s2 += o[i] * o[i]; }
            s1 += __shfl_xor(s1, 32); s2 += __shfl_xor(s2, 32);
            if (hf == 0) *(LAS f32x2*)(lds + LR_LN + (et * 128 + 32 * ib + l31) * 8) = (f32x2){s1, s2};
            ++ownc;
            {
                volatile LAS unsigned* fl = (volatile LAS unsigned*)(lds + LR_FLAG);
                asm volatile("" ::: "memory");
                if (lane == 0) fl[wave] = ownc;
                unsigned sp = 0u;
                while (fl[wave ^ 1] < ownc) { __builtin_amdgcn_s_sleep(1); if (++sp > (1u << 22)) break; }
                asm volatile("" ::: "memory");
            }
            const f32x2 ot = *(const LAS f32x2*)(lds + LR_LN + ((et ^ 1) * 128 + 32 * ib + l31) * 8);
            const float mu = (s1 + ot.x) * (1.0f / 64.0f), var = fmaxf((s2 + ot.y) * (1.0f / 64.0f) - mu * mu, 0.f), rs = 1.0f / sqrtf(var + 1e-6f);
            v2u yw[4];
#pragma unroll
            for (int g = 0; g < 4; ++g) {
                float y[4];
#pragma unroll
                for (int u = 0; u < 4; ++u) { const unsigned w = gv[g][u >> 1]; const float gg = (u & 1) ? bf_hi(w) : bf_lo(w); const float sg = gg * __builtin_amdgcn_rcpf(1.0f + __expf(-gg)); y[u] = sg * ((o[4 * g + u] - mu) * rs); }
                yw[g].x = pk2(y[0], y[1]); yw[g].y = pk2(y[2], y[3]);
            }
#pragma unroll
            for (int g = 0; g < 4; g += 2) *(v4u*)(MIXED + orow * D + h * 64 + 32 * et + 8 * g + 8 * hf) = widen_pair(yw[g], yw[g + 1]);
        }
        if (wave < 4) {
            const int se = wave >> 1, sd = wave & 1;
            f32x16 tmp;
#pragma unroll
            for (int i = 0; i < 16; ++i) tmp[i] = 0.f;
#pragma unroll
            for (int ks = 0; ks < 8; ++ks)
                tmp = MFMA32(cat8(lds_tr4(lds + LR_VS, 16 * ks + 8 * hf, 32 * se, lane), lds_tr4(lds + LR_VS, 16 * ks + 8 * hf + 4, 32 * se, lane)),
                             cat8(lds_tr4(lds + LR_KS, 16 * ks + 8 * hf, 32 * sd, lane), lds_tr4(lds + LR_KS, 16 * ks + 8 * hf + 4, 32 * sd, lane)), tmp);
#pragma unroll
            for (int i = 0; i < 16; ++i) stacc[i] = cd * (stacc[i] + 0.125f * tmp[i]);
#pragma unroll
            for (int i = 0; i < 16; i += 2) { const unsigned w = pk2(stacc[i], stacc[i + 1]);
                *(LAS bf16*)(lds + (stp ? LR_ST : LR_ST2) + (32 * se + crow(i, hf)) * RQ + (32 * sd + l31) * 2) = (bf16)(w & 0xffffu);
                *(LAS bf16*)(lds + (stp ? LR_ST : LR_ST2) + (32 * se + crow(i + 1, hf)) * RQ + (32 * sd + l31) * 2) = (bf16)(w >> 16); }
        }
        stp ^= 1;
    }
    __syncthreads();
#undef RET_LOAD
}

constexpr int LS_KN = 0, LS_VS = LS_KN + 256 * RQ, LS_QN = LS_VS + 256 * RQ, LS_END = LS_QN + 256 * RQ;
static_assert(LS_END <= RING_BYTES, "swa LDS");
__device__ __forceinline__ void swa_unit(const bf16* __restrict__ PROJ, bf16* __restrict__ MIXED, const float* __restrict__ qnw, const float* __restrict__ knw, const float* __restrict__ sinks,
                                         LAS unsigned char* lds, int b, int kvh, int n, int tid, int lane, int wave) {
    const int l31 = lane & 31, hf = lane >> 5;
    const int row = tid >> 1, half = tid & 1;
    v4u qq[4];
    { const int hs = row >> 7, qrow = row & 127, hq = kvh * 4 + hs;
      const bf16* pr = PROJ + ((size_t)b * SQ + n * 128 + qrow) * NIN + 2048 + hq * 64 + 32 * half;
#pragma unroll
      for (int c = 0; c < 4; ++c) qq[c] = *(const v4u*)(pr + 8 * c); }
    {
        const int kpos = (n - 1) * 128 + row; const bool valid = kpos >= 0;
        v4u kk[4], vv[4];
#pragma unroll
        for (int c = 0; c < 4; ++c) { kk[c] = (v4u){0u, 0u, 0u, 0u}; vv[c] = (v4u){0u, 0u, 0u, 0u}; }
        if (valid) { const bf16* pr = PROJ + ((size_t)b * SQ + kpos) * NIN + 32 * half;
#pragma unroll
            for (int c = 0; c < 4; ++c) { kk[c] = *(const v4u*)(pr + 2560 + kvh * 64 + 8 * c); vv[c] = *(const v4u*)(pr + 2688 + kvh * 64 + 8 * c); } }
        float kf[32]; float ss = 0.f;
#pragma unroll
        for (int c = 0; c < 4; ++c)
#pragma unroll
            for (int u = 0; u < 4; ++u) { kf[8 * c + 2 * u] = bf_lo(kk[c][u]); kf[8 * c + 2 * u + 1] = bf_hi(kk[c][u]); }
#pragma unroll
        for (int i = 0; i < 32; ++i) ss += kf[i] * kf[i];
        ss += __shfl_xor(ss, 1);
        const float rstd = (0.125f * 1.4426950408889634f) / sqrtf(ss * (1.0f / 64.0f) + 1e-6f);
#pragma unroll
        for (int c = 0; c < 4; ++c) {
            const f32x4 g0 = *(const f32x4*)(knw + 32 * half + 8 * c), g1 = *(const f32x4*)(knw + 32 * half + 8 * c + 4);
            *(LAS bf16x8*)(lds + LS_KN + row * RQ + (32 * half + 8 * c) * 2) = pack8(kf[8 * c] * rstd * g0[0], kf[8 * c + 1] * rstd * g0[1], kf[8 * c + 2] * rstd * g0[2], kf[8 * c + 3] * rstd * g0[3],
                                                                                  kf[8 * c + 4] * rstd * g1[0], kf[8 * c + 5] * rstd * g1[1], kf[8 * c + 6] * rstd * g1[2], kf[8 * c + 7] * rstd * g1[3]);
            *(LAS v4u*)(lds + LS_VS + row * RQ + (32 * half + 8 * c) * 2) = vv[c];
        }
    }
    for (int rnd = 0; rnd < 2; ++rnd) {
        {
            float qf[32]; float ss = 0.f;
#pragma unroll
            for (int c = 0; c < 4; ++c)
#pragma unroll
                for (int u = 0; u < 4; ++u) { qf[8 * c + 2 * u] = bf_lo(qq[c][u]); qf[8 * c + 2 * u + 1] = bf_hi(qq[c][u]); }
#pragma unroll
            for (int i = 0; i < 32; ++i) ss += qf[i] * qf[i];
            ss += __shfl_xor(ss, 1);
            const float rstd = 1.0f / sqrtf(ss * (1.0f / 64.0f) + 1e-6f);
#pragma unroll
            for (int c = 0; c < 4; ++c) {
                const f32x4 g0 = *(const f32x4*)(qnw + 32 * half + 8 * c), g1 = *(const f32x4*)(qnw + 32 * half + 8 * c + 4);
                *(LAS bf16x8*)(lds + LS_QN + row * RQ + (32 * half + 8 * c) * 2) = pack8(qf[8 * c] * rstd * g0[0], qf[8 * c + 1] * rstd * g0[1], qf[8 * c + 2] * rstd * g0[2], qf[8 * c + 3] * rstd * g0[3],
                                                                                      qf[8 * c + 4] * rstd * g1[0], qf[8 * c + 5] * rstd * g1[1], qf[8 * c + 6] * rstd * g1[2], qf[8 * c + 7] * rstd * g1[3]);
            }
        }
        if (rnd == 0) {
            const int hs = row >> 7, qrow = row & 127, hq = kvh * 4 + 2 + hs;
            const bf16* pr = PROJ + ((size_t)b * SQ + n * 128 + qrow) * NIN + 2048 + hq * 64 + 32 * half;
#pragma unroll
            for (int c = 0; c < 4; ++c) qq[c] = *(const v4u*)(pr + 8 * c);
        }
        __syncthreads();
        {
            const int hs = wave >> 2, ib = wave & 3, hq = kvh * 4 + rnd * 2 + hs;
            bf16x8 qf[4];
#pragma unroll
            for (int ks = 0; ks < 4; ++ks) qf[ks] = lds_frag16(lds + LS_QN + (hs * 128 + 32 * ib + l31) * RQ + (16 * ks + 8 * hf) * 2);
            f32x16 s[5];
#pragma unroll
            for (int t = 0; t < 5; ++t) {
#pragma unroll
                for (int i = 0; i < 16; ++i) s[t][i] = 0.f;
#pragma unroll
                for (int ks = 0; ks < 4; ++ks) s[t] = MFMA32(lds_frag16(lds + LS_KN + (32 * (ib + t) + l31) * RQ + (16 * ks + 8 * hf) * 2), qf[ks], s[t]);
            }
            const float sink = sinks[hq] * 1.4426950408889634f;
            float m = sink;
#pragma unroll
            for (int t = 0; t < 5; ++t)
#pragma unroll
                for (int i = 0; i < 16; ++i) {
                    bool ok = true;
                    if (t == 0) ok = crow(i, hf) > l31;
                    if (t == 4) ok = crow(i, hf) <= l31;
                    if (n == 0 && ib + t < 4) ok = false;
                    s[t][i] = ok ? s[t][i] : -INFINITY;
                    m = fmaxf(m, s[t][i]);
                }
            m = fmaxf(m, __shfl_xor(m, 32));
            float l = 0.f;
#pragma unroll
            for (int t = 0; t < 5; ++t)
#pragma unroll
                for (int i = 0; i < 16; ++i) { s[t][i] = __builtin_amdgcn_exp2f(s[t][i] - m); l += s[t][i]; }
            l += __shfl_xor(l, 32);
            l += __builtin_amdgcn_exp2f(sink - m);
            f32x16 o[2];
#pragma unroll
            for (int e2 = 0; e2 < 2; ++e2)
#pragma unroll
                for (int i = 0; i < 16; ++i) o[e2][i] = 0.f;
#pragma unroll
            for (int t = 0; t < 5; ++t)
#pragma unroll
                for (int st = 0; st < 2; ++st) {
                    const bf16x8 pf = pack8(s[t][8 * st], s[t][8 * st + 1], s[t][8 * st + 2], s[t][8 * st + 3], s[t][8 * st + 4], s[t][8 * st + 5], s[t][8 * st + 6], s[t][8 * st + 7]);
#pragma unroll
                    for (int e2 = 0; e2 < 2; ++e2) o[e2] = MFMA32(cat8(lds_tr4(lds + LS_VS, 32 * (ib + t) + 16 * st + 4 * hf, 32 * e2, lane), lds_tr4(lds + LS_VS, 32 * (ib + t) + 16 * st + 8 + 4 * hf, 32 * e2, lane)), pf, o[e2]);
                }
            const float inv = 1.0f / l;
            const size_t orow = (size_t)b * SQ + n * 128 + 32 * ib + l31;
#pragma unroll
            for (int e2 = 0; e2 < 2; ++e2)
#pragma unroll
                for (int g = 0; g < 4; g += 2) { v2u w0, w1; w0.x = pk2(o[e2][4 * g] * inv, o[e2][4 * g + 1] * inv); w0.y = pk2(o[e2][4 * g + 2] * inv, o[e2][4 * g + 3] * inv);
                    w1.x = pk2(o[e2][4 * g + 4] * inv, o[e2][4 * g + 5] * inv); w1.y = pk2(o[e2][4 * g + 6] * inv, o[e2][4 * g + 7] * inv);
                    *(v4u*)(MIXED + orow * D + 512 + hq * 64 + 32 * e2 + 8 * g + 8 * hf) = widen_pair(w0, w1); }
        }
        __syncthreads();
    }
}

__device__ __forceinline__ void p2_mixing(const Args& a, LAS unsigned char* lds, int bx, int G, int tid, int lane, int wave, int parts = 3) {
    const bf16* PROJ = (const bf16*)(a.ws + WS_R2); bf16* MIXED = (bf16*)(a.ws + WS_R1); const float* rope = (const float*)(a.ws + WS_ROPE);
    if (parts & 1) for (int u = bx; u < 256; u += G) {
        const int b = u & 7, h = (u >> 3) & 7, grp = u >> 6;
        const int c0 = grp == 0 ? 0 : grp == 1 ? 11 : grp == 2 ? 20 : 27, c1 = grp == 0 ? 11 : grp == 1 ? 20 : grp == 2 ? 27 : 32;
        ret_unit(PROJ, MIXED, rope, lds, b, h, c0, c1, tid, lane, wave);
    }
    if (parts & 2) for (int su = bx; su < 512; su += G) swa_unit(PROJ, MIXED, a.in[4], a.in[5], a.in[6], lds, su >> 6, (su >> 5) & 1, su & 31, tid, lane, wave);
}


__device__ __forceinline__ float wave_sum_dpp(float x) {
    x += __builtin_bit_cast(float, __builtin_amdgcn_update_dpp(0, __builtin_bit_cast(int, x), 0xB1, 0xf, 0xf, false));
    x += __builtin_bit_cast(float, __builtin_amdgcn_update_dpp(0, __builtin_bit_cast(int, x), 0x4E, 0xf, 0xf, false));
    x += __builtin_bit_cast(float, __builtin_amdgcn_update_dpp(0, __builtin_bit_cast(int, x), 0x141, 0xf, 0xf, false));
    x += __builtin_bit_cast(float, __builtin_amdgcn_update_dpp(0, __builtin_bit_cast(int, x), 0x140, 0xf, 0xf, false));
    x += __builtin_bit_cast(float, __builtin_amdgcn_update_dpp(0, __builtin_bit_cast(int, x), 0x142, 0xa, 0xf, false));
    x += __builtin_bit_cast(float, __builtin_amdgcn_update_dpp(0, __builtin_bit_cast(int, x), 0x143, 0xc, 0xf, false));
    return __builtin_bit_cast(float, __builtin_amdgcn_readlane(__builtin_bit_cast(int, x), 63));
}
__device__ __forceinline__ float wave_max_dpp(float x) {
    int v = __builtin_bit_cast(int, x);
    v = max(v, __builtin_amdgcn_update_dpp(0, v, 0xB1, 0xf, 0xf, false));
    v = max(v, __builtin_amdgcn_update_dpp(0, v, 0x4E, 0xf, 0xf, false));
    v = max(v, __builtin_amdgcn_update_dpp(0, v, 0x141, 0xf, 0xf, false));
    v = max(v, __builtin_amdgcn_update_dpp(0, v, 0x140, 0xf, 0xf, false));
    v = max(v, __builtin_amdgcn_update_dpp(0, v, 0x142, 0xa, 0xf, false));
    v = max(v, __builtin_amdgcn_update_dpp(0, v, 0x143, 0xc, 0xf, false));
    return __builtin_bit_cast(float, __builtin_amdgcn_readlane(v, 63));
}
__device__ __forceinline__ int row16_sum(int x) {
    x += __builtin_amdgcn_update_dpp(0, x, 0xB1, 0xf, 0xf, false);
    x += __builtin_amdgcn_update_dpp(0, x, 0x4E, 0xf, 0xf, false);
    x += __builtin_amdgcn_update_dpp(0, x, 0x141, 0xf, 0xf, false);
    x += __builtin_amdgcn_update_dpp(0, x, 0x140, 0xf, 0xf, false);
    return x;
}
template <int N> __device__ __forceinline__ void bitonic_sort_desc(float (&v)[N]) {
#pragma unroll
    for (int k = 2; k <= N; k <<= 1)
#pragma unroll
        for (int j = k >> 1; j > 0; j >>= 1)
#pragma unroll
            for (int i = 0; i < N; ++i) { const int l = i ^ j; if (l > i) { const bool desc = ((i & k) == 0); const float a = v[i], b = v[l]; const float hi = fmaxf(a, b), lo = fminf(a, b); v[i] = desc ? hi : lo; v[l] = desc ? lo : hi; } }
}
__device__ __forceinline__ void sort4_desc(float& a, float& b, float& c, float& d) {
    const float h = fmaxf(fmaxf(a, b), c), m = __builtin_amdgcn_fmed3f(a, b, c), l = fminf(fminf(a, b), c);
    a = fmaxf(h, d); b = __builtin_amdgcn_fmed3f(h, m, d); c = __builtin_amdgcn_fmed3f(m, l, d); d = fminf(l, d);
}
__device__ __forceinline__ void sort16_desc(float (&v)[16]) {
    sort4_desc(v[0], v[1], v[2], v[3]); sort4_desc(v[4], v[5], v[6], v[7]); sort4_desc(v[8], v[9], v[10], v[11]); sort4_desc(v[12], v[13], v[14], v[15]);
    constexpr int A[43] = {0,2,2,1,3,3,1,3,5, 8,10,10,9,11,11,9,11,13, 0,4,4,2,6,6,2,6,10,1,5,5,3,7,7,3,7,11,1,3,5,7,9,11,13};
    constexpr int B[43] = {4,6,4,5,7,5,2,4,6, 12,14,12,13,15,13,10,12,14, 8,12,8,10,14,10,4,8,12,9,13,9,11,15,11,5,9,13,2,4,6,8,10,12,14};
#pragma unroll
    for (int i = 0; i < 43; ++i) { const float a = v[A[i]], b = v[B[i]]; v[A[i]] = fmaxf(a, b); v[B[i]] = fminf(a, b); }
}
__device__ __forceinline__ void bitonic_merge16_desc(float (&v)[16]) {
#pragma unroll
    for (int j = 8; j > 0; j >>= 1)
#pragma unroll
        for (int i = 0; i < 16; ++i) { const int l = i ^ j; if (l > i) { const float a = v[i], b = v[l]; v[i] = fmaxf(a, b); v[l] = fminf(a, b); } }
}
__device__ __forceinline__ void top16_of_64(float (&v)[64], float (&out)[16]) {
    float b[4][16];
#pragma unroll
    for (int q = 0; q < 4; ++q) {
#pragma unroll
        for (int i = 0; i < 16; ++i) b[q][i] = v[16 * q + i];
        sort16_desc(b[q]);
    }
    float t0[16], t1[16];
#pragma unroll
    for (int i = 0; i < 16; ++i) { t0[i] = fmaxf(b[0][i], b[1][15 - i]); t1[i] = fmaxf(b[2][i], b[3][15 - i]); }
    bitonic_merge16_desc(t0); bitonic_merge16_desc(t1);
#pragma unroll
    for (int i = 0; i < 16; ++i) out[i] = fmaxf(t0[i], t1[15 - i]);
    bitonic_merge16_desc(out);
}
__device__ __forceinline__ float dot2u(unsigned a, unsigned b, float c) { return __builtin_amdgcn_fdot2_f32_bf16(__builtin_bit_cast(b16x2, a), __builtin_bit_cast(b16x2, b), c, false); }
__device__ __forceinline__ float gelu_erf(float v) {
    const float av = fabsf(v), t = __builtin_amdgcn_rcpf(av * 0.2316418882f + 1.0f);
    float q = t * 0.5307027145f + (-0.7265760135f); q = q * t + 0.7107068705f; q = q * t + (-0.142248368f); q = q * t + 0.127414796f; q = q * t;
    const float e = __builtin_amdgcn_exp2f((v * v) * (-0.72134752044f));
    const float m = v * (q * e);
    return v < 0.f ? m : v - m;
}

constexpr int KROW = 272;
constexpr int LP_KEYS = 0, LP_LUT = LP_KEYS + 256 * KROW, LP_RSTD = LP_LUT + NWAVES * 32 * 32, LP_END = LP_RSTD + 4 * 128;
static_assert(LP_END <= RING_BYTES, "peer LDS");

__device__ __forceinline__ void p5a_topk(const Args& a, LAS unsigned char* lds, int vcu, int G, int tid, int lane, int wave PT_DECL) {
    unsigned char* ws = a.ws;
    const bf16* Q = (const bf16*)(ws + WS_R2 + 64 * MB); const bf16* XB1 = (const bf16*)(ws + WS_R2); unsigned char* H8 = ws + WS_R1; float* SH = (float*)(ws + WS_SH); float* SHS = (float*)(ws + WS_SHS); const float* gffn = a.in[8];
    unsigned* PK = (unsigned*)(ws + WS_PK);
    const int l31 = lane & 31, hf = lane >> 5;
    for (int i = tid; i < 256 * 16; i += NTHR) { const int rr = i >> 4, c = i & 15; *(LAS v4u*)(lds + LP_KEYS + rr * KROW + c * 16) = *(const v4u*)((const bf16*)(ws + WS_KEYS) + rr * 128 + c * 8); }
    float gw[16];
    { const f32x4 g0 = *(const f32x4*)(gffn + 16 * lane), g1 = *(const f32x4*)(gffn + 16 * lane + 4), g2 = *(const f32x4*)(gffn + 16 * lane + 8), g3 = *(const f32x4*)(gffn + 16 * lane + 12);
#pragma unroll
      for (int u = 0; u < 4; ++u) { gw[u] = g0[u]; gw[4 + u] = g1[u]; gw[8 + u] = g2[u]; gw[12 + u] = g3[u]; } }
    { int gi = 0;
      for (int grp = vcu; grp < T / 32 && gi < 4; grp += G, ++gi) {
        const int t0 = grp * 32;
        {
            float xs[4][16];
#pragma unroll
            for (int q = 0; q < 4; ++q) {
                const bf16* xr = XB1 + ((size_t)t0 + 4 * wave + q) * D + 16 * lane;
                const v4u x0 = *(const v4u*)xr, x1 = *(const v4u*)(xr + 8);
#pragma unroll
                for (int u = 0; u < 4; ++u) { xs[q][2 * u] = bf_lo(x0[u]); xs[q][2 * u + 1] = bf_hi(x0[u]); xs[q][8 + 2 * u] = bf_lo(x1[u]); xs[q][8 + 2 * u + 1] = bf_hi(x1[u]); }
            }
            float ssq[4];
#pragma unroll
            for (int q = 0; q < 4; ++q) { float sq = 0.f;
#pragma unroll
                for (int u = 0; u < 16; ++u) sq += xs[q][u] * xs[q][u];
                ssq[q] = sq; }
#pragma unroll
            for (int o = 1; o < 64; o <<= 1)
#pragma unroll
                for (int q = 0; q < 4; ++q) ssq[q] += __shfl_xor(ssq[q], o);
            float am[4], hs2[4];
#pragma unroll
            for (int q = 0; q < 4; ++q) {
                const float rstd = 1.0f / sqrtf(ssq[q] * (1.0f / D) + 1e-6f);
                if (lane == 0) *(LAS float*)(lds + LP_RSTD + gi * 128 + (4 * wave + q) * 4) = rstd;
                float m = 0.f, s2 = 0.f;
#pragma unroll
                for (int u = 0; u < 16; ++u) { xs[q][u] = xs[q][u] * rstd * gw[u]; m = fmaxf(m, fabsf(xs[q][u])); s2 += xs[q][u] * xs[q][u]; }
                am[q] = m; hs2[q] = s2;
            }
#pragma unroll
            for (int o = 1; o < 64; o <<= 1)
#pragma unroll
                for (int q = 0; q < 4; ++q) am[q] = fmaxf(am[q], __shfl_xor(am[q], o));
#pragma unroll
            for (int q = 0; q < 4; ++q) {
                const size_t tok = (size_t)t0 + 4 * wave + q;
                const float step = fminf(0.355f * sqrtf(wave_sum_dpp(hs2[q]) * (1.0f / D)), am[q] * (1.0f / 7.0f));
                const float inv = step > 0.f ? 1.0f / step : 0.f;
                v2u wh = {0u, 0u}; int hsum = 0;
#pragma unroll
                for (int u = 0; u < 16; ++u) { int qi = __float2int_rn(xs[q][u] * inv); qi = qi < -7 ? -7 : qi > 7 ? 7 : qi; hsum += qi; const unsigned nb = (unsigned)qi & 15u;
                    if (u < 8) wh.x |= nb << (4 * u); else wh.y |= nb << (4 * (u - 8)); }
                *(v2u*)(H8 + tok * 512 + 8 * lane) = wh;
                const float hs = wave_sum_dpp((float)hsum);
                if (lane == 0) { SH[tok] = step; SHS[tok] = 0.5f * hs; }
            }
        }
      }
    }
    __syncthreads();
    int gi = 0;
    bf16x8 qfr[8];
    { const bf16* qrow = Q + (size_t)(vcu * 32 + (lane & 31)) * NQ + wave * 256 + 8 * (lane >> 5);
#pragma unroll
      for (int ks = 0; ks < 8; ++ks) qfr[ks] = *(const bf16x8*)(qrow + 16 * ks); }
#pragma unroll 1
    for (int grp = vcu; grp < T / 32 && gi < 4; grp += G, ++gi) {
        const int t0 = grp * 32;
        PT_BEGIN();
        PT_ADD(0);
        {
            const int h = wave;
            float lst[2][16];
#pragma unroll
            for (int p = 0; p < 2; ++p) {
                f32x16 acc[4];
#pragma unroll
                for (int q = 0; q < 4; ++q)
#pragma unroll
                    for (int i = 0; i < 16; ++i) acc[q][i] = 0.f;
#pragma unroll
                for (int ks = 0; ks < 8; ++ks) {
#pragma unroll
                    for (int q = 0; q < 4; ++q) acc[q] = MFMA32(lds_frag16(lds + LP_KEYS + (p * 128 + 32 * q + l31) * KROW + (16 * ks + 8 * hf) * 2), qfr[ks], acc[q]);
                }
                {
                    const bool more = (p == 0) || (gi + 1 < 4 && grp + G < T / 32);
                    const size_t tn = (p == 0) ? (size_t)(t0 + l31) : (size_t)(t0 + G * 32 + l31);
                    const bf16* qrow = Q + tn * NQ + h * 256 + (p == 0 ? 128 : 0) + 8 * hf;
                    if (more) {
#pragma unroll
                        for (int ks = 0; ks < 8; ++ks) qfr[ks] = *(const bf16x8*)(qrow + 16 * ks);
                    }
                    __builtin_amdgcn_sched_barrier(0);
                }
                float v[64];
#pragma unroll
                for (int q = 0; q < 4; ++q)
#pragma unroll
                    for (int i = 0; i < 16; ++i) v[16 * q + i] = __uint_as_float((__float_as_uint(acc[q][i]) & 0xffffff80u) | (unsigned)(32 * q + crow(i, hf)));
                float mine[16];
                top16_of_64(v, mine);
                float t[16];
#pragma unroll
                for (int i = 0; i < 16; ++i) t[i] = __shfl_xor(mine[i], 32);
#pragma unroll
                for (int i = 0; i < 16; ++i) lst[p][i] = fmaxf(mine[i], t[15 - i]);
                bitonic_merge16_desc(lst[p]);
            }
            PT_ADD(1);
            LAS unsigned char* lut = lds + LP_LUT + wave * 1024 + l31 * 32;
            {
                v4u wa, wb;
#pragma unroll
                for (int c = 0; c < 4; ++c) {
                    wa[c] = (__float_as_uint(lst[0][4 * c]) & 0x7fu) | ((__float_as_uint(lst[0][4 * c + 1]) & 0x7fu) << 8) | ((__float_as_uint(lst[0][4 * c + 2]) & 0x7fu) << 16) | ((__float_as_uint(lst[0][4 * c + 3]) & 0x7fu) << 24);
                    wb[c] = (__float_as_uint(lst[1][4 * c]) & 0x7fu) | ((__float_as_uint(lst[1][4 * c + 1]) & 0x7fu) << 8) | ((__float_as_uint(lst[1][4 * c + 2]) & 0x7fu) << 16) | ((__float_as_uint(lst[1][4 * c + 3]) & 0x7fu) << 24);
                }
                if (hf == 0) { *(LAS v4u*)lut = wa; *(LAS v4u*)(lut + 16) = wb; }
            }
            float best[16];
            {
            constexpr int CIA[25] = {0,0,0,0,0,0,0,0,0,0,0,0,0,0,0,0,2,2,2,2,2,3,3,3,3};
            constexpr int CJA[25] = {0,1,2,3,4,5,6,7,8,9,10,11,12,13,14,15,0,1,2,3,4,0,1,2,3};
            constexpr int CIB[25] = {1,1,1,1,1,1,1,1,4,4,4,5,5,6,6,7,7,8,9,10,11,12,13,14,15};
            constexpr int CJB[25] = {0,1,2,3,4,5,6,7,0,1,2,0,1,0,1,0,1,0,0,0,0,0,0,0,0};
                const unsigned hm = hf ? 0xffffffffu : 0u;
                float l0[16], l1[16];
#pragma unroll
                for (int i = 0; i < 16; ++i) { l0[i] = __uint_as_float(__float_as_uint(lst[0][i]) & 0xffffff80u); l1[i] = __uint_as_float(__float_as_uint(lst[1][i]) & 0xffffff80u); }
                float b0[16], b1[16];
#pragma unroll
                for (int c = 0; c < 32; ++c) {
                    float val = -3.0e38f;
                    if (c < 25) {
                        const unsigned ca = (__float_as_uint(l0[CIA[c]] + l1[CJA[c]]) & 0xffffff00u) | (unsigned)(CIA[c] * 16 + CJA[c]);
                        const unsigned cb = (__float_as_uint(l0[CIB[c]] + l1[CJB[c]]) & 0xffffff00u) | (unsigned)(CIB[c] * 16 + CJB[c]);
                        val = __uint_as_float((cb & hm) | (ca & ~hm));
                    }
                    if (c < 16) b0[c] = val; else b1[c - 16] = val;
                }
                sort16_desc(b0); sort16_desc(b1);
                float m2[16];
#pragma unroll
                for (int i = 0; i < 16; ++i) m2[i] = fmaxf(b0[i], b1[15 - i]);
                bitonic_merge16_desc(m2);
                float t2[16];
#pragma unroll
                for (int i = 0; i < 16; ++i) t2[i] = __shfl_xor(m2[i], 32);
#pragma unroll
                for (int i = 0; i < 16; ++i) best[i] = fmaxf(m2[i], t2[15 - i]);
            }
            const float rstd = *(const LAS float*)(lds + LP_RSTD + gi * 128 + l31 * 4);
            float bmax = best[0];
#pragma unroll
            for (int k = 1; k < 16; k += 2) bmax = (k + 1 < 16) ? fmaxf(fmaxf(bmax, best[k]), best[k + 1]) : fmaxf(bmax, best[k]);
            const float s0 = __uint_as_float(__float_as_uint(bmax) & 0xffffff00u);
            float ev[16], esum = 0.f;
#pragma unroll
            for (int k = 0; k < 16; ++k) { const float sk = __uint_as_float(__float_as_uint(best[k]) & 0xffffff00u); ev[k] = __expf(rstd * (sk - s0)); esum += ev[k]; }
            const float einv = __builtin_amdgcn_rcpf(esum);
            asm volatile("" ::: "memory");
            {
                const size_t ob = (size_t)(t0 + l31) * 128 + h * 16 + 8 * hf;
                unsigned e8[8];
#pragma unroll
                for (int j = 0; j < 8; ++j) { const unsigned code = __float_as_uint(best[j]) & 0xffu;
                    const float gk = ev[j] * einv;
                    const unsigned ia = *(const LAS unsigned char*)(lut + (code >> 4)), ib = *(const LAS unsigned char*)(lut + 16 + (code & 15u));
                    e8[j] = (ia * 128u + ib) | (pk2(0.f, gk) & 0xffff0000u); }
                *(v4u*)(PK + ob) = (v4u){e8[0], e8[1], e8[2], e8[3]}; *(v4u*)(PK + ob + 4) = (v4u){e8[4], e8[5], e8[6], e8[7]};
            }
            PT_ADD(2);
        }
    }
    __syncthreads();
}

constexpr int LB_H = 0, LB_LIST = LB_H + NWAVES * 4096, LB_GATE = LB_LIST + NWAVES * 2304, LB_SH = LB_GATE + NWAVES * 2048, LB_STEP = LB_SH + NWAVES * 32, LB_END = LB_STEP + 4096 * 8;
static_assert(LB_END <= RING_BYTES, "p5b LDS");
struct B5Batch { v4u ur[4][2]; };
struct B5Blk { unsigned em; float scl, svl; };
__device__ __forceinline__ void b5_issue(B5Batch& b, const LAS unsigned* list, int bt, const unsigned char* U8, int lane) {
    const int g = lane >> 4, c = lane & 15;
#pragma unroll
    for (int ps = 0; ps < 4; ++ps) {
        const unsigned ent = list[16 * bt + 4 * ps + g];
        const unsigned char* rp = U8 + ((ent & 0xffffu) * 512u + 16u * (unsigned)c);
#pragma unroll
        for (int i = 0; i < 2; ++i) b.ur[ps][i] = *(const v4u*)(rp + 256 * i);
    }
}
__device__ __forceinline__ void b5_blk_issue(B5Blk& k, const LAS unsigned* list, int blk, const LAS unsigned char* steps, int lane) {
    const int g = lane >> 4, c = lane & 15;
    k.em = list[64 * blk + 16 * (c >> 2) + 4 * (c & 3) + g];
    const f32x2 st2 = *(const LAS f32x2*)(steps + (k.em & 4095u) * 8u); k.scl = st2[0]; k.svl = st2[1];
}
__device__ __forceinline__ void b5_compute(const B5Batch& b, const LAS unsigned* list, int bt, LAS unsigned char* hreg, int lane, int& res) {
    const int g = lane >> 4, c = lane & 15;
    int acc[4];
#pragma unroll
    for (int ps = 0; ps < 4; ++ps) {
        const unsigned ent = list[16 * bt + 4 * ps + g];
        LAS unsigned char* hp = hreg + ((ent >> 28) & 3u) * 512 + 16 * c;
        int ac = 0;
#pragma unroll
        for (int i = 0; i < 2; ++i) { const v4u hv = *(const LAS v4u*)(hp + 256 * i);
#pragma unroll
            for (int u = 0; u < 4; ++u) ac = __builtin_amdgcn_sdot8((int)hv[u], (int)b.ur[ps][i][u], ac, false); }
        acc[ps] = ac;
    }
    const bool o1 = (c & 1) != 0, o2 = (c & 2) != 0;
    const int k0 = o1 ? acc[1] : acc[0], s0 = o1 ? acc[0] : acc[1], k1 = o1 ? acc[3] : acc[2], s1 = o1 ? acc[2] : acc[3];
    const int b0 = k0 + __builtin_amdgcn_update_dpp(0, s0, 0xB1, 0xf, 0xf, false);
    const int b1 = k1 + __builtin_amdgcn_update_dpp(0, s1, 0xB1, 0xf, 0xf, false);
    const int k2 = o2 ? b1 : b0, s2 = o2 ? b0 : b1;
    int d = k2 + __builtin_amdgcn_update_dpp(0, s2, 0x4E, 0xf, 0xf, false);
    d += __builtin_amdgcn_update_dpp(0, d, 0x124, 0xf, 0xf, false);
    d += __builtin_amdgcn_update_dpp(0, d, 0x128, 0xf, 0xf, false);
    res = ((c >> 2) == (bt & 3)) ? d : res;
}
__device__ __forceinline__ void b5_epilogue(const B5Blk& k, int res, const LAS float* gts, const LAS float* shs, unsigned* PK, int tok0) {
    const unsigned eslot = k.em >> 28, ek = (k.em >> 16) & 0xffu;
    if (eslot < 4u) {
        const float dot = ((float)res + shs[4 + eslot]) * k.scl * shs[eslot];
        ((unsigned short*)(PK + ((size_t)tok0 + eslot) * 128 + ek))[1] = (unsigned short)(pk2(0.f, gelu_erf(dot) * gts[eslot * 128 + ek] * k.svl) >> 16);
    }
}
struct B5Pre { v2u pk[4]; v2u h0[4]; float shv; };
__device__ __forceinline__ void b5_prefetch(B5Pre& p, const unsigned* PK, const unsigned char* H8, const float* SH, int tok0, int lane) {
#pragma unroll
    for (int s = 0; s < 4; ++s) { const size_t tok = (size_t)tok0 + s;
        p.pk[s] = *(const v2u*)(PK + tok * 128 + 2 * lane); p.h0[s] = *(const v2u*)(H8 + tok * 512 + 8 * lane); }
    p.shv = (lane & 4) ? SH[T + tok0 + (lane & 3)] : SH[tok0 + (lane & 3)];
}
__device__ __forceinline__ void p5b_dots(const Args& a, LAS unsigned char* lds, int bx, int G, int tid, int lane, int wave) {
    unsigned char* ws = a.ws;
    const unsigned char* H8 = ws + WS_R1; const unsigned char* U8 = ws + WS_UB; const float* SU = (const float*)(ws + WS_SU); const float* SV = (const float*)(ws + WS_SV); const float* SH = (const float*)(ws + WS_SH);
    unsigned* PK = (unsigned*)(ws + WS_PK);
    LAS unsigned char* hreg = lds + LB_H + wave * 4096; LAS unsigned* list = (LAS unsigned*)(lds + LB_LIST + wave * 2304); LAS float* gts = (LAS float*)(lds + LB_GATE + wave * 2048); LAS float* shs = (LAS float*)(lds + LB_SH + wave * 32);
    const int jmine = ((lane >> 5) & 1) * 8 + ((lane >> 4) & 1) * 4 + ((lane >> 3) & 1) * 2 + ((lane >> 2) & 1);
    const unsigned long long ltmask = (1ull << lane) - 1ull;
    for (int vb = bx; vb < 256; vb += G) {
        const unsigned vx = (unsigned)(vb & 3); const int wi = vb >> 3;
        const int tw0 = ((vb >> 2) & 1) * (T / 2) + wi * 512 + wave * 64;
        B5Pre P;
        b5_prefetch(P, PK, H8, SH, tw0, lane);
        __syncthreads();
        for (int i = tid; i < 4096 * 8 / 16; i += NTHR) *(LAS v4u*)(lds + LB_STEP + i * 16) = *(const v4u*)((const unsigned char*)SU + (size_t)vx * (4096 * 8) + (size_t)i * 16);
        __syncthreads();
#pragma unroll 1
        for (int ch = 0; ch < 16; ++ch) {
            const int tok0 = tw0 + 4 * ch;
            int n = 0;
            if (lane < 8) shs[lane] = P.shv;
#pragma unroll
            for (int s = 0; s < 4; ++s) {
                *(LAS v2u*)(hreg + s * 512 + lane * 8) = P.h0[s];
                *(LAS f32x2*)(gts + s * 128 + 2 * lane) = (f32x2){bf_hi(P.pk[s].x), bf_hi(P.pk[s].y)};
                const unsigned id0 = P.pk[s].x & 0xffffu, id1 = P.pk[s].y & 0xffffu;
                const bool in0 = (id0 >> 12) == vx, in1 = (id1 >> 12) == vx;
                const unsigned long long m0 = __ballot(in0), m1 = __ballot(in1);
                const int c0 = __popcll(m0), c1 = __popcll(m1);
                if (in0) list[n + __popcll(m0 & ltmask)] = ((unsigned)s << 28) | ((unsigned)(2 * lane) << 16) | id0;
                if (in1) list[n + c0 + __popcll(m1 & ltmask)] = ((unsigned)s << 28) | ((unsigned)(2 * lane + 1) << 16) | id1;
                n += c0 + c1;
            }
            const int nb = (n + 15) >> 4;
            list[n + lane] = (0xfu << 28) | (vx << 12);
            if (ch + 1 < 16) b5_prefetch(P, PK, H8, SH, tok0 + 4, lane);
            asm volatile("" ::: "memory");
            B5Batch A, B; B5Blk K; int res = 0;
            if (nb > 0) b5_issue(A, list, 0, U8, lane);
#pragma unroll 1
            for (int bt = 0; bt < nb; bt += 2) {
                if (bt + 1 < nb) b5_issue(B, list, bt + 1, U8, lane);
                if ((bt & 3) == 0) b5_blk_issue(K, list, bt >> 2, lds + LB_STEP, lane);
                b5_compute(A, list, bt, hreg, lane, res);
                if (bt + 1 < nb) {
                    if (bt + 2 < nb) b5_issue(A, list, bt + 2, U8, lane);
                    b5_compute(B, list, bt + 1, hreg, lane, res);
                    if ((bt & 3) == 2) b5_epilogue(K, res, gts, shs, PK, tok0);
                }
            }
            if ((nb & 3) != 0) b5_epilogue(K, res, gts, shs, PK, tok0);
        }
    }
}

constexpr int LC_BUF = 0, LC_SB = 640, LC_TILE = NWAVES * 2 * LC_SB, LC_ROW = 144, LC_END = LC_TILE + NWAVES * 128 * LC_ROW;
static_assert(LC_END <= MISC_OFF, "p5c LDS");
struct C5Tok { v4u vv[16]; v2u xa; float sa; };
__device__ __forceinline__ void c5_stage(C5Tok& t, LAS unsigned char* buf, v2u pk, int lane) {
    const f32x2 av = {bf_hi(pk.x), bf_hi(pk.y)};
    const float am = wave_max_dpp(fmaxf(fabsf(av[0]), fabsf(av[1])));
    const float inv = am > 0.f ? 119.0f * __builtin_amdgcn_rcpf(am) : 0.f;
    const int q0 = __float2int_rn(av[0] * inv), q1 = __float2int_rn(av[1] * inv);
    const int k0 = 2 * lane, k1 = 2 * lane + 1;
    *(LAS unsigned*)(buf + ((k0 & 7) * 16 + (k0 >> 3)) * 4) = (pk.x & 0xffffu) << 7;
    *(LAS unsigned*)(buf + ((k1 & 7) * 16 + (k1 >> 3)) * 4) = (pk.y & 0xffffu) << 7;
    const unsigned b0 = (unsigned)(q0 + 8), b1 = (unsigned)(q1 + 8);
    *(LAS unsigned char*)(buf + 512 + (lane >> 3) * 16 + (lane & 7)) = (unsigned char)(((b0 >> 4) & 15u) | (((b1 >> 4) & 15u) << 4));
    *(LAS unsigned char*)(buf + 512 + (lane >> 3) * 16 + 8 + (lane & 7)) = (unsigned char)(((b0 & 15u) ^ 8u) | (((b1 & 15u) ^ 8u) << 4));
    t.sa = am * (1.0f / 119.0f);
}
__device__ __forceinline__ void c5_issue(C5Tok& t, LAS unsigned char* buf, const unsigned char* vbase, unsigned coff, const bf16* xr, int g) {
#pragma unroll
    for (int jj = 0; jj < 4; ++jj) {
        const v4u iv = *(const LAS v4u*)(buf + g * 64 + 16 * jj);
#pragma unroll
        for (int u = 0; u < 4; ++u) t.vv[4 * jj + u] = *(const v4u*)(vbase + (iv[u] | coff));
    }
    t.xa = *(const v2u*)xr;
}
__device__ __forceinline__ void c5_finish(const C5Tok& t, LAS unsigned char* buf, LAS unsigned char* tile, bf16* xb, float* rss, int lane, int g, int c) {
    LAS unsigned char* wp = tile + g * LC_ROW + 16 * c;
    const LAS unsigned char* rp = tile + (lane & 15) * LC_ROW + 8 * (lane >> 4);
    int yh[4] = {0, 0, 0, 0}, yl[4] = {0, 0, 0, 0};
    v4u av[8];
#pragma unroll
    for (int rb = 0; rb < 8; ++rb) av[rb] = *(const LAS v4u*)(buf + 512 + 16 * rb);
#pragma unroll
    for (int rb = 0; rb < 8; ++rb) {
        *(LAS v4u*)(wp + (2 * rb) * 8 * LC_ROW) = t.vv[2 * rb]; *(LAS v4u*)(wp + (2 * rb + 1) * 8 * LC_ROW) = t.vv[2 * rb + 1];
#pragma unroll
        for (int m = 0; m < 4; ++m) {
            const v2i tv = __builtin_amdgcn_ds_read_tr4_b64_v2i32((LAS v2i*)(rp + rb * 16 * LC_ROW + 32 * m));
            yh[m] = __builtin_amdgcn_sdot8(tv.x, (int)av[rb].x, yh[m], false); yl[m] = __builtin_amdgcn_sdot8(tv.x, (int)av[rb].z, yl[m], false);
            yh[m] = __builtin_amdgcn_sdot8(tv.y, (int)av[rb].y, yh[m], false); yl[m] = __builtin_amdgcn_sdot8(tv.y, (int)av[rb].w, yl[m], false);
        }
    }
    float o[4], sq = 0.f;
#pragma unroll
    for (int m = 0; m < 4; ++m) { const unsigned xw = (m < 2) ? t.xa.x : t.xa.y; o[m] = ((m & 1) ? bf_hi(xw) : bf_lo(xw)) + (float)(16 * yh[m] + yl[m]) * t.sa; sq += o[m] * o[m]; }
    const float ss = wave_sum_dpp(sq);
    *(v2u*)xb = (v2u){pk2(o[0], o[1]), pk2(o[2], o[3])};
    if (lane == 0) rss[0] = ss;
}
__device__ __forceinline__ void p5c_axpy(const Args& a, LAS unsigned char* lds, int bx, int G, int tid, int lane, int wave) {
    unsigned char* ws = a.ws;
    const unsigned char* V8 = ws + WS_VB; const unsigned* PK = (const unsigned*)(ws + WS_PK);
    const bf16* XB1 = (const bf16*)(ws + WS_R2); bf16* XB2 = (bf16*)(ws + WS_R1); float* RSS2 = (float*)(ws + WS_RSS2);
    const int g = lane >> 3, c = lane & 7;
    LAS unsigned char* buf0 = lds + LC_BUF + wave * (2 * LC_SB); LAS unsigned char* buf1 = buf0 + LC_SB; LAS unsigned char* tile = lds + LC_TILE + wave * (128 * LC_ROW);
    for (int vb = bx; vb < 256; vb += G) {
        const int vx = vb & 7, cs = vx & 3, wi = vb >> 3;
        const size_t tw0 = (size_t)(vx >> 2) * (T / 2) + (size_t)wi * 512 + wave * 64;
        const unsigned char* vbase = V8 + (size_t)cs * ((size_t)NEXP * 128); const unsigned coff = 16u * (unsigned)c;
        const bf16* xcol = XB1 + cs * 256 + 4 * lane; bf16* xbcol = XB2 + cs * 256 + 4 * lane;
        C5Tok A, B;
        v2u pk = *(const v2u*)(PK + tw0 * 128 + 2 * lane);
        c5_stage(A, buf0, pk, lane);
        pk = *(const v2u*)(PK + (tw0 + 1) * 128 + 2 * lane);
        asm volatile("" ::: "memory");
        c5_issue(A, buf0, vbase, coff, xcol + tw0 * D, g);
#pragma unroll 1
        for (int i = 0; i < 64; i += 2) {
            const size_t tok = tw0 + i;
            c5_stage(B, buf1, pk, lane);
            if (i + 2 < 64) pk = *(const v2u*)(PK + (tok + 2) * 128 + 2 * lane);
            asm volatile("" ::: "memory");
            c5_issue(B, buf1, vbase, coff, xcol + (tok + 1) * D, g);
            c5_finish(A, buf0, tile, xbcol + tok * D, RSS2 + tok * 8 + cs, lane, g, c);
            if (i + 2 < 64) {
                c5_stage(A, buf0, pk, lane);
                if (i + 3 < 64) pk = *(const v2u*)(PK + (tok + 3) * 128 + 2 * lane);
                asm volatile("" ::: "memory");
                c5_issue(A, buf0, vbase, coff, xcol + (tok + 2) * D, g);
            }
            c5_finish(B, buf1, tile, xbcol + (tok + 1) * D, RSS2 + (tok + 1) * 8 + cs, lane, g, c);
        }
    }
}

__global__ void __launch_bounds__(NTHR, 2) mk_fwd(Args a) {
    extern __shared__ __attribute__((aligned(16))) unsigned char lds_raw[];
    LAS unsigned char* lds = (LAS unsigned char*)lds_raw;
    const int tid = threadIdx.x, lane = tid & 63, wave = __builtin_amdgcn_readfirstlane(tid >> 6);
    const int G = gridDim.x, bx = blockIdx.x, vcu = (G % 8 == 0) ? (bx % 8) * (G / 8) + bx / 8 : bx;
    volatile LAS unsigned* MISC = (volatile LAS unsigned*)(lds + MISC_OFF);
    if (tid < 64) MISC[tid] = 0u;
    __syncthreads();
    unsigned char* ws = a.ws;
    const int lo = a.ph_lo, hi = a.ph_hi;
    XcdBarrier bar; bar.bar = (unsigned*)(ws + WS_CTL) + CW_BAR + a.li * XCD_BAR_WORDS; bar.x = 0; bar.st = nullptr;
    if (hi - lo > 1) { bar = xcd_barrier_post((unsigned*)(ws + WS_CTL) + CW_BAR + a.li * XCD_BAR_WORDS, MISC + 8);
        if (tid == 0) (void)__hip_atomic_fetch_or(&bar.bar[XB_CENSUS + (bx & 7)], 1u << bar.x, __ATOMIC_RELAXED, __HIP_MEMORY_SCOPE_AGENT); }
#define IN(k) (lo <= (k) && (k) < hi)
#define BOTH(k) (IN(k) && IN((k) + 1))
    if (IN(0)) { p0_prologue(a, lds, vcu, G, tid, lane, wave); if (BOTH(0)) xcd_barrier_work(bar, a, lds, 0, vcu, G, wave, lane); }
    bool xloc = false;
    if (hi - lo > 1 && lo == 0 && G == 256) {
        if (tid == 0) { unsigned all = 0u; bool one = true;
            for (int v = 0; v < 8; ++v) { const unsigned m = xb_ld(&bar.bar[XB_CENSUS + v]); one = one && (__builtin_popcount(m) == 1); all |= m; }
            MISC[10] = (one && __builtin_popcount(all) == 8 && bar.st[0] == 32u && bar.st[1] == 8u) ? 1u : 0u; }
        __syncthreads();
        xloc = MISC[10] != 0u;
    }
    if (IN(1)) {
        { pg8::Gemm g{(const bf16*)(ws + WS_XB0), (const bf16*)(ws + WS_WIN), T, NIN, D}; pg8::StaticOrder S; S.init(T, NIN, G, bx);
          EpiStoreBf16 E{(bf16*)(ws + WS_R2), NIN, (const float*)(ws + WS_RSTD0)};
          pg8::gemm_phase<EpiStoreBf16, pg8::StaticOrder, true, true>(lds, g, S, E); }
        { pg8::Gemm g{(const bf16*)(ws + WS_PB), (const bf16*)(ws + WS_WP), T / 2, D, PLE}; pg8::StaticOrder S; S.init(T / 2, D, G, bx);
          EpiStoreBf16 E{(bf16*)(ws + WS_PP), D, nullptr};
          pg8::gemm_phase<EpiStoreBf16, pg8::StaticOrder, true, true>(lds, g, S, E); }
        { pg8::Gemm g{(const bf16*)(ws + WS_PB) + (size_t)(T / 2) * PLE, (const bf16*)(ws + WS_WP), T / 2, D, PLE}; pg8::StaticOrder S;
          if (G == 256) S.init(T / 2, D, 128, bx >= 128 ? bx - 128 : (1 << 28)); else S.init(T / 2, D, G, bx);
          EpiStoreBf16 E{(bf16*)(ws + WS_PP) + (size_t)(T / 2) * D, D, nullptr};
          pg8::gemm_phase<EpiStoreBf16, pg8::StaticOrder, true, true>(lds, g, S, E); }
        if (BOTH(1)) xcd_barrier_work(bar, a, lds, 1, vcu, G, wave, lane);
    }
    if (IN(2)) { p2_mixing(a, lds, bx, G, tid, lane, wave); if (BOTH(2)) xcd_barrier_work(bar, a, lds, 2, vcu, G, wave, lane); }
    if (IN(3)) {
        pg8::Gemm g{(const bf16*)(ws + WS_R1), (const bf16*)(ws + WS_WOUT), T, D, D}; pg8::StaticOrder S; S.init(T, D, G, bx);
        EpiResid E{(const bf16*)(ws + WS_XB0), (bf16*)(ws + WS_R2)};
        pg8::gemm_phase<EpiResid, pg8::StaticOrder, true, true>(lds, g, S, E);
        if (BOTH(3)) xcd_barrier_work(bar, a, lds, 3, vcu, G, wave, lane, xloc);
    }
    if (IN(4)) {
        pg8::Gemm g{(const bf16*)(ws + WS_R2), (const bf16*)(ws + WS_WQ), T, NQ, D}; pg8::StaticOrder S; S.init(T, NQ, G, bx);
        EpiStoreBf16 E{(bf16*)(ws + WS_R2 + 64 * MB), NQ, nullptr};
        pg8::gemm_phase<EpiStoreBf16, pg8::StaticOrder, true, true>(lds, g, S, E);
        if (BOTH(4)) xcd_barrier_work(bar, a, lds, 4, vcu, G, wave, lane, xloc);
    }
    if (IN(5)) {
        if (G == 256) p5a_topk(a, lds, (bx & 7) * 128 + (bx >> 3), 32, tid, lane, wave PT_ARG);
        else p5a_topk(a, lds, vcu, G, tid, lane, wave PT_ARG);
        xcd_barrier(bar);
        p5b_dots(a, lds, bx, G, tid, lane, wave); xcd_barrier(bar);
        p5c_axpy(a, lds, bx, G, tid, lane, wave);
        if (BOTH(5)) xcd_barrier(bar);
    }
    if (IN(6)) {
        pg8::Gemm g{(const bf16*)(ws + WS_R1), (const bf16*)(ws + WS_WG), T, D, D}; pg8::StaticOrder S; S.init(T, D, G, bx);
        EpiGate E{a.out, (const bf16*)(ws + WS_R1), (const bf16*)(ws + WS_PP), (const float*)(ws + WS_RSS2)};
        pg8::gemm_phase<EpiGate, pg8::StaticOrder, true, true>(lds, g, S, E);
    }
#undef IN
#undef BOTH
}
}
extern "C" void kernel_launch(void* const* d_in, const int* in_sizes, int n_in, void* d_out, int out_size, void* d_ws, size_t ws_size, hipStream_t stream) {
    using namespace mk;
    static int grid = 0;
    if (grid == 0) {
        int dev = 0, cus = 0;
        if (n_in != 16 || out_size != T * D || ws_size < WS_END) { fprintf(stderr, "kernel_launch: unexpected problem shape / workspace (%d inputs, out %d, ws %zu)\n", n_in, out_size, ws_size); grid = -1; return; }
        if (hipGetDevice(&dev) != hipSuccess || hipDeviceGetAttribute(&cus, hipDeviceAttributeMultiprocessorCount, dev) != hipSuccess) { fprintf(stderr, "device query failed\n"); grid = -1; return; }
        if (hipFuncSetAttribute((const void*)mk_fwd, hipFuncAttributeMaxDynamicSharedMemorySize, LDS_BYTES) != hipSuccess) { fprintf(stderr, "hipFuncSetAttribute failed\n"); grid = -1; return; }
        int per_cu = 0;
        if (hipOccupancyMaxActiveBlocksPerMultiprocessor(&per_cu, (const void*)mk_fwd, NTHR, LDS_BYTES) != hipSuccess || per_cu < 1) { fprintf(stderr, "occupancy query: %d blocks per CU\n", per_cu); (void)hipGetLastError(); }
        if (cus < 256) { fprintf(stderr, "kernel_launch: this kernel is laid out for a 256-CU device (found %d CUs)\n", cus); grid = -1; return; }
        grid = 256;
    }
    if (grid < 0) return;
    unsigned char* ws = (unsigned char*)d_ws;
    (void)hipMemsetAsync(ws + WS_CTL, 0, CTL_BYTES, stream);
    Args a{};
    for (int i = 0; i < 16; ++i) a.in[i] = (const float*)d_in[i];
    a.out = (float*)d_out; a.ws = ws; a.ph_lo = 0; a.ph_hi = 7; a.li = 0; a.pad = 0;
    hipLaunchKernelGGL(mk_fwd, dim3(grid), dim3(NTHR), LDS_BYTES, stream, a);
}
```
